# Optimizing an MI355X kernel written in HIP

```python
import jax, jax.numpy as jnp
from jax import lax
import numpy as np

D_MODEL = 1024
BATCH = 2
SEQ = 8192
DEPTH = 1

CHUNK = 64
N_META = 16
EPS = 1e-6
ATT_HEADS = 8
ATT_KV_HEADS = 2
ATT_HEAD_DIM = 64
WINDOW = 128
WINDOW_CHUNKS = WINDOW // CHUNK
GLA_HEADS = 4
GLA_DK = 64
GLA_DV = 128
GLA_GATE_RANK = 16
GLA_GATE_TEMP = 16.0
D_FF = 2816

ATT_Q = ATT_HEADS * ATT_HEAD_DIM
ATT_KV = ATT_KV_HEADS * ATT_HEAD_DIM
GLA_QK = GLA_HEADS * GLA_DK
GLA_V = GLA_HEADS * GLA_DV
SPLITS = (ATT_Q, ATT_KV, ATT_KV, GLA_QK, GLA_QK, GLA_V, GLA_V, GLA_GATE_RANK, D_MODEL, D_MODEL)
D_IN = ATT_Q + 2 * ATT_KV + 2 * GLA_QK + 2 * GLA_V + GLA_GATE_RANK + 2 * D_MODEL

kernel_name = "hybrid_swa_sink_alibi_gla_macaron_meta"


def rmsnorm(x, g):
    xf = x.astype(jnp.float32)
    y = xf * lax.rsqrt(jnp.mean(xf * xf, axis=-1, keepdims=True) + EPS)
    return (y * g.astype(jnp.float32)).astype(x.dtype)


def swiglu(x, w_gate, w_up, w_down):
    return (jax.nn.silu(x @ w_gate) * (x @ w_up)) @ w_down


def window_sink_attention(q, k, v, sinks):
    B, L = q.shape[0], q.shape[1]
    n_frames = L - N_META
    nc = n_frames // CHUNK
    G = ATT_HEADS // ATT_KV_HEADS
    NB = (WINDOW_CHUNKS + 1) * CHUNK
    pad = WINDOW_CHUNKS * CHUNK
    scale = ATT_HEAD_DIM ** -0.5
    slopes = jnp.exp2(-8.0 * jnp.arange(1, ATT_HEADS + 1, dtype=jnp.float32) / ATT_HEADS).reshape(ATT_KV_HEADS, G)
    sink = sinks.astype(jnp.float32).reshape(ATT_KV_HEADS, G)

    qm = q[:, :N_META].reshape(B, N_META, ATT_KV_HEADS, G, ATT_HEAD_DIM)
    qf = q[:, N_META:].reshape(B, nc, CHUNK, ATT_KV_HEADS, G, ATT_HEAD_DIM)
    km, kf = k[:, :N_META], k[:, N_META:]
    vm, vf = v[:, :N_META], v[:, N_META:]

    def band(t):
        tp = jnp.pad(t, ((0, 0), (pad, 0), (0, 0), (0, 0)))
        tp = tp.reshape(B, nc + WINDOW_CHUNKS, CHUNK, ATT_KV_HEADS, ATT_HEAD_DIM)
        return jnp.concatenate([tp[:, j:j + nc] for j in range(WINDOW_CHUNKS + 1)], axis=2)

    kb, vb = band(kf), band(vf)
    qi = jnp.arange(nc)[:, None] * CHUNK + jnp.arange(CHUNK)[None, :]
    ki = jnp.arange(nc)[:, None] * CHUNK - pad + jnp.arange(NB)[None, :]
    dist = jnp.abs(qi[:, :, None] - ki[:, None, :]).astype(jnp.float32)
    valid = (ki >= 0)[:, None, :]

    s_band = jnp.einsum('bcqkgd,bcskd->bkgcqs', qf, kb).astype(jnp.float32) * scale
    s_band = s_band - slopes[None, :, :, None, None, None] * dist[None, None, None]
    s_band = jnp.where(valid, s_band, -jnp.inf)
    s_meta = jnp.einsum('bcqkgd,bmkd->bkgcqm', qf, km).astype(jnp.float32) * scale
    s_sink = jnp.broadcast_to(sink[None, :, :, None, None, None], (B, ATT_KV_HEADS, G, nc, CHUNK, 1))
    p = jax.nn.softmax(jnp.concatenate([s_meta, s_band, s_sink], axis=-1), axis=-1).astype(v.dtype)
    of = (jnp.einsum('bkgcqm,bmkd->bcqkgd', p[..., :N_META], vm)
          + jnp.einsum('bkgcqs,bcskd->bcqkgd', p[..., N_META:N_META + NB], vb))
    of = of.reshape(B, n_frames, ATT_Q)

    sm = jnp.einsum('bqkgd,bmkd->bkgqm', qm, km).astype(jnp.float32) * scale
    sm_sink = jnp.broadcast_to(sink[None, :, :, None, None], (B, ATT_KV_HEADS, G, N_META, 1))
    pm = jax.nn.softmax(jnp.concatenate([sm, sm_sink], axis=-1), axis=-1).astype(v.dtype)
    om = jnp.einsum('bkgqm,bmkd->bqkgd', pm[..., :N_META], vm).reshape(B, N_META, ATT_Q)
    return jnp.concatenate([om, of], axis=1)


def gated_linear_attention(q, k, v, log_a):
    B, L = q.shape[0], q.shape[1]
    lead = (-L) % CHUNK
    nc = (L + lead) // CHUNK

    def chunked(t):
        t = jnp.pad(t.astype(jnp.float32), ((0, 0), (lead, 0), (0, 0), (0, 0)))
        return t.reshape(B, nc, CHUNK, t.shape[2], t.shape[3]).transpose(0, 3, 1, 2, 4)

    qc = chunked(q) * (GLA_DK ** -0.5)
    kc, vc, gc = chunked(k), chunked(v), chunked(log_a)
    b = jnp.cumsum(gc, axis=3)
    qe = qc * jnp.exp(b)
    ke = kc * jnp.exp(-b)
    causal = jnp.tril(jnp.ones((CHUNK, CHUNK), dtype=bool))
    att = jnp.where(causal, jnp.einsum('bhcid,bhcjd->bhcij', qe, ke), 0.0)
    o_intra = jnp.einsum('bhcij,bhcjv->bhciv', att, vc)

    b_last = b[:, :, :, -1:]
    chunk_kv = jnp.einsum('bhcjd,bhcjv->bhcdv', kc * jnp.exp(b_last - b), vc)
    decay = jnp.exp(b_last[:, :, :, 0])

    def step(S, inp):
        dec, kv = inp
        return dec[..., None] * S + kv, S

    S0 = jnp.zeros((B, q.shape[2], GLA_DK, GLA_DV), jnp.float32)
    _, S_start = lax.scan(step, S0, (jnp.moveaxis(decay, 2, 0), jnp.moveaxis(chunk_kv, 2, 0)))
    S_start = jnp.moveaxis(S_start, 0, 2)
    o_inter = jnp.einsum('bhcid,bhcdv->bhciv', qe, S_start)
    o = (o_intra + o_inter).transpose(0, 2, 3, 1, 4).reshape(B, nc * CHUNK, q.shape[2], GLA_DV)
    return o[:, lead:]


def setup_inputs(seed: int = 0) -> dict:
    key = jax.random.key(seed)
    ks = jax.random.split(key, 24)
    f32 = jnp.float32

    def nrm(k, shape, scale):
        return jax.random.normal(k, shape, f32) * scale

    def gain(k, shape):
        return 1.0 + 0.02 * jax.random.normal(k, shape, f32)

    return {
        "x": nrm(ks[0], (BATCH, SEQ, D_MODEL), 1.0),
        "meta_tokens": nrm(ks[1], (N_META, D_MODEL), 1.0),
        "ffn1_norm": gain(ks[2], (DEPTH, D_MODEL)),
        "ffn1_w_gate": nrm(ks[3], (DEPTH, D_MODEL, D_FF), D_MODEL ** -0.5),
        "ffn1_w_up": nrm(ks[4], (DEPTH, D_MODEL, D_FF), D_MODEL ** -0.5),
        "ffn1_w_down": nrm(ks[5], (DEPTH, D_FF, D_MODEL), D_FF ** -0.5),
        "mix_norm": gain(ks[6], (DEPTH, D_MODEL)),
        "w_in": nrm(ks[7], (DEPTH, D_MODEL, D_IN), D_MODEL ** -0.5),
        "gla_gate_w": nrm(ks[8], (DEPTH, GLA_GATE_RANK, GLA_QK), GLA_GATE_RANK ** -0.5),
        "gla_gate_b": nrm(ks[9], (DEPTH, GLA_QK), 0.1),
        "gla_out_norm": gain(ks[10], (DEPTH, GLA_DV)),
        "att_sinks": nrm(ks[11], (DEPTH, ATT_HEADS), 1.0),
        "w_branch_att": nrm(ks[12], (DEPTH, ATT_Q, D_MODEL), ATT_Q ** -0.5),
        "w_branch_gla": nrm(ks[13], (DEPTH, GLA_V, D_MODEL), GLA_V ** -0.5),
        "w_out": nrm(ks[14], (DEPTH, D_MODEL, D_MODEL), D_MODEL ** -0.5),
        "ffn2_norm": gain(ks[15], (DEPTH, D_MODEL)),
        "ffn2_w_gate": nrm(ks[16], (DEPTH, D_MODEL, D_FF), D_MODEL ** -0.5),
        "ffn2_w_up": nrm(ks[17], (DEPTH, D_MODEL, D_FF), D_MODEL ** -0.5),
        "ffn2_w_down": nrm(ks[18], (DEPTH, D_FF, D_MODEL), D_FF ** -0.5),
        "final_norm": gain(ks[19], (D_MODEL,)),
    }


def reference(x, meta_tokens, ffn1_norm, ffn1_w_gate, ffn1_w_up, ffn1_w_down, mix_norm, w_in,
              gla_gate_w, gla_gate_b, gla_out_norm, att_sinks, w_branch_att, w_branch_gla, w_out,
              ffn2_norm, ffn2_w_gate, ffn2_w_up, ffn2_w_down, final_norm):
    B = x.shape[0]
    meta = jnp.broadcast_to(meta_tokens[None].astype(x.dtype), (B, N_META, D_MODEL))
    h = jnp.concatenate([meta, x], axis=1)
    L = h.shape[1]
    offsets = np.cumsum(SPLITS)[:-1]
    for l in range(DEPTH):
        h = h + 0.5 * swiglu(rmsnorm(h, ffn1_norm[l]), ffn1_w_gate[l], ffn1_w_up[l], ffn1_w_down[l])

        u = rmsnorm(h, mix_norm[l])
        (aq, ak, av, gq, gk, gv, gr, g_low, gate_a, gate_b) = jnp.split(u @ w_in[l], offsets, axis=-1)

        ya = window_sink_attention(aq.reshape(B, L, ATT_HEADS, ATT_HEAD_DIM),
                                   ak.reshape(B, L, ATT_KV_HEADS, ATT_HEAD_DIM),
                                   av.reshape(B, L, ATT_KV_HEADS, ATT_HEAD_DIM),
                                   att_sinks[l])

        z = (g_low @ gla_gate_w[l] + gla_gate_b[l]).astype(jnp.float32)
        log_a = jax.nn.log_sigmoid(z) / GLA_GATE_TEMP
        og = gated_linear_attention(gq.reshape(B, L, GLA_HEADS, GLA_DK),
                                    gk.reshape(B, L, GLA_HEADS, GLA_DK),
                                    gv.reshape(B, L, GLA_HEADS, GLA_DV),
                                    log_a.reshape(B, L, GLA_HEADS, GLA_DK)).astype(x.dtype)
        og = rmsnorm(og, gla_out_norm[l]) * jax.nn.silu(gr.reshape(B, L, GLA_HEADS, GLA_DV))
        yb = og.reshape(B, L, GLA_V)

        mixed = (jax.nn.sigmoid(gate_a) * (ya @ w_branch_att[l])
                 + jax.nn.sigmoid(gate_b) * (yb @ w_branch_gla[l]))
        h = h + mixed @ w_out[l]

        h = h + 0.5 * swiglu(rmsnorm(h, ffn2_norm[l]), ffn2_w_gate[l], ffn2_w_up[l], ffn2_w_down[l])
    return rmsnorm(h, final_norm)[:, N_META:]
```

```cpp
#include <hip/hip_runtime.h>
#include <hip/hip_cooperative_groups.h>
#include <cstdio>
#include <cstdint>
namespace cg = cooperative_groups;
namespace pg8 {
#define PG8_LAS __attribute__((address_space(3)))
typedef unsigned short bf16_t;
typedef short bf16x8 __attribute__((ext_vector_type(8)));
typedef float f32x4 __attribute__((ext_vector_type(4)));
typedef unsigned u32x4 __attribute__((ext_vector_type(4)));
constexpr int BM = 256, BK = 64, HALF = 128, HTB = HALF * BK * 2  , STAGE_BYTES = 8 * HTB, NXCD = 8, WGM = 8;

__host__ __device__ __forceinline__ int lds_byte(int r, int c) { const int st = (r >> 4) * 2 + (c >> 5), rr = r & 15, cc = c & 31, ob = rr * 64 + cc * 2; return st * 1024 + (ob ^ (((ob >> 9) & 1) << 5)); }
__host__ __device__ __forceinline__ void stage_rc(int b, int& R, int& C) { const int st = b / 1024, sb = b % 1024, swz = sb ^ (((sb >> 9) & 1) << 5); R = (st >> 1) * 16 + swz / 64; C = (st & 1) * 32 + (swz % 64) / 2; }
__host__ __device__ __forceinline__ int perm32(int rho) { const int n = rho >> 4, i = rho & 15; return 8 * (i >> 2) + 4 * n + (i & 3); }

struct Unit { int pm, pn; };
struct Gemm { const bf16_t* A; const bf16_t* Bt; int M, N, K; };

struct StaticOrder {
    int nM, nN, nwg, G, c;
    __host__ __device__ void init(int M, int N, int G_, int c_) { nM = M / BM; nN = N / BM; nwg = nM * nN; G = G_; c = c_; }
    __host__ __device__ bool next(int i, Unit& u) const {
        const long L = (long)i * G + c; if (L >= nwg) return false;
        int wgid = (int)L; { const int q = nwg / NXCD, r = nwg % NXCD, xcd = wgid % NXCD, off = wgid / NXCD; wgid = (xcd < r ? xcd * (q + 1) : r * (q + 1) + (xcd - r) * q) + off; }
        const int nig = WGM * nN, gid = wgid / nig, fm = gid * WGM, gsz = (nM - fm) < WGM ? (nM - fm) : WGM;
        u.pm = fm + ((wgid % nig) % gsz); u.pn = (wgid % nig) / gsz; return true;
    }
    __device__ __forceinline__ void a_ready(const Unit&) const {}
    __device__ __forceinline__ void done(const Unit&) const {}
};

__device__ __forceinline__ unsigned cvt_pk_bf16(float lo, float hi) { unsigned r; asm volatile("v_cvt_pk_bf16_f32 %0, %1, %2" : "=v"(r) : "v"(lo), "v"(hi)); return r; }
typedef float f32x2 __attribute__((ext_vector_type(2)));
constexpr int XD = 1024, XFF = 2816, XPBW = 4352, XNFR = 16384;
__device__ __forceinline__ float row_rstd(const float* ssp, int row, int fq) {
    const f32x4 p = *(const f32x4*)(ssp + (size_t)row * 16 + 4 * fq);
    float s = (p[0] + p[1]) + (p[2] + p[3]);
    s += __shfl_xor(s, 16); s += __shfl_xor(s, 32);
    return __builtin_amdgcn_rsqf(s * (1.0f / 1024.0f) + 1e-6f);
}
__device__ __forceinline__ float sigm(float x) { return __builtin_amdgcn_rcpf(1.0f + __expf(-x)); }
__device__ __forceinline__ float bf2f(unsigned short b) { return __uint_as_float((unsigned)b << 16); }
__device__ __forceinline__ float bflo(unsigned w) { return __uint_as_float(w << 16); }
__device__ __forceinline__ float bfhi(unsigned w) { return __uint_as_float(w & 0xffff0000u); }

struct EpiSwiglu {
    static constexpr bool PERM = true, AFTER_DRAIN = false;
    bf16_t* O; const float* ssp;
    __device__ __forceinline__ void operator()(const f32x4 (&acc)[2][2][4][2], const Unit& u, int wr, int wc, int fr, int fq) const {
        const int row0 = u.pm * BM + wr * 64 + fr, col0 = u.pn * HALF + wc * 32 + 8 * fq;
#pragma unroll
        for (int ai = 0; ai < 2; ++ai)
#pragma unroll
            for (int m = 0; m < 4; ++m) {
                const int row = row0 + ai * HALF + m * 16; const float rs = row_rstd(ssp, row, fq);
                const f32x4 g0 = acc[ai][0][m][0] * rs, g1 = acc[ai][0][m][1] * rs, u0 = acc[ai][1][m][0] * rs, u1 = acc[ai][1][m][1] * rs;
                u32x4 w;
                w.x = cvt_pk_bf16(g0[0] * sigm(g0[0]) * u0[0], g0[1] * sigm(g0[1]) * u0[1]);
                w.y = cvt_pk_bf16(g0[2] * sigm(g0[2]) * u0[2], g0[3] * sigm(g0[3]) * u0[3]);
                w.z = cvt_pk_bf16(g1[0] * sigm(g1[0]) * u1[0], g1[1] * sigm(g1[1]) * u1[1]);
                w.w = cvt_pk_bf16(g1[2] * sigm(g1[2]) * u1[2], g1[3] * sigm(g1[3]) * u1[3]);
                *(u32x4*)(O + (size_t)row * XFF + col0) = w;
            }
    }
};

struct EpiResid {
    static constexpr bool PERM = false, AFTER_DRAIN = false;
    const float* base; const float* meta; float* out; bf16_t* hb; float* ssp; float scale;
    __device__ __forceinline__ void operator()(const f32x4 (&acc)[2][2][4][2], const Unit& u, int wr, int wc, int fr, int fq) const {
        typedef unsigned u32x2v __attribute__((ext_vector_type(2)));
        const int row0 = u.pm * BM + wr * 64 + fr, col0 = u.pn * BM + wc * 32 + 4 * fq;
#pragma unroll
        for (int ai = 0; ai < 2; ++ai)
#pragma unroll
            for (int m = 0; m < 4; ++m) {
                const int row = row0 + ai * HALF + m * 16;
                const bool fr_row = row < XNFR, has = row < XNFR + 16;
                const float* bp = fr_row ? base + (size_t)row * XD : meta + (size_t)(has ? row - XNFR : 0) * XD;
                float sq = 0.f;
#pragma unroll
                for (int bj = 0; bj < 2; ++bj)
#pragma unroll
                    for (int n = 0; n < 2; ++n) {
                        const int c = col0 + bj * HALF + n * 16;
                        f32x4 b = *(const f32x4*)(bp + c);
                        if (!has) b = (f32x4){0.f, 0.f, 0.f, 0.f};
                        const f32x4 v = b + acc[ai][bj][m][n] * scale;
                        sq += (v[0] * v[0] + v[1] * v[1]) + (v[2] * v[2] + v[3] * v[3]);
                        if (fr_row) *(f32x4*)(out + (size_t)row * XD + c) = v;
                        if (hb) { u32x2v w; w.x = cvt_pk_bf16(v[0], v[1]); w.y = cvt_pk_bf16(v[2], v[3]); *(u32x2v*)(hb + (size_t)row * XD + c) = w; }
                    }
                sq += __shfl_xor(sq, 16); sq += __shfl_xor(sq, 32);
                if (fq == 0) ssp[(size_t)row * 16 + u.pn * 4 + wc] = sq;
            }
    }
};

struct EpiIn {
    static constexpr bool PERM = true, AFTER_DRAIN = false;
    bf16_t* PB; float* glow; const float* ssp;
    __device__ __forceinline__ void operator()(const f32x4 (&acc)[2][2][4][2], const Unit& u, int wr, int wc, int fr, int fq) const {
        const int row0 = u.pm * BM + wr * 64 + fr, tile = u.pn;
        if (tile == 17) {
            if (wc == 0 && fq < 2) {
#pragma unroll
                for (int ai = 0; ai < 2; ++ai)
#pragma unroll
                    for (int m = 0; m < 4; ++m) {
                        const int row = row0 + ai * HALF + m * 16;
                        const f32x4 p = *(const f32x4*)(ssp + (size_t)row * 16), q = *(const f32x4*)(ssp + (size_t)row * 16 + 4), r = *(const f32x4*)(ssp + (size_t)row * 16 + 8), t = *(const f32x4*)(ssp + (size_t)row * 16 + 12);
                        const float s = (((p[0] + p[1]) + (p[2] + p[3])) + ((q[0] + q[1]) + (q[2] + q[3]))) + (((r[0] + r[1]) + (r[2] + r[3])) + ((t[0] + t[1]) + (t[2] + t[3])));
                        const float rs = __builtin_amdgcn_rsqf(s * (1.0f / 1024.0f) + 1e-6f);
                        *(f32x4*)(glow + (size_t)row * 16 + 8 * fq) = acc[ai][0][m][0] * rs;
                        *(f32x4*)(glow + (size_t)row * 16 + 8 * fq + 4) = acc[ai][0][m][1] * rs;
                    }
            }
            return;
        }
        const int mode = (tile <= 1 || tile == 3) ? 1 : (tile == 7 || tile == 8) ? 2 : (tile >= 9 ? 3 : 0);
        const int col0 = tile * BM + wc * 32 + 8 * fq;
#pragma unroll
        for (int ai = 0; ai < 2; ++ai)
#pragma unroll
            for (int m = 0; m < 4; ++m) {
                const int row = row0 + ai * HALF + m * 16; const float rs = row_rstd(ssp, row, fq);
#pragma unroll
                for (int bj = 0; bj < 2; ++bj) {
                    f32x4 v0 = acc[ai][bj][m][0] * rs, v1 = acc[ai][bj][m][1] * rs;
                    if (mode == 1) { v0 = v0 * 0.125f; v1 = v1 * 0.125f; }
                    else if (mode == 2) {
#pragma unroll
                        for (int j = 0; j < 4; ++j) { v0[j] = v0[j] * sigm(v0[j]); v1[j] = v1[j] * sigm(v1[j]); } }
                    else if (mode == 3) {
#pragma unroll
                        for (int j = 0; j < 4; ++j) { v0[j] = sigm(v0[j]); v1[j] = sigm(v1[j]); } }
                    u32x4 w; w.x = cvt_pk_bf16(v0[0], v0[1]); w.y = cvt_pk_bf16(v0[2], v0[3]); w.z = cvt_pk_bf16(v1[0], v1[1]); w.w = cvt_pk_bf16(v1[2], v1[3]);
                    *(u32x4*)(PB + (size_t)row * XPBW + col0 + bj * HALF) = w;
                }
            }
    }
};

template <bool ADD> struct EpiMix {
    static constexpr bool PERM = true, AFTER_DRAIN = false;
    const bf16_t* gate; bf16_t* mixed;
    __device__ __forceinline__ void operator()(const f32x4 (&acc)[2][2][4][2], const Unit& u, int wr, int wc, int fr, int fq) const {
        const int row0 = u.pm * BM + wr * 64 + fr, col0 = u.pn * BM + wc * 32 + 8 * fq;
#pragma unroll
        for (int ai = 0; ai < 2; ++ai)
#pragma unroll
            for (int m = 0; m < 4; ++m) {
                const int row = row0 + ai * HALF + m * 16;
#pragma unroll
                for (int bj = 0; bj < 2; ++bj) {
                    const int c = col0 + bj * HALF;
                    const u32x4 g = *(const u32x4*)(gate + (size_t)row * XPBW + c);
                    const f32x4 a0 = acc[ai][bj][m][0], a1 = acc[ai][bj][m][1];
                    float v[8] = {bflo(g.x) * a0[0], bfhi(g.x) * a0[1], bflo(g.y) * a0[2], bfhi(g.y) * a0[3], bflo(g.z) * a1[0], bfhi(g.z) * a1[1], bflo(g.w) * a1[2], bfhi(g.w) * a1[3]};
                    if (ADD) { const u32x4 o = *(const u32x4*)(mixed + (size_t)row * XD + c);
                        v[0] += bflo(o.x); v[1] += bfhi(o.x); v[2] += bflo(o.y); v[3] += bfhi(o.y); v[4] += bflo(o.z); v[5] += bfhi(o.z); v[6] += bflo(o.w); v[7] += bfhi(o.w); }
                    u32x4 w; w.x = cvt_pk_bf16(v[0], v[1]); w.y = cvt_pk_bf16(v[2], v[3]); w.z = cvt_pk_bf16(v[4], v[5]); w.w = cvt_pk_bf16(v[6], v[7]);
                    *(u32x4*)(mixed + (size_t)row * XD + c) = w;
                }
            }
    }
};

template <class Epi, class Sched, bool ALIGN_EPI = false, bool SP2 = false>
__device__ __forceinline__ void gemm_phase(PG8_LAS unsigned char* lds, const Gemm g, const Sched& S, const Epi& E) {
    const int tid = threadIdx.x, wid = __builtin_amdgcn_readfirstlane(tid >> 6), lane = tid & 63, wr = wid >> 2, wc = wid & 3, fr = lane & 15, fq = lane >> 4;
    const int K = g.K, nt = K / BK;
    unsigned voffA[2], voffB[2];
#pragma unroll
    for (int i = 0; i < 2; ++i) { int R, C; stage_rc(tid * 16 + i * 8192, R, C); const int Rb = Epi::PERM ? ((R & ~31) + perm32(R & 31)) : R;
        voffA[i] = (unsigned)(R * K + C) * 2u; voffB[i] = (unsigned)(Rb * K + C) * 2u; }
    const size_t kstep = (size_t)(BK * 2);
    const size_t hstep = (size_t)HALF * K * 2;
    const size_t tstep = 2 * hstep;
    const unsigned ldsw = (unsigned)wid * 1024u;
    const int aoff = lds_byte(wr * 64 + fr, fq * 8), boff = lds_byte(wc * 32 + fr, fq * 8);
#define PG8_SA(b, h) (((b) * 2 + (h)) * HTB)
#define PG8_SB(b, h) ((4 + (b) * 2 + (h)) * HTB)
#define PG8_STAGE(bufoff, gbase, voff) do { _Pragma("unroll") for (int _i = 0; _i < 2; ++_i) \
        __builtin_amdgcn_global_load_lds((const unsigned*)((const char*)(gbase) + (voff)[_i]), (PG8_LAS unsigned*)(lds + (bufoff) + ldsw + _i * 8192), 16, 0, 0); } while (0)
#define PG8_LDA(dst, b, h) do { _Pragma("unroll") for (int m = 0; m < 4; ++m) _Pragma("unroll") for (int k = 0; k < 2; ++k) dst[m][k] = *(const PG8_LAS bf16x8*)(lds + PG8_SA(b, h) + aoff + m * 2048 + k * 1024); } while (0)
#define PG8_LDB(dst, b, h) do { _Pragma("unroll") for (int n = 0; n < 2; ++n) _Pragma("unroll") for (int k = 0; k < 2; ++k) dst[n][k] = *(const PG8_LAS bf16x8*)(lds + PG8_SB(b, h) + boff + n * 2048 + k * 1024); } while (0)
#define PG8_MMA(ai, bj, At, Bt) do { __builtin_amdgcn_s_setprio(1); _Pragma("unroll") for (int m = 0; m < 4; ++m) _Pragma("unroll") for (int n = 0; n < 2; ++n) _Pragma("unroll") for (int k = 0; k < 2; ++k) \
        acc[ai][bj][m][n] = __builtin_amdgcn_mfma_f32_16x16x32_bf16(Bt[n][k], At[m][k], acc[ai][bj][m][n], 0, 0, 0); __builtin_amdgcn_s_setprio(0); } while (0)
#define PG8_WAIT_V(n) asm volatile("s_waitcnt vmcnt(" #n ")" ::: "memory")
#define PG8_WAIT_L(n) asm volatile("s_waitcnt lgkmcnt(" #n ")" ::: "memory")
#define PG8_BAR __builtin_amdgcn_s_barrier()
#define PG8_SCHED __builtin_amdgcn_sched_barrier(0)
    Unit cur, nxt; int ui = 0;
    if (!S.next(0, cur)) return;
    f32x4 acc[2][2][4][2];
#pragma unroll
    for (int a = 0; a < 2; ++a)
#pragma unroll
        for (int b = 0; b < 2; ++b)
#pragma unroll
            for (int m = 0; m < 4; ++m)
#pragma unroll
                for (int n = 0; n < 2; ++n) acc[a][b][m][n] = (f32x4){0.f, 0.f, 0.f, 0.f};
    bf16x8 At[4][2], B0[2][2], B1[2][2];
    const char* cA = (const char*)g.A + (size_t)cur.pm * tstep; const char* cB = (const char*)g.Bt + (size_t)cur.pn * tstep;
    S.a_ready(cur);
    if constexpr (SP2) {
        PG8_STAGE(PG8_SB(0, 0), cB, voffB); PG8_STAGE(PG8_SB(0, 1), cB + hstep, voffB); PG8_STAGE(PG8_SA(0, 0), cA, voffA); PG8_STAGE(PG8_SA(0, 1), cA + hstep, voffA);
        if (wr == 1) PG8_BAR;
        PG8_WAIT_V(2); PG8_BAR;
        PG8_STAGE(PG8_SB(1, 0), cB + kstep, voffB); PG8_STAGE(PG8_SA(1, 0), cA + kstep, voffA); PG8_STAGE(PG8_SB(1, 1), cB + hstep + kstep, voffB);
        PG8_WAIT_V(6); PG8_BAR;
    } else {
        PG8_STAGE(PG8_SB(0, 0), cB, voffB); PG8_STAGE(PG8_SA(0, 0), cA, voffA); PG8_STAGE(PG8_SB(0, 1), cB + hstep, voffB); PG8_STAGE(PG8_SA(0, 1), cA + hstep, voffA);
        if (wr == 1) PG8_BAR;
        PG8_WAIT_V(4); PG8_BAR;
        PG8_STAGE(PG8_SB(1, 0), cB + kstep, voffB); PG8_STAGE(PG8_SA(1, 0), cA + kstep, voffA); PG8_STAGE(PG8_SB(1, 1), cB + hstep + kstep, voffB);
        PG8_WAIT_V(6); PG8_BAR;
    }
    for (;;) {
        const bool has_next = S.next(ui + 1, nxt);
        const char* nA = has_next ? (const char*)g.A + (size_t)nxt.pm * tstep : cA; const char* nB = has_next ? (const char*)g.Bt + (size_t)nxt.pn * tstep : cB;
        for (int t = 0; t < nt; t += 2) {
            const bool last = (t == nt - 2);
            const char* a1 = cA + (size_t)(t + 1) * kstep;
            const char* a2 = last ? nA : cA + (size_t)(t + 2) * kstep; const char* b2 = last ? nB : cB + (size_t)(t + 2) * kstep;
            const char* a3 = a2 + kstep; const char* b3 = b2 + kstep;
            if (last && has_next) S.a_ready(nxt);
            if constexpr (SP2) {
            PG8_LDB(B0, 0, 0); PG8_LDB(B1, 0, 1); PG8_SCHED; PG8_LDA(At, 0, 0); PG8_STAGE(PG8_SA(1, 1), a1 + hstep, voffA);
            PG8_WAIT_V(8); PG8_WAIT_L(0); PG8_BAR; PG8_MMA(0, 0, At, B0); PG8_MMA(0, 1, At, B1); PG8_BAR; PG8_SCHED;
            PG8_LDA(At, 0, 1); PG8_STAGE(PG8_SB(0, 0), b2, voffB); PG8_STAGE(PG8_SB(0, 1), b2 + hstep, voffB); PG8_STAGE(PG8_SA(0, 0), a2, voffA);
            PG8_WAIT_V(8); PG8_WAIT_L(0); PG8_BAR; PG8_MMA(1, 0, At, B0); PG8_MMA(1, 1, At, B1); PG8_BAR; PG8_SCHED;
            PG8_LDB(B0, 1, 0); PG8_LDB(B1, 1, 1); PG8_SCHED; PG8_LDA(At, 1, 0); PG8_STAGE(PG8_SA(0, 1), a2 + hstep, voffA);
            PG8_WAIT_V(8); PG8_WAIT_L(0); PG8_BAR; PG8_MMA(0, 0, At, B0); PG8_MMA(0, 1, At, B1); PG8_BAR; PG8_SCHED;
            PG8_LDA(At, 1, 1); PG8_STAGE(PG8_SB(1, 0), b3, voffB); PG8_STAGE(PG8_SB(1, 1), b3 + hstep, voffB); PG8_STAGE(PG8_SA(1, 0), a3, voffA);
            PG8_WAIT_V(8); PG8_WAIT_L(0); PG8_BAR; PG8_MMA(1, 0, At, B0); PG8_MMA(1, 1, At, B1); PG8_BAR; PG8_SCHED;
            } else {
            PG8_LDB(B0, 0, 0); PG8_SCHED; PG8_LDA(At, 0, 0); PG8_STAGE(PG8_SA(1, 1), a1 + hstep, voffA);
            PG8_WAIT_L(8); PG8_BAR; PG8_WAIT_L(0); PG8_MMA(0, 0, At, B0); PG8_BAR; PG8_SCHED;
            PG8_LDB(B1, 0, 1); PG8_STAGE(PG8_SB(0, 0), b2, voffB);
            PG8_BAR; PG8_WAIT_L(0); PG8_MMA(0, 1, At, B1); PG8_BAR;
            PG8_LDA(At, 0, 1); PG8_STAGE(PG8_SA(0, 0), a2, voffA);
            PG8_BAR; PG8_WAIT_L(0); PG8_MMA(1, 0, At, B0); PG8_BAR; PG8_SCHED;
            PG8_STAGE(PG8_SB(0, 1), b2 + hstep, voffB);
            PG8_WAIT_V(6); PG8_BAR; PG8_MMA(1, 1, At, B1); PG8_BAR;
            PG8_LDB(B0, 1, 0); PG8_SCHED; PG8_LDA(At, 1, 0); PG8_STAGE(PG8_SA(0, 1), a2 + hstep, voffA);
            PG8_WAIT_L(8); PG8_BAR; PG8_WAIT_L(0); PG8_MMA(0, 0, At, B0); PG8_BAR; PG8_SCHED;
            PG8_LDB(B1, 1, 1); PG8_STAGE(PG8_SB(1, 0), b3, voffB);
            PG8_BAR; PG8_WAIT_L(0); PG8_MMA(0, 1, At, B1); PG8_BAR;
            PG8_LDA(At, 1, 1); PG8_STAGE(PG8_SA(1, 0), a3, voffA);
            PG8_BAR; PG8_WAIT_L(0); PG8_MMA(1, 0, At, B0); PG8_BAR; PG8_SCHED;
            PG8_STAGE(PG8_SB(1, 1), b3 + hstep, voffB);
            PG8_WAIT_V(6); PG8_BAR; PG8_MMA(1, 1, At, B1); PG8_BAR;
            }
        }
        if constexpr (ALIGN_EPI) { if (wr == 0) PG8_BAR; }
        if constexpr (!Epi::AFTER_DRAIN) { E(acc, cur, wr, wc, fr, fq); S.done(cur); }
        if (!has_next) break;
#pragma unroll
        for (int a = 0; a < 2; ++a)
#pragma unroll
            for (int b = 0; b < 2; ++b)
#pragma unroll
                for (int m = 0; m < 4; ++m)
#pragma unroll
                    for (int n = 0; n < 2; ++n) acc[a][b][m][n] = (f32x4){0.f, 0.f, 0.f, 0.f};
        cur = nxt; cA = nA; cB = nB; ++ui;
        if constexpr (ALIGN_EPI) { if (wr == 1) PG8_BAR; }
    }
    PG8_WAIT_V(0);
    if constexpr (!ALIGN_EPI) { if (wr == 0) PG8_BAR; }
    PG8_BAR;
    if constexpr (Epi::AFTER_DRAIN) { E.fused(acc, cur, wr, wc, fr, fq, lds, wid, lane); S.done(cur); }
#undef PG8_SA
#undef PG8_SB
#undef PG8_STAGE
#undef PG8_LDA
#undef PG8_LDB
#undef PG8_MMA
#undef PG8_WAIT_V
#undef PG8_WAIT_L
#undef PG8_BAR
#undef PG8_SCHED
}
}

#ifndef MK_PER_PHASE
#define MK_PER_PHASE 0
#endif
#define LAS __attribute__((address_space(3)))
typedef unsigned short bf16;
typedef short bf16x8 __attribute__((ext_vector_type(8)));
typedef short s16x4 __attribute__((ext_vector_type(4)));
typedef float f32x4 __attribute__((ext_vector_type(4)));
typedef float f32x16 __attribute__((ext_vector_type(16)));
typedef unsigned u32x4 __attribute__((ext_vector_type(4)));
typedef unsigned u32x2 __attribute__((ext_vector_type(2)));
typedef float f32x2m __attribute__((ext_vector_type(2)));
#define MFMA32(a, b, c) __builtin_amdgcn_mfma_f32_32x32x16_bf16((a), (b), (c), 0, 0, 0)
#define LDS_WAIT() asm volatile("s_waitcnt lgkmcnt(0)" ::: "memory")

constexpr int NFR = 16384, MT = 16640, D = 1024, FF = 2816, NGU = 5632, NIN = 4608, PBW = 4352, DIN = 4368;
constexpr int NPH = 12;
constexpr int LDS_BYTES = 147456;
constexpr size_t MiB = 1u << 20;
constexpr size_t WS_WGU1 = 0, WS_WD1 = 11 * MiB, WS_ST = 0  , WS_WGU2 = 17 * MiB, WS_WD2 = 28 * MiB, WS_WIN = 34 * MiB,
                 WS_WA = 43 * MiB, WS_WB = 44 * MiB, WS_WOUT = 45 * MiB, WS_SSP = 47 * MiB, WS_GLOW = 49 * MiB, WS_DEC = 51 * MiB,
                 WS_HB = 52 * MiB, WS_YA = 52 * MiB, WS_YB = 68 * MiB  , WS_R1 = 85 * MiB  ,
                 WS_KV = 223 * MiB + MiB / 2  , WS_END = 256 * MiB;
static_assert(WS_ST + (size_t)1032 * 8192 * 2 <= WS_WGU2 && WS_R1 + (size_t)MT * PBW * 2 <= WS_KV && WS_KV + (size_t)1032 * 8192 * 4 <= WS_END && WS_HB + (size_t)MT * D * 2 <= WS_R1, "d_ws map");

struct Params { const float* in[20]; float* out; unsigned char* ws; int ph_lo, ph_hi; };

__device__ __forceinline__ int crow(int reg, int h) { return (reg & 3) + 8 * (reg >> 2) + 4 * h; }
__device__ __forceinline__ unsigned f2bf(float f) { unsigned u = __float_as_uint(f); return (u + 0x7fffu + ((u >> 16) & 1u)) >> 16; }
__device__ __forceinline__ unsigned pk2(float lo, float hi) { return f2bf(lo) | (f2bf(hi) << 16); }
__device__ __forceinline__ float wave_sum(float v) {
#pragma unroll
    for (int o = 1; o < 64; o <<= 1) v += __shfl_xor(v, o);
    return v;
}
__device__ __forceinline__ bf16x8 pack8(float a, float b, float c, float d, float e, float f, float g, float h) {
    u32x4 p; p.x = pk2(a, b); p.y = pk2(c, d); p.z = pk2(e, f); p.w = pk2(g, h); return __builtin_bit_cast(bf16x8, p);
}

__device__ __forceinline__ void tr_item(const float* W, int K, int N, int k0, int sn0, int nvalid, const float* gain, bf16* WT, int drow0, LAS float* scr, int lane) {
    const int cl = lane & 31, kh = lane >> 5; const bool cv = cl < nvalid;
#pragma unroll 8
    for (int i = 0; i < 32; ++i) { const int kk = 2 * i + kh; float v = cv ? W[(size_t)(k0 + kk) * N + sn0 + cl] : 0.f; if (gain) v *= gain[k0 + kk]; scr[kk * 33 + cl] = v; }
    LDS_WAIT(); asm volatile("" ::: "memory");
    const int c = lane & 7;
#pragma unroll
    for (int j = 0; j < 4; ++j) { const int n = (lane >> 3) + 8 * j; const LAS float* s = scr + (8 * c) * 33 + n;
        u32x4 o; o.x = pk2(s[0 * 33], s[1 * 33]); o.y = pk2(s[2 * 33], s[3 * 33]); o.z = pk2(s[4 * 33], s[5 * 33]); o.w = pk2(s[6 * 33], s[7 * 33]);
        *(u32x4*)(WT + (size_t)(drow0 + n) * K + k0 + 8 * c) = o; }
    LDS_WAIT(); asm volatile("" ::: "memory");
}
__device__ __forceinline__ void p0_prep(const Params& P, LAS unsigned char* lds, int wave, int lane, int G) {
    unsigned char* ws = P.ws;
    LAS float* scr = (LAS float*)(lds + wave * 16384);
    const int gw = blockIdx.x * 8 + wave, NGW = G * 8;
    constexpr int I_GU = 16 * 88, I_DN = 44 * 32, I_IN = 16 * 144, I_BR = 8 * 32, I_WO = 16 * 32;
    constexpr int NITEMS = 4 * I_GU + 2 * I_DN + I_IN + 2 * I_BR + I_WO;
    for (int it = gw; it < NITEMS; it += NGW) {
        int r = it;
        if (r < 2 * I_GU + I_DN) {
            if (r < 2 * I_GU) { const int up = r >= I_GU; r -= up * I_GU; const int kb = r / 88, n0 = (r % 88) * 32;
                tr_item(up ? P.in[4] : P.in[3], D, FF, kb * 64, n0, 32, P.in[2], (bf16*)(ws + WS_WGU1), (n0 >> 7) * 256 + (n0 & 127) + up * 128, scr, lane); }
            else { r -= 2 * I_GU; tr_item(P.in[5], FF, D, (r / 32) * 64, (r % 32) * 32, 32, nullptr, (bf16*)(ws + WS_WD1), (r % 32) * 32, scr, lane); }
            continue; }
        r -= 2 * I_GU + I_DN;
        if (r < 2 * I_GU + I_DN) {
            if (r < 2 * I_GU) { const int up = r >= I_GU; r -= up * I_GU; const int kb = r / 88, n0 = (r % 88) * 32;
                tr_item(up ? P.in[17] : P.in[16], D, FF, kb * 64, n0, 32, P.in[15], (bf16*)(ws + WS_WGU2), (n0 >> 7) * 256 + (n0 & 127) + up * 128, scr, lane); }
            else { r -= 2 * I_GU; tr_item(P.in[18], FF, D, (r / 32) * 64, (r % 32) * 32, 32, nullptr, (bf16*)(ws + WS_WD2), (r % 32) * 32, scr, lane); }
            continue; }
        r -= 2 * I_GU + I_DN;
        if (r < I_IN) { const int kb = r / 144, d0 = (r % 144) * 32; int sn0, nv;
            if (d0 < 2304) { sn0 = d0; nv = 32; } else if (d0 < 4352) { sn0 = d0 + 16; nv = 32; } else if (d0 == 4352) { sn0 = 2304; nv = 16; } else { sn0 = 0; nv = 0; }
            tr_item(P.in[7], D, DIN, kb * 64, sn0, nv, P.in[6], (bf16*)(ws + WS_WIN), d0, scr, lane); continue; }
        r -= I_IN;
        if (r < I_BR) { tr_item(P.in[12], 512, D, (r / 32) * 64, (r % 32) * 32, 32, nullptr, (bf16*)(ws + WS_WA), (r % 32) * 32, scr, lane); continue; }
        r -= I_BR;
        if (r < I_BR) { tr_item(P.in[13], 512, D, (r / 32) * 64, (r % 32) * 32, 32, nullptr, (bf16*)(ws + WS_WB), (r % 32) * 32, scr, lane); continue; }
        r -= I_BR;
        tr_item(P.in[14], D, D, (r / 32) * 64, (r % 32) * 32, 32, nullptr, (bf16*)(ws + WS_WOUT), (r % 32) * 32, scr, lane);
    }
    bf16* hb = (bf16*)(ws + WS_HB); float* ssp = (float*)(ws + WS_SSP);
    for (int m = gw; m < MT; m += NGW) {
        const float* src = m < NFR ? P.in[0] + (size_t)m * D : (m < NFR + 16 ? P.in[1] + (size_t)(m - NFR) * D : nullptr);
        f32x4 v[4]; float s = 0.f;
#pragma unroll
        for (int j = 0; j < 4; ++j) { v[j] = src ? ((const f32x4*)src)[lane + 64 * j] : (f32x4){0.f, 0.f, 0.f, 0.f}; s += (v[j][0] * v[j][0] + v[j][1] * v[j][1]) + (v[j][2] * v[j][2] + v[j][3] * v[j][3]); }
        s = wave_sum(s);
        u32x2* o8 = (u32x2*)(hb + (size_t)m * D) + lane;
#pragma unroll
        for (int j = 0; j < 4; ++j) { u32x2 w; w.x = pk2(v[j][0], v[j][1]); w.y = pk2(v[j][2], v[j][3]); o8[64 * j] = w; }
        if (lane < 16) ssp[(size_t)m * 16 + lane] = lane == 0 ? s : 0.f;
    }
}

constexpr int A_KS = 0, A_VT = 32256, A_VTS = 228;
__device__ __forceinline__ void attn_item(const Params& P, LAS unsigned char* L, int item, int tid, int wave, int lane) {
    const bf16* PB = (const bf16*)(P.ws + WS_R1); bf16* ya = (bf16*)(P.ws + WS_YA);
    const int kvh = item & 1, c = (item >> 1) & 127, b = item >> 8;
#pragma unroll
    for (int i = 0; i < 4; ++i) {
        const int key = (tid & 63) + 64 * i;
        if (key < 224) {
            bool valid; int row;
            if (key < 16) { valid = true; row = NFR + key; }
            else if (key < 32) { valid = false; row = 0; }
            else { const int ki = c * 64 - 128 + (key - 32); valid = ki >= 0; row = b * 8192 + (valid ? ki : 0); }
            u32x4 kk = (u32x4){0u, 0u, 0u, 0u}, vv = (u32x4){0u, 0u, 0u, 0u};
            if (valid) { const bf16* p = PB + (size_t)row * PBW + 512 + kvh * 64 + wave * 8; kk = *(const u32x4*)p; vv = *(const u32x4*)(p + 128); }
            *(LAS u32x4*)(L + A_KS + key * 144 + wave * 16) = kk;
            LAS unsigned short* vt = (LAS unsigned short*)(L + A_VT) + (wave * 8) * A_VTS + key;
            vt[0 * A_VTS] = (unsigned short)(vv.x & 0xffffu); vt[1 * A_VTS] = (unsigned short)(vv.x >> 16);
            vt[2 * A_VTS] = (unsigned short)(vv.y & 0xffffu); vt[3 * A_VTS] = (unsigned short)(vv.y >> 16);
            vt[4 * A_VTS] = (unsigned short)(vv.z & 0xffffu); vt[5 * A_VTS] = (unsigned short)(vv.z >> 16);
            vt[6 * A_VTS] = (unsigned short)(vv.w & 0xffffu); vt[7 * A_VTS] = (unsigned short)(vv.w >> 16);
        }
    }
    __syncthreads();
    const int g = wave >> 1, pos0 = (wave & 1) * 32, h = kvh * 4 + g, r = lane & 31, hi = lane >> 5;
    const int qrow = b * 8192 + c * 64 + pos0 + r;
    bf16x8 q[4];
#pragma unroll
    for (int s = 0; s < 4; ++s) q[s] = *(const bf16x8*)(PB + (size_t)qrow * PBW + h * 64 + 16 * s + 8 * hi);
    f32x16 S[7];
#pragma unroll
    for (int kt = 0; kt < 7; ++kt) {
#pragma unroll
        for (int i = 0; i < 16; ++i) S[kt][i] = 0.f;
#pragma unroll
        for (int s = 0; s < 4; ++s) { const bf16x8 a = *(const LAS bf16x8*)(L + A_KS + (kt * 32 + r) * 144 + (16 * s + 8 * hi) * 2); S[kt] = MFMA32(a, q[s], S[kt]); }
        asm volatile("" ::: "memory");
    }
    __builtin_amdgcn_sched_barrier(0);
    const float slope = exp2f(-(float)(h + 1)), sink = P.in[11][h];
    const float NEG = -__builtin_inff();
    float m = sink;
#pragma unroll
    for (int i = 0; i < 16; ++i) { if (i >= 8) S[0][i] = NEG; else m = fmaxf(m, S[0][i]); }
    int oz; asm volatile("v_mov_b32 %0, 0" : "=v"(oz));
    const int smin = 128 - 64 * c, pq = pos0 + r + 128 + oz;
#pragma unroll
    for (int kt = 1; kt < 7; ++kt) {
#pragma unroll
        for (int i = 0; i < 16; ++i) { const int s = (kt - 1) * 32 + crow(i, hi); float v = S[kt][i] - slope * fabsf((float)(pq - s)); if (s < smin) v = NEG; S[kt][i] = v; m = fmaxf(m, v); }
        __builtin_amdgcn_sched_barrier(0);
    }
    m = fmaxf(m, __shfl_xor(m, 32));
    __builtin_amdgcn_sched_barrier(0);
    float sum = 0.f; const float ml = m * 1.44269504f;
    bf16x8 pbv[7][2];
#pragma unroll
    for (int kt = 0; kt < 7; ++kt) {
#pragma unroll
        for (int i = 0; i < 16; ++i) { const float p = __builtin_amdgcn_exp2f(S[kt][i] * 1.44269504f - ml); S[kt][i] = p; sum += p; }
        pbv[kt][0] = pack8(S[kt][0], S[kt][1], S[kt][2], S[kt][3], S[kt][4], S[kt][5], S[kt][6], S[kt][7]);
        pbv[kt][1] = pack8(S[kt][8], S[kt][9], S[kt][10], S[kt][11], S[kt][12], S[kt][13], S[kt][14], S[kt][15]);
    }
    __builtin_amdgcn_sched_barrier(0);
    sum += __shfl_xor(sum, 32); sum += exp2f(sink * 1.44269504f - ml);
    const float inv = 1.0f / sum;
    f32x16 O[2];
#pragma unroll
    for (int i = 0; i < 16; ++i) { O[0][i] = 0.f; O[1][i] = 0.f; }
#pragma unroll
    for (int kt = 0; kt < 7; ++kt)
#pragma unroll
        for (int s2 = 0; s2 < 2; ++s2) {
            const bf16x8 pb = pbv[kt][s2];
#pragma unroll
            for (int dt = 0; dt < 2; ++dt) {
                const LAS unsigned char* vp = L + A_VT + ((dt * 32 + r) * A_VTS + kt * 32 + 16 * s2 + 4 * hi) * 2;
                const s16x4 lo = *(const LAS s16x4*)vp, h4 = *(const LAS s16x4*)(vp + 16);
                const bf16x8 va = __builtin_shufflevector(lo, h4, 0, 1, 2, 3, 4, 5, 6, 7);
                O[dt] = MFMA32(va, pb, O[dt]);
            }
            asm volatile("" ::: "memory");
        }
#pragma unroll
    for (int dt = 0; dt < 2; ++dt)
#pragma unroll
        for (int g4 = 0; g4 < 4; ++g4) {
            u32x2 w; w.x = pk2(O[dt][4 * g4] * inv, O[dt][4 * g4 + 1] * inv); w.y = pk2(O[dt][4 * g4 + 2] * inv, O[dt][4 * g4 + 3] * inv);
            *(u32x2*)(ya + (size_t)qrow * 512 + h * 64 + dt * 32 + 8 * g4 + 4 * hi) = w;
        }
    __syncthreads();
}

constexpr int G_QE = 0, G_KE = 9216, G_K2T = 18432, G_VT = 27648, G_ST = 46080, G_SEG = 64512, G_SS = 66560, G_GL = 67584;
template <bool KV> __device__ __forceinline__ void gla_prep(const Params& P, LAS unsigned char* L, int b, int h, int j, int tid) {
    const bf16* PB = (const bf16*)(P.ws + WS_R1); const float* glow = (const float*)(P.ws + WS_GLOW);
    const int d = tid & 63, seg = tid >> 6;
    float gw[16];
#pragma unroll
    for (int r = 0; r < 16; ++r) gw[r] = P.in[8][r * 256 + h * 64 + d];
    const float bias = P.in[9][h * 64 + d];
    {
      const int pos = tid >> 3, e2 = (tid & 7) * 2; const bool valid = (j > 0) || (pos >= 48);
      const int row = valid ? (j == 0 ? NFR + pos - 48 : b * 8192 + (j - 1) * 64 + pos) : NFR;
      *(LAS f32x2m*)(L + G_GL + (pos * 16 + e2) * 4) = *(const f32x2m*)(glow + (size_t)row * 16 + e2); }
    __syncthreads();
    float cs[8], qv[8], kv[8]; float run = 0.f;
#pragma unroll
    for (int p = 0; p < 8; ++p) {
        const int pos = seg * 8 + p; const bool valid = (j > 0) || (pos >= 48);
        const int row = valid ? (j == 0 ? NFR + pos - 48 : b * 8192 + (j - 1) * 64 + pos) : NFR;
        const LAS f32x4* gl = (const LAS f32x4*)(L + G_GL + pos * 64);
        const f32x4 g0 = gl[0], g1 = gl[1], g2 = gl[2], g3 = gl[3];
        float z = bias;
#pragma unroll
        for (int e = 0; e < 4; ++e) { z += g0[e] * gw[e]; z += g1[e] * gw[4 + e]; z += g2[e] * gw[8 + e]; z += g3[e] * gw[12 + e]; }
        float la = (fminf(z, 0.f) - __logf(1.0f + __expf(-fabsf(z)))) * 0.0625f;
        if (!valid) la = 0.f;
        run += la; cs[p] = run;
        const bf16* pr = PB + (size_t)row * PBW + h * 64 + d;
        qv[p] = valid ? pg8::bf2f(pr[768]) : 0.f; kv[p] = valid ? pg8::bf2f(pr[1024]) : 0.f;
        if (p & 1) __builtin_amdgcn_sched_barrier(0);
    }
    LAS float* SEG = (LAS float*)(L + G_SEG);
    SEG[seg * 64 + d] = run;
    __syncthreads();
    float off = 0.f, tot = 0.f;
#pragma unroll
    for (int s = 0; s < 8; ++s) { const float v = SEG[s * 64 + d]; tot += v; if (s < seg) off += v; }
    LAS unsigned short* QE = (LAS unsigned short*)(L + G_QE); LAS unsigned short* KE = (LAS unsigned short*)(L + G_KE);
    float k2[8];
#pragma unroll
    for (int p = 0; p < 8; ++p) {
        const int pos = seg * 8 + p; const float bb = off + cs[p];
        QE[pos * 72 + d] = (unsigned short)f2bf(qv[p] * __expf(bb));
        KE[pos * 72 + d] = (unsigned short)f2bf(kv[p] * __expf(-bb));
        k2[p] = kv[p] * __expf(tot - bb);
    }
    if (KV) {
        *(LAS bf16x8*)(L + G_K2T + (d * 72 + seg * 8) * 2) = pack8(k2[0], k2[1], k2[2], k2[3], k2[4], k2[5], k2[6], k2[7]);
        if (seg == 0) ((float*)(P.ws + WS_DEC))[(size_t)((b * 4 + h) * 129 + j) * 64 + d] = __expf(tot);
    }
}
__device__ __forceinline__ void gla_stage_v(const Params& P, LAS unsigned char* L, int b, int h, int j, int tid) {
    const bf16* PB = (const bf16*)(P.ws + WS_R1);
    const int pos = tid & 63, dvg = tid >> 6; const bool valid = (j > 0) || (pos >= 48);
    const int row = valid ? (j == 0 ? NFR + pos - 48 : b * 8192 + (j - 1) * 64 + pos) : NFR;
    u32x4 a = (u32x4){0u, 0u, 0u, 0u}, c = a;
    if (valid) { const bf16* p = PB + (size_t)row * PBW + 1280 + h * 128 + dvg * 16; a = *(const u32x4*)p; c = *(const u32x4*)(p + 8); }
    LAS unsigned short* vt = (LAS unsigned short*)(L + G_VT) + (dvg * 16) * 72 + pos;
    vt[0 * 72] = (unsigned short)(a.x & 0xffffu); vt[1 * 72] = (unsigned short)(a.x >> 16); vt[2 * 72] = (unsigned short)(a.y & 0xffffu); vt[3 * 72] = (unsigned short)(a.y >> 16);
    vt[4 * 72] = (unsigned short)(a.z & 0xffffu); vt[5 * 72] = (unsigned short)(a.z >> 16); vt[6 * 72] = (unsigned short)(a.w & 0xffffu); vt[7 * 72] = (unsigned short)(a.w >> 16);
    vt[8 * 72] = (unsigned short)(c.x & 0xffffu); vt[9 * 72] = (unsigned short)(c.x >> 16); vt[10 * 72] = (unsigned short)(c.y & 0xffffu); vt[11 * 72] = (unsigned short)(c.y >> 16);
    vt[12 * 72] = (unsigned short)(c.z & 0xffffu); vt[13 * 72] = (unsigned short)(c.z >> 16); vt[14 * 72] = (unsigned short)(c.w & 0xffffu); vt[15 * 72] = (unsigned short)(c.w >> 16);
}
__device__ __forceinline__ void gla_kv_item(const Params& P, LAS unsigned char* L, int item, int tid, int wave, int lane) {
    const int j = item % 129, bh = item / 129, h = bh & 3, b = bh >> 2;
    gla_prep<true>(P, L, b, h, j, tid);
    gla_stage_v(P, L, b, h, j, tid);
    __syncthreads();
    const int dvt = wave >> 1, dkt = wave & 1, r = lane & 31, hi = lane >> 5;
    f32x16 acc;
#pragma unroll
    for (int i = 0; i < 16; ++i) acc[i] = 0.f;
#pragma unroll
    for (int s = 0; s < 4; ++s) {
        const bf16x8 a = *(const LAS bf16x8*)(L + G_VT + ((dvt * 32 + r) * 72 + 16 * s + 8 * hi) * 2);
        const bf16x8 bb = *(const LAS bf16x8*)(L + G_K2T + ((dkt * 32 + r) * 72 + 16 * s + 8 * hi) * 2);
        acc = MFMA32(a, bb, acc);
    }
    float* kvg = (float*)(P.ws + WS_KV) + (size_t)item * 8192;
#pragma unroll
    for (int i = 0; i < 16; ++i) kvg[(dvt * 32 + crow(i, hi)) * 64 + dkt * 32 + r] = acc[i];
    __syncthreads();
}
__device__ __forceinline__ void gla_scan(const Params& P, int wave, int lane, int G) {
    const float* kvg = (const float*)(P.ws + WS_KV); const float* dec = (const float*)(P.ws + WS_DEC); bf16* st = (bf16*)(P.ws + WS_ST);
    for (int wv = wave * G + blockIdx.x; wv < 1024; wv += G * 8) {
        const int gidx = wv * 64 + lane, bh = gidx >> 13, e = gidx & 8191, dk = e & 63;
        const size_t base = (size_t)bh * 129;
        float S = 0.f;
        for (int j0 = 0; j0 < 128; j0 += 8) {
            float kvv[8], dd[8];
#pragma unroll
            for (int u = 0; u < 8; ++u) { kvv[u] = kvg[(base + j0 + u) * 8192 + e]; dd[u] = dec[(base + j0 + u) * 64 + dk]; }
#pragma unroll
            for (int u = 0; u < 8; ++u) { S = dd[u] * S + kvv[u]; st[(base + j0 + u + 1) * 8192 + e] = (bf16)f2bf(S); }
        }
    }
}
__device__ __forceinline__ void gla_out_item(const Params& P, LAS unsigned char* L, int item  , int tid, int wave, int lane) {
    const int j = (item & 127) + 1, bh = item >> 7, h = bh & 3, b = bh >> 2;
    const bf16* PB = (const bf16*)(P.ws + WS_R1); bf16* yb = (bf16*)(P.ws + WS_YB);
    gla_prep<false>(P, L, b, h, j, tid);
    gla_stage_v(P, L, b, h, j, tid);
    { const bf16* sg = (const bf16*)(P.ws + WS_ST) + (size_t)(bh * 129 + j) * 8192; const int dv = tid >> 2, part = tid & 3;
      const u32x4 a = *(const u32x4*)(sg + dv * 64 + part * 16), c = *(const u32x4*)(sg + dv * 64 + part * 16 + 8);
      *(LAS u32x4*)(L + G_ST + (dv * 72 + part * 16) * 2) = a; *(LAS u32x4*)(L + G_ST + (dv * 72 + part * 16 + 8) * 2) = c; }
    __syncthreads();
    const int it = wave & 1, dvt = wave >> 1, r = lane & 31, hi = lane >> 5;
    bf16x8 qf[4];
#pragma unroll
    for (int s = 0; s < 4; ++s) qf[s] = *(const LAS bf16x8*)(L + G_QE + ((it * 32 + r) * 72 + 16 * s + 8 * hi) * 2);
    f32x16 o;
#pragma unroll
    for (int i = 0; i < 16; ++i) o[i] = 0.f;
#pragma unroll
    for (int jt = 0; jt < 2; ++jt) {
        if (jt <= it) {
            f32x16 at;
#pragma unroll
            for (int i = 0; i < 16; ++i) at[i] = 0.f;
#pragma unroll
            for (int s = 0; s < 4; ++s) { const bf16x8 a = *(const LAS bf16x8*)(L + G_KE + ((jt * 32 + r) * 72 + 16 * s + 8 * hi) * 2); at = MFMA32(a, qf[s], at); }
            if (jt == it) {
#pragma unroll
                for (int i = 0; i < 16; ++i) if (crow(i, hi) > r) at[i] = 0.f;
            }
#pragma unroll
            for (int s2 = 0; s2 < 2; ++s2) {
                const bf16x8 pb = pack8(at[8 * s2], at[8 * s2 + 1], at[8 * s2 + 2], at[8 * s2 + 3], at[8 * s2 + 4], at[8 * s2 + 5], at[8 * s2 + 6], at[8 * s2 + 7]);
                const LAS unsigned char* vp = L + G_VT + ((dvt * 32 + r) * 72 + jt * 32 + 16 * s2 + 4 * hi) * 2;
                const s16x4 lo = *(const LAS s16x4*)vp, h4 = *(const LAS s16x4*)(vp + 16);
                o = MFMA32(__builtin_shufflevector(lo, h4, 0, 1, 2, 3, 4, 5, 6, 7), pb, o);
            }
        }
    }
#pragma unroll
    for (int s = 0; s < 4; ++s) { const bf16x8 a = *(const LAS bf16x8*)(L + G_ST + ((dvt * 32 + r) * 72 + 16 * s + 8 * hi) * 2); o = MFMA32(a, qf[s], o); }
    float ss = 0.f;
#pragma unroll
    for (int i = 0; i < 16; ++i) ss += o[i] * o[i];
    ss += __shfl_xor(ss, 32);
    LAS float* SS = (LAS float*)(L + G_SS);
    if (hi == 0) SS[dvt * 64 + it * 32 + r] = ss;
    __syncthreads();
    const float tot = (SS[it * 32 + r] + SS[64 + it * 32 + r]) + (SS[128 + it * 32 + r] + SS[192 + it * 32 + r]);
    const float rstd = __builtin_amdgcn_rsqf(tot * (1.0f / 128.0f) + 1e-6f);
    const int row = b * 8192 + (j - 1) * 64 + it * 32 + r;
#pragma unroll
    for (int g4 = 0; g4 < 4; ++g4) {
        const int dv0 = dvt * 32 + 8 * g4 + 4 * hi;
        const f32x4 gn = *(const f32x4*)(P.in[10] + dv0);
        const u32x2 gr = *(const u32x2*)(PB + (size_t)row * PBW + 1792 + h * 128 + dv0);
        u32x2 w;
        w.x = pk2(o[4 * g4] * rstd * gn[0] * pg8::bflo(gr.x), o[4 * g4 + 1] * rstd * gn[1] * pg8::bfhi(gr.x));
        w.y = pk2(o[4 * g4 + 2] * rstd * gn[2] * pg8::bflo(gr.y), o[4 * g4 + 3] * rstd * gn[3] * pg8::bfhi(gr.y));
        *(u32x2*)(yb + (size_t)row * 512 + h * 128 + dv0) = w;
    }
    __syncthreads();
}

__global__ void __launch_bounds__(512, 2) mega_fwd(Params P) {
    extern __shared__ __attribute__((aligned(16))) unsigned char lds_raw[];
    LAS unsigned char* lds = (LAS unsigned char*)lds_raw;
    cg::grid_group grid = cg::this_grid();
    const int tid = threadIdx.x, lane = tid & 63, wave = __builtin_amdgcn_readfirstlane(tid >> 6), G = gridDim.x;
    unsigned char* ws = P.ws;
    const int lo = P.ph_lo, hi = P.ph_hi;
#define IN(k) (lo <= (k) && (k) < hi)
#define SEAM(k) do { if (IN(k) && IN((k) + 1)) grid.sync(); } while (0)
    bf16* hb = (bf16*)(ws + WS_HB); float* ssp = (float*)(ws + WS_SSP); bf16* R1 = (bf16*)(ws + WS_R1);

    if (IN(0)) p0_prep(P, lds, wave, lane, G);
    SEAM(0);
    if (IN(1)) {
        pg8::Gemm g{hb, (const bf16*)(ws + WS_WGU1), MT, NGU, D}; pg8::StaticOrder S; S.init(MT, NGU, G, (int)blockIdx.x);
        pg8::EpiSwiglu E{R1, ssp};
        pg8::gemm_phase<pg8::EpiSwiglu, pg8::StaticOrder, true, true>(lds, g, S, E);
    }
    SEAM(1);
    if (IN(2)) {
        pg8::Gemm g{R1, (const bf16*)(ws + WS_WD1), MT, D, FF}; pg8::StaticOrder S; S.init(MT, D, G, (int)blockIdx.x);
        pg8::EpiResid E{P.in[0], P.in[1], P.out, hb, ssp, 0.5f};
        pg8::gemm_phase<pg8::EpiResid, pg8::StaticOrder, true, true>(lds, g, S, E);
    }
    SEAM(2);
    if (IN(3)) {
        pg8::Gemm g{hb, (const bf16*)(ws + WS_WIN), MT, NIN, D}; pg8::StaticOrder S; S.init(MT, NIN, G, (int)blockIdx.x);
        pg8::EpiIn E{R1, (float*)(ws + WS_GLOW), ssp};
        pg8::gemm_phase<pg8::EpiIn, pg8::StaticOrder, true, true>(lds, g, S, E);
    }
    SEAM(3);
    if (IN(4)) {
        for (int it = blockIdx.x; it < 512; it += G) attn_item(P, lds, it, tid, wave, lane);
        for (int it = blockIdx.x; it < 1032; it += G) gla_kv_item(P, lds, it, tid, wave, lane);
    }
    SEAM(4);
    if (IN(5)) gla_scan(P, wave, lane, G);
    SEAM(5);
    if (IN(6)) { for (int it = blockIdx.x; it < 1024; it += G) gla_out_item(P, lds, it, tid, wave, lane); }
    SEAM(6);
    if (IN(7)) {
        bf16* mixed = (bf16*)(ws + WS_KV);
        { pg8::Gemm g{(const bf16*)(ws + WS_YA), (const bf16*)(ws + WS_WA), NFR, D, 512}; pg8::StaticOrder S; S.init(NFR, D, G, (int)blockIdx.x);
          pg8::EpiMix<false> E{R1 + 2304, mixed};
          pg8::gemm_phase<pg8::EpiMix<false>, pg8::StaticOrder, true, true>(lds, g, S, E); }
        { pg8::Gemm g{(const bf16*)(ws + WS_YB), (const bf16*)(ws + WS_WB), NFR, D, 512}; pg8::StaticOrder S; S.init(NFR, D, G, (int)blockIdx.x);
          pg8::EpiMix<true> E{R1 + 3328, mixed};
          pg8::gemm_phase<pg8::EpiMix<true>, pg8::StaticOrder, true, true>(lds, g, S, E); }
    }
    SEAM(7);
    if (IN(8)) {
        pg8::Gemm g{(const bf16*)(ws + WS_KV), (const bf16*)(ws + WS_WOUT), NFR, D, D}; pg8::StaticOrder S; S.init(NFR, D, G, (int)blockIdx.x);
        pg8::EpiResid E{P.out, P.in[1], P.out, hb, ssp, 1.0f};
        pg8::gemm_phase<pg8::EpiResid, pg8::StaticOrder, true, true>(lds, g, S, E);
    }
    SEAM(8);
    if (IN(9)) {
        pg8::Gemm g{hb, (const bf16*)(ws + WS_WGU2), NFR, NGU, D}; pg8::StaticOrder S; S.init(NFR, NGU, G, (int)blockIdx.x);
        pg8::EpiSwiglu E{R1, ssp};
        pg8::gemm_phase<pg8::EpiSwiglu, pg8::StaticOrder, true, true>(lds, g, S, E);
    }
    SEAM(9);
    if (IN(10)) {
        pg8::Gemm g{R1, (const bf16*)(ws + WS_WD2), NFR, D, FF}; pg8::StaticOrder S; S.init(NFR, D, G, (int)blockIdx.x);
        pg8::EpiResid E{P.out, P.in[1], P.out, nullptr, ssp, 0.5f};
        pg8::gemm_phase<pg8::EpiResid, pg8::StaticOrder, true, true>(lds, g, S, E);
    }
    SEAM(10);
    if (IN(11)) {
        const int gw = blockIdx.x * 8 + wave, NGW = G * 8;
        for (int m = gw; m < NFR; m += NGW) {
            f32x4* rowp = (f32x4*)(P.out + (size_t)m * D) + lane;
            float s = ssp[(size_t)m * 16 + (lane & 15)];
            s += __shfl_xor(s, 1); s += __shfl_xor(s, 2); s += __shfl_xor(s, 4); s += __shfl_xor(s, 8);
            const float rs = __builtin_amdgcn_rsqf(s * (1.0f / 1024.0f) + 1e-6f);
#pragma unroll
            for (int j = 0; j < 4; ++j) { const f32x4 gn = ((const f32x4*)P.in[19])[lane + 64 * j]; f32x4 v = rowp[64 * j]; rowp[64 * j] = v * rs * gn; }
        }
    }
#undef IN
#undef SEAM
}

extern "C" void kernel_launch(void* const* d_in, const int* in_sizes, int n_in, void* d_out, int out_size, void* d_ws, size_t ws_size, hipStream_t stream) {
    static int grid = 0;
    if (grid == 0) {
        if (n_in != 20 || out_size != NFR * D || ws_size < WS_END) { fprintf(stderr, "kernel_launch: unexpected shapes (n_in %d out %d ws %zu)\n", n_in, out_size, ws_size); grid = -1; return; }
        int dev = 0, cus = 0, per_cu = 0;
        hipGetDevice(&dev); hipDeviceGetAttribute(&cus, hipDeviceAttributeMultiprocessorCount, dev);
        if (hipFuncSetAttribute((const void*)mega_fwd, hipFuncAttributeMaxDynamicSharedMemorySize, LDS_BYTES) != hipSuccess) { fprintf(stderr, "kernel_launch: hipFuncSetAttribute failed\n"); grid = -1; return; }
        if (hipOccupancyMaxActiveBlocksPerMultiprocessor(&per_cu, (const void*)mega_fwd, 512, LDS_BYTES) != hipSuccess || per_cu < 1) { fprintf(stderr, "kernel_launch: occupancy query failed (%d)\n", per_cu); (void)hipGetLastError(); grid = -1; return; }
        grid = cus * per_cu;
        fprintf(stderr, "kernel_launch: %d CUs x %d blocks -> grid %d\n", cus, per_cu, grid);
    }
    if (grid < 0) return;
    Params p{};
    for (int i = 0; i < 20; ++i) p.in[i] = (const float*)d_in[i];
    p.out = (float*)d_out; p.ws = (unsigned char*)d_ws;
#if MK_PER_PHASE
    for (int ph = 0; ph < NPH; ++ph) { p.ph_lo = ph; p.ph_hi = ph + 1; hipLaunchKernelGGL(mega_fwd, dim3(grid), dim3(512), LDS_BYTES, stream, p); }
#else
    p.ph_lo = 0; p.ph_hi = NPH;
    void* args[] = {&p};
    hipError_t e = hipLaunchCooperativeKernel((const void*)mega_fwd, dim3(grid), dim3(512), args, LDS_BYTES, stream);
    if (e != hipSuccess) fprintf(stderr, "kernel_launch: cooperative launch failed: %s (grid %d)\n", hipGetErrorString(e), grid);
#endif
}
```

```cpp
#include <hip/hip_runtime.h>
#include <hip/hip_cooperative_groups.h>
#include <cstdio>
#include <cstdint>
namespace cg = cooperative_groups;
namespace pg8 {
#define PG8_LAS __attribute__((address_space(3)))
typedef unsigned short bf16_t;
typedef short bf16x8 __attribute__((ext_vector_type(8)));
typedef float f32x4 __attribute__((ext_vector_type(4)));
typedef unsigned u32x4 __attribute__((ext_vector_type(4)));
constexpr int BM = 256, BK = 64, HALF = 128, HTB = HALF * BK * 2  , STAGE_BYTES = 8 * HTB, NXCD = 8, WGM = 8;

__host__ __device__ __forceinline__ int lds_byte(int r, int c) { const int st = (r >> 4) * 2 + (c >> 5), rr = r & 15, cc = c & 31, ob = rr * 64 + cc * 2; return st * 1024 + (ob ^ (((ob >> 9) & 1) << 5)); }
__host__ __device__ __forceinline__ void stage_rc(int b, int& R, int& C) { const int st = b / 1024, sb = b % 1024, swz = sb ^ (((sb >> 9) & 1) << 5); R = (st >> 1) * 16 + swz / 64; C = (st & 1) * 32 + (swz % 64) / 2; }
__host__ __device__ __forceinline__ int perm32(int rho) { const int n = rho >> 4, i = rho & 15; return 8 * (i >> 2) + 4 * n + (i & 3); }

struct Unit { int pm, pn; };
struct Gemm { const bf16_t* A; const bf16_t* Bt; int M, N, K; };

struct StaticOrder {
    int nM, nN, nwg, G, c;
    __host__ __device__ void init(int M, int N, int G_, int c_) { nM = M / BM; nN = N / BM; nwg = nM * nN; G = G_; c = c_; }
    __host__ __device__ bool next(int i, Unit& u) const {
        const long L = (long)i * G + c; if (L >= nwg) return false;
        int wgid = (int)L; { const int q = nwg / NXCD, r = nwg % NXCD, xcd = wgid % NXCD, off = wgid / NXCD; wgid = (xcd < r ? xcd * (q + 1) : r * (q + 1) + (xcd - r) * q) + off; }
        const int nig = WGM * nN, gid = wgid / nig, fm = gid * WGM, gsz = (nM - fm) < WGM ? (nM - fm) : WGM;
        u.pm = fm + ((wgid % nig) % gsz); u.pn = (wgid % nig) / gsz; return true;
    }
    __device__ __forceinline__ void a_ready(const Unit&) const {}
    __device__ __forceinline__ void done(const Unit&) const {}
};

__device__ __forceinline__ unsigned cvt_pk_bf16(float lo, float hi) { unsigned r; asm volatile("v_cvt_pk_bf16_f32 %0, %1, %2" : "=v"(r) : "v"(lo), "v"(hi)); return r; }
typedef float f32x2 __attribute__((ext_vector_type(2)));
constexpr int XD = 1024, XFF = 2816, XPBW = 4352, XNFR = 16384;
__device__ __forceinline__ float row_rstd(const float* ssp, int row, int fq) {
    const f32x4 p = *(const f32x4*)(ssp + (size_t)row * 16 + 4 * fq);
    float s = (p[0] + p[1]) + (p[2] + p[3]);
    s += __shfl_xor(s, 16); s += __shfl_xor(s, 32);
    return __builtin_amdgcn_rsqf(s * (1.0f / 1024.0f) + 1e-6f);
}
__device__ __forceinline__ float sigm(float x) { return __builtin_amdgcn_rcpf(1.0f + __expf(-x)); }
__device__ __forceinline__ float bf2f(unsigned short b) { return __uint_as_float((unsigned)b << 16); }
__device__ __forceinline__ float bflo(unsigned w) { return __uint_as_float(w << 16); }
__device__ __forceinline__ float bfhi(unsigned w) { return __uint_as_float(w & 0xffff0000u); }

struct EpiSwiglu {
    static constexpr bool PERM = true, AFTER_DRAIN = false;
    bf16_t* O; const float* ssp;
    __device__ __forceinline__ void operator()(const f32x4 (&acc)[2][2][4][2], const Unit& u, int wr, int wc, int fr, int fq) const {
        const int row0 = u.pm * BM + wr * 64 + fr, col0 = u.pn * HALF + wc * 32 + 8 * fq;
#pragma unroll
        for (int ai = 0; ai < 2; ++ai)
#pragma unroll
            for (int m = 0; m < 4; ++m) {
                const int row = row0 + ai * HALF + m * 16; const float rs = row_rstd(ssp, row, fq);
                const f32x4 g0 = acc[ai][0][m][0] * rs, g1 = acc[ai][0][m][1] * rs, u0 = acc[ai][1][m][0] * rs, u1 = acc[ai][1][m][1] * rs;
                u32x4 w;
                w.x = cvt_pk_bf16(g0[0] * sigm(g0[0]) * u0[0], g0[1] * sigm(g0[1]) * u0[1]);
                w.y = cvt_pk_bf16(g0[2] * sigm(g0[2]) * u0[2], g0[3] * sigm(g0[3]) * u0[3]);
                w.z = cvt_pk_bf16(g1[0] * sigm(g1[0]) * u1[0], g1[1] * sigm(g1[1]) * u1[1]);
                w.w = cvt_pk_bf16(g1[2] * sigm(g1[2]) * u1[2], g1[3] * sigm(g1[3]) * u1[3]);
                *(u32x4*)(O + (size_t)row * XFF + col0) = w;
            }
    }
};

struct EpiResid {
    static constexpr bool PERM = false, AFTER_DRAIN = false;
    const float* base; const float* meta; float* out; bf16_t* hb; float* ssp; float scale;
    __device__ __forceinline__ void operator()(const f32x4 (&acc)[2][2][4][2], const Unit& u, int wr, int wc, int fr, int fq) const {
        typedef unsigned u32x2v __attribute__((ext_vector_type(2)));
        const int row0 = u.pm * BM + wr * 64 + fr, col0 = u.pn * BM + wc * 32 + 4 * fq;
#pragma unroll
        for (int ai = 0; ai < 2; ++ai)
#pragma unroll
            for (int m = 0; m < 4; ++m) {
                const int row = row0 + ai * HALF + m * 16;
                const bool fr_row = row < XNFR, has = row < XNFR + 16;
                const float* bp = fr_row ? base + (size_t)row * XD : meta + (size_t)(has ? row - XNFR : 0) * XD;
                float sq = 0.f;
#pragma unroll
                for (int bj = 0; bj < 2; ++bj)
#pragma unroll
                    for (int n = 0; n < 2; ++n) {
                        const int c = col0 + bj * HALF + n * 16;
                        f32x4 b = *(const f32x4*)(bp + c);
                        if (!has) b = (f32x4){0.f, 0.f, 0.f, 0.f};
                        const f32x4 v = b + acc[ai][bj][m][n] * scale;
                        sq += (v[0] * v[0] + v[1] * v[1]) + (v[2] * v[2] + v[3] * v[3]);
                        if (fr_row) *(f32x4*)(out + (size_t)row * XD + c) = v;
                        if (hb) { u32x2v w; w.x = cvt_pk_bf16(v[0], v[1]); w.y = cvt_pk_bf16(v[2], v[3]); *(u32x2v*)(hb + (size_t)row * XD + c) = w; }
                    }
                sq += __shfl_xor(sq, 16); sq += __shfl_xor(sq, 32);
                if (fq == 0) ssp[(size_t)row * 16 + u.pn * 4 + wc] = sq;
            }
    }
};

struct EpiIn {
    static constexpr bool PERM = true, AFTER_DRAIN = false;
    bf16_t* PB; float* glow; const float* ssp;
    __device__ __forceinline__ void operator()(const f32x4 (&acc)[2][2][4][2], const Unit& u, int wr, int wc, int fr, int fq) const {
        const int row0 = u.pm * BM + wr * 64 + fr, tile = u.pn;
        if (tile == 17) {
            if (wc == 0 && fq < 2) {
#pragma unroll
                for (int ai = 0; ai < 2; ++ai)
#pragma unroll
                    for (int m = 0; m < 4; ++m) {
                        const int row = row0 + ai * HALF + m * 16;
                        const f32x4 p = *(const f32x4*)(ssp + (size_t)row * 16), q = *(const f32x4*)(ssp + (size_t)row * 16 + 4), r = *(const f32x4*)(ssp + (size_t)row * 16 + 8), t = *(const f32x4*)(ssp + (size_t)row * 16 + 12);
                        const float s = (((p[0] + p[1]) + (p[2] + p[3])) + ((q[0] + q[1]) + (q[2] + q[3]))) + (((r[0] + r[1]) + (r[2] + r[3])) + ((t[0] + t[1]) + (t[2] + t[3])));
                        const float rs = __builtin_amdgcn_rsqf(s * (1.0f / 1024.0f) + 1e-6f);
                        *(f32x4*)(glow + (size_t)row * 16 + 8 * fq) = acc[ai][0][m][0] * rs;
                        *(f32x4*)(glow + (size_t)row * 16 + 8 * fq + 4) = acc[ai][0][m][1] * rs;
                    }
            }
            return;
        }
        const int mode = (tile <= 1 || tile == 3) ? 1 : (tile == 7 || tile == 8) ? 2 : (tile >= 9 ? 3 : 0);
        const int col0 = tile * BM + wc * 32 + 8 * fq;
#pragma unroll
        for (int ai = 0; ai < 2; ++ai)
#pragma unroll
            for (int m = 0; m < 4; ++m) {
                const int row = row0 + ai * HALF + m * 16; const float rs = row_rstd(ssp, row, fq);
#pragma unroll
                for (int bj = 0; bj < 2; ++bj) {
                    f32x4 v0 = acc[ai][bj][m][0] * rs, v1 = acc[ai][bj][m][1] * rs;
                    if (mode == 1) { v0 = v0 * 0.125f; v1 = v1 * 0.125f; }
                    else if (mode == 2) {
#pragma unroll
                        for (int j = 0; j < 4; ++j) { v0[j] = v0[j] * sigm(v0[j]); v1[j] = v1[j] * sigm(v1[j]); } }
                    else if (mode == 3) {
#pragma unroll
                        for (int j = 0; j < 4; ++j) { v0[j] = sigm(v0[j]); v1[j] = sigm(v1[j]); } }
                    u32x4 w; w.x = cvt_pk_bf16(v0[0], v0[1]); w.y = cvt_pk_bf16(v0[2], v0[3]); w.z = cvt_pk_bf16(v1[0], v1[1]); w.w = cvt_pk_bf16(v1[2], v1[3]);
                    *(u32x4*)(PB + (size_t)row * XPBW + col0 + bj * HALF) = w;
                }
            }
    }
};

template <bool ADD> struct EpiMix {
    static constexpr bool PERM = true, AFTER_DRAIN = false;
    const bf16_t* gate; bf16_t* mixed;
    __device__ __forceinline__ void operator()(const f32x4 (&acc)[2][2][4][2], const Unit& u, int wr, int wc, int fr, int fq) const {
        const int row0 = u.pm * BM + wr * 64 + fr, col0 = u.pn * BM + wc * 32 + 8 * fq;
#pragma unroll
        for (int ai = 0; ai < 2; ++ai)
#pragma unroll
            for (int m = 0; m < 4; ++m) {
                const int row = row0 + ai * HALF + m * 16;
#pragma unroll
                for (int bj = 0; bj < 2; ++bj) {
                    const int c = col0 + bj * HALF;
                    const u32x4 g = *(const u32x4*)(gate + (size_t)row * XPBW + c);
                    const f32x4 a0 = acc[ai][bj][m][0], a1 = acc[ai][bj][m][1];
                    float v[8] = {bflo(g.x) * a0[0], bfhi(g.x) * a0[1], bflo(g.y) * a0[2], bfhi(g.y) * a0[3], bflo(g.z) * a1[0], bfhi(g.z) * a1[1], bflo(g.w) * a1[2], bfhi(g.w) * a1[3]};
                    if (ADD) { const u32x4 o = *(const u32x4*)(mixed + (size_t)row * XD + c);
                        v[0] += bflo(o.x); v[1] += bfhi(o.x); v[2] += bflo(o.y); v[3] += bfhi(o.y); v[4] += bflo(o.z); v[5] += bfhi(o.z); v[6] += bflo(o.w); v[7] += bfhi(o.w); }
                    u32x4 w; w.x = cvt_pk_bf16(v[0], v[1]); w.y = cvt_pk_bf16(v[2], v[3]); w.z = cvt_pk_bf16(v[4], v[5]); w.w = cvt_pk_bf16(v[6], v[7]);
                    *(u32x4*)(mixed + (size_t)row * XD + c) = w;
                }
            }
    }
};

template <class Epi, class Sched, bool ALIGN_EPI = false, bool SP2 = false>
__device__ __forceinline__ void gemm_phase(PG8_LAS unsigned char* lds, const Gemm g, const Sched& S, const Epi& E) {
    const int tid = threadIdx.x, wid = __builtin_amdgcn_readfirstlane(tid >> 6), lane = tid & 63, wr = wid >> 2, wc = wid & 3, fr = lane & 15, fq = lane >> 4;
    const int K = g.K, nt = K / BK;
    unsigned voffA[2], voffB[2];
#pragma unroll
    for (int i = 0; i < 2; ++i) { int R, C; stage_rc(tid * 16 + i * 8192, R, C); const int Rb = Epi::PERM ? ((R & ~31) + perm32(R & 31)) : R;
        voffA[i] = (unsigned)(R * K + C) * 2u; voffB[i] = (unsigned)(Rb * K + C) * 2u; }
    const size_t kstep = (size_t)(BK * 2);
    const size_t hstep = (size_t)HALF * K * 2;
    const size_t tstep = 2 * hstep;
    const unsigned ldsw = (unsigned)wid * 1024u;
    const int aoff = lds_byte(wr * 64 + fr, fq * 8), boff = lds_byte(wc * 32 + fr, fq * 8);
#define PG8_SA(b, h) (((b) * 2 + (h)) * HTB)
#define PG8_SB(b, h) ((4 + (b) * 2 + (h)) * HTB)
#define PG8_STAGE(bufoff, gbase, voff) do { _Pragma("unroll") for (int _i = 0; _i < 2; ++_i) \
        __builtin_amdgcn_global_load_lds((const unsigned*)((const char*)(gbase) + (voff)[_i]), (PG8_LAS unsigned*)(lds + (bufoff) + ldsw + _i * 8192), 16, 0, 0); } while (0)
#define PG8_LDA(dst, b, h) do { _Pragma("unroll") for (int m = 0; m < 4; ++m) _Pragma("unroll") for (int k = 0; k < 2; ++k) dst[m][k] = *(const PG8_LAS bf16x8*)(lds + PG8_SA(b, h) + aoff + m * 2048 + k * 1024); } while (0)
#define PG8_LDB(dst, b, h) do { _Pragma("unroll") for (int n = 0; n < 2; ++n) _Pragma("unroll") for (int k = 0; k < 2; ++k) dst[n][k] = *(const PG8_LAS bf16x8*)(lds + PG8_SB(b, h) + boff + n * 2048 + k * 1024); } while (0)
#define PG8_MMA(ai, bj, At, Bt) do { __builtin_amdgcn_s_setprio(1); _Pragma("unroll") for (int m = 0; m < 4; ++m) _Pragma("unroll") for (int n = 0; n < 2; ++n) _Pragma("unroll") for (int k = 0; k < 2; ++k) \
        acc[ai][bj][m][n] = __builtin_amdgcn_mfma_f32_16x16x32_bf16(Bt[n][k], At[m][k], acc[ai][bj][m][n], 0, 0, 0); __builtin_amdgcn_s_setprio(0); } while (0)
#define PG8_WAIT_V(n) asm volatile("s_waitcnt vmcnt(" #n ")" ::: "memory")
#define PG8_WAIT_L(n) asm volatile("s_waitcnt lgkmcnt(" #n ")" ::: "memory")
#define PG8_BAR __builtin_amdgcn_s_barrier()
#define PG8_SCHED __builtin_amdgcn_sched_barrier(0)
    Unit cur, nxt; int ui = 0;
    if (!S.next(0, cur)) return;
    f32x4 acc[2][2][4][2];
#pragma unroll
    for (int a = 0; a < 2; ++a)
#pragma unroll
        for (int b = 0; b < 2; ++b)
#pragma unroll
            for (int m = 0; m < 4; ++m)
#pragma unroll
                for (int n = 0; n < 2; ++n) acc[a][b][m][n] = (f32x4){0.f, 0.f, 0.f, 0.f};
    bf16x8 At[4][2], B0[2][2], B1[2][2];
    const char* cA = (const char*)g.A + (size_t)cur.pm * tstep; const char* cB = (const char*)g.Bt + (size_t)cur.pn * tstep;
    S.a_ready(cur);
    if constexpr (SP2) {
        PG8_STAGE(PG8_SB(0, 0), cB, voffB); PG8_STAGE(PG8_SB(0, 1), cB + hstep, voffB); PG8_STAGE(PG8_SA(0, 0), cA, voffA); PG8_STAGE(PG8_SA(0, 1), cA + hstep, voffA);
        if (wr == 1) PG8_BAR;
        PG8_WAIT_V(2); PG8_BAR;
        PG8_STAGE(PG8_SB(1, 0), cB + kstep, voffB); PG8_STAGE(PG8_SA(1, 0), cA + kstep, voffA); PG8_STAGE(PG8_SB(1, 1), cB + hstep + kstep, voffB);
        PG8_WAIT_V(6); PG8_BAR;
    } else {
        PG8_STAGE(PG8_SB(0, 0), cB, voffB); PG8_STAGE(PG8_SA(0, 0), cA, voffA); PG8_STAGE(PG8_SB(0, 1), cB + hstep, voffB); PG8_STAGE(PG8_SA(0, 1), cA + hstep, voffA);
        if (wr == 1) PG8_BAR;
        PG8_WAIT_V(4); PG8_BAR;
        PG8_STAGE(PG8_SB(1, 0), cB + kstep, voffB); PG8_STAGE(PG8_SA(1, 0), cA + kstep, voffA); PG8_STAGE(PG8_SB(1, 1), cB + hstep + kstep, voffB);
        PG8_WAIT_V(6); PG8_BAR;
    }
    for (;;) {
        const bool has_next = S.next(ui + 1, nxt);
        const char* nA = has_next ? (const char*)g.A + (size_t)nxt.pm * tstep : cA; const char* nB = has_next ? (const char*)g.Bt + (size_t)nxt.pn * tstep : cB;
        for (int t = 0; t < nt; t += 2) {
            const bool last = (t == nt - 2);
            const char* a1 = cA + (size_t)(t + 1) * kstep;
            const char* a2 = last ? nA : cA + (size_t)(t + 2) * kstep; const char* b2 = last ? nB : cB + (size_t)(t + 2) * kstep;
            const char* a3 = a2 + kstep; const char* b3 = b2 + kstep;
            if (last && has_next) S.a_ready(nxt);
            if constexpr (SP2) {
            PG8_LDB(B0, 0, 0); PG8_LDB(B1, 0, 1); PG8_SCHED; PG8_LDA(At, 0, 0); PG8_STAGE(PG8_SA(1, 1), a1 + hstep, voffA);
            PG8_WAIT_V(8); PG8_WAIT_L(0); PG8_BAR; PG8_MMA(0, 0, At, B0); PG8_MMA(0, 1, At, B1); PG8_BAR; PG8_SCHED;
            PG8_LDA(At, 0, 1); PG8_STAGE(PG8_SB(0, 0), b2, voffB); PG8_STAGE(PG8_SB(0, 1), b2 + hstep, voffB); PG8_STAGE(PG8_SA(0, 0), a2, voffA);
            PG8_WAIT_V(8); PG8_WAIT_L(0); PG8_BAR; PG8_MMA(1, 0, At, B0); PG8_MMA(1, 1, At, B1); PG8_BAR; PG8_SCHED;
            PG8_LDB(B0, 1, 0); PG8_LDB(B1, 1, 1); PG8_SCHED; PG8_LDA(At, 1, 0); PG8_STAGE(PG8_SA(0, 1), a2 + hstep, voffA);
            PG8_WAIT_V(8); PG8_WAIT_L(0); PG8_BAR; PG8_MMA(0, 0, At, B0); PG8_MMA(0, 1, At, B1); PG8_BAR; PG8_SCHED;
            PG8_LDA(At, 1, 1); PG8_STAGE(PG8_SB(1, 0), b3, voffB); PG8_STAGE(PG8_SB(1, 1), b3 + hstep, voffB); PG8_STAGE(PG8_SA(1, 0), a3, voffA);
            PG8_WAIT_V(8); PG8_WAIT_L(0); PG8_BAR; PG8_MMA(1, 0, At, B0); PG8_MMA(1, 1, At, B1); PG8_BAR; PG8_SCHED;
            } else {
            PG8_LDB(B0, 0, 0); PG8_SCHED; PG8_LDA(At, 0, 0); PG8_STAGE(PG8_SA(1, 1), a1 + hstep, voffA);
            PG8_WAIT_L(8); PG8_BAR; PG8_WAIT_L(0); PG8_MMA(0, 0, At, B0); PG8_BAR; PG8_SCHED;
            PG8_LDB(B1, 0, 1); PG8_STAGE(PG8_SB(0, 0), b2, voffB);
            PG8_BAR; PG8_WAIT_L(0); PG8_MMA(0, 1, At, B1); PG8_BAR;
            PG8_LDA(At, 0, 1); PG8_STAGE(PG8_SA(0, 0), a2, voffA);
            PG8_BAR; PG8_WAIT_L(0); PG8_MMA(1, 0, At, B0); PG8_BAR; PG8_SCHED;
            PG8_STAGE(PG8_SB(0, 1), b2 + hstep, voffB);
            PG8_WAIT_V(6); PG8_BAR; PG8_MMA(1, 1, At, B1); PG8_BAR;
            PG8_LDB(B0, 1, 0); PG8_SCHED; PG8_LDA(At, 1, 0); PG8_STAGE(PG8_SA(0, 1), a2 + hstep, voffA);
            PG8_WAIT_L(8); PG8_BAR; PG8_WAIT_L(0); PG8_MMA(0, 0, At, B0); PG8_BAR; PG8_SCHED;
            PG8_LDB(B1, 1, 1); PG8_STAGE(PG8_SB(1, 0), b3, voffB);
            PG8_BAR; PG8_WAIT_L(0); PG8_MMA(0, 1, At, B1); PG8_BAR;
            PG8_LDA(At, 1, 1); PG8_STAGE(PG8_SA(1, 0), a3, voffA);
            PG8_BAR; PG8_WAIT_L(0); PG8_MMA(1, 0, At, B0); PG8_BAR; PG8_SCHED;
            PG8_STAGE(PG8_SB(1, 1), b3 + hstep, voffB);
            PG8_WAIT_V(6); PG8_BAR; PG8_MMA(1, 1, At, B1); PG8_BAR;
            }
        }
        if constexpr (ALIGN_EPI) { if (wr == 0) PG8_BAR; }
        if constexpr (!Epi::AFTER_DRAIN) { E(acc, cur, wr, wc, fr, fq); S.done(cur); }
        if (!has_next) break;
#pragma unroll
        for (int a = 0; a < 2; ++a)
#pragma unroll
            for (int b = 0; b < 2; ++b)
#pragma unroll
                for (int m = 0; m < 4; ++m)
#pragma unroll
                    for (int n = 0; n < 2; ++n) acc[a][b][m][n] = (f32x4){0.f, 0.f, 0.f, 0.f};
        cur = nxt; cA = nA; cB = nB; ++ui;
        if constexpr (ALIGN_EPI) { if (wr == 1) PG8_BAR; }
    }
    PG8_WAIT_V(0);
    if constexpr (!ALIGN_EPI) { if (wr == 0) PG8_BAR; }
    PG8_BAR;
    if constexpr (Epi::AFTER_DRAIN) { E.fused(acc, cur, wr, wc, fr, fq, lds, wid, lane); S.done(cur); }
#undef PG8_SA
#undef PG8_SB
#undef PG8_STAGE
#undef PG8_LDA
#undef PG8_LDB
#undef PG8_MMA
#undef PG8_WAIT_V
#undef PG8_WAIT_L
#undef PG8_BAR
#undef PG8_SCHED
}
}
#define LAS __attribute__((address_space(3)))
#define XB_TMO      128
#define XB_XCNT(j)  (256  + 64 * (j))
#define XB_XSUB(j)  (1280 + 64 * (j))
#define XB_XGEN(j)  (2304 + 64 * (j))
#define XB_TOP      3328
#define XB_TOPGEN   3392
#define XCD_BAR_WORDS 3456
#define XB_SPIN_CAP (1u << 18)

__device__ __forceinline__ unsigned xb_ld(unsigned* p)              { return __hip_atomic_load(p, __ATOMIC_RELAXED, __HIP_MEMORY_SCOPE_AGENT); }
__device__ __forceinline__ unsigned xb_add(unsigned* p, unsigned v) { return __hip_atomic_fetch_add(p, v, __ATOMIC_RELAXED, __HIP_MEMORY_SCOPE_AGENT); }
__device__ __forceinline__ unsigned xb_xcc_id() { return (unsigned)__builtin_amdgcn_s_getreg((3 << 11) | 20) & 0xFu; }
#define XB_SPIN(cond, bar) do { unsigned _sp = 0; while (cond) { __builtin_amdgcn_s_sleep(1); \
    if ((++_sp & 255u) == 0u) { if (xb_ld(&(bar)[XB_TMO])) break; if (_sp > XB_SPIN_CAP) { atomicAdd(&(bar)[XB_TMO], 1u); break; } } } } while (0)

struct XcdBarrier {
    unsigned* bar; unsigned x;
    volatile LAS unsigned* st;
};

__device__ __forceinline__ XcdBarrier xcd_barrier_post(unsigned* bar, volatile LAS unsigned* st) {
    XcdBarrier b; b.bar = bar; b.x = xb_xcc_id(); b.st = st;
    if (threadIdx.x == 0) (void)xb_add(&bar[XB_XCNT(b.x)], 1u);
    return b;
}
__device__ __forceinline__ void xcd_barrier_complete(unsigned* bar, unsigned x, unsigned& nloc, unsigned& nx) {
    const unsigned G = gridDim.x * gridDim.y * gridDim.z;
    unsigned sum, cnt, mine, sp = 0u;
    for (;;) {
        sum = 0u; cnt = 0u; mine = 0u;
#pragma unroll
        for (unsigned j = 0; j < 16; ++j) { const unsigned c = xb_ld(&bar[XB_XCNT(j)]); sum += c; cnt += (c > 0u) ? 1u : 0u; mine = (j == x) ? c : mine; }
        if (sum == G) break;
        __builtin_amdgcn_s_sleep(1);
        if ((++sp & 255u) == 0u) { if (xb_ld(&bar[XB_TMO])) break; if (sp > XB_SPIN_CAP) { atomicAdd(&bar[XB_TMO], 1u); break; } }
    }
    nloc = mine > 0u ? mine : 1u; nx = cnt > 0u ? cnt : 1u;
}

__device__ __forceinline__ void xcd_barrier(const XcdBarrier& b) {
    asm volatile("s_waitcnt vmcnt(0)" ::: "memory");
    __syncthreads();
    if (threadIdx.x == 0) {
        unsigned* bar = b.bar;
        __builtin_amdgcn_s_waitcnt(0);
        unsigned nloc = b.st[0], nx = b.st[1];
        if (nloc == 0u) { xcd_barrier_complete(bar, b.x, nloc, nx); b.st[0] = nloc; b.st[1] = nx; }
        const unsigned old = xb_add(&bar[XB_XSUB(b.x)], 1u);
        const unsigned gen = old / nloc;
        if (old + 1u == (gen + 1u) * nloc) {
            __builtin_amdgcn_fence(__ATOMIC_RELEASE, "agent");
            asm volatile("s_waitcnt vmcnt(0)" ::: "memory");
            const unsigned og = xb_add(&bar[XB_TOP], 1u);
            const unsigned tg = og / nx;
            if (og + 1u == (tg + 1u) * nx) xb_add(&bar[XB_TOPGEN], 1u);
            else XB_SPIN(xb_ld(&bar[XB_TOPGEN]) == tg, bar);
            __builtin_amdgcn_fence(__ATOMIC_ACQUIRE, "agent");
            xb_add(&bar[XB_XGEN(b.x)], 1u);
            asm volatile("s_waitcnt vmcnt(0)" ::: "memory");
        } else {
            XB_SPIN(xb_ld(&bar[XB_XGEN(b.x)]) == gen, bar);
            __builtin_amdgcn_fence(__ATOMIC_ACQUIRE, "agent");
            asm volatile("s_waitcnt vmcnt(0)" ::: "memory");
        }
    }
    __syncthreads();
}

#ifndef MK_DUP
#define MK_DUP 0
#endif
#ifndef MK_PER_PHASE
#define MK_PER_PHASE 0
#endif
#define LAS __attribute__((address_space(3)))
typedef unsigned short bf16;
typedef short bf16x8 __attribute__((ext_vector_type(8)));
typedef short s16x4 __attribute__((ext_vector_type(4)));
typedef float f32x4 __attribute__((ext_vector_type(4)));
typedef float f32x16 __attribute__((ext_vector_type(16)));
typedef unsigned u32x4 __attribute__((ext_vector_type(4)));
typedef unsigned u32x2 __attribute__((ext_vector_type(2)));
typedef float f32x2m __attribute__((ext_vector_type(2)));
#define MFMA32(a, b, c) __builtin_amdgcn_mfma_f32_32x32x16_bf16((a), (b), (c), 0, 0, 0)
#define LDS_WAIT() asm volatile("s_waitcnt lgkmcnt(0)" ::: "memory")

constexpr int NFR = 16384, MT = 16640, D = 1024, FF = 2816, NGU = 5632, NIN = 4608, PBW = 4352, DIN = 4368;
constexpr int NPH = 12;
constexpr int LDS_BYTES = 147456, MISC_OFF = 131072 + 320, CTL_BYTES = 16384;
constexpr size_t MiB = 1u << 20;
constexpr size_t WS_WGU1 = 0, WS_WD1 = 11 * MiB, WS_ST = 0  , WS_WGU2 = 17 * MiB, WS_WD2 = 28 * MiB, WS_WIN = 34 * MiB,
                 WS_WA = 43 * MiB, WS_WB = 44 * MiB, WS_WOUT = 45 * MiB, WS_SSP = 47 * MiB, WS_GLOW = 49 * MiB, WS_DEC = 51 * MiB, WS_CTL = 51 * MiB + MiB / 2  ,
                 WS_HB = 52 * MiB, WS_YA = 52 * MiB, WS_YB = 68 * MiB  , WS_R1 = 85 * MiB  ,
                 WS_KV = 223 * MiB + MiB / 2  , WS_END = 256 * MiB;
static_assert(WS_ST + (size_t)1032 * 8192 * 2 <= WS_WGU2 && WS_R1 + (size_t)MT * PBW * 2 <= WS_KV && WS_KV + (size_t)1032 * 8192 * 4 <= WS_END && WS_HB + (size_t)MT * D * 2 <= WS_R1, "d_ws map");

struct Params { const float* in[20]; float* out; unsigned char* ws; int ph_lo, ph_hi, cg_sync, pad; };

__device__ __forceinline__ int crow(int reg, int h) { return (reg & 3) + 8 * (reg >> 2) + 4 * h; }
__device__ __forceinline__ unsigned f2bf(float f) { unsigned u = __float_as_uint(f); return (u + 0x7fffu + ((u >> 16) & 1u)) >> 16; }
__device__ __forceinline__ unsigned pk2(float lo, float hi) { return f2bf(lo) | (f2bf(hi) << 16); }
__device__ __forceinline__ float wave_sum(float v) {
#pragma unroll
    for (int o = 1; o < 64; o <<= 1) v += __shfl_xor(v, o);
    return v;
}
__device__ __forceinline__ bf16x8 pack8(float a, float b, float c, float d, float e, float f, float g, float h) {
    u32x4 p; p.x = pk2(a, b); p.y = pk2(c, d); p.z = pk2(e, f); p.w = pk2(g, h); return __builtin_bit_cast(bf16x8, p);
}

__device__ __forceinline__ void tr_item(const float* W, int K, int N, int k0, int sn0, int nvalid, const float* gain, bf16* WT, int drow0, LAS float* scr, int lane) {
    const int cl = lane & 31, kh = lane >> 5; const bool cv = cl < nvalid;
#pragma unroll 8
    for (int i = 0; i < 32; ++i) { const int kk = 2 * i + kh; float v = cv ? W[(size_t)(k0 + kk) * N + sn0 + cl] : 0.f; if (gain) v *= gain[k0 + kk]; scr[kk * 33 + cl] = v; }
    LDS_WAIT(); asm volatile("" ::: "memory");
    const int c = lane & 7;
#pragma unroll
    for (int j = 0; j < 4; ++j) { const int n = (lane >> 3) + 8 * j; const LAS float* s = scr + (8 * c) * 33 + n;
        u32x4 o; o.x = pk2(s[0 * 33], s[1 * 33]); o.y = pk2(s[2 * 33], s[3 * 33]); o.z = pk2(s[4 * 33], s[5 * 33]); o.w = pk2(s[6 * 33], s[7 * 33]);
        *(u32x4*)(WT + (size_t)(drow0 + n) * K + k0 + 8 * c) = o; }
    LDS_WAIT(); asm volatile("" ::: "memory");
}
__device__ __forceinline__ void p0_prep(const Params& P, LAS unsigned char* lds, int wave, int lane, int G) {
    unsigned char* ws = P.ws;
    LAS float* scr = (LAS float*)(lds + wave * 16384);
    const int gw = blockIdx.x * 8 + wave, NGW = G * 8;
    constexpr int I_GU = 16 * 88, I_DN = 44 * 32, I_IN = 16 * 144, I_BR = 8 * 32, I_WO = 16 * 32;
    constexpr int NITEMS = 4 * I_GU + 2 * I_DN + I_IN + 2 * I_BR + I_WO;
    for (int it = gw; it < NITEMS; it += NGW) {
        int r = it;
        if (r < 2 * I_GU + I_DN) {
            if (r < 2 * I_GU) { const int up = r >= I_GU; r -= up * I_GU; const int kb = r / 88, n0 = (r % 88) * 32;
                tr_item(up ? P.in[4] : P.in[3], D, FF, kb * 64, n0, 32, P.in[2], (bf16*)(ws + WS_WGU1), (n0 >> 7) * 256 + (n0 & 127) + up * 128, scr, lane); }
            else { r -= 2 * I_GU; tr_item(P.in[5], FF, D, (r / 32) * 64, (r % 32) * 32, 32, nullptr, (bf16*)(ws + WS_WD1), (r % 32) * 32, scr, lane); }
            continue; }
        r -= 2 * I_GU + I_DN;
        if (r < 2 * I_GU + I_DN) {
            if (r < 2 * I_GU) { const int up = r >= I_GU; r -= up * I_GU; const int kb = r / 88, n0 = (r % 88) * 32;
                tr_item(up ? P.in[17] : P.in[16], D, FF, kb * 64, n0, 32, P.in[15], (bf16*)(ws + WS_WGU2), (n0 >> 7) * 256 + (n0 & 127) + up * 128, scr, lane); }
            else { r -= 2 * I_GU; tr_item(P.in[18], FF, D, (r / 32) * 64, (r % 32) * 32, 32, nullptr, (bf16*)(ws + WS_WD2), (r % 32) * 32, scr, lane); }
            continue; }
        r -= 2 * I_GU + I_DN;
        if (r < I_IN) { const int kb = r / 144, d0 = (r % 144) * 32; int sn0, nv;
            if (d0 < 2304) { sn0 = d0; nv = 32; } else if (d0 < 4352) { sn0 = d0 + 16; nv = 32; } else if (d0 == 4352) { sn0 = 2304; nv = 16; } else { sn0 = 0; nv = 0; }
            tr_item(P.in[7], D, DIN, kb * 64, sn0, nv, P.in[6], (bf16*)(ws + WS_WIN), d0, scr, lane); continue; }
        r -= I_IN;
        if (r < I_BR) { tr_item(P.in[12], 512, D, (r / 32) * 64, (r % 32) * 32, 32, nullptr, (bf16*)(ws + WS_WA), (r % 32) * 32, scr, lane); continue; }
        r -= I_BR;
        if (r < I_BR) { tr_item(P.in[13], 512, D, (r / 32) * 64, (r % 32) * 32, 32, nullptr, (bf16*)(ws + WS_WB), (r % 32) * 32, scr, lane); continue; }
        r -= I_BR;
        tr_item(P.in[14], D, D, (r / 32) * 64, (r % 32) * 32, 32, nullptr, (bf16*)(ws + WS_WOUT), (r % 32) * 32, scr, lane);
    }
    bf16* hb = (bf16*)(ws + WS_HB); float* ssp = (float*)(ws + WS_SSP);
    for (int m = gw; m < MT; m += NGW) {
        const float* src = m < NFR ? P.in[0] + (size_t)m * D : (m < NFR + 16 ? P.in[1] + (size_t)(m - NFR) * D : nullptr);
        f32x4 v[4]; float s = 0.f;
#pragma unroll
        for (int j = 0; j < 4; ++j) { v[j] = src ? ((const f32x4*)src)[lane + 64 * j] : (f32x4){0.f, 0.f, 0.f, 0.f}; s += (v[j][0] * v[j][0] + v[j][1] * v[j][1]) + (v[j][2] * v[j][2] + v[j][3] * v[j][3]); }
        s = wave_sum(s);
        u32x2* o8 = (u32x2*)(hb + (size_t)m * D) + lane;
#pragma unroll
        for (int j = 0; j < 4; ++j) { u32x2 w; w.x = pk2(v[j][0], v[j][1]); w.y = pk2(v[j][2], v[j][3]); o8[64 * j] = w; }
        if (lane < 16) ssp[(size_t)m * 16 + lane] = lane == 0 ? s : 0.f;
    }
}

constexpr int A_KS = 0, A_VT = 32256, A_VTS = 228;
__device__ __forceinline__ void attn_item(const Params& P, LAS unsigned char* L, int item, int tid, int wave, int lane) {
    const bf16* PB = (const bf16*)(P.ws + WS_R1); bf16* ya = (bf16*)(P.ws + WS_YA);
    const int kvh = item & 1, c = (item >> 1) & 127, b = item >> 8;
#pragma unroll
    for (int i = 0; i < 4; ++i) {
        const int key = (tid & 63) + 64 * i;
        if (key < 224) {
            bool valid; int row;
            if (key < 16) { valid = true; row = NFR + key; }
            else if (key < 32) { valid = false; row = 0; }
            else { const int ki = c * 64 - 128 + (key - 32); valid = ki >= 0; row = b * 8192 + (valid ? ki : 0); }
            u32x4 kk = (u32x4){0u, 0u, 0u, 0u}, vv = (u32x4){0u, 0u, 0u, 0u};
            if (valid) { const bf16* p = PB + (size_t)row * PBW + 512 + kvh * 64 + wave * 8; kk = *(const u32x4*)p; vv = *(const u32x4*)(p + 128); }
            *(LAS u32x4*)(L + A_KS + key * 144 + wave * 16) = kk;
            LAS unsigned short* vt = (LAS unsigned short*)(L + A_VT) + (wave * 8) * A_VTS + key;
            vt[0 * A_VTS] = (unsigned short)(vv.x & 0xffffu); vt[1 * A_VTS] = (unsigned short)(vv.x >> 16);
            vt[2 * A_VTS] = (unsigned short)(vv.y & 0xffffu); vt[3 * A_VTS] = (unsigned short)(vv.y >> 16);
            vt[4 * A_VTS] = (unsigned short)(vv.z & 0xffffu); vt[5 * A_VTS] = (unsigned short)(vv.z >> 16);
            vt[6 * A_VTS] = (unsigned short)(vv.w & 0xffffu); vt[7 * A_VTS] = (unsigned short)(vv.w >> 16);
        }
    }
    __syncthreads();
    const int g = wave >> 1, pos0 = (wave & 1) * 32, h = kvh * 4 + g, r = lane & 31, hi = lane >> 5;
    const int qrow = b * 8192 + c * 64 + pos0 + r;
    bf16x8 q[4];
#pragma unroll
    for (int s = 0; s < 4; ++s) q[s] = *(const bf16x8*)(PB + (size_t)qrow * PBW + h * 64 + 16 * s + 8 * hi);
    f32x16 S[7];
#pragma unroll
    for (int kt = 0; kt < 7; ++kt) {
#pragma unroll
        for (int i = 0; i < 16; ++i) S[kt][i] = 0.f;
#pragma unroll
        for (int s = 0; s < 4; ++s) { const bf16x8 a = *(const LAS bf16x8*)(L + A_KS + (kt * 32 + r) * 144 + (16 * s + 8 * hi) * 2); S[kt] = MFMA32(a, q[s], S[kt]); }
        asm volatile("" ::: "memory");
    }
    __builtin_amdgcn_sched_barrier(0);
    const float slope = exp2f(-(float)(h + 1)), sink = P.in[11][h];
    const float NEG = -__builtin_inff();
    float m = sink;
#pragma unroll
    for (int i = 0; i < 16; ++i) { if (i >= 8) S[0][i] = NEG; else m = fmaxf(m, S[0][i]); }
    int oz; asm volatile("v_mov_b32 %0, 0" : "=v"(oz));
    const int smin = 128 - 64 * c, pq = pos0 + r + 128 + oz;
#pragma unroll
    for (int kt = 1; kt < 7; ++kt) {
#pragma unroll
        for (int i = 0; i < 16; ++i) { const int s = (kt - 1) * 32 + crow(i, hi); float v = S[kt][i] - slope * fabsf((float)(pq - s)); if (s < smin) v = NEG; S[kt][i] = v; m = fmaxf(m, v); }
        __builtin_amdgcn_sched_barrier(0);
    }
    m = fmaxf(m, __shfl_xor(m, 32));
    __builtin_amdgcn_sched_barrier(0);
    float sum = 0.f; const float ml = m * 1.44269504f;
    bf16x8 pbv[7][2];
#pragma unroll
    for (int kt = 0; kt < 7; ++kt) {
#pragma unroll
        for (int i = 0; i < 16; ++i) { const float p = __builtin_amdgcn_exp2f(S[kt][i] * 1.44269504f - ml); S[kt][i] = p; sum += p; }
        pbv[kt][0] = pack8(S[kt][0], S[kt][1], S[kt][2], S[kt][3], S[kt][4], S[kt][5], S[kt][6], S[kt][7]);
        pbv[kt][1] = pack8(S[kt][8], S[kt][9], S[kt][10], S[kt][11], S[kt][12], S[kt][13], S[kt][14], S[kt][15]);
    }
    __builtin_amdgcn_sched_barrier(0);
    sum += __shfl_xor(sum, 32); sum += exp2f(sink * 1.44269504f - ml);
    const float inv = 1.0f / sum;
    f32x16 O[2];
#pragma unroll
    for (int i = 0; i < 16; ++i) { O[0][i] = 0.f; O[1][i] = 0.f; }
#pragma unroll
    for (int kt = 0; kt < 7; ++kt)
#pragma unroll
        for (int s2 = 0; s2 < 2; ++s2) {
            const bf16x8 pb = pbv[kt][s2];
#pragma unroll
            for (int dt = 0; dt < 2; ++dt) {
                const LAS unsigned char* vp = L + A_VT + ((dt * 32 + r) * A_VTS + kt * 32 + 16 * s2 + 4 * hi) * 2;
                const s16x4 lo = *(const LAS s16x4*)vp, h4 = *(const LAS s16x4*)(vp + 16);
                const bf16x8 va = __builtin_shufflevector(lo, h4, 0, 1, 2, 3, 4, 5, 6, 7);
                O[dt] = MFMA32(va, pb, O[dt]);
            }
            asm volatile("" ::: "memory");
        }
#pragma unroll
    for (int dt = 0; dt < 2; ++dt)
#pragma unroll
        for (int g4 = 0; g4 < 4; ++g4) {
            u32x2 w; w.x = pk2(O[dt][4 * g4] * inv, O[dt][4 * g4 + 1] * inv); w.y = pk2(O[dt][4 * g4 + 2] * inv, O[dt][4 * g4 + 3] * inv);
            *(u32x2*)(ya + (size_t)qrow * 512 + h * 64 + dt * 32 + 8 * g4 + 4 * hi) = w;
        }
    __syncthreads();
}

constexpr int G_QE = 0, G_KE = 9216, G_K2T = 18432, G_VT = 27648, G_ST = 46080, G_SEG = 64512, G_SS = 66560, G_GL = 67584;
template <bool KV> __device__ __forceinline__ void gla_prep(const Params& P, LAS unsigned char* L, int b, int h, int j, int tid) {
    const bf16* PB = (const bf16*)(P.ws + WS_R1); const float* glow = (const float*)(P.ws + WS_GLOW);
    const int d = tid & 63, seg = tid >> 6;
    float gw[16];
#pragma unroll
    for (int r = 0; r < 16; ++r) gw[r] = P.in[8][r * 256 + h * 64 + d];
    const float bias = P.in[9][h * 64 + d];
    {
      const int pos = tid >> 3, e2 = (tid & 7) * 2; const bool valid = (j > 0) || (pos >= 48);
      const int row = valid ? (j == 0 ? NFR + pos - 48 : b * 8192 + (j - 1) * 64 + pos) : NFR;
      *(LAS f32x2m*)(L + G_GL + (pos * 16 + e2) * 4) = *(const f32x2m*)(glow + (size_t)row * 16 + e2); }
    __syncthreads();
    float cs[8], qv[8], kv[8]; float run = 0.f;
#pragma unroll
    for (int p = 0; p < 8; ++p) {
        const int pos = seg * 8 + p; const bool valid = (j > 0) || (pos >= 48);
        const int row = valid ? (j == 0 ? NFR + pos - 48 : b * 8192 + (j - 1) * 64 + pos) : NFR;
        const LAS f32x4* gl = (const LAS f32x4*)(L + G_GL + pos * 64);
        const f32x4 g0 = gl[0], g1 = gl[1], g2 = gl[2], g3 = gl[3];
        float z = bias;
#pragma unroll
        for (int e = 0; e < 4; ++e) { z += g0[e] * gw[e]; z += g1[e] * gw[4 + e]; z += g2[e] * gw[8 + e]; z += g3[e] * gw[12 + e]; }
        float la = (fminf(z, 0.f) - __logf(1.0f + __expf(-fabsf(z)))) * 0.0625f;
        if (!valid) la = 0.f;
        run += la; cs[p] = run;
        const bf16* pr = PB + (size_t)row * PBW + h * 64 + d;
        qv[p] = valid ? pg8::bf2f(pr[768]) : 0.f; kv[p] = valid ? pg8::bf2f(pr[1024]) : 0.f;
        if (p & 1) __builtin_amdgcn_sched_barrier(0);
    }
    LAS float* SEG = (LAS float*)(L + G_SEG);
    SEG[seg * 64 + d] = run;
    __syncthreads();
    float off = 0.f, tot = 0.f;
#pragma unroll
    for (int s = 0; s < 8; ++s) { const float v = SEG[s * 64 + d]; tot += v; if (s < seg) off += v; }
    LAS unsigned short* QE = (LAS unsigned short*)(L + G_QE); LAS unsigned short* KE = (LAS unsigned short*)(L + G_KE);
    float k2[8];
#pragma unroll
    for (int p = 0; p < 8; ++p) {
        const int pos = seg * 8 + p; const float bb = off + cs[p];
        QE[pos * 72 + d] = (unsigned short)f2bf(qv[p] * __expf(bb));
        KE[pos * 72 + d] = (unsigned short)f2bf(kv[p] * __expf(-bb));
        k2[p] = kv[p] * __expf(tot - bb);
    }
    if (KV) {
        *(LAS bf16x8*)(L + G_K2T + (d * 72 + seg * 8) * 2) = pack8(k2[0], k2[1], k2[2], k2[3], k2[4], k2[5], k2[6], k2[7]);
        if (seg == 0) ((float*)(P.ws + WS_DEC))[(size_t)((b * 4 + h) * 129 + j) * 64 + d] = __expf(tot);
    }
}
__device__ __forceinline__ void gla_stage_v(const Params& P, LAS unsigned char* L, int b, int h, int j, int tid) {
    const bf16* PB = (const bf16*)(P.ws + WS_R1);
    const int pos = tid & 63, dvg = tid >> 6; const bool valid = (j > 0) || (pos >= 48);
    const int row = valid ? (j == 0 ? NFR + pos - 48 : b * 8192 + (j - 1) * 64 + pos) : NFR;
    u32x4 a = (u32x4){0u, 0u, 0u, 0u}, c = a;
    if (valid) { const bf16* p = PB + (size_t)row * PBW + 1280 + h * 128 + dvg * 16; a = *(const u32x4*)p; c = *(const u32x4*)(p + 8); }
    LAS unsigned short* vt = (LAS unsigned short*)(L + G_VT) + (dvg * 16) * 72 + pos;
    vt[0 * 72] = (unsigned short)(a.x & 0xffffu); vt[1 * 72] = (unsigned short)(a.x >> 16); vt[2 * 72] = (unsigned short)(a.y & 0xffffu); vt[3 * 72] = (unsigned short)(a.y >> 16);
    vt[4 * 72] = (unsigned short)(a.z & 0xffffu); vt[5 * 72] = (unsigned short)(a.z >> 16); vt[6 * 72] = (unsigned short)(a.w & 0xffffu); vt[7 * 72] = (unsigned short)(a.w >> 16);
    vt[8 * 72] = (unsigned short)(c.x & 0xffffu); vt[9 * 72] = (unsigned short)(c.x >> 16); vt[10 * 72] = (unsigned short)(c.y & 0xffffu); vt[11 * 72] = (unsigned short)(c.y >> 16);
    vt[12 * 72] = (unsigned short)(c.z & 0xffffu); vt[13 * 72] = (unsigned short)(c.z >> 16); vt[14 * 72] = (unsigned short)(c.w & 0xffffu); vt[15 * 72] = (unsigned short)(c.w >> 16);
}
__device__ __forceinline__ void gla_kv_item(const Params& P, LAS unsigned char* L, int item, int tid, int wave, int lane) {
    const int j = item % 129, bh = item / 129, h = bh & 3, b = bh >> 2;
    gla_prep<true>(P, L, b, h, j, tid);
    gla_stage_v(P, L, b, h, j, tid);
    __syncthreads();
    const int dvt = wave >> 1, dkt = wave & 1, r = lane & 31, hi = lane >> 5;
    f32x16 acc;
#pragma unroll
    for (int i = 0; i < 16; ++i) acc[i] = 0.f;
#pragma unroll
    for (int s = 0; s < 4; ++s) {
        const bf16x8 a = *(const LAS bf16x8*)(L + G_VT + ((dvt * 32 + r) * 72 + 16 * s + 8 * hi) * 2);
        const bf16x8 bb = *(const LAS bf16x8*)(L + G_K2T + ((dkt * 32 + r) * 72 + 16 * s + 8 * hi) * 2);
        acc = MFMA32(a, bb, acc);
    }
    float* kvg = (float*)(P.ws + WS_KV) + (size_t)item * 8192;
#pragma unroll
    for (int i = 0; i < 16; ++i) kvg[(dvt * 32 + crow(i, hi)) * 64 + dkt * 32 + r] = acc[i];
    __syncthreads();
}
__device__ __forceinline__ void gla_scan(const Params& P, int wave, int lane, int G) {
    const float* kvg = (const float*)(P.ws + WS_KV); const float* dec = (const float*)(P.ws + WS_DEC); bf16* st = (bf16*)(P.ws + WS_ST);
    for (int wv = wave * G + blockIdx.x; wv < 1024; wv += G * 8) {
        const int gidx = wv * 64 + lane, bh = gidx >> 13, e = gidx & 8191, dk = e & 63;
        const size_t base = (size_t)bh * 129;
        float S = 0.f;
        for (int j0 = 0; j0 < 128; j0 += 8) {
            float kvv[8], dd[8];
#pragma unroll
            for (int u = 0; u < 8; ++u) { kvv[u] = kvg[(base + j0 + u) * 8192 + e]; dd[u] = dec[(base + j0 + u) * 64 + dk]; }
#pragma unroll
            for (int u = 0; u < 8; ++u) { S = dd[u] * S + kvv[u]; st[(base + j0 + u + 1) * 8192 + e] = (bf16)f2bf(S); }
        }
    }
}
__device__ __forceinline__ void gla_out_item(const Params& P, LAS unsigned char* L, int item  , int tid, int wave, int lane) {
    const int j = (item & 127) + 1, bh = item >> 7, h = bh & 3, b = bh >> 2;
    const bf16* PB = (const bf16*)(P.ws + WS_R1); bf16* yb = (bf16*)(P.ws + WS_YB);
    gla_prep<false>(P, L, b, h, j, tid);
    gla_stage_v(P, L, b, h, j, tid);
    { const bf16* sg = (const bf16*)(P.ws + WS_ST) + (size_t)(bh * 129 + j) * 8192; const int dv = tid >> 2, part = tid & 3;
      const u32x4 a = *(const u32x4*)(sg + dv * 64 + part * 16), c = *(const u32x4*)(sg + dv * 64 + part * 16 + 8);
      *(LAS u32x4*)(L + G_ST + (dv * 72 + part * 16) * 2) = a; *(LAS u32x4*)(L + G_ST + (dv * 72 + part * 16 + 8) * 2) = c; }
    __syncthreads();
    const int it = wave & 1, dvt = wave >> 1, r = lane & 31, hi = lane >> 5;
    bf16x8 qf[4];
#pragma unroll
    for (int s = 0; s < 4; ++s) qf[s] = *(const LAS bf16x8*)(L + G_QE + ((it * 32 + r) * 72 + 16 * s + 8 * hi) * 2);
    f32x16 o;
#pragma unroll
    for (int i = 0; i < 16; ++i) o[i] = 0.f;
#pragma unroll
    for (int jt = 0; jt < 2; ++jt) {
        if (jt <= it) {
            f32x16 at;
#pragma unroll
            for (int i = 0; i < 16; ++i) at[i] = 0.f;
#pragma unroll
            for (int s = 0; s < 4; ++s) { const bf16x8 a = *(const LAS bf16x8*)(L + G_KE + ((jt * 32 + r) * 72 + 16 * s + 8 * hi) * 2); at = MFMA32(a, qf[s], at); }
            if (jt == it) {
#pragma unroll
                for (int i = 0; i < 16; ++i) if (crow(i, hi) > r) at[i] = 0.f;
            }
#pragma unroll
            for (int s2 = 0; s2 < 2; ++s2) {
                const bf16x8 pb = pack8(at[8 * s2], at[8 * s2 + 1], at[8 * s2 + 2], at[8 * s2 + 3], at[8 * s2 + 4], at[8 * s2 + 5], at[8 * s2 + 6], at[8 * s2 + 7]);
                const LAS unsigned char* vp = L + G_VT + ((dvt * 32 + r) * 72 + jt * 32 + 16 * s2 + 4 * hi) * 2;
                const s16x4 lo = *(const LAS s16x4*)vp, h4 = *(const LAS s16x4*)(vp + 16);
                o = MFMA32(__builtin_shufflevector(lo, h4, 0, 1, 2, 3, 4, 5, 6, 7), pb, o);
            }
        }
    }
#pragma unroll
    for (int s = 0; s < 4; ++s) { const bf16x8 a = *(const LAS bf16x8*)(L + G_ST + ((dvt * 32 + r) * 72 + 16 * s + 8 * hi) * 2); o = MFMA32(a, qf[s], o); }
    float ss = 0.f;
#pragma unroll
    for (int i = 0; i < 16; ++i) ss += o[i] * o[i];
    ss += __shfl_xor(ss, 32);
    LAS float* SS = (LAS float*)(L + G_SS);
    if (hi == 0) SS[dvt * 64 + it * 32 + r] = ss;
    __syncthreads();
    const float tot = (SS[it * 32 + r] + SS[64 + it * 32 + r]) + (SS[128 + it * 32 + r] + SS[192 + it * 32 + r]);
    const float rstd = __builtin_amdgcn_rsqf(tot * (1.0f / 128.0f) + 1e-6f);
    const int row = b * 8192 + (j - 1) * 64 + it * 32 + r;
#pragma unroll
    for (int g4 = 0; g4 < 4; ++g4) {
        const int dv0 = dvt * 32 + 8 * g4 + 4 * hi;
        const f32x4 gn = *(const f32x4*)(P.in[10] + dv0);
        const u32x2 gr = *(const u32x2*)(PB + (size_t)row * PBW + 1792 + h * 128 + dv0);
        u32x2 w;
        w.x = pk2(o[4 * g4] * rstd * gn[0] * pg8::bflo(gr.x), o[4 * g4 + 1] * rstd * gn[1] * pg8::bfhi(gr.x));
        w.y = pk2(o[4 * g4 + 2] * rstd * gn[2] * pg8::bflo(gr.y), o[4 * g4 + 3] * rstd * gn[3] * pg8::bfhi(gr.y));
        *(u32x2*)(yb + (size_t)row * 512 + h * 128 + dv0) = w;
    }
    __syncthreads();
}

__global__ void __launch_bounds__(512, 2) mega_fwd(Params P) {
    extern __shared__ __attribute__((aligned(16))) unsigned char lds_raw[];
    LAS unsigned char* lds = (LAS unsigned char*)lds_raw;
    cg::grid_group grid = cg::this_grid();
    const int tid = threadIdx.x, lane = tid & 63, wave = __builtin_amdgcn_readfirstlane(tid >> 6), G = gridDim.x;
    unsigned char* ws = P.ws;
    const int lo = P.ph_lo, hi = P.ph_hi;
    if (tid < 32) ((LAS unsigned*)(lds + MISC_OFF))[tid] = 0u;
    __syncthreads();
    XcdBarrier bar = xcd_barrier_post((unsigned*)(ws + WS_CTL), (volatile LAS unsigned*)(lds + MISC_OFF) + 8);
#define IN(k) (lo <= (k) && (k) < hi)
#define GSYNC() do { if (P.cg_sync) grid.sync(); else xcd_barrier(bar); } while (0)
#define SEAM(k) do { if (IN(k) && IN((k) + 1)) GSYNC(); } while (0)
#define DUPQ(k) ((MK_DUP >> (k)) & 1)
    bf16* hb = (bf16*)(ws + WS_HB); float* ssp = (float*)(ws + WS_SSP); bf16* R1 = (bf16*)(ws + WS_R1);

    if (IN(0)) {
        p0_prep(P, lds, wave, lane, G);
#if (MK_DUP >> 0) & 1
        GSYNC();
        p0_prep(P, lds, wave, lane, G);
#endif
    }
    SEAM(0);
    if (IN(1)) {
        {
        pg8::Gemm g{hb, (const bf16*)(ws + WS_WGU1), MT, NGU, D}; pg8::StaticOrder S; S.init(MT, NGU, G, (int)blockIdx.x);
        pg8::EpiSwiglu E{R1, ssp};
        pg8::gemm_phase<pg8::EpiSwiglu, pg8::StaticOrder, true, true>(lds, g, S, E);
    }
#if (MK_DUP >> 1) & 1
        GSYNC();
        {
        pg8::Gemm g{hb, (const bf16*)(ws + WS_WGU1), MT, NGU, D}; pg8::StaticOrder S; S.init(MT, NGU, G, (int)blockIdx.x);
        pg8::EpiSwiglu E{R1, ssp};
        pg8::gemm_phase<pg8::EpiSwiglu, pg8::StaticOrder, true, true>(lds, g, S, E);
    }
#endif
    }
    SEAM(1);
    if (IN(2)) {
        {
        pg8::Gemm g{R1, (const bf16*)(ws + WS_WD1), MT, D, FF}; pg8::StaticOrder S; S.init(MT, D, G, (int)blockIdx.x);
        pg8::EpiResid E{P.in[0], P.in[1], P.out, hb, ssp, 0.5f};
        pg8::gemm_phase<pg8::EpiResid, pg8::StaticOrder, true, true>(lds, g, S, E);
    }
#if (MK_DUP >> 2) & 1
        GSYNC();
        {
        pg8::Gemm g{R1, (const bf16*)(ws + WS_WD1), MT, D, FF}; pg8::StaticOrder S; S.init(MT, D, G, (int)blockIdx.x);
        pg8::EpiResid E{P.in[0], P.in[1], P.out, hb, ssp, 0.5f};
        pg8::gemm_phase<pg8::EpiResid, pg8::StaticOrder, true, true>(lds, g, S, E);
    }
#endif
    }
    SEAM(2);
    if (IN(3)) {
        {
        pg8::Gemm g{hb, (const bf16*)(ws + WS_WIN), MT, NIN, D}; pg8::StaticOrder S; S.init(MT, NIN, G, (int)blockIdx.x);
        pg8::EpiIn E{R1, (float*)(ws + WS_GLOW), ssp};
        pg8::gemm_phase<pg8::EpiIn, pg8::StaticOrder, true, true>(lds, g, S, E);
    }
#if (MK_DUP >> 3) & 1
        GSYNC();
        {
        pg8::Gemm g{hb, (const bf16*)(ws + WS_WIN), MT, NIN, D}; pg8::StaticOrder S; S.init(MT, NIN, G, (int)blockIdx.x);
        pg8::EpiIn E{R1, (float*)(ws + WS_GLOW), ssp};
        pg8::gemm_phase<pg8::EpiIn, pg8::StaticOrder, true, true>(lds, g, S, E);
    }
#endif
    }
    SEAM(3);
    if (IN(4)) {
        {
        for (int it = blockIdx.x; it < 512; it += G) attn_item(P, lds, it, tid, wave, lane);
        for (int it = blockIdx.x; it < 1032; it += G) gla_kv_item(P, lds, it, tid, wave, lane);
    }
#if (MK_DUP >> 4) & 1
        GSYNC();
        {
        for (int it = blockIdx.x; it < 512; it += G) attn_item(P, lds, it, tid, wave, lane);
        for (int it = blockIdx.x; it < 1032; it += G) gla_kv_item(P, lds, it, tid, wave, lane);
    }
#endif
    }
    SEAM(4);
    if (IN(5)) {
        gla_scan(P, wave, lane, G);
#if (MK_DUP >> 5) & 1
        GSYNC();
        gla_scan(P, wave, lane, G);
#endif
    }
    SEAM(5);
    if (IN(6)) {
        { for (int it = blockIdx.x; it < 1024; it += G) gla_out_item(P, lds, it, tid, wave, lane); }
#if (MK_DUP >> 6) & 1
        GSYNC();
        { for (int it = blockIdx.x; it < 1024; it += G) gla_out_item(P, lds, it, tid, wave, lane); }
#endif
    }
    SEAM(6);
    if (IN(7)) {
        {
        bf16* mixed = (bf16*)(ws + WS_KV);
        { pg8::Gemm g{(const bf16*)(ws + WS_YA), (const bf16*)(ws + WS_WA), NFR, D, 512}; pg8::StaticOrder S; S.init(NFR, D, G, (int)blockIdx.x);
          pg8::EpiMix<false> E{R1 + 2304, mixed};
          pg8::gemm_phase<pg8::EpiMix<false>, pg8::StaticOrder, true, true>(lds, g, S, E); }
        { pg8::Gemm g{(const bf16*)(ws + WS_YB), (const bf16*)(ws + WS_WB), NFR, D, 512}; pg8::StaticOrder S; S.init(NFR, D, G, (int)blockIdx.x);
          pg8::EpiMix<true> E{R1 + 3328, mixed};
          pg8::gemm_phase<pg8::EpiMix<true>, pg8::StaticOrder, true, true>(lds, g, S, E); }
    }
#if (MK_DUP >> 7) & 1
        GSYNC();
        {
        bf16* mixed = (bf16*)(ws + WS_KV);
        { pg8::Gemm g{(const bf16*)(ws + WS_YA), (const bf16*)(ws + WS_WA), NFR, D, 512}; pg8::StaticOrder S; S.init(NFR, D, G, (int)blockIdx.x);
          pg8::EpiMix<false> E{R1 + 2304, mixed};
          pg8::gemm_phase<pg8::EpiMix<false>, pg8::StaticOrder, true, true>(lds, g, S, E); }
        { pg8::Gemm g{(const bf16*)(ws + WS_YB), (const bf16*)(ws + WS_WB), NFR, D, 512}; pg8::StaticOrder S; S.init(NFR, D, G, (int)blockIdx.x);
          pg8::EpiMix<true> E{R1 + 3328, mixed};
          pg8::gemm_phase<pg8::EpiMix<true>, pg8::StaticOrder, true, true>(lds, g, S, E); }
    }
#endif
    }
    SEAM(7);
    if (IN(8)) {
        {
        pg8::Gemm g{(const bf16*)(ws + WS_KV), (const bf16*)(ws + WS_WOUT), NFR, D, D}; pg8::StaticOrder S; S.init(NFR, D, G, (int)blockIdx.x);
        pg8::EpiResid E{P.out, P.in[1], P.out, hb, ssp, 1.0f};
        pg8::gemm_phase<pg8::EpiResid, pg8::StaticOrder, true, true>(lds, g, S, E);
    }
#if (MK_DUP >> 8) & 1
        GSYNC();
        {
        pg8::Gemm g{(const bf16*)(ws + WS_KV), (const bf16*)(ws + WS_WOUT), NFR, D, D}; pg8::StaticOrder S; S.init(NFR, D, G, (int)blockIdx.x);
        pg8::EpiResid E{P.out, P.in[1], P.out, hb, ssp, 1.0f};
        pg8::gemm_phase<pg8::EpiResid, pg8::StaticOrder, true, true>(lds, g, S, E);
    }
#endif
    }
    SEAM(8);
    if (IN(9)) {
        {
        pg8::Gemm g{hb, (const bf16*)(ws + WS_WGU2), NFR, NGU, D}; pg8::StaticOrder S; S.init(NFR, NGU, G, (int)blockIdx.x);
        pg8::EpiSwiglu E{R1, ssp};
        pg8::gemm_phase<pg8::EpiSwiglu, pg8::StaticOrder, true, true>(lds, g, S, E);
    }
#if (MK_DUP >> 9) & 1
        GSYNC();
        {
        pg8::Gemm g{hb, (const bf16*)(ws + WS_WGU2), NFR, NGU, D}; pg8::StaticOrder S; S.init(NFR, NGU, G, (int)blockIdx.x);
        pg8::EpiSwiglu E{R1, ssp};
        pg8::gemm_phase<pg8::EpiSwiglu, pg8::StaticOrder, true, true>(lds, g, S, E);
    }
#endif
    }
    SEAM(9);
    if (IN(10)) {
        {
        pg8::Gemm g{R1, (const bf16*)(ws + WS_WD2), NFR, D, FF}; pg8::StaticOrder S; S.init(NFR, D, G, (int)blockIdx.x);
        pg8::EpiResid E{P.out, P.in[1], P.out, nullptr, ssp, 0.5f};
        pg8::gemm_phase<pg8::EpiResid, pg8::StaticOrder, true, true>(lds, g, S, E);
    }
#if (MK_DUP >> 10) & 1
        GSYNC();
        {
        pg8::Gemm g{R1, (const bf16*)(ws + WS_WD2), NFR, D, FF}; pg8::StaticOrder S; S.init(NFR, D, G, (int)blockIdx.x);
        pg8::EpiResid E{P.out, P.in[1], P.out, nullptr, ssp, 0.5f};
        pg8::gemm_phase<pg8::EpiResid, pg8::StaticOrder, true, true>(lds, g, S, E);
    }
#endif
    }
    SEAM(10);
    if (IN(11)) {
        {
        const int gw = blockIdx.x * 8 + wave, NGW = G * 8;
        for (int m = gw; m < NFR; m += NGW) {
            f32x4* rowp = (f32x4*)(P.out + (size_t)m * D) + lane;
            float s = ssp[(size_t)m * 16 + (lane & 15)];
            s += __shfl_xor(s, 1); s += __shfl_xor(s, 2); s += __shfl_xor(s, 4); s += __shfl_xor(s, 8);
            const float rs = __builtin_amdgcn_rsqf(s * (1.0f / 1024.0f) + 1e-6f);
#pragma unroll
            for (int j = 0; j < 4; ++j) { const f32x4 gn = ((const f32x4*)P.in[19])[lane + 64 * j]; f32x4 v = rowp[64 * j]; rowp[64 * j] = v * rs * gn; }
        }
    }
#if (MK_DUP >> 11) & 1
        GSYNC();
        {
        const int gw = blockIdx.x * 8 + wave, NGW = G * 8;
        for (int m = gw; m < NFR; m += NGW) {
            f32x4* rowp = (f32x4*)(P.out + (size_t)m * D) + lane;
            float s = ssp[(size_t)m * 16 + (lane & 15)];
            s += __shfl_xor(s, 1); s += __shfl_xor(s, 2); s += __shfl_xor(s, 4); s += __shfl_xor(s, 8);
            const float rs = __builtin_amdgcn_rsqf(s * (1.0f / 1024.0f) + 1e-6f);
#pragma unroll
            for (int j = 0; j < 4; ++j) { const f32x4 gn = ((const f32x4*)P.in[19])[lane + 64 * j]; f32x4 v = rowp[64 * j]; rowp[64 * j] = v * rs * gn; }
        }
    }
#endif
    }
#if defined(MK_XSYNC)
    for (int xs_ = 0; xs_ < MK_XSYNC; ++xs_) GSYNC();
#endif
#undef IN
#undef SEAM
}

extern "C" void kernel_launch(void* const* d_in, const int* in_sizes, int n_in, void* d_out, int out_size, void* d_ws, size_t ws_size, hipStream_t stream) {
    static int grid = 0;
    if (grid == 0) {
        if (n_in != 20 || out_size != NFR * D || ws_size < WS_END) { fprintf(stderr, "kernel_launch: unexpected shapes (n_in %d out %d ws %zu)\n", n_in, out_size, ws_size); grid = -1; return; }
        int dev = 0, cus = 0, per_cu = 0;
        hipGetDevice(&dev); hipDeviceGetAttribute(&cus, hipDeviceAttributeMultiprocessorCount, dev);
        if (hipFuncSetAttribute((const void*)mega_fwd, hipFuncAttributeMaxDynamicSharedMemorySize, LDS_BYTES) != hipSuccess) { fprintf(stderr, "kernel_launch: hipFuncSetAttribute failed\n"); grid = -1; return; }
        if (hipOccupancyMaxActiveBlocksPerMultiprocessor(&per_cu, (const void*)mega_fwd, 512, LDS_BYTES) != hipSuccess || per_cu < 1) { fprintf(stderr, "kernel_launch: occupancy query failed (%d)\n", per_cu); (void)hipGetLastError(); grid = -1; return; }
        grid = cus * per_cu;
        fprintf(stderr, "kernel_launch: %d CUs x %d blocks -> grid %d\n", cus, per_cu, grid);
    }
    if (grid < 0) return;
    Params p{};
    for (int i = 0; i < 20; ++i) p.in[i] = (const float*)d_in[i];
    p.out = (float*)d_out; p.ws = (unsigned char*)d_ws; p.cg_sync = 0; p.pad = 0;
    if (hipMemsetAsync((char*)d_ws + WS_CTL, 0, CTL_BYTES, stream) != hipSuccess) { fprintf(stderr, "kernel_launch: hipMemsetAsync failed\n"); return; }
#if MK_PER_PHASE
    for (int ph = 0; ph < NPH; ++ph) { p.ph_lo = ph; p.ph_hi = ph + 1; hipLaunchKernelGGL(mega_fwd, dim3(grid), dim3(512), LDS_BYTES, stream, p); }
#else
    p.ph_lo = 0; p.ph_hi = NPH;
    void* args[] = {&p};
    hipError_t e = hipLaunchCooperativeKernel((const void*)mega_fwd, dim3(grid), dim3(512), args, LDS_BYTES, stream);
    if (e != hipSuccess) fprintf(stderr, "kernel_launch: cooperative launch failed: %s (grid %d)\n", hipGetErrorString(e), grid);
#endif
}
```

```cpp
#include <hip/hip_runtime.h>
#include <hip/hip_cooperative_groups.h>
#include <cstdio>
#include <cstdint>
namespace cg = cooperative_groups;
namespace pg8 {
#define PG8_LAS __attribute__((address_space(3)))
typedef unsigned short bf16_t;
typedef short bf16x8 __attribute__((ext_vector_type(8)));
typedef float f32x4 __attribute__((ext_vector_type(4)));
typedef unsigned u32x4 __attribute__((ext_vector_type(4)));
constexpr int BM = 256, BK = 64, HALF = 128, HTB = HALF * BK * 2  , STAGE_BYTES = 8 * HTB, NXCD = 8, WGM = 8;

__host__ __device__ __forceinline__ int lds_byte(int r, int c) { const int st = (r >> 4) * 2 + (c >> 5), rr = r & 15, cc = c & 31, ob = rr * 64 + cc * 2; return st * 1024 + (ob ^ (((ob >> 9) & 1) << 5)); }
__host__ __device__ __forceinline__ void stage_rc(int b, int& R, int& C) { const int st = b / 1024, sb = b % 1024, swz = sb ^ (((sb >> 9) & 1) << 5); R = (st >> 1) * 16 + swz / 64; C = (st & 1) * 32 + (swz % 64) / 2; }
__host__ __device__ __forceinline__ int perm32(int rho) { const int n = rho >> 4, i = rho & 15; return 8 * (i >> 2) + 4 * n + (i & 3); }

struct Unit { int pm, pn; };
struct Gemm { const bf16_t* A; const bf16_t* Bt; int M, N, K; };

struct StaticOrder {
    int nM, nN, nwg, G, c;
    __host__ __device__ void init(int M, int N, int G_, int c_) { nM = M / BM; nN = N / BM; nwg = nM * nN; G = G_; c = c_; }
    __host__ __device__ bool next(int i, Unit& u) const {
        const long L = (long)i * G + c; if (L >= nwg) return false;
        int wgid = (int)L; { const int q = nwg / NXCD, r = nwg % NXCD, xcd = wgid % NXCD, off = wgid / NXCD; wgid = (xcd < r ? xcd * (q + 1) : r * (q + 1) + (xcd - r) * q) + off; }
        const int nig = WGM * nN, gid = wgid / nig, fm = gid * WGM, gsz = (nM - fm) < WGM ? (nM - fm) : WGM;
        u.pm = fm + ((wgid % nig) % gsz); u.pn = (wgid % nig) / gsz; return true;
    }
    __device__ __forceinline__ void a_ready(const Unit&) const {}
    __device__ __forceinline__ void done(const Unit&) const {}
};

__device__ __forceinline__ unsigned cvt_pk_bf16(float lo, float hi) { unsigned r; asm volatile("v_cvt_pk_bf16_f32 %0, %1, %2" : "=v"(r) : "v"(lo), "v"(hi)); return r; }
typedef float f32x2 __attribute__((ext_vector_type(2)));
constexpr int XD = 1024, XFF = 2816, XPBW = 4352, XNFR = 16384;
__device__ __forceinline__ float row_rstd(const float* ssp, int row, int fq) {
    const f32x4 p = *(const f32x4*)(ssp + (size_t)row * 16 + 4 * fq);
    float s = (p[0] + p[1]) + (p[2] + p[3]);
    s += __shfl_xor(s, 16); s += __shfl_xor(s, 32);
    return __builtin_amdgcn_rsqf(s * (1.0f / 1024.0f) + 1e-6f);
}
__device__ __forceinline__ float sigm(float x) { return __builtin_amdgcn_rcpf(1.0f + __expf(-x)); }
__device__ __forceinline__ float bf2f(unsigned short b) { return __uint_as_float((unsigned)b << 16); }
__device__ __forceinline__ float bflo(unsigned w) { return __uint_as_float(w << 16); }
__device__ __forceinline__ float bfhi(unsigned w) { return __uint_as_float(w & 0xffff0000u); }

struct EpiSwiglu {
    static constexpr bool PERM = true, AFTER_DRAIN = false;
    bf16_t* O; const float* ssp;
    __device__ __forceinline__ void operator()(const f32x4 (&acc)[2][2][4][2], const Unit& u, int wr, int wc, int fr, int fq) const {
        const int row0 = u.pm * BM + wr * 64 + fr, col0 = u.pn * HALF + wc * 32 + 8 * fq;
#pragma unroll
        for (int ai = 0; ai < 2; ++ai)
#pragma unroll
            for (int m = 0; m < 4; ++m) {
                const int row = row0 + ai * HALF + m * 16; const float rs = row_rstd(ssp, row, fq);
                const f32x4 g0 = acc[ai][0][m][0] * rs, g1 = acc[ai][0][m][1] * rs, u0 = acc[ai][1][m][0] * rs, u1 = acc[ai][1][m][1] * rs;
                u32x4 w;
                w.x = cvt_pk_bf16(g0[0] * sigm(g0[0]) * u0[0], g0[1] * sigm(g0[1]) * u0[1]);
                w.y = cvt_pk_bf16(g0[2] * sigm(g0[2]) * u0[2], g0[3] * sigm(g0[3]) * u0[3]);
                w.z = cvt_pk_bf16(g1[0] * sigm(g1[0]) * u1[0], g1[1] * sigm(g1[1]) * u1[1]);
                w.w = cvt_pk_bf16(g1[2] * sigm(g1[2]) * u1[2], g1[3] * sigm(g1[3]) * u1[3]);
                *(u32x4*)(O + (size_t)row * XFF + col0) = w;
            }
    }
};

struct EpiResid {
    static constexpr bool PERM = false, AFTER_DRAIN = false;
    const float* base; const float* meta; float* out; bf16_t* hb; float* ssp; float scale;
    __device__ __forceinline__ void operator()(const f32x4 (&acc)[2][2][4][2], const Unit& u, int wr, int wc, int fr, int fq) const {
        typedef unsigned u32x2v __attribute__((ext_vector_type(2)));
        const int row0 = u.pm * BM + wr * 64 + fr, col0 = u.pn * BM + wc * 32 + 4 * fq;
#pragma unroll
        for (int ai = 0; ai < 2; ++ai)
#pragma unroll
            for (int m = 0; m < 4; ++m) {
                const int row = row0 + ai * HALF + m * 16;
                const bool fr_row = row < XNFR, has = row < XNFR + 16;
                const float* bp = fr_row ? base + (size_t)row * XD : meta + (size_t)(has ? row - XNFR : 0) * XD;
                float sq = 0.f;
#pragma unroll
                for (int bj = 0; bj < 2; ++bj)
#pragma unroll
                    for (int n = 0; n < 2; ++n) {
                        const int c = col0 + bj * HALF + n * 16;
                        f32x4 b = *(const f32x4*)(bp + c);
                        if (!has) b = (f32x4){0.f, 0.f, 0.f, 0.f};
                        const f32x4 v = b + acc[ai][bj][m][n] * scale;
                        sq += (v[0] * v[0] + v[1] * v[1]) + (v[2] * v[2] + v[3] * v[3]);
                        if (fr_row) *(f32x4*)(out + (size_t)row * XD + c) = v;
                        if (hb) { u32x2v w; w.x = cvt_pk_bf16(v[0], v[1]); w.y = cvt_pk_bf16(v[2], v[3]); *(u32x2v*)(hb + (size_t)row * XD + c) = w; }
                    }
                sq += __shfl_xor(sq, 16); sq += __shfl_xor(sq, 32);
                if (fq == 0) ssp[(size_t)row * 16 + u.pn * 4 + wc] = sq;
            }
    }
};

struct EpiIn {
    static constexpr bool PERM = true, AFTER_DRAIN = false;
    bf16_t* PB; float* glow; const float* ssp;
    __device__ __forceinline__ void operator()(const f32x4 (&acc)[2][2][4][2], const Unit& u, int wr, int wc, int fr, int fq) const {
        const int row0 = u.pm * BM + wr * 64 + fr, tile = u.pn;
        if (tile == 17) {
            if (wc == 0 && fq < 2) {
#pragma unroll
                for (int ai = 0; ai < 2; ++ai)
#pragma unroll
                    for (int m = 0; m < 4; ++m) {
                        const int row = row0 + ai * HALF + m * 16;
                        const f32x4 p = *(const f32x4*)(ssp + (size_t)row * 16), q = *(const f32x4*)(ssp + (size_t)row * 16 + 4), r = *(const f32x4*)(ssp + (size_t)row * 16 + 8), t = *(const f32x4*)(ssp + (size_t)row * 16 + 12);
                        const float s = (((p[0] + p[1]) + (p[2] + p[3])) + ((q[0] + q[1]) + (q[2] + q[3]))) + (((r[0] + r[1]) + (r[2] + r[3])) + ((t[0] + t[1]) + (t[2] + t[3])));
                        const float rs = __builtin_amdgcn_rsqf(s * (1.0f / 1024.0f) + 1e-6f);
                        *(f32x4*)(glow + (size_t)row * 16 + 8 * fq) = acc[ai][0][m][0] * rs;
                        *(f32x4*)(glow + (size_t)row * 16 + 8 * fq + 4) = acc[ai][0][m][1] * rs;
                    }
            }
            return;
        }
        const int mode = (tile <= 1 || tile == 3) ? 1 : (tile == 7 || tile == 8) ? 2 : (tile >= 9 ? 3 : 0);
        const int col0 = tile * BM + wc * 32 + 8 * fq;
#pragma unroll
        for (int ai = 0; ai < 2; ++ai)
#pragma unroll
            for (int m = 0; m < 4; ++m) {
                const int row = row0 + ai * HALF + m * 16; const float rs = row_rstd(ssp, row, fq);
#pragma unroll
                for (int bj = 0; bj < 2; ++bj) {
                    f32x4 v0 = acc[ai][bj][m][0] * rs, v1 = acc[ai][bj][m][1] * rs;
                    if (mode == 1) { v0 = v0 * 0.125f; v1 = v1 * 0.125f; }
                    else if (mode == 2) {
#pragma unroll
                        for (int j = 0; j < 4; ++j) { v0[j] = v0[j] * sigm(v0[j]); v1[j] = v1[j] * sigm(v1[j]); } }
                    else if (mode == 3) {
#pragma unroll
                        for (int j = 0; j < 4; ++j) { v0[j] = sigm(v0[j]); v1[j] = sigm(v1[j]); } }
                    u32x4 w; w.x = cvt_pk_bf16(v0[0], v0[1]); w.y = cvt_pk_bf16(v0[2], v0[3]); w.z = cvt_pk_bf16(v1[0], v1[1]); w.w = cvt_pk_bf16(v1[2], v1[3]);
                    *(u32x4*)(PB + (size_t)row * XPBW + col0 + bj * HALF) = w;
                }
            }
    }
};

template <bool ADD> struct EpiMix {
    static constexpr bool PERM = true, AFTER_DRAIN = false;
    const bf16_t* gate; bf16_t* mixed;
    __device__ __forceinline__ void operator()(const f32x4 (&acc)[2][2][4][2], const Unit& u, int wr, int wc, int fr, int fq) const {
        const int row0 = u.pm * BM + wr * 64 + fr, col0 = u.pn * BM + wc * 32 + 8 * fq;
#pragma unroll
        for (int ai = 0; ai < 2; ++ai)
#pragma unroll
            for (int m = 0; m < 4; ++m) {
                const int row = row0 + ai * HALF + m * 16;
#pragma unroll
                for (int bj = 0; bj < 2; ++bj) {
                    const int c = col0 + bj * HALF;
                    const u32x4 g = *(const u32x4*)(gate + (size_t)row * XPBW + c);
                    const f32x4 a0 = acc[ai][bj][m][0], a1 = acc[ai][bj][m][1];
                    float v[8] = {bflo(g.x) * a0[0], bfhi(g.x) * a0[1], bflo(g.y) * a0[2], bfhi(g.y) * a0[3], bflo(g.z) * a1[0], bfhi(g.z) * a1[1], bflo(g.w) * a1[2], bfhi(g.w) * a1[3]};
                    if (ADD) { const u32x4 o = *(const u32x4*)(mixed + (size_t)row * XD + c);
                        v[0] += bflo(o.x); v[1] += bfhi(o.x); v[2] += bflo(o.y); v[3] += bfhi(o.y); v[4] += bflo(o.z); v[5] += bfhi(o.z); v[6] += bflo(o.w); v[7] += bfhi(o.w); }
                    u32x4 w; w.x = cvt_pk_bf16(v[0], v[1]); w.y = cvt_pk_bf16(v[2], v[3]); w.z = cvt_pk_bf16(v[4], v[5]); w.w = cvt_pk_bf16(v[6], v[7]);
                    *(u32x4*)(mixed + (size_t)row * XD + c) = w;
                }
            }
    }
};

template <class Epi, class Sched, bool ALIGN_EPI = false, bool SP2 = false>
__device__ __forceinline__ void gemm_phase(PG8_LAS unsigned char* lds, const Gemm g, const Sched& S, const Epi& E) {
    const int tid = threadIdx.x, wid = __builtin_amdgcn_readfirstlane(tid >> 6), lane = tid & 63, wr = wid >> 2, wc = wid & 3, fr = lane & 15, fq = lane >> 4;
    const int K = g.K, nt = K / BK;
    unsigned voffA[2], voffB[2];
#pragma unroll
    for (int i = 0; i < 2; ++i) { int R, C; stage_rc(tid * 16 + i * 8192, R, C); const int Rb = Epi::PERM ? ((R & ~31) + perm32(R & 31)) : R;
        voffA[i] = (unsigned)(R * K + C) * 2u; voffB[i] = (unsigned)(Rb * K + C) * 2u; }
    const size_t kstep = (size_t)(BK * 2);
    const size_t hstep = (size_t)HALF * K * 2;
    const size_t tstep = 2 * hstep;
    const unsigned ldsw = (unsigned)wid * 1024u;
    const int aoff = lds_byte(wr * 64 + fr, fq * 8), boff = lds_byte(wc * 32 + fr, fq * 8);
#define PG8_SA(b, h) (((b) * 2 + (h)) * HTB)
#define PG8_SB(b, h) ((4 + (b) * 2 + (h)) * HTB)
#define PG8_STAGE(bufoff, gbase, voff) do { _Pragma("unroll") for (int _i = 0; _i < 2; ++_i) \
        __builtin_amdgcn_global_load_lds((const unsigned*)((const char*)(gbase) + (voff)[_i]), (PG8_LAS unsigned*)(lds + (bufoff) + ldsw + _i * 8192), 16, 0, 0); } while (0)
#define PG8_LDA(dst, b, h) do { _Pragma("unroll") for (int m = 0; m < 4; ++m) _Pragma("unroll") for (int k = 0; k < 2; ++k) dst[m][k] = *(const PG8_LAS bf16x8*)(lds + PG8_SA(b, h) + aoff + m * 2048 + k * 1024); } while (0)
#define PG8_LDB(dst, b, h) do { _Pragma("unroll") for (int n = 0; n < 2; ++n) _Pragma("unroll") for (int k = 0; k < 2; ++k) dst[n][k] = *(const PG8_LAS bf16x8*)(lds + PG8_SB(b, h) + boff + n * 2048 + k * 1024); } while (0)
#define PG8_MMA(ai, bj, At, Bt) do { __builtin_amdgcn_s_setprio(1); _Pragma("unroll") for (int m = 0; m < 4; ++m) _Pragma("unroll") for (int n = 0; n < 2; ++n) _Pragma("unroll") for (int k = 0; k < 2; ++k) \
        acc[ai][bj][m][n] = __builtin_amdgcn_mfma_f32_16x16x32_bf16(Bt[n][k], At[m][k], acc[ai][bj][m][n], 0, 0, 0); __builtin_amdgcn_s_setprio(0); } while (0)
#define PG8_WAIT_V(n) asm volatile("s_waitcnt vmcnt(" #n ")" ::: "memory")
#define PG8_WAIT_L(n) asm volatile("s_waitcnt lgkmcnt(" #n ")" ::: "memory")
#define PG8_BAR __builtin_amdgcn_s_barrier()
#define PG8_SCHED __builtin_amdgcn_sched_barrier(0)
    Unit cur, nxt; int ui = 0;
    if (!S.next(0, cur)) return;
    f32x4 acc[2][2][4][2];
#pragma unroll
    for (int a = 0; a < 2; ++a)
#pragma unroll
        for (int b = 0; b < 2; ++b)
#pragma unroll
            for (int m = 0; m < 4; ++m)
#pragma unroll
                for (int n = 0; n < 2; ++n) acc[a][b][m][n] = (f32x4){0.f, 0.f, 0.f, 0.f};
    bf16x8 At[4][2], B0[2][2], B1[2][2];
    const char* cA = (const char*)g.A + (size_t)cur.pm * tstep; const char* cB = (const char*)g.Bt + (size_t)cur.pn * tstep;
    S.a_ready(cur);
    if constexpr (SP2) {
        PG8_STAGE(PG8_SB(0, 0), cB, voffB); PG8_STAGE(PG8_SB(0, 1), cB + hstep, voffB); PG8_STAGE(PG8_SA(0, 0), cA, voffA); PG8_STAGE(PG8_SA(0, 1), cA + hstep, voffA);
        if (wr == 1) PG8_BAR;
        PG8_WAIT_V(2); PG8_BAR;
        PG8_STAGE(PG8_SB(1, 0), cB + kstep, voffB); PG8_STAGE(PG8_SA(1, 0), cA + kstep, voffA); PG8_STAGE(PG8_SB(1, 1), cB + hstep + kstep, voffB);
        PG8_WAIT_V(6); PG8_BAR;
    } else {
        PG8_STAGE(PG8_SB(0, 0), cB, voffB); PG8_STAGE(PG8_SA(0, 0), cA, voffA); PG8_STAGE(PG8_SB(0, 1), cB + hstep, voffB); PG8_STAGE(PG8_SA(0, 1), cA + hstep, voffA);
        if (wr == 1) PG8_BAR;
        PG8_WAIT_V(4); PG8_BAR;
        PG8_STAGE(PG8_SB(1, 0), cB + kstep, voffB); PG8_STAGE(PG8_SA(1, 0), cA + kstep, voffA); PG8_STAGE(PG8_SB(1, 1), cB + hstep + kstep, voffB);
        PG8_WAIT_V(6); PG8_BAR;
    }
    for (;;) {
        const bool has_next = S.next(ui + 1, nxt);
        const char* nA = has_next ? (const char*)g.A + (size_t)nxt.pm * tstep : cA; const char* nB = has_next ? (const char*)g.Bt + (size_t)nxt.pn * tstep : cB;
        for (int t = 0; t < nt; t += 2) {
            const bool last = (t == nt - 2);
            const char* a1 = cA + (size_t)(t + 1) * kstep;
            const char* a2 = last ? nA : cA + (size_t)(t + 2) * kstep; const char* b2 = last ? nB : cB + (size_t)(t + 2) * kstep;
            const char* a3 = a2 + kstep; const char* b3 = b2 + kstep;
            if (last && has_next) S.a_ready(nxt);
            if constexpr (SP2) {
            PG8_LDB(B0, 0, 0); PG8_LDB(B1, 0, 1); PG8_SCHED; PG8_LDA(At, 0, 0); PG8_STAGE(PG8_SA(1, 1), a1 + hstep, voffA);
            PG8_WAIT_V(8); PG8_WAIT_L(0); PG8_BAR; PG8_MMA(0, 0, At, B0); PG8_MMA(0, 1, At, B1); PG8_BAR; PG8_SCHED;
            PG8_LDA(At, 0, 1); PG8_STAGE(PG8_SB(0, 0), b2, voffB); PG8_STAGE(PG8_SB(0, 1), b2 + hstep, voffB); PG8_STAGE(PG8_SA(0, 0), a2, voffA);
            PG8_WAIT_V(8); PG8_WAIT_L(0); PG8_BAR; PG8_MMA(1, 0, At, B0); PG8_MMA(1, 1, At, B1); PG8_BAR; PG8_SCHED;
            PG8_LDB(B0, 1, 0); PG8_LDB(B1, 1, 1); PG8_SCHED; PG8_LDA(At, 1, 0); PG8_STAGE(PG8_SA(0, 1), a2 + hstep, voffA);
            PG8_WAIT_V(8); PG8_WAIT_L(0); PG8_BAR; PG8_MMA(0, 0, At, B0); PG8_MMA(0, 1, At, B1); PG8_BAR; PG8_SCHED;
            PG8_LDA(At, 1, 1); PG8_STAGE(PG8_SB(1, 0), b3, voffB); PG8_STAGE(PG8_SB(1, 1), b3 + hstep, voffB); PG8_STAGE(PG8_SA(1, 0), a3, voffA);
            PG8_WAIT_V(8); PG8_WAIT_L(0); PG8_BAR; PG8_MMA(1, 0, At, B0); PG8_MMA(1, 1, At, B1); PG8_BAR; PG8_SCHED;
            } else {
            PG8_LDB(B0, 0, 0); PG8_SCHED; PG8_LDA(At, 0, 0); PG8_STAGE(PG8_SA(1, 1), a1 + hstep, voffA);
            PG8_WAIT_L(8); PG8_BAR; PG8_WAIT_L(0); PG8_MMA(0, 0, At, B0); PG8_BAR; PG8_SCHED;
            PG8_LDB(B1, 0, 1); PG8_STAGE(PG8_SB(0, 0), b2, voffB);
            PG8_BAR; PG8_WAIT_L(0); PG8_MMA(0, 1, At, B1); PG8_BAR;
            PG8_LDA(At, 0, 1); PG8_STAGE(PG8_SA(0, 0), a2, voffA);
            PG8_BAR; PG8_WAIT_L(0); PG8_MMA(1, 0, At, B0); PG8_BAR; PG8_SCHED;
            PG8_STAGE(PG8_SB(0, 1), b2 + hstep, voffB);
            PG8_WAIT_V(6); PG8_BAR; PG8_MMA(1, 1, At, B1); PG8_BAR;
            PG8_LDB(B0, 1, 0); PG8_SCHED; PG8_LDA(At, 1, 0); PG8_STAGE(PG8_SA(0, 1), a2 + hstep, voffA);
            PG8_WAIT_L(8); PG8_BAR; PG8_WAIT_L(0); PG8_MMA(0, 0, At, B0); PG8_BAR; PG8_SCHED;
            PG8_LDB(B1, 1, 1); PG8_STAGE(PG8_SB(1, 0), b3, voffB);
            PG8_BAR; PG8_WAIT_L(0); PG8_MMA(0, 1, At, B1); PG8_BAR;
            PG8_LDA(At, 1, 1); PG8_STAGE(PG8_SA(1, 0), a3, voffA);
            PG8_BAR; PG8_WAIT_L(0); PG8_MMA(1, 0, At, B0); PG8_BAR; PG8_SCHED;
            PG8_STAGE(PG8_SB(1, 1), b3 + hstep, voffB);
            PG8_WAIT_V(6); PG8_BAR; PG8_MMA(1, 1, At, B1); PG8_BAR;
            }
        }
        if constexpr (ALIGN_EPI) { if (wr == 0) PG8_BAR; }
        if constexpr (!Epi::AFTER_DRAIN) { E(acc, cur, wr, wc, fr, fq); S.done(cur); }
        if (!has_next) break;
#pragma unroll
        for (int a = 0; a < 2; ++a)
#pragma unroll
            for (int b = 0; b < 2; ++b)
#pragma unroll
                for (int m = 0; m < 4; ++m)
#pragma unroll
                    for (int n = 0; n < 2; ++n) acc[a][b][m][n] = (f32x4){0.f, 0.f, 0.f, 0.f};
        cur = nxt; cA = nA; cB = nB; ++ui;
        if constexpr (ALIGN_EPI) { if (wr == 1) PG8_BAR; }
    }
    PG8_WAIT_V(0);
    if constexpr (!ALIGN_EPI) { if (wr == 0) PG8_BAR; }
    PG8_BAR;
    if constexpr (Epi::AFTER_DRAIN) { E.fused(acc, cur, wr, wc, fr, fq, lds, wid, lane); S.done(cur); }
#undef PG8_SA
#undef PG8_SB
#undef PG8_STAGE
#undef PG8_LDA
#undef PG8_LDB
#undef PG8_MMA
#undef PG8_WAIT_V
#undef PG8_WAIT_L
#undef PG8_BAR
#undef PG8_SCHED
}
}
#define LAS __attribute__((address_space(3)))
#define XB_TMO      128
#define XB_XCNT(j)  (256  + 64 * (j))
#define XB_XSUB(j)  (1280 + 64 * (j))
#define XB_XGEN(j)  (2304 + 64 * (j))
#define XB_TOP      3328
#define XB_TOPGEN   3392
#define XCD_BAR_WORDS 3456
#define XB_SPIN_CAP (1u << 18)

__device__ __forceinline__ unsigned xb_ld(unsigned* p)              { return __hip_atomic_load(p, __ATOMIC_RELAXED, __HIP_MEMORY_SCOPE_AGENT); }
__device__ __forceinline__ unsigned xb_add(unsigned* p, unsigned v) { return __hip_atomic_fetch_add(p, v, __ATOMIC_RELAXED, __HIP_MEMORY_SCOPE_AGENT); }
__device__ __forceinline__ unsigned xb_xcc_id() { return (unsigned)__builtin_amdgcn_s_getreg((3 << 11) | 20) & 0xFu; }
#define XB_SPIN(cond, bar) do { unsigned _sp = 0; while (cond) { __builtin_amdgcn_s_sleep(1); \
    if ((++_sp & 255u) == 0u) { if (xb_ld(&(bar)[XB_TMO])) break; if (_sp > XB_SPIN_CAP) { atomicAdd(&(bar)[XB_TMO], 1u); break; } } } } while (0)

struct XcdBarrier {
    unsigned* bar; unsigned x;
    volatile LAS unsigned* st;
};

__device__ __forceinline__ XcdBarrier xcd_barrier_post(unsigned* bar, volatile LAS unsigned* st) {
    XcdBarrier b; b.bar = bar; b.x = xb_xcc_id(); b.st = st;
    if (threadIdx.x == 0) (void)xb_add(&bar[XB_XCNT(b.x)], 1u);
    return b;
}
__device__ __forceinline__ void xcd_barrier_complete(unsigned* bar, unsigned x, unsigned& nloc, unsigned& nx) {
    const unsigned G = gridDim.x * gridDim.y * gridDim.z;
    unsigned sum, cnt, mine, sp = 0u;
    for (;;) {
        sum = 0u; cnt = 0u; mine = 0u;
#pragma unroll
        for (unsigned j = 0; j < 16; ++j) { const unsigned c = xb_ld(&bar[XB_XCNT(j)]); sum += c; cnt += (c > 0u) ? 1u : 0u; mine = (j == x) ? c : mine; }
        if (sum == G) break;
        __builtin_amdgcn_s_sleep(1);
        if ((++sp & 255u) == 0u) { if (xb_ld(&bar[XB_TMO])) break; if (sp > XB_SPIN_CAP) { atomicAdd(&bar[XB_TMO], 1u); break; } }
    }
    nloc = mine > 0u ? mine : 1u; nx = cnt > 0u ? cnt : 1u;
}

__device__ __forceinline__ void xcd_barrier(const XcdBarrier& b) {
    asm volatile("s_waitcnt vmcnt(0)" ::: "memory");
    __syncthreads();
    if (threadIdx.x == 0) {
        unsigned* bar = b.bar;
        __builtin_amdgcn_s_waitcnt(0);
        unsigned nloc = b.st[0], nx = b.st[1];
        if (nloc == 0u) { xcd_barrier_complete(bar, b.x, nloc, nx); b.st[0] = nloc; b.st[1] = nx; }
        const unsigned old = xb_add(&bar[XB_XSUB(b.x)], 1u);
        const unsigned gen = old / nloc;
        if (old + 1u == (gen + 1u) * nloc) {
            __builtin_amdgcn_fence(__ATOMIC_RELEASE, "agent");
            asm volatile("s_waitcnt vmcnt(0)" ::: "memory");
            const unsigned og = xb_add(&bar[XB_TOP], 1u);
            const unsigned tg = og / nx;
            if (og + 1u == (tg + 1u) * nx) xb_add(&bar[XB_TOPGEN], 1u);
            else XB_SPIN(xb_ld(&bar[XB_TOPGEN]) == tg, bar);
            __builtin_amdgcn_fence(__ATOMIC_ACQUIRE, "agent");
            xb_add(&bar[XB_XGEN(b.x)], 1u);
            asm volatile("s_waitcnt vmcnt(0)" ::: "memory");
        } else {
            XB_SPIN(xb_ld(&bar[XB_XGEN(b.x)]) == gen, bar);
            __builtin_amdgcn_fence(__ATOMIC_ACQUIRE, "agent");
            asm volatile("s_waitcnt vmcnt(0)" ::: "memory");
        }
    }
    __syncthreads();
}

#ifndef MK_DUP
#define MK_DUP 0
#endif
#ifndef MK_PER_PHASE
#define MK_PER_PHASE 0
#endif
#define LAS __attribute__((address_space(3)))
typedef unsigned short bf16;
typedef short bf16x8 __attribute__((ext_vector_type(8)));
typedef short s16x4 __attribute__((ext_vector_type(4)));
typedef float f32x4 __attribute__((ext_vector_type(4)));
typedef float f32x16 __attribute__((ext_vector_type(16)));
typedef unsigned u32x4 __attribute__((ext_vector_type(4)));
typedef unsigned u32x2 __attribute__((ext_vector_type(2)));
typedef float f32x2m __attribute__((ext_vector_type(2)));
#define MFMA32(a, b, c) __builtin_amdgcn_mfma_f32_32x32x16_bf16((a), (b), (c), 0, 0, 0)
#define LDS_WAIT() asm volatile("s_waitcnt lgkmcnt(0)" ::: "memory")

constexpr int NFR = 16384, MT = 16640, D = 1024, FF = 2816, NGU = 5632, NIN = 4608, PBW = 4352, DIN = 4368;
constexpr int NPH = 12;
constexpr int LDS_BYTES = 147456, MISC_OFF = 131072 + 320, CTL_BYTES = 16384;
constexpr size_t MiB = 1u << 20;
constexpr size_t WS_WGU1 = 0, WS_WD1 = 11 * MiB, WS_ST = 0  , WS_WGU2 = 17 * MiB, WS_WD2 = 28 * MiB, WS_WIN = 34 * MiB,
                 WS_WA = 43 * MiB, WS_WB = 44 * MiB, WS_WOUT = 45 * MiB, WS_SSP = 47 * MiB, WS_GLOW = 49 * MiB, WS_DEC = 51 * MiB, WS_CTL = 51 * MiB + MiB / 2  ,
                 WS_HB = 52 * MiB, WS_YA = 52 * MiB, WS_YB = 68 * MiB  , WS_R1 = 85 * MiB  ,
                 WS_KV = 223 * MiB + MiB / 2  , WS_END = 256 * MiB;
static_assert(WS_ST + (size_t)1032 * 8192 * 2 <= WS_WGU2 && WS_R1 + (size_t)MT * PBW * 2 <= WS_KV && WS_KV + (size_t)1032 * 8192 * 4 <= WS_END && WS_HB + (size_t)MT * D * 2 <= WS_R1, "d_ws map");

struct Params { const float* in[20]; float* out; unsigned char* ws; int ph_lo, ph_hi, cg_sync, pad; };

__device__ __forceinline__ int crow(int reg, int h) { return (reg & 3) + 8 * (reg >> 2) + 4 * h; }
__device__ __forceinline__ unsigned f2bf(float f) { unsigned u = __float_as_uint(f); return (u + 0x7fffu + ((u >> 16) & 1u)) >> 16; }
__device__ __forceinline__ unsigned pk2(float lo, float hi) { return f2bf(lo) | (f2bf(hi) << 16); }
__device__ __forceinline__ float wave_sum(float v) {
#pragma unroll
    for (int o = 1; o < 64; o <<= 1) v += __shfl_xor(v, o);
    return v;
}
__device__ __forceinline__ bf16x8 pack8(float a, float b, float c, float d, float e, float f, float g, float h) {
    u32x4 p; p.x = pk2(a, b); p.y = pk2(c, d); p.z = pk2(e, f); p.w = pk2(g, h); return __builtin_bit_cast(bf16x8, p);
}

__device__ __forceinline__ void tr_item64(const float* W, int K, int N, int k0, int sn0, int nvalid, const float* gain, bf16* WT, int drow0, LAS unsigned* T, int lane) {
    const int n4 = (lane & 15) * 4, kp = lane >> 4; const bool cv = n4 < nvalid;
    f32x4 a[8], b[8];
#pragma unroll
    for (int st = 0; st < 8; ++st) { const float* p = W + (size_t)(k0 + 8 * st + 2 * kp) * N + sn0 + n4;
        a[st] = cv ? *(const f32x4*)p : (f32x4){0.f, 0.f, 0.f, 0.f}; b[st] = cv ? *(const f32x4*)(p + N) : (f32x4){0.f, 0.f, 0.f, 0.f}; }
#pragma unroll
    for (int st = 0; st < 8; ++st) { const int k = k0 + 8 * st + 2 * kp; float g0 = 1.f, g1 = 1.f; if (gain) { g0 = gain[k]; g1 = gain[k + 1]; }
        LAS unsigned* t = T + n4 * 33 + 4 * st + kp;
        t[0] = pk2(a[st][0] * g0, b[st][0] * g1); t[33] = pk2(a[st][1] * g0, b[st][1] * g1); t[66] = pk2(a[st][2] * g0, b[st][2] * g1); t[99] = pk2(a[st][3] * g0, b[st][3] * g1); }
    LDS_WAIT(); asm volatile("" ::: "memory");
    const int c = lane & 7;
#pragma unroll
    for (int q = 0; q < 8; ++q) { const int n = (lane >> 3) + 8 * q; const LAS unsigned* t = T + n * 33 + 4 * c;
        u32x4 o; o.x = t[0]; o.y = t[1]; o.z = t[2]; o.w = t[3];
        *(u32x4*)(WT + (size_t)(drow0 + n) * K + k0 + 8 * c) = o; }
    LDS_WAIT(); asm volatile("" ::: "memory");
}
__device__ __forceinline__ void p0_prep(const Params& P, LAS unsigned char* lds, int wave, int lane, int G) {
    unsigned char* ws = P.ws;
    LAS unsigned* scr = (LAS unsigned*)(lds + wave * 16384);
    const int gw = blockIdx.x * 8 + wave, NGW = G * 8;
    constexpr int I_GU = 16 * 44, I_DN = 44 * 16, I_IN = 16 * 72, I_BR = 8 * 16, I_WO = 16 * 16;
    constexpr int NITEMS = 4 * I_GU + 2 * I_DN + I_IN + 2 * I_BR + I_WO;
    for (int it = gw; it < NITEMS; it += NGW) {
        int r = it;
        if (r < 2 * I_GU + I_DN) {
            if (r < 2 * I_GU) { const int up = r >= I_GU; r -= up * I_GU; const int kb = r / 44, n0 = (r % 44) * 64;
                tr_item64(up ? P.in[4] : P.in[3], D, FF, kb * 64, n0, 64, P.in[2], (bf16*)(ws + WS_WGU1), (n0 >> 7) * 256 + (n0 & 127) + up * 128, scr, lane); }
            else { r -= 2 * I_GU; tr_item64(P.in[5], FF, D, (r / 16) * 64, (r % 16) * 64, 64, nullptr, (bf16*)(ws + WS_WD1), (r % 16) * 64, scr, lane); }
            continue; }
        r -= 2 * I_GU + I_DN;
        if (r < 2 * I_GU + I_DN) {
            if (r < 2 * I_GU) { const int up = r >= I_GU; r -= up * I_GU; const int kb = r / 44, n0 = (r % 44) * 64;
                tr_item64(up ? P.in[17] : P.in[16], D, FF, kb * 64, n0, 64, P.in[15], (bf16*)(ws + WS_WGU2), (n0 >> 7) * 256 + (n0 & 127) + up * 128, scr, lane); }
            else { r -= 2 * I_GU; tr_item64(P.in[18], FF, D, (r / 16) * 64, (r % 16) * 64, 64, nullptr, (bf16*)(ws + WS_WD2), (r % 16) * 64, scr, lane); }
            continue; }
        r -= 2 * I_GU + I_DN;
        if (r < I_IN) { const int kb = r / 72, d0 = (r % 72) * 64; int sn0, nv;
            if (d0 < 2304) { sn0 = d0; nv = 64; } else if (d0 < 4352) { sn0 = d0 + 16; nv = 64; } else if (d0 == 4352) { sn0 = 2304; nv = 16; } else { sn0 = 0; nv = 0; }
            tr_item64(P.in[7], D, DIN, kb * 64, sn0, nv, P.in[6], (bf16*)(ws + WS_WIN), d0, scr, lane); continue; }
        r -= I_IN;
        if (r < I_BR) { tr_item64(P.in[12], 512, D, (r / 16) * 64, (r % 16) * 64, 64, nullptr, (bf16*)(ws + WS_WA), (r % 16) * 64, scr, lane); continue; }
        r -= I_BR;
        if (r < I_BR) { tr_item64(P.in[13], 512, D, (r / 16) * 64, (r % 16) * 64, 64, nullptr, (bf16*)(ws + WS_WB), (r % 16) * 64, scr, lane); continue; }
        r -= I_BR;
        tr_item64(P.in[14], D, D, (r / 16) * 64, (r % 16) * 64, 64, nullptr, (bf16*)(ws + WS_WOUT), (r % 16) * 64, scr, lane);
    }
    bf16* hb = (bf16*)(ws + WS_HB); float* ssp = (float*)(ws + WS_SSP);
    for (int m0 = gw; m0 < MT; m0 += 2 * NGW) {
        f32x4 v[2][4]; float s[2];
#pragma unroll
        for (int u = 0; u < 2; ++u) { const int m = m0 + u * NGW;
            const float* src = m < NFR ? P.in[0] + (size_t)m * D : (m < NFR + 16 ? P.in[1] + (size_t)(m - NFR) * D : nullptr);
#pragma unroll
            for (int j = 0; j < 4; ++j) v[u][j] = src ? ((const f32x4*)src)[lane + 64 * j] : (f32x4){0.f, 0.f, 0.f, 0.f}; }
#pragma unroll
        for (int u = 0; u < 2; ++u) { const int m = m0 + u * NGW; s[u] = 0.f;
#pragma unroll
            for (int j = 0; j < 4; ++j) s[u] += (v[u][j][0] * v[u][j][0] + v[u][j][1] * v[u][j][1]) + (v[u][j][2] * v[u][j][2] + v[u][j][3] * v[u][j][3]);
            s[u] = wave_sum(s[u]);
            if (m < MT) {
                u32x2* o8 = (u32x2*)(hb + (size_t)m * D) + lane;
#pragma unroll
                for (int j = 0; j < 4; ++j) { u32x2 w; w.x = pk2(v[u][j][0], v[u][j][1]); w.y = pk2(v[u][j][2], v[u][j][3]); o8[64 * j] = w; }
                if (lane < 16) ssp[(size_t)m * 16 + lane] = lane == 0 ? s[u] : 0.f; } }
    }
}

constexpr int A_KS = 0, A_VT = 32256, A_VTS = 228;
__device__ __forceinline__ void attn_item(const Params& P, LAS unsigned char* L, int item, int tid, int wave, int lane) {
    const bf16* PB = (const bf16*)(P.ws + WS_R1); bf16* ya = (bf16*)(P.ws + WS_YA);
    const int kvh = item & 1, c = (item >> 1) & 127, b = item >> 8;
#pragma unroll
    for (int i = 0; i < 4; ++i) {
        const int key = (tid & 63) + 64 * i;
        if (key < 224) {
            bool valid; int row;
            if (key < 16) { valid = true; row = NFR + key; }
            else if (key < 32) { valid = false; row = 0; }
            else { const int ki = c * 64 - 128 + (key - 32); valid = ki >= 0; row = b * 8192 + (valid ? ki : 0); }
            u32x4 kk = (u32x4){0u, 0u, 0u, 0u}, vv = (u32x4){0u, 0u, 0u, 0u};
            if (valid) { const bf16* p = PB + (size_t)row * PBW + 512 + kvh * 64 + wave * 8; kk = *(const u32x4*)p; vv = *(const u32x4*)(p + 128); }
            *(LAS u32x4*)(L + A_KS + key * 144 + wave * 16) = kk;
            LAS unsigned short* vt = (LAS unsigned short*)(L + A_VT) + (wave * 8) * A_VTS + key;
            vt[0 * A_VTS] = (unsigned short)(vv.x & 0xffffu); vt[1 * A_VTS] = (unsigned short)(vv.x >> 16);
            vt[2 * A_VTS] = (unsigned short)(vv.y & 0xffffu); vt[3 * A_VTS] = (unsigned short)(vv.y >> 16);
            vt[4 * A_VTS] = (unsigned short)(vv.z & 0xffffu); vt[5 * A_VTS] = (unsigned short)(vv.z >> 16);
            vt[6 * A_VTS] = (unsigned short)(vv.w & 0xffffu); vt[7 * A_VTS] = (unsigned short)(vv.w >> 16);
        }
    }
    __syncthreads();
    const int g = wave >> 1, pos0 = (wave & 1) * 32, h = kvh * 4 + g, r = lane & 31, hi = lane >> 5;
    const int qrow = b * 8192 + c * 64 + pos0 + r;
    bf16x8 q[4];
#pragma unroll
    for (int s = 0; s < 4; ++s) q[s] = *(const bf16x8*)(PB + (size_t)qrow * PBW + h * 64 + 16 * s + 8 * hi);
    f32x16 S[7];
#pragma unroll
    for (int kt = 0; kt < 7; ++kt) {
#pragma unroll
        for (int i = 0; i < 16; ++i) S[kt][i] = 0.f;
#pragma unroll
        for (int s = 0; s < 4; ++s) { const bf16x8 a = *(const LAS bf16x8*)(L + A_KS + (kt * 32 + r) * 144 + (16 * s + 8 * hi) * 2); S[kt] = MFMA32(a, q[s], S[kt]); }
        asm volatile("" ::: "memory");
    }
    __builtin_amdgcn_sched_barrier(0);
    const float slope = exp2f(-(float)(h + 1)), sink = P.in[11][h];
    const float NEG = -__builtin_inff();
    float m = sink;
#pragma unroll
    for (int i = 0; i < 16; ++i) { if (i >= 8) S[0][i] = NEG; else m = fmaxf(m, S[0][i]); }
    int oz; asm volatile("v_mov_b32 %0, 0" : "=v"(oz));
    const int smin = 128 - 64 * c, pq = pos0 + r + 128 + oz;
#pragma unroll
    for (int kt = 1; kt < 7; ++kt) {
#pragma unroll
        for (int i = 0; i < 16; ++i) { const int s = (kt - 1) * 32 + crow(i, hi); float v = S[kt][i] - slope * fabsf((float)(pq - s)); if (s < smin) v = NEG; S[kt][i] = v; m = fmaxf(m, v); }
        __builtin_amdgcn_sched_barrier(0);
    }
    m = fmaxf(m, __shfl_xor(m, 32));
    __builtin_amdgcn_sched_barrier(0);
    float sum = 0.f; const float ml = m * 1.44269504f;
    bf16x8 pbv[7][2];
#pragma unroll
    for (int kt = 0; kt < 7; ++kt) {
#pragma unroll
        for (int i = 0; i < 16; ++i) { const float p = __builtin_amdgcn_exp2f(S[kt][i] * 1.44269504f - ml); S[kt][i] = p; sum += p; }
        pbv[kt][0] = pack8(S[kt][0], S[kt][1], S[kt][2], S[kt][3], S[kt][4], S[kt][5], S[kt][6], S[kt][7]);
        pbv[kt][1] = pack8(S[kt][8], S[kt][9], S[kt][10], S[kt][11], S[kt][12], S[kt][13], S[kt][14], S[kt][15]);
    }
    __builtin_amdgcn_sched_barrier(0);
    sum += __shfl_xor(sum, 32); sum += exp2f(sink * 1.44269504f - ml);
    const float inv = 1.0f / sum;
    f32x16 O[2];
#pragma unroll
    for (int i = 0; i < 16; ++i) { O[0][i] = 0.f; O[1][i] = 0.f; }
#pragma unroll
    for (int kt = 0; kt < 7; ++kt)
#pragma unroll
        for (int s2 = 0; s2 < 2; ++s2) {
            const bf16x8 pb = pbv[kt][s2];
#pragma unroll
            for (int dt = 0; dt < 2; ++dt) {
                const LAS unsigned char* vp = L + A_VT + ((dt * 32 + r) * A_VTS + kt * 32 + 16 * s2 + 4 * hi) * 2;
                const s16x4 lo = *(const LAS s16x4*)vp, h4 = *(const LAS s16x4*)(vp + 16);
                const bf16x8 va = __builtin_shufflevector(lo, h4, 0, 1, 2, 3, 4, 5, 6, 7);
                O[dt] = MFMA32(va, pb, O[dt]);
            }
            asm volatile("" ::: "memory");
        }
#pragma unroll
    for (int dt = 0; dt < 2; ++dt)
#pragma unroll
        for (int g4 = 0; g4 < 4; ++g4) {
            u32x2 w; w.x = pk2(O[dt][4 * g4] * inv, O[dt][4 * g4 + 1] * inv); w.y = pk2(O[dt][4 * g4 + 2] * inv, O[dt][4 * g4 + 3] * inv);
            *(u32x2*)(ya + (size_t)qrow * 512 + h * 64 + dt * 32 + 8 * g4 + 4 * hi) = w;
        }
    __syncthreads();
}

constexpr int G_QE = 0, G_KE = 9216, G_K2T = 18432, G_VT = 27648, G_ST = 46080, G_SEG = 64512, G_SS = 66560, G_GL = 67584;
template <bool KV> __device__ __forceinline__ void gla_prep(const Params& P, LAS unsigned char* L, int b, int h, int j, int tid) {
    const bf16* PB = (const bf16*)(P.ws + WS_R1); const float* glow = (const float*)(P.ws + WS_GLOW);
    const int d = tid & 63, seg = tid >> 6;
    float gw[16];
#pragma unroll
    for (int r = 0; r < 16; ++r) gw[r] = P.in[8][r * 256 + h * 64 + d];
    const float bias = P.in[9][h * 64 + d];
    {
      const int pos = tid >> 3, e2 = (tid & 7) * 2; const bool valid = (j > 0) || (pos >= 48);
      const int row = valid ? (j == 0 ? NFR + pos - 48 : b * 8192 + (j - 1) * 64 + pos) : NFR;
      *(LAS f32x2m*)(L + G_GL + (pos * 16 + e2) * 4) = *(const f32x2m*)(glow + (size_t)row * 16 + e2); }
    __syncthreads();
    float cs[8], qv[8], kv[8]; float run = 0.f;
#pragma unroll
    for (int p = 0; p < 8; ++p) {
        const int pos = seg * 8 + p; const bool valid = (j > 0) || (pos >= 48);
        const int row = valid ? (j == 0 ? NFR + pos - 48 : b * 8192 + (j - 1) * 64 + pos) : NFR;
        const LAS f32x4* gl = (const LAS f32x4*)(L + G_GL + pos * 64);
        const f32x4 g0 = gl[0], g1 = gl[1], g2 = gl[2], g3 = gl[3];
        float z = bias;
#pragma unroll
        for (int e = 0; e < 4; ++e) { z += g0[e] * gw[e]; z += g1[e] * gw[4 + e]; z += g2[e] * gw[8 + e]; z += g3[e] * gw[12 + e]; }
        float la = (fminf(z, 0.f) - __logf(1.0f + __expf(-fabsf(z)))) * 0.0625f;
        if (!valid) la = 0.f;
        run += la; cs[p] = run;
        const bf16* pr = PB + (size_t)row * PBW + h * 64 + d;
        qv[p] = valid ? pg8::bf2f(pr[768]) : 0.f; kv[p] = valid ? pg8::bf2f(pr[1024]) : 0.f;
        if (p & 1) __builtin_amdgcn_sched_barrier(0);
    }
    LAS float* SEG = (LAS float*)(L + G_SEG);
    SEG[seg * 64 + d] = run;
    __syncthreads();
    float off = 0.f, tot = 0.f;
#pragma unroll
    for (int s = 0; s < 8; ++s) { const float v = SEG[s * 64 + d]; tot += v; if (s < seg) off += v; }
    LAS unsigned short* QE = (LAS unsigned short*)(L + G_QE); LAS unsigned short* KE = (LAS unsigned short*)(L + G_KE);
    float k2[8];
#pragma unroll
    for (int p = 0; p < 8; ++p) {
        const int pos = seg * 8 + p; const float bb = off + cs[p];
        QE[pos * 72 + d] = (unsigned short)f2bf(qv[p] * __expf(bb));
        KE[pos * 72 + d] = (unsigned short)f2bf(kv[p] * __expf(-bb));
        k2[p] = kv[p] * __expf(tot - bb);
    }
    if (KV) {
        *(LAS bf16x8*)(L + G_K2T + (d * 72 + seg * 8) * 2) = pack8(k2[0], k2[1], k2[2], k2[3], k2[4], k2[5], k2[6], k2[7]);
        if (seg == 0) ((float*)(P.ws + WS_DEC))[(size_t)((b * 4 + h) * 129 + j) * 64 + d] = __expf(tot);
    }
}
__device__ __forceinline__ void gla_stage_v(const Params& P, LAS unsigned char* L, int b, int h, int j, int tid) {
    const bf16* PB = (const bf16*)(P.ws + WS_R1);
    const int pos = tid & 63, dvg = tid >> 6; const bool valid = (j > 0) || (pos >= 48);
    const int row = valid ? (j == 0 ? NFR + pos - 48 : b * 8192 + (j - 1) * 64 + pos) : NFR;
    u32x4 a = (u32x4){0u, 0u, 0u, 0u}, c = a;
    if (valid) { const bf16* p = PB + (size_t)row * PBW + 1280 + h * 128 + dvg * 16; a = *(const u32x4*)p; c = *(const u32x4*)(p + 8); }
    LAS unsigned short* vt = (LAS unsigned short*)(L + G_VT) + (dvg * 16) * 72 + pos;
    vt[0 * 72] = (unsigned short)(a.x & 0xffffu); vt[1 * 72] = (unsigned short)(a.x >> 16); vt[2 * 72] = (unsigned short)(a.y & 0xffffu); vt[3 * 72] = (unsigned short)(a.y >> 16);
    vt[4 * 72] = (unsigned short)(a.z & 0xffffu); vt[5 * 72] = (unsigned short)(a.z >> 16); vt[6 * 72] = (unsigned short)(a.w & 0xffffu); vt[7 * 72] = (unsigned short)(a.w >> 16);
    vt[8 * 72] = (unsigned short)(c.x & 0xffffu); vt[9 * 72] = (unsigned short)(c.x >> 16); vt[10 * 72] = (unsigned short)(c.y & 0xffffu); vt[11 * 72] = (unsigned short)(c.y >> 16);
    vt[12 * 72] = (unsigned short)(c.z & 0xffffu); vt[13 * 72] = (unsigned short)(c.z >> 16); vt[14 * 72] = (unsigned short)(c.w & 0xffffu); vt[15 * 72] = (unsigned short)(c.w >> 16);
}
__device__ __forceinline__ void gla_kv_item(const Params& P, LAS unsigned char* L, int item, int tid, int wave, int lane) {
    const int j = item % 129, bh = item / 129, h = bh & 3, b = bh >> 2;
    gla_prep<true>(P, L, b, h, j, tid);
    gla_stage_v(P, L, b, h, j, tid);
    __syncthreads();
    const int dvt = wave >> 1, dkt = wave & 1, r = lane & 31, hi = lane >> 5;
    f32x16 acc;
#pragma unroll
    for (int i = 0; i < 16; ++i) acc[i] = 0.f;
#pragma unroll
    for (int s = 0; s < 4; ++s) {
        const bf16x8 a = *(const LAS bf16x8*)(L + G_VT + ((dvt * 32 + r) * 72 + 16 * s + 8 * hi) * 2);
        const bf16x8 bb = *(const LAS bf16x8*)(L + G_K2T + ((dkt * 32 + r) * 72 + 16 * s + 8 * hi) * 2);
        acc = MFMA32(a, bb, acc);
    }
    float* kvg = (float*)(P.ws + WS_KV) + (size_t)item * 8192;
#pragma unroll
    for (int i = 0; i < 16; ++i) kvg[(dvt * 32 + crow(i, hi)) * 64 + dkt * 32 + r] = acc[i];
    __syncthreads();
}
__device__ __forceinline__ void gla_scan(const Params& P, int wave, int lane, int G) {
    const float* kvg = (const float*)(P.ws + WS_KV); const float* dec = (const float*)(P.ws + WS_DEC); bf16* st = (bf16*)(P.ws + WS_ST);
    for (int wv = wave * G + blockIdx.x; wv < 1024; wv += G * 8) {
        const int gidx = wv * 64 + lane, bh = gidx >> 13, e = gidx & 8191, dk = e & 63;
        const size_t base = (size_t)bh * 129;
        float S = 0.f;
        for (int j0 = 0; j0 < 128; j0 += 8) {
            float kvv[8], dd[8];
#pragma unroll
            for (int u = 0; u < 8; ++u) { kvv[u] = kvg[(base + j0 + u) * 8192 + e]; dd[u] = dec[(base + j0 + u) * 64 + dk]; }
#pragma unroll
            for (int u = 0; u < 8; ++u) { S = dd[u] * S + kvv[u]; st[(base + j0 + u + 1) * 8192 + e] = (bf16)f2bf(S); }
        }
    }
}
__device__ __forceinline__ void gla_out_item(const Params& P, LAS unsigned char* L, int item  , int tid, int wave, int lane) {
    const int j = (item & 127) + 1, bh = item >> 7, h = bh & 3, b = bh >> 2;
    const bf16* PB = (const bf16*)(P.ws + WS_R1); bf16* yb = (bf16*)(P.ws + WS_YB);
    gla_prep<false>(P, L, b, h, j, tid);
    gla_stage_v(P, L, b, h, j, tid);
    { const bf16* sg = (const bf16*)(P.ws + WS_ST) + (size_t)(bh * 129 + j) * 8192; const int dv = tid >> 2, part = tid & 3;
      const u32x4 a = *(const u32x4*)(sg + dv * 64 + part * 16), c = *(const u32x4*)(sg + dv * 64 + part * 16 + 8);
      *(LAS u32x4*)(L + G_ST + (dv * 72 + part * 16) * 2) = a; *(LAS u32x4*)(L + G_ST + (dv * 72 + part * 16 + 8) * 2) = c; }
    __syncthreads();
    const int it = wave & 1, dvt = wave >> 1, r = lane & 31, hi = lane >> 5;
    bf16x8 qf[4];
#pragma unroll
    for (int s = 0; s < 4; ++s) qf[s] = *(const LAS bf16x8*)(L + G_QE + ((it * 32 + r) * 72 + 16 * s + 8 * hi) * 2);
    f32x16 o;
#pragma unroll
    for (int i = 0; i < 16; ++i) o[i] = 0.f;
#pragma unroll
    for (int jt = 0; jt < 2; ++jt) {
        if (jt <= it) {
            f32x16 at;
#pragma unroll
            for (int i = 0; i < 16; ++i) at[i] = 0.f;
#pragma unroll
            for (int s = 0; s < 4; ++s) { const bf16x8 a = *(const LAS bf16x8*)(L + G_KE + ((jt * 32 + r) * 72 + 16 * s + 8 * hi) * 2); at = MFMA32(a, qf[s], at); }
            if (jt == it) {
#pragma unroll
                for (int i = 0; i < 16; ++i) if (crow(i, hi) > r) at[i] = 0.f;
            }
#pragma unroll
            for (int s2 = 0; s2 < 2; ++s2) {
                const bf16x8 pb = pack8(at[8 * s2], at[8 * s2 + 1], at[8 * s2 + 2], at[8 * s2 + 3], at[8 * s2 + 4], at[8 * s2 + 5], at[8 * s2 + 6], at[8 * s2 + 7]);
                const LAS unsigned char* vp = L + G_VT + ((dvt * 32 + r) * 72 + jt * 32 + 16 * s2 + 4 * hi) * 2;
                const s16x4 lo = *(const LAS s16x4*)vp, h4 = *(const LAS s16x4*)(vp + 16);
                o = MFMA32(__builtin_shufflevector(lo, h4, 0, 1, 2, 3, 4, 5, 6, 7), pb, o);
            }
        }
    }
#pragma unroll
    for (int s = 0; s < 4; ++s) { const bf16x8 a = *(const LAS bf16x8*)(L + G_ST + ((dvt * 32 + r) * 72 + 16 * s + 8 * hi) * 2); o = MFMA32(a, qf[s], o); }
    float ss = 0.f;
#pragma unroll
    for (int i = 0; i < 16; ++i) ss += o[i] * o[i];
    ss += __shfl_xor(ss, 32);
    LAS float* SS = (LAS float*)(L + G_SS);
    if (hi == 0) SS[dvt * 64 + it * 32 + r] = ss;
    __syncthreads();
    const float tot = (SS[it * 32 + r] + SS[64 + it * 32 + r]) + (SS[128 + it * 32 + r] + SS[192 + it * 32 + r]);
    const float rstd = __builtin_amdgcn_rsqf(tot * (1.0f / 128.0f) + 1e-6f);
    const int row = b * 8192 + (j - 1) * 64 + it * 32 + r;
#pragma unroll
    for (int g4 = 0; g4 < 4; ++g4) {
        const int dv0 = dvt * 32 + 8 * g4 + 4 * hi;
        const f32x4 gn = *(const f32x4*)(P.in[10] + dv0);
        const u32x2 gr = *(const u32x2*)(PB + (size_t)row * PBW + 1792 + h * 128 + dv0);
        u32x2 w;
        w.x = pk2(o[4 * g4] * rstd * gn[0] * pg8::bflo(gr.x), o[4 * g4 + 1] * rstd * gn[1] * pg8::bfhi(gr.x));
        w.y = pk2(o[4 * g4 + 2] * rstd * gn[2] * pg8::bflo(gr.y), o[4 * g4 + 3] * rstd * gn[3] * pg8::bfhi(gr.y));
        *(u32x2*)(yb + (size_t)row * 512 + h * 128 + dv0) = w;
    }
    __syncthreads();
}

__global__ void __launch_bounds__(512, 2) mega_fwd(Params P) {
    extern __shared__ __attribute__((aligned(16))) unsigned char lds_raw[];
    LAS unsigned char* lds = (LAS unsigned char*)lds_raw;
    cg::grid_group grid = cg::this_grid();
    const int tid = threadIdx.x, lane = tid & 63, wave = __builtin_amdgcn_readfirstlane(tid >> 6), G = gridDim.x;
    unsigned char* ws = P.ws;
    const int lo = P.ph_lo, hi = P.ph_hi;
    if (tid < 32) ((LAS unsigned*)(lds + MISC_OFF))[tid] = 0u;
    __syncthreads();
    XcdBarrier bar = xcd_barrier_post((unsigned*)(ws + WS_CTL), (volatile LAS unsigned*)(lds + MISC_OFF) + 8);
#define IN(k) (lo <= (k) && (k) < hi)
#define GSYNC() do { if (P.cg_sync) grid.sync(); else xcd_barrier(bar); } while (0)
#define SEAM(k) do { if (IN(k) && IN((k) + 1)) GSYNC(); } while (0)
#define DUPQ(k) ((MK_DUP >> (k)) & 1)
    bf16* hb = (bf16*)(ws + WS_HB); float* ssp = (float*)(ws + WS_SSP); bf16* R1 = (bf16*)(ws + WS_R1);

    if (IN(0)) {
        p0_prep(P, lds, wave, lane, G);
#if (MK_DUP >> 0) & 1
        GSYNC();
        p0_prep(P, lds, wave, lane, G);
#endif
    }
    SEAM(0);
    if (IN(1)) {
        {
        pg8::Gemm g{hb, (const bf16*)(ws + WS_WGU1), MT, NGU, D}; pg8::StaticOrder S; S.init(MT, NGU, G, (int)blockIdx.x);
        pg8::EpiSwiglu E{R1, ssp};
        pg8::gemm_phase<pg8::EpiSwiglu, pg8::StaticOrder, true, true>(lds, g, S, E);
    }
#if (MK_DUP >> 1) & 1
        GSYNC();
        {
        pg8::Gemm g{hb, (const bf16*)(ws + WS_WGU1), MT, NGU, D}; pg8::StaticOrder S; S.init(MT, NGU, G, (int)blockIdx.x);
        pg8::EpiSwiglu E{R1, ssp};
        pg8::gemm_phase<pg8::EpiSwiglu, pg8::StaticOrder, true, true>(lds, g, S, E);
    }
#endif
    }
    SEAM(1);
    if (IN(2)) {
        {
        pg8::Gemm g{R1, (const bf16*)(ws + WS_WD1), MT, D, FF}; pg8::StaticOrder S; S.init(MT, D, G, (int)blockIdx.x);
        pg8::EpiResid E{P.in[0], P.in[1], P.out, hb, ssp, 0.5f};
        pg8::gemm_phase<pg8::EpiResid, pg8::StaticOrder, true, true>(lds, g, S, E);
    }
#if (MK_DUP >> 2) & 1
        GSYNC();
        {
        pg8::Gemm g{R1, (const bf16*)(ws + WS_WD1), MT, D, FF}; pg8::StaticOrder S; S.init(MT, D, G, (int)blockIdx.x);
        pg8::EpiResid E{P.in[0], P.in[1], P.out, hb, ssp, 0.5f};
        pg8::gemm_phase<pg8::EpiResid, pg8::StaticOrder, true, true>(lds, g, S, E);
    }
#endif
    }
    SEAM(2);
    if (IN(3)) {
        {
        pg8::Gemm g{hb, (const bf16*)(ws + WS_WIN), MT, NIN, D}; pg8::StaticOrder S; S.init(MT, NIN, G, (int)blockIdx.x);
        pg8::EpiIn E{R1, (float*)(ws + WS_GLOW), ssp};
        pg8::gemm_phase<pg8::EpiIn, pg8::StaticOrder, true, true>(lds, g, S, E);
    }
#if (MK_DUP >> 3) & 1
        GSYNC();
        {
        pg8::Gemm g{hb, (const bf16*)(ws + WS_WIN), MT, NIN, D}; pg8::StaticOrder S; S.init(MT, NIN, G, (int)blockIdx.x);
        pg8::EpiIn E{R1, (float*)(ws + WS_GLOW), ssp};
        pg8::gemm_phase<pg8::EpiIn, pg8::StaticOrder, true, true>(lds, g, S, E);
    }
#endif
    }
    SEAM(3);
    if (IN(4)) {
        {
        for (int it = blockIdx.x; it < 512; it += G) attn_item(P, lds, it, tid, wave, lane);
        for (int it = blockIdx.x; it < 1032; it += G) gla_kv_item(P, lds, it, tid, wave, lane);
    }
#if (MK_DUP >> 4) & 1
        GSYNC();
        {
        for (int it = blockIdx.x; it < 512; it += G) attn_item(P, lds, it, tid, wave, lane);
        for (int it = blockIdx.x; it < 1032; it += G) gla_kv_item(P, lds, it, tid, wave, lane);
    }
#endif
    }
    SEAM(4);
    if (IN(5)) {
        gla_scan(P, wave, lane, G);
#if (MK_DUP >> 5) & 1
        GSYNC();
        gla_scan(P, wave, lane, G);
#endif
    }
    SEAM(5);
    if (IN(6)) {
        { for (int it = blockIdx.x; it < 1024; it += G) gla_out_item(P, lds, it, tid, wave, lane); }
#if (MK_DUP >> 6) & 1
        GSYNC();
        { for (int it = blockIdx.x; it < 1024; it += G) gla_out_item(P, lds, it, tid, wave, lane); }
#endif
    }
    SEAM(6);
    if (IN(7)) {
        {
        bf16* mixed = (bf16*)(ws + WS_KV);
        { pg8::Gemm g{(const bf16*)(ws + WS_YA), (const bf16*)(ws + WS_WA), NFR, D, 512}; pg8::StaticOrder S; S.init(NFR, D, G, (int)blockIdx.x);
          pg8::EpiMix<false> E{R1 + 2304, mixed};
          pg8::gemm_phase<pg8::EpiMix<false>, pg8::StaticOrder, true, true>(lds, g, S, E); }
        { pg8::Gemm g{(const bf16*)(ws + WS_YB), (const bf16*)(ws + WS_WB), NFR, D, 512}; pg8::StaticOrder S; S.init(NFR, D, G, (int)blockIdx.x);
          pg8::EpiMix<true> E{R1 + 3328, mixed};
          pg8::gemm_phase<pg8::EpiMix<true>, pg8::StaticOrder, true, true>(lds, g, S, E); }
    }
#if (MK_DUP >> 7) & 1
        GSYNC();
        {
        bf16* mixed = (bf16*)(ws + WS_KV);
        { pg8::Gemm g{(const bf16*)(ws + WS_YA), (const bf16*)(ws + WS_WA), NFR, D, 512}; pg8::StaticOrder S; S.init(NFR, D, G, (int)blockIdx.x);
          pg8::EpiMix<false> E{R1 + 2304, mixed};
          pg8::gemm_phase<pg8::EpiMix<false>, pg8::StaticOrder, true, true>(lds, g, S, E); }
        { pg8::Gemm g{(const bf16*)(ws + WS_YB), (const bf16*)(ws + WS_WB), NFR, D, 512}; pg8::StaticOrder S; S.init(NFR, D, G, (int)blockIdx.x);
          pg8::EpiMix<true> E{R1 + 3328, mixed};
          pg8::gemm_phase<pg8::EpiMix<true>, pg8::StaticOrder, true, true>(lds, g, S, E); }
    }
#endif
    }
    SEAM(7);
    if (IN(8)) {
        {
        pg8::Gemm g{(const bf16*)(ws + WS_KV), (const bf16*)(ws + WS_WOUT), NFR, D, D}; pg8::StaticOrder S; S.init(NFR, D, G, (int)blockIdx.x);
        pg8::EpiResid E{P.out, P.in[1], P.out, hb, ssp, 1.0f};
        pg8::gemm_phase<pg8::EpiResid, pg8::StaticOrder, true, true>(lds, g, S, E);
    }
#if (MK_DUP >> 8) & 1
        GSYNC();
        {
        pg8::Gemm g{(const bf16*)(ws + WS_KV), (const bf16*)(ws + WS_WOUT), NFR, D, D}; pg8::StaticOrder S; S.init(NFR, D, G, (int)blockIdx.x);
        pg8::EpiResid E{P.out, P.in[1], P.out, hb, ssp, 1.0f};
        pg8::gemm_phase<pg8::EpiResid, pg8::StaticOrder, true, true>(lds, g, S, E);
    }
#endif
    }
    SEAM(8);
    if (IN(9)) {
        {
        pg8::Gemm g{hb, (const bf16*)(ws + WS_WGU2), NFR, NGU, D}; pg8::StaticOrder S; S.init(NFR, NGU, G, (int)blockIdx.x);
        pg8::EpiSwiglu E{R1, ssp};
        pg8::gemm_phase<pg8::EpiSwiglu, pg8::StaticOrder, true, true>(lds, g, S, E);
    }
#if (MK_DUP >> 9) & 1
        GSYNC();
        {
        pg8::Gemm g{hb, (const bf16*)(ws + WS_WGU2), NFR, NGU, D}; pg8::StaticOrder S; S.init(NFR, NGU, G, (int)blockIdx.x);
        pg8::EpiSwiglu E{R1, ssp};
        pg8::gemm_phase<pg8::EpiSwiglu, pg8::StaticOrder, true, true>(lds, g, S, E);
    }
#endif
    }
    SEAM(9);
    if (IN(10)) {
        {
        pg8::Gemm g{R1, (const bf16*)(ws + WS_WD2), NFR, D, FF}; pg8::StaticOrder S; S.init(NFR, D, G, (int)blockIdx.x);
        pg8::EpiResid E{P.out, P.in[1], P.out, nullptr, ssp, 0.5f};
        pg8::gemm_phase<pg8::EpiResid, pg8::StaticOrder, true, true>(lds, g, S, E);
    }
#if (MK_DUP >> 10) & 1
        GSYNC();
        {
        pg8::Gemm g{R1, (const bf16*)(ws + WS_WD2), NFR, D, FF}; pg8::StaticOrder S; S.init(NFR, D, G, (int)blockIdx.x);
        pg8::EpiResid E{P.out, P.in[1], P.out, nullptr, ssp, 0.5f};
        pg8::gemm_phase<pg8::EpiResid, pg8::StaticOrder, true, true>(lds, g, S, E);
    }
#endif
    }
    SEAM(10);
    if (IN(11)) {
        {
        const int gw = blockIdx.x * 8 + wave, NGW = G * 8;
        for (int m = gw; m < NFR; m += NGW) {
            f32x4* rowp = (f32x4*)(P.out + (size_t)m * D) + lane;
            float s = ssp[(size_t)m * 16 + (lane & 15)];
            s += __shfl_xor(s, 1); s += __shfl_xor(s, 2); s += __shfl_xor(s, 4); s += __shfl_xor(s, 8);
            const float rs = __builtin_amdgcn_rsqf(s * (1.0f / 1024.0f) + 1e-6f);
#pragma unroll
            for (int j = 0; j < 4; ++j) { const f32x4 gn = ((const f32x4*)P.in[19])[lane + 64 * j]; f32x4 v = rowp[64 * j]; rowp[64 * j] = v * rs * gn; }
        }
    }
#if (MK_DUP >> 11) & 1
        GSYNC();
        {
        const int gw = blockIdx.x * 8 + wave, NGW = G * 8;
        for (int m = gw; m < NFR; m += NGW) {
            f32x4* rowp = (f32x4*)(P.out + (size_t)m * D) + lane;
            float s = ssp[(size_t)m * 16 + (lane & 15)];
            s += __shfl_xor(s, 1); s += __shfl_xor(s, 2); s += __shfl_xor(s, 4); s += __shfl_xor(s, 8);
            const float rs = __builtin_amdgcn_rsqf(s * (1.0f / 1024.0f) + 1e-6f);
#pragma unroll
            for (int j = 0; j < 4; ++j) { const f32x4 gn = ((const f32x4*)P.in[19])[lane + 64 * j]; f32x4 v = rowp[64 * j]; rowp[64 * j] = v * rs * gn; }
        }
    }
#endif
    }
#if defined(MK_XSYNC)
    for (int xs_ = 0; xs_ < MK_XSYNC; ++xs_) GSYNC();
#endif
#undef IN
#undef SEAM
}

extern "C" void kernel_launch(void* const* d_in, const int* in_sizes, int n_in, void* d_out, int out_size, void* d_ws, size_t ws_size, hipStream_t stream) {
    static int grid = 0;
    if (grid == 0) {
        if (n_in != 20 || out_size != NFR * D || ws_size < WS_END) { fprintf(stderr, "kernel_launch: unexpected shapes (n_in %d out %d ws %zu)\n", n_in, out_size, ws_size); grid = -1; return; }
        int dev = 0, cus = 0, per_cu = 0;
        hipGetDevice(&dev); hipDeviceGetAttribute(&cus, hipDeviceAttributeMultiprocessorCount, dev);
        if (hipFuncSetAttribute((const void*)mega_fwd, hipFuncAttributeMaxDynamicSharedMemorySize, LDS_BYTES) != hipSuccess) { fprintf(stderr, "kernel_launch: hipFuncSetAttribute failed\n"); grid = -1; return; }
        if (hipOccupancyMaxActiveBlocksPerMultiprocessor(&per_cu, (const void*)mega_fwd, 512, LDS_BYTES) != hipSuccess || per_cu < 1) { fprintf(stderr, "kernel_launch: occupancy query failed (%d)\n", per_cu); (void)hipGetLastError(); grid = -1; return; }
        grid = cus * per_cu;
        fprintf(stderr, "kernel_launch: %d CUs x %d blocks -> grid %d\n", cus, per_cu, grid);
    }
    if (grid < 0) return;
    Params p{};
    for (int i = 0; i < 20; ++i) p.in[i] = (const float*)d_in[i];
    p.out = (float*)d_out; p.ws = (unsigned char*)d_ws; p.cg_sync = 0; p.pad = 0;
    if (hipMemsetAsync((char*)d_ws + WS_CTL, 0, CTL_BYTES, stream) != hipSuccess) { fprintf(stderr, "kernel_launch: hipMemsetAsync failed\n"); return; }
#if MK_PER_PHASE
    for (int ph = 0; ph < NPH; ++ph) { p.ph_lo = ph; p.ph_hi = ph + 1; hipLaunchKernelGGL(mega_fwd, dim3(grid), dim3(512), LDS_BYTES, stream, p); }
#else
    p.ph_lo = 0; p.ph_hi = NPH;
    void* args[] = {&p};
    hipError_t e = hipLaunchCooperativeKernel((const void*)mega_fwd, dim3(grid), dim3(512), args, LDS_BYTES, stream);
    if (e != hipSuccess) fprintf(stderr, "kernel_launch: cooperative launch failed: %s (grid %d)\n", hipGetErrorString(e), grid);
#endif
}
```

```cpp
#include <hip/hip_runtime.h>
#include <hip/hip_cooperative_groups.h>
#include <cstdio>
#include <cstdint>
namespace cg = cooperative_groups;
namespace pg8 {
#define PG8_LAS __attribute__((address_space(3)))
typedef unsigned short bf16_t;
typedef short bf16x8 __attribute__((ext_vector_type(8)));
typedef float f32x4 __attribute__((ext_vector_type(4)));
typedef unsigned u32x4 __attribute__((ext_vector_type(4)));
constexpr int BM = 256, BK = 64, HALF = 128, HTB = HALF * BK * 2  , STAGE_BYTES = 8 * HTB, NXCD = 8, WGM = 8;

__host__ __device__ __forceinline__ int lds_byte(int r, int c) { const int st = (r >> 4) * 2 + (c >> 5), rr = r & 15, cc = c & 31, ob = rr * 64 + cc * 2; return st * 1024 + (ob ^ (((ob >> 9) & 1) << 5)); }
__host__ __device__ __forceinline__ void stage_rc(int b, int& R, int& C) { const int st = b / 1024, sb = b % 1024, swz = sb ^ (((sb >> 9) & 1) << 5); R = (st >> 1) * 16 + swz / 64; C = (st & 1) * 32 + (swz % 64) / 2; }
__host__ __device__ __forceinline__ int perm32(int rho) { const int n = rho >> 4, i = rho & 15; return 8 * (i >> 2) + 4 * n + (i & 3); }

struct Unit { int pm, pn; };
struct Gemm { const bf16_t* A; const bf16_t* Bt; int M, N, K; };

struct StaticOrder {
    int nM, nN, nwg, G, c;
    __host__ __device__ void init(int M, int N, int G_, int c_) { nM = M / BM; nN = N / BM; nwg = nM * nN; G = G_; c = c_; }
    __host__ __device__ bool next(int i, Unit& u) const {
        const long L = (long)i * G + c; if (L >= nwg) return false;
        int wgid = (int)L; { const int q = nwg / NXCD, r = nwg % NXCD, xcd = wgid % NXCD, off = wgid / NXCD; wgid = (xcd < r ? xcd * (q + 1) : r * (q + 1) + (xcd - r) * q) + off; }
        const int nig = WGM * nN, gid = wgid / nig, fm = gid * WGM, gsz = (nM - fm) < WGM ? (nM - fm) : WGM;
        u.pm = fm + ((wgid % nig) % gsz); u.pn = (wgid % nig) / gsz; return true;
    }
    __device__ __forceinline__ void a_ready(const Unit&) const {}
    __device__ __forceinline__ void done(const Unit&) const {}
};

__device__ __forceinline__ unsigned cvt_pk_bf16(float lo, float hi) { unsigned r; asm volatile("v_cvt_pk_bf16_f32 %0, %1, %2" : "=v"(r) : "v"(lo), "v"(hi)); return r; }
typedef float f32x2 __attribute__((ext_vector_type(2)));
constexpr int XD = 1024, XFF = 2816, XPBW = 4352, XNFR = 16384;
__device__ __forceinline__ float row_rstd(const float* ssp, int row, int fq) {
    const f32x4 p = *(const f32x4*)(ssp + (size_t)row * 16 + 4 * fq);
    float s = (p[0] + p[1]) + (p[2] + p[3]);
    s += __shfl_xor(s, 16); s += __shfl_xor(s, 32);
    return __builtin_amdgcn_rsqf(s * (1.0f / 1024.0f) + 1e-6f);
}
__device__ __forceinline__ float sigm(float x) { return __builtin_amdgcn_rcpf(1.0f + __expf(-x)); }
__device__ __forceinline__ float bf2f(unsigned short b) { return __uint_as_float((unsigned)b << 16); }
__device__ __forceinline__ float bflo(unsigned w) { return __uint_as_float(w << 16); }
__device__ __forceinline__ float bfhi(unsigned w) { return __uint_as_float(w & 0xffff0000u); }

struct EpiSwiglu {
    static constexpr bool PERM = true, AFTER_DRAIN = false;
    bf16_t* O; const float* ssp;
    __device__ __forceinline__ void operator()(const f32x4 (&acc)[2][2][4][2], const Unit& u, int wr, int wc, int fr, int fq) const {
        const int row0 = u.pm * BM + wr * 64 + fr, col0 = u.pn * HALF + wc * 32 + 8 * fq;
#pragma unroll
        for (int ai = 0; ai < 2; ++ai)
#pragma unroll
            for (int m = 0; m < 4; ++m) {
                const int row = row0 + ai * HALF + m * 16; const float rs = row_rstd(ssp, row, fq);
                const f32x4 g0 = acc[ai][0][m][0] * rs, g1 = acc[ai][0][m][1] * rs, u0 = acc[ai][1][m][0] * rs, u1 = acc[ai][1][m][1] * rs;
                u32x4 w;
                w.x = cvt_pk_bf16(g0[0] * sigm(g0[0]) * u0[0], g0[1] * sigm(g0[1]) * u0[1]);
                w.y = cvt_pk_bf16(g0[2] * sigm(g0[2]) * u0[2], g0[3] * sigm(g0[3]) * u0[3]);
                w.z = cvt_pk_bf16(g1[0] * sigm(g1[0]) * u1[0], g1[1] * sigm(g1[1]) * u1[1]);
                w.w = cvt_pk_bf16(g1[2] * sigm(g1[2]) * u1[2], g1[3] * sigm(g1[3]) * u1[3]);
                *(u32x4*)(O + (size_t)row * XFF + col0) = w;
            }
    }
};

struct EpiResid {
    static constexpr bool PERM = false, AFTER_DRAIN = false;
    const float* base; const float* meta; float* out; bf16_t* hb; float* ssp; float scale;
    __device__ __forceinline__ void operator()(const f32x4 (&acc)[2][2][4][2], const Unit& u, int wr, int wc, int fr, int fq) const {
        typedef unsigned u32x2v __attribute__((ext_vector_type(2)));
        const int row0 = u.pm * BM + wr * 64 + fr, col0 = u.pn * BM + wc * 32 + 4 * fq;
#pragma unroll
        for (int ai = 0; ai < 2; ++ai)
#pragma unroll
            for (int m = 0; m < 4; ++m) {
                const int row = row0 + ai * HALF + m * 16;
                const bool fr_row = row < XNFR, has = row < XNFR + 16;
                const float* bp = fr_row ? base + (size_t)row * XD : meta + (size_t)(has ? row - XNFR : 0) * XD;
                float sq = 0.f;
#pragma unroll
                for (int bj = 0; bj < 2; ++bj)
#pragma unroll
                    for (int n = 0; n < 2; ++n) {
                        const int c = col0 + bj * HALF + n * 16;
                        f32x4 b = *(const f32x4*)(bp + c);
                        if (!has) b = (f32x4){0.f, 0.f, 0.f, 0.f};
                        const f32x4 v = b + acc[ai][bj][m][n] * scale;
                        sq += (v[0] * v[0] + v[1] * v[1]) + (v[2] * v[2] + v[3] * v[3]);
                        if (fr_row) *(f32x4*)(out + (size_t)row * XD + c) = v;
                        if (hb) { u32x2v w; w.x = cvt_pk_bf16(v[0], v[1]); w.y = cvt_pk_bf16(v[2], v[3]); *(u32x2v*)(hb + (size_t)row * XD + c) = w; }
                    }
                sq += __shfl_xor(sq, 16); sq += __shfl_xor(sq, 32);
                if (fq == 0) ssp[(size_t)row * 16 + u.pn * 4 + wc] = sq;
            }
    }
};

struct EpiIn {
    static constexpr bool PERM = true, AFTER_DRAIN = false;
    bf16_t* PB; float* glow; const float* ssp;
    __device__ __forceinline__ void operator()(const f32x4 (&acc)[2][2][4][2], const Unit& u, int wr, int wc, int fr, int fq) const {
        const int row0 = u.pm * BM + wr * 64 + fr, tile = u.pn;
        if (tile == 17) {
            if (wc == 0 && fq < 2) {
#pragma unroll
                for (int ai = 0; ai < 2; ++ai)
#pragma unroll
                    for (int m = 0; m < 4; ++m) {
                        const int row = row0 + ai * HALF + m * 16;
                        const f32x4 p = *(const f32x4*)(ssp + (size_t)row * 16), q = *(const f32x4*)(ssp + (size_t)row * 16 + 4), r = *(const f32x4*)(ssp + (size_t)row * 16 + 8), t = *(const f32x4*)(ssp + (size_t)row * 16 + 12);
                        const float s = (((p[0] + p[1]) + (p[2] + p[3])) + ((q[0] + q[1]) + (q[2] + q[3]))) + (((r[0] + r[1]) + (r[2] + r[3])) + ((t[0] + t[1]) + (t[2] + t[3])));
                        const float rs = __builtin_amdgcn_rsqf(s * (1.0f / 1024.0f) + 1e-6f);
                        *(f32x4*)(glow + (size_t)row * 16 + 8 * fq) = acc[ai][0][m][0] * rs;
                        *(f32x4*)(glow + (size_t)row * 16 + 8 * fq + 4) = acc[ai][0][m][1] * rs;
                    }
            }
            return;
        }
        const int mode = (tile <= 1 || tile == 3) ? 1 : (tile == 7 || tile == 8) ? 2 : (tile >= 9 ? 3 : 0);
        const int col0 = tile * BM + wc * 32 + 8 * fq;
#pragma unroll
        for (int ai = 0; ai < 2; ++ai)
#pragma unroll
            for (int m = 0; m < 4; ++m) {
                const int row = row0 + ai * HALF + m * 16; const float rs = row_rstd(ssp, row, fq);
#pragma unroll
                for (int bj = 0; bj < 2; ++bj) {
                    f32x4 v0 = acc[ai][bj][m][0] * rs, v1 = acc[ai][bj][m][1] * rs;
                    if (mode == 1) { v0 = v0 * 0.125f; v1 = v1 * 0.125f; }
                    else if (mode == 2) {
#pragma unroll
                        for (int j = 0; j < 4; ++j) { v0[j] = v0[j] * sigm(v0[j]); v1[j] = v1[j] * sigm(v1[j]); } }
                    else if (mode == 3) {
#pragma unroll
                        for (int j = 0; j < 4; ++j) { v0[j] = sigm(v0[j]); v1[j] = sigm(v1[j]); } }
                    u32x4 w; w.x = cvt_pk_bf16(v0[0], v0[1]); w.y = cvt_pk_bf16(v0[2], v0[3]); w.z = cvt_pk_bf16(v1[0], v1[1]); w.w = cvt_pk_bf16(v1[2], v1[3]);
                    *(u32x4*)(PB + (size_t)row * XPBW + col0 + bj * HALF) = w;
                }
            }
    }
};

template <bool ADD> struct EpiMix {
    static constexpr bool PERM = true, AFTER_DRAIN = false;
    const bf16_t* gate; bf16_t* mixed;
    __device__ __forceinline__ void operator()(const f32x4 (&acc)[2][2][4][2], const Unit& u, int wr, int wc, int fr, int fq) const {
        const int row0 = u.pm * BM + wr * 64 + fr, col0 = u.pn * BM + wc * 32 + 8 * fq;
#pragma unroll
        for (int ai = 0; ai < 2; ++ai)
#pragma unroll
            for (int m = 0; m < 4; ++m) {
                const int row = row0 + ai * HALF + m * 16;
#pragma unroll
                for (int bj = 0; bj < 2; ++bj) {
                    const int c = col0 + bj * HALF;
                    const u32x4 g = *(const u32x4*)(gate + (size_t)row * XPBW + c);
                    const f32x4 a0 = acc[ai][bj][m][0], a1 = acc[ai][bj][m][1];
                    float v[8] = {bflo(g.x) * a0[0], bfhi(g.x) * a0[1], bflo(g.y) * a0[2], bfhi(g.y) * a0[3], bflo(g.z) * a1[0], bfhi(g.z) * a1[1], bflo(g.w) * a1[2], bfhi(g.w) * a1[3]};
                    if (ADD) { const u32x4 o = *(const u32x4*)(mixed + (size_t)row * XD + c);
                        v[0] += bflo(o.x); v[1] += bfhi(o.x); v[2] += bflo(o.y); v[3] += bfhi(o.y); v[4] += bflo(o.z); v[5] += bfhi(o.z); v[6] += bflo(o.w); v[7] += bfhi(o.w); }
                    u32x4 w; w.x = cvt_pk_bf16(v[0], v[1]); w.y = cvt_pk_bf16(v[2], v[3]); w.z = cvt_pk_bf16(v[4], v[5]); w.w = cvt_pk_bf16(v[6], v[7]);
                    *(u32x4*)(mixed + (size_t)row * XD + c) = w;
                }
            }
    }
};

template <class Epi, class Sched, bool ALIGN_EPI = false, bool SP2 = false>
__device__ __forceinline__ void gemm_phase(PG8_LAS unsigned char* lds, const Gemm g, const Sched& S, const Epi& E) {
    const int tid = threadIdx.x, wid = __builtin_amdgcn_readfirstlane(tid >> 6), lane = tid & 63, wr = wid >> 2, wc = wid & 3, fr = lane & 15, fq = lane >> 4;
    const int K = g.K, nt = K / BK;
    unsigned voffA[2], voffB[2];
#pragma unroll
    for (int i = 0; i < 2; ++i) { int R, C; stage_rc(tid * 16 + i * 8192, R, C); const int Rb = Epi::PERM ? ((R & ~31) + perm32(R & 31)) : R;
        voffA[i] = (unsigned)(R * K + C) * 2u; voffB[i] = (unsigned)(Rb * K + C) * 2u; }
    const size_t kstep = (size_t)(BK * 2);
    const size_t hstep = (size_t)HALF * K * 2;
    const size_t tstep = 2 * hstep;
    const unsigned ldsw = (unsigned)wid * 1024u;
    const int aoff = lds_byte(wr * 64 + fr, fq * 8), boff = lds_byte(wc * 32 + fr, fq * 8);
#define PG8_SA(b, h) (((b) * 2 + (h)) * HTB)
#define PG8_SB(b, h) ((4 + (b) * 2 + (h)) * HTB)
#define PG8_STAGE(bufoff, gbase, voff) do { _Pragma("unroll") for (int _i = 0; _i < 2; ++_i) \
        __builtin_amdgcn_global_load_lds((const unsigned*)((const char*)(gbase) + (voff)[_i]), (PG8_LAS unsigned*)(lds + (bufoff) + ldsw + _i * 8192), 16, 0, 0); } while (0)
#define PG8_LDA(dst, b, h) do { _Pragma("unroll") for (int m = 0; m < 4; ++m) _Pragma("unroll") for (int k = 0; k < 2; ++k) dst[m][k] = *(const PG8_LAS bf16x8*)(lds + PG8_SA(b, h) + aoff + m * 2048 + k * 1024); } while (0)
#define PG8_LDB(dst, b, h) do { _Pragma("unroll") for (int n = 0; n < 2; ++n) _Pragma("unroll") for (int k = 0; k < 2; ++k) dst[n][k] = *(const PG8_LAS bf16x8*)(lds + PG8_SB(b, h) + boff + n * 2048 + k * 1024); } while (0)
#define PG8_MMA(ai, bj, At, Bt) do { __builtin_amdgcn_s_setprio(1); _Pragma("unroll") for (int m = 0; m < 4; ++m) _Pragma("unroll") for (int n = 0; n < 2; ++n) _Pragma("unroll") for (int k = 0; k < 2; ++k) \
        acc[ai][bj][m][n] = __builtin_amdgcn_mfma_f32_16x16x32_bf16(Bt[n][k], At[m][k], acc[ai][bj][m][n], 0, 0, 0); __builtin_amdgcn_s_setprio(0); } while (0)
#define PG8_WAIT_V(n) asm volatile("s_waitcnt vmcnt(" #n ")" ::: "memory")
#define PG8_WAIT_L(n) asm volatile("s_waitcnt lgkmcnt(" #n ")" ::: "memory")
#define PG8_BAR __builtin_amdgcn_s_barrier()
#define PG8_SCHED __builtin_amdgcn_sched_barrier(0)
    Unit cur, nxt; int ui = 0;
    if (!S.next(0, cur)) return;
    f32x4 acc[2][2][4][2];
#pragma unroll
    for (int a = 0; a < 2; ++a)
#pragma unroll
        for (int b = 0; b < 2; ++b)
#pragma unroll
            for (int m = 0; m < 4; ++m)
#pragma unroll
                for (int n = 0; n < 2; ++n) acc[a][b][m][n] = (f32x4){0.f, 0.f, 0.f, 0.f};
    bf16x8 At[4][2], B0[2][2], B1[2][2];
    const char* cA = (const char*)g.A + (size_t)cur.pm * tstep; const char* cB = (const char*)g.Bt + (size_t)cur.pn * tstep;
    S.a_ready(cur);
    if constexpr (SP2) {
        PG8_STAGE(PG8_SB(0, 0), cB, voffB); PG8_STAGE(PG8_SB(0, 1), cB + hstep, voffB); PG8_STAGE(PG8_SA(0, 0), cA, voffA); PG8_STAGE(PG8_SA(0, 1), cA + hstep, voffA);
        if (wr == 1) PG8_BAR;
        PG8_WAIT_V(2); PG8_BAR;
        PG8_STAGE(PG8_SB(1, 0), cB + kstep, voffB); PG8_STAGE(PG8_SA(1, 0), cA + kstep, voffA); PG8_STAGE(PG8_SB(1, 1), cB + hstep + kstep, voffB);
        PG8_WAIT_V(6); PG8_BAR;
    } else {
        PG8_STAGE(PG8_SB(0, 0), cB, voffB); PG8_STAGE(PG8_SA(0, 0), cA, voffA); PG8_STAGE(PG8_SB(0, 1), cB + hstep, voffB); PG8_STAGE(PG8_SA(0, 1), cA + hstep, voffA);
        if (wr == 1) PG8_BAR;
        PG8_WAIT_V(4); PG8_BAR;
        PG8_STAGE(PG8_SB(1, 0), cB + kstep, voffB); PG8_STAGE(PG8_SA(1, 0), cA + kstep, voffA); PG8_STAGE(PG8_SB(1, 1), cB + hstep + kstep, voffB);
        PG8_WAIT_V(6); PG8_BAR;
    }
    for (;;) {
        const bool has_next = S.next(ui + 1, nxt);
        const char* nA = has_next ? (const char*)g.A + (size_t)nxt.pm * tstep : cA; const char* nB = has_next ? (const char*)g.Bt + (size_t)nxt.pn * tstep : cB;
        for (int t = 0; t < nt; t += 2) {
            const bool last = (t == nt - 2);
            const char* a1 = cA + (size_t)(t + 1) * kstep;
            const char* a2 = last ? nA : cA + (size_t)(t + 2) * kstep; const char* b2 = last ? nB : cB + (size_t)(t + 2) * kstep;
            const char* a3 = a2 + kstep; const char* b3 = b2 + kstep;
            if (last && has_next) S.a_ready(nxt);
            if constexpr (SP2) {
            PG8_LDB(B0, 0, 0); PG8_LDB(B1, 0, 1); PG8_SCHED; PG8_LDA(At, 0, 0); PG8_STAGE(PG8_SA(1, 1), a1 + hstep, voffA);
            PG8_WAIT_V(8); PG8_WAIT_L(0); PG8_BAR; PG8_MMA(0, 0, At, B0); PG8_MMA(0, 1, At, B1); PG8_BAR; PG8_SCHED;
            PG8_LDA(At, 0, 1); PG8_STAGE(PG8_SB(0, 0), b2, voffB); PG8_STAGE(PG8_SB(0, 1), b2 + hstep, voffB); PG8_STAGE(PG8_SA(0, 0), a2, voffA);
            PG8_WAIT_V(8); PG8_WAIT_L(0); PG8_BAR; PG8_MMA(1, 0, At, B0); PG8_MMA(1, 1, At, B1); PG8_BAR; PG8_SCHED;
            PG8_LDB(B0, 1, 0); PG8_LDB(B1, 1, 1); PG8_SCHED; PG8_LDA(At, 1, 0); PG8_STAGE(PG8_SA(0, 1), a2 + hstep, voffA);
            PG8_WAIT_V(8); PG8_WAIT_L(0); PG8_BAR; PG8_MMA(0, 0, At, B0); PG8_MMA(0, 1, At, B1); PG8_BAR; PG8_SCHED;
            PG8_LDA(At, 1, 1); PG8_STAGE(PG8_SB(1, 0), b3, voffB); PG8_STAGE(PG8_SB(1, 1), b3 + hstep, voffB); PG8_STAGE(PG8_SA(1, 0), a3, voffA);
            PG8_WAIT_V(8); PG8_WAIT_L(0); PG8_BAR; PG8_MMA(1, 0, At, B0); PG8_MMA(1, 1, At, B1); PG8_BAR; PG8_SCHED;
            } else {
            PG8_LDB(B0, 0, 0); PG8_SCHED; PG8_LDA(At, 0, 0); PG8_STAGE(PG8_SA(1, 1), a1 + hstep, voffA);
            PG8_WAIT_L(8); PG8_BAR; PG8_WAIT_L(0); PG8_MMA(0, 0, At, B0); PG8_BAR; PG8_SCHED;
            PG8_LDB(B1, 0, 1); PG8_STAGE(PG8_SB(0, 0), b2, voffB);
            PG8_BAR; PG8_WAIT_L(0); PG8_MMA(0, 1, At, B1); PG8_BAR;
            PG8_LDA(At, 0, 1); PG8_STAGE(PG8_SA(0, 0), a2, voffA);
            PG8_BAR; PG8_WAIT_L(0); PG8_MMA(1, 0, At, B0); PG8_BAR; PG8_SCHED;
            PG8_STAGE(PG8_SB(0, 1), b2 + hstep, voffB);
            PG8_WAIT_V(6); PG8_BAR; PG8_MMA(1, 1, At, B1); PG8_BAR;
            PG8_LDB(B0, 1, 0); PG8_SCHED; PG8_LDA(At, 1, 0); PG8_STAGE(PG8_SA(0, 1), a2 + hstep, voffA);
            PG8_WAIT_L(8); PG8_BAR; PG8_WAIT_L(0); PG8_MMA(0, 0, At, B0); PG8_BAR; PG8_SCHED;
            PG8_LDB(B1, 1, 1); PG8_STAGE(PG8_SB(1, 0), b3, voffB);
            PG8_BAR; PG8_WAIT_L(0); PG8_MMA(0, 1, At, B1); PG8_BAR;
            PG8_LDA(At, 1, 1); PG8_STAGE(PG8_SA(1, 0), a3, voffA);
            PG8_BAR; PG8_WAIT_L(0); PG8_MMA(1, 0, At, B0); PG8_BAR; PG8_SCHED;
            PG8_STAGE(PG8_SB(1, 1), b3 + hstep, voffB);
            PG8_WAIT_V(6); PG8_BAR; PG8_MMA(1, 1, At, B1); PG8_BAR;
            }
        }
        if constexpr (ALIGN_EPI) { if (wr == 0) PG8_BAR; }
        if constexpr (!Epi::AFTER_DRAIN) { E(acc, cur, wr, wc, fr, fq); S.done(cur); }
        if (!has_next) break;
#pragma unroll
        for (int a = 0; a < 2; ++a)
#pragma unroll
            for (int b = 0; b < 2; ++b)
#pragma unroll
                for (int m = 0; m < 4; ++m)
#pragma unroll
                    for (int n = 0; n < 2; ++n) acc[a][b][m][n] = (f32x4){0.f, 0.f, 0.f, 0.f};
        cur = nxt; cA = nA; cB = nB; ++ui;
        if constexpr (ALIGN_EPI) { if (wr == 1) PG8_BAR; }
    }
    PG8_WAIT_V(0);
    if constexpr (!ALIGN_EPI) { if (wr == 0) PG8_BAR; }
    PG8_BAR;
    if constexpr (Epi::AFTER_DRAIN) { E.fused(acc, cur, wr, wc, fr, fq, lds, wid, lane); S.done(cur); }
#undef PG8_SA
#undef PG8_SB
#undef PG8_STAGE
#undef PG8_LDA
#undef PG8_LDB
#undef PG8_MMA
#undef PG8_WAIT_V
#undef PG8_WAIT_L
#undef PG8_BAR
#undef PG8_SCHED
}
}
#define LAS __attribute__((address_space(3)))
#define XB_TMO      128
#define XB_XCNT(j)  (256  + 64 * (j))
#define XB_XSUB(j)  (1280 + 64 * (j))
#define XB_XGEN(j)  (2304 + 64 * (j))
#define XB_TOP      3328
#define XB_TOPGEN   3392
#define XCD_BAR_WORDS 3456
#define XB_SPIN_CAP (1u << 18)

__device__ __forceinline__ unsigned xb_ld(unsigned* p)              { return __hip_atomic_load(p, __ATOMIC_RELAXED, __HIP_MEMORY_SCOPE_AGENT); }
__device__ __forceinline__ unsigned xb_add(unsigned* p, unsigned v) { return __hip_atomic_fetch_add(p, v, __ATOMIC_RELAXED, __HIP_MEMORY_SCOPE_AGENT); }
__device__ __forceinline__ unsigned xb_xcc_id() { return (unsigned)__builtin_amdgcn_s_getreg((3 << 11) | 20) & 0xFu; }
#define XB_SPIN(cond, bar) do { unsigned _sp = 0; while (cond) { __builtin_amdgcn_s_sleep(1); \
    if ((++_sp & 255u) == 0u) { if (xb_ld(&(bar)[XB_TMO])) break; if (_sp > XB_SPIN_CAP) { atomicAdd(&(bar)[XB_TMO], 1u); break; } } } } while (0)

struct XcdBarrier {
    unsigned* bar; unsigned x;
    volatile LAS unsigned* st;
};

__device__ __forceinline__ XcdBarrier xcd_barrier_post(unsigned* bar, volatile LAS unsigned* st) {
    XcdBarrier b; b.bar = bar; b.x = xb_xcc_id(); b.st = st;
    if (threadIdx.x == 0) (void)xb_add(&bar[XB_XCNT(b.x)], 1u);
    return b;
}
__device__ __forceinline__ void xcd_barrier_complete(unsigned* bar, unsigned x, unsigned& nloc, unsigned& nx) {
    const unsigned G = gridDim.x * gridDim.y * gridDim.z;
    unsigned sum, cnt, mine, sp = 0u;
    for (;;) {
        sum = 0u; cnt = 0u; mine = 0u;
#pragma unroll
        for (unsigned j = 0; j < 16; ++j) { const unsigned c = xb_ld(&bar[XB_XCNT(j)]); sum += c; cnt += (c > 0u) ? 1u : 0u; mine = (j == x) ? c : mine; }
        if (sum == G) break;
        __builtin_amdgcn_s_sleep(1);
        if ((++sp & 255u) == 0u) { if (xb_ld(&bar[XB_TMO])) break; if (sp > XB_SPIN_CAP) { atomicAdd(&bar[XB_TMO], 1u); break; } }
    }
    nloc = mine > 0u ? mine : 1u; nx = cnt > 0u ? cnt : 1u;
}

__device__ __forceinline__ void xcd_barrier(const XcdBarrier& b) {
    asm volatile("s_waitcnt vmcnt(0)" ::: "memory");
    __syncthreads();
    if (threadIdx.x == 0) {
        unsigned* bar = b.bar;
        __builtin_amdgcn_s_waitcnt(0);
        unsigned nloc = b.st[0], nx = b.st[1];
        if (nloc == 0u) { xcd_barrier_complete(bar, b.x, nloc, nx); b.st[0] = nloc; b.st[1] = nx; }
        const unsigned old = xb_add(&bar[XB_XSUB(b.x)], 1u);
        const unsigned gen = old / nloc;
        if (old + 1u == (gen + 1u) * nloc) {
            __builtin_amdgcn_fence(__ATOMIC_RELEASE, "agent");
            asm volatile("s_waitcnt vmcnt(0)" ::: "memory");
            const unsigned og = xb_add(&bar[XB_TOP], 1u);
            const unsigned tg = og / nx;
            if (og + 1u == (tg + 1u) * nx) xb_add(&bar[XB_TOPGEN], 1u);
            else XB_SPIN(xb_ld(&bar[XB_TOPGEN]) == tg, bar);
            __builtin_amdgcn_fence(__ATOMIC_ACQUIRE, "agent");
            xb_add(&bar[XB_XGEN(b.x)], 1u);
            asm volatile("s_waitcnt vmcnt(0)" ::: "memory");
        } else {
            XB_SPIN(xb_ld(&bar[XB_XGEN(b.x)]) == gen, bar);
            __builtin_amdgcn_fence(__ATOMIC_ACQUIRE, "agent");
            asm volatile("s_waitcnt vmcnt(0)" ::: "memory");
        }
    }
    __syncthreads();
}

#ifndef MK_DUP
#define MK_DUP 0
#endif
#ifndef MK_PER_PHASE
#define MK_PER_PHASE 0
#endif
#define LAS __attribute__((address_space(3)))
typedef unsigned short bf16;
typedef short bf16x8 __attribute__((ext_vector_type(8)));
typedef short s16x4 __attribute__((ext_vector_type(4)));
typedef float f32x4 __attribute__((ext_vector_type(4)));
typedef float f32x16 __attribute__((ext_vector_type(16)));
typedef unsigned u32x4 __attribute__((ext_vector_type(4)));
typedef unsigned u32x2 __attribute__((ext_vector_type(2)));
typedef float f32x2m __attribute__((ext_vector_type(2)));
#define MFMA32(a, b, c) __builtin_amdgcn_mfma_f32_32x32x16_bf16((a), (b), (c), 0, 0, 0)
#define LDS_WAIT() asm volatile("s_waitcnt lgkmcnt(0)" ::: "memory")

constexpr int NFR = 16384, MT = 16640, D = 1024, FF = 2816, NGU = 5632, NIN = 4608, PBW = 4352, DIN = 4368;
constexpr int NPH = 12;
constexpr int LDS_BYTES = 147456, MISC_OFF = 131072 + 320, CTL_BYTES = 16384;
constexpr size_t MiB = 1u << 20;
constexpr size_t WS_WGU1 = 0, WS_WD1 = 11 * MiB, WS_ST = 0  , WS_WGU2 = 17 * MiB, WS_WD2 = 28 * MiB, WS_WIN = 34 * MiB,
                 WS_WA = 43 * MiB, WS_WB = 44 * MiB, WS_WOUT = 45 * MiB, WS_SSP = 47 * MiB, WS_GLOW = 49 * MiB, WS_DEC = 51 * MiB, WS_CTL = 51 * MiB + MiB / 2  , WS_MSSP = 51 * MiB + 3 * MiB / 4  ,
                 WS_HB = 52 * MiB, WS_YA = 52 * MiB, WS_YB = 68 * MiB  , WS_R1 = 85 * MiB  ,
                 WS_KV = 223 * MiB + MiB / 2  , WS_END = 256 * MiB;
static_assert(WS_ST + (size_t)1032 * 8192 * 2 <= WS_WGU2 && WS_R1 + (size_t)MT * PBW * 2 <= WS_KV && WS_KV + (size_t)1032 * 8192 * 4 <= WS_END && WS_HB + (size_t)MT * D * 2 <= WS_R1, "d_ws map");

struct Params { const float* in[20]; float* out; unsigned char* ws; int ph_lo, ph_hi, cg_sync, pad; };

__device__ __forceinline__ int crow(int reg, int h) { return (reg & 3) + 8 * (reg >> 2) + 4 * h; }
__device__ __forceinline__ unsigned f2bf(float f) { unsigned u = __float_as_uint(f); return (u + 0x7fffu + ((u >> 16) & 1u)) >> 16; }
__device__ __forceinline__ unsigned pk2(float lo, float hi) { return f2bf(lo) | (f2bf(hi) << 16); }
__device__ __forceinline__ float wave_sum(float v) {
#pragma unroll
    for (int o = 1; o < 64; o <<= 1) v += __shfl_xor(v, o);
    return v;
}
__device__ __forceinline__ bf16x8 pack8(float a, float b, float c, float d, float e, float f, float g, float h) {
    u32x4 p; p.x = pk2(a, b); p.y = pk2(c, d); p.z = pk2(e, f); p.w = pk2(g, h); return __builtin_bit_cast(bf16x8, p);
}

__device__ __forceinline__ void tr_item64(const float* W, int K, int N, int k0, int sn0, int nvalid, const float* gain, bf16* WT, int drow0, LAS unsigned* T, int lane) {
    const int n4 = (lane & 15) * 4, kp = lane >> 4; const bool cv = n4 < nvalid;
    f32x4 a[8], b[8];
#pragma unroll
    for (int st = 0; st < 8; ++st) { const float* p = W + (size_t)(k0 + 8 * st + 2 * kp) * N + sn0 + n4;
        a[st] = cv ? *(const f32x4*)p : (f32x4){0.f, 0.f, 0.f, 0.f}; b[st] = cv ? *(const f32x4*)(p + N) : (f32x4){0.f, 0.f, 0.f, 0.f}; }
#pragma unroll
    for (int st = 0; st < 8; ++st) { const int k = k0 + 8 * st + 2 * kp; float g0 = 1.f, g1 = 1.f; if (gain) { g0 = gain[k]; g1 = gain[k + 1]; }
        LAS unsigned* t = T + n4 * 33 + 4 * st + kp;
        t[0] = pk2(a[st][0] * g0, b[st][0] * g1); t[33] = pk2(a[st][1] * g0, b[st][1] * g1); t[66] = pk2(a[st][2] * g0, b[st][2] * g1); t[99] = pk2(a[st][3] * g0, b[st][3] * g1); }
    LDS_WAIT(); asm volatile("" ::: "memory");
    const int c = lane & 7;
#pragma unroll
    for (int q = 0; q < 8; ++q) { const int n = (lane >> 3) + 8 * q; const LAS unsigned* t = T + n * 33 + 4 * c;
        u32x4 o; o.x = t[0]; o.y = t[1]; o.z = t[2]; o.w = t[3];
        *(u32x4*)(WT + (size_t)(drow0 + n) * K + k0 + 8 * c) = o; }
    LDS_WAIT(); asm volatile("" ::: "memory");
}
__device__ __forceinline__ void p0_prep(const Params& P, LAS unsigned char* lds, int wave, int lane, int G) {
    unsigned char* ws = P.ws;
    LAS unsigned* scr = (LAS unsigned*)(lds + wave * 16384);
    const int gw = blockIdx.x * 8 + wave, NGW = G * 8;
    constexpr int I_GU = 16 * 44, I_DN = 44 * 16, I_IN = 16 * 72, I_BR = 8 * 16, I_WO = 16 * 16;
    constexpr int NITEMS = 4 * I_GU + 2 * I_DN + I_IN + 2 * I_BR + I_WO;
    for (int it = gw; it < NITEMS; it += NGW) {
        int r = it;
        if (r < 2 * I_GU + I_DN) {
            if (r < 2 * I_GU) { const int up = r >= I_GU; r -= up * I_GU; const int kb = r / 44, n0 = (r % 44) * 64;
                tr_item64(up ? P.in[4] : P.in[3], D, FF, kb * 64, n0, 64, P.in[2], (bf16*)(ws + WS_WGU1), (n0 >> 7) * 256 + (n0 & 127) + up * 128, scr, lane); }
            else { r -= 2 * I_GU; tr_item64(P.in[5], FF, D, (r / 16) * 64, (r % 16) * 64, 64, nullptr, (bf16*)(ws + WS_WD1), (r % 16) * 64, scr, lane); }
            continue; }
        r -= 2 * I_GU + I_DN;
        if (r < 2 * I_GU + I_DN) {
            if (r < 2 * I_GU) { const int up = r >= I_GU; r -= up * I_GU; const int kb = r / 44, n0 = (r % 44) * 64;
                tr_item64(up ? P.in[17] : P.in[16], D, FF, kb * 64, n0, 64, P.in[15], (bf16*)(ws + WS_WGU2), (n0 >> 7) * 256 + (n0 & 127) + up * 128, scr, lane); }
            else { r -= 2 * I_GU; tr_item64(P.in[18], FF, D, (r / 16) * 64, (r % 16) * 64, 64, nullptr, (bf16*)(ws + WS_WD2), (r % 16) * 64, scr, lane); }
            continue; }
        r -= 2 * I_GU + I_DN;
        if (r < I_IN) { const int kb = r / 72, d0 = (r % 72) * 64; int sn0, nv;
            if (d0 < 2304) { sn0 = d0; nv = 64; } else if (d0 < 4352) { sn0 = d0 + 16; nv = 64; } else if (d0 == 4352) { sn0 = 2304; nv = 16; } else { sn0 = 0; nv = 0; }
            tr_item64(P.in[7], D, DIN, kb * 64, sn0, nv, P.in[6], (bf16*)(ws + WS_WIN), d0, scr, lane); continue; }
        r -= I_IN;
        if (r < I_BR) { tr_item64(P.in[12], 512, D, (r / 16) * 64, (r % 16) * 64, 64, nullptr, (bf16*)(ws + WS_WA), (r % 16) * 64, scr, lane); continue; }
        r -= I_BR;
        if (r < I_BR) { tr_item64(P.in[13], 512, D, (r / 16) * 64, (r % 16) * 64, 64, nullptr, (bf16*)(ws + WS_WB), (r % 16) * 64, scr, lane); continue; }
        r -= I_BR;
        tr_item64(P.in[14], D, D, (r / 16) * 64, (r % 16) * 64, 64, nullptr, (bf16*)(ws + WS_WOUT), (r % 16) * 64, scr, lane);
    }
    bf16* hb = (bf16*)(ws + WS_HB); float* ssp = (float*)(ws + WS_SSP);
    for (int m0 = gw; m0 < MT; m0 += 2 * NGW) {
        f32x4 v[2][4]; float s[2];
#pragma unroll
        for (int u = 0; u < 2; ++u) { const int m = m0 + u * NGW;
            const float* src = m < NFR ? P.in[0] + (size_t)m * D : (m < NFR + 16 ? P.in[1] + (size_t)(m - NFR) * D : nullptr);
#pragma unroll
            for (int j = 0; j < 4; ++j) v[u][j] = src ? ((const f32x4*)src)[lane + 64 * j] : (f32x4){0.f, 0.f, 0.f, 0.f}; }
#pragma unroll
        for (int u = 0; u < 2; ++u) { const int m = m0 + u * NGW; s[u] = 0.f;
#pragma unroll
            for (int j = 0; j < 4; ++j) s[u] += (v[u][j][0] * v[u][j][0] + v[u][j][1] * v[u][j][1]) + (v[u][j][2] * v[u][j][2] + v[u][j][3] * v[u][j][3]);
            s[u] = wave_sum(s[u]);
            if (m < MT) {
                u32x2* o8 = (u32x2*)(hb + (size_t)m * D) + lane;
#pragma unroll
                for (int j = 0; j < 4; ++j) { u32x2 w; w.x = pk2(v[u][j][0], v[u][j][1]); w.y = pk2(v[u][j][2], v[u][j][3]); o8[64 * j] = w; }
                if (lane < 16) ssp[(size_t)m * 16 + lane] = lane == 0 ? s[u] : 0.f; } }
    }
}

typedef float f32x4m __attribute__((ext_vector_type(4)));
#define MFMA16(a, b, c) __builtin_amdgcn_mfma_f32_16x16x32_bf16((a), (b), (c), 0, 0, 0)
__device__ __forceinline__ f32x4m meta_mm(const bf16* A, const bf16* Brow, int K, int k0, int nsteps, int lane) {
    const int r = lane & 15, quad = lane >> 4;
    const bf16* ap = A + (size_t)r * K + k0 + quad * 8; const bf16* bp = Brow + (size_t)r * K + k0 + quad * 8;
    f32x4m acc = (f32x4m){0.f, 0.f, 0.f, 0.f};
#pragma unroll 8
    for (int st = 0; st < nsteps; ++st) { const bf16x8 a = *(const bf16x8*)(ap + 32 * st), b = *(const bf16x8*)(bp + 32 * st); acc = MFMA16(a, b, acc); }
    return acc;
}
__device__ __forceinline__ float sum16(const float* p) { const f32x4 a = *(const f32x4*)p, b = *(const f32x4*)(p + 4), c = *(const f32x4*)(p + 8), d = *(const f32x4*)(p + 12);
    return (((a[0] + a[1]) + (a[2] + a[3])) + ((b[0] + b[1]) + (b[2] + b[3]))) + (((c[0] + c[1]) + (c[2] + c[3])) + ((d[0] + d[1]) + (d[2] + d[3]))); }
__device__ __forceinline__ void meta_p1(const Params& P, int wave, int lane, int G) {
    const int mt = (G - 1 - (int)blockIdx.x) * 8 + wave; if (mt >= 176) return;
    unsigned char* ws = P.ws; const bf16* hbm = (const bf16*)(ws + WS_HB) + (size_t)NFR * D; const bf16* W = (const bf16*)(ws + WS_WGU1);
    bf16* actm = (bf16*)(ws + WS_R1) + (size_t)NFR * FF; const float* ssp = (const float*)(ws + WS_SSP) + (size_t)NFR * 16;
    const int c0 = 16 * mt, grow = (c0 >> 7) * 256 + (c0 & 127), r = lane & 15, quad = lane >> 4;
    const f32x4m g = meta_mm(hbm, W + (size_t)grow * D, D, 0, 32, lane), u = meta_mm(hbm, W + (size_t)(grow + 128) * D, D, 0, 32, lane);
#pragma unroll
    for (int j = 0; j < 4; ++j) { const int row = quad * 4 + j; const float rs = __builtin_amdgcn_rsqf(sum16(ssp + row * 16) * (1.0f / 1024.0f) + 1e-6f);
        const float gv = g[j] * rs, uv = u[j] * rs; actm[(size_t)row * FF + c0 + r] = (bf16)f2bf(gv * pg8::sigm(gv) * uv); }
}
__device__ __forceinline__ void meta_p2(const Params& P, LAS unsigned char* L, int wave, int lane) {
    if (blockIdx.x >= 32) return;
    unsigned char* ws = P.ws; const bf16* actm = (const bf16*)(ws + WS_R1) + (size_t)NFR * FF; const bf16* W = (const bf16*)(ws + WS_WD1);
    bf16* hbm = (bf16*)(ws + WS_HB) + (size_t)NFR * D; float* mssp = (float*)(ws + WS_MSSP);
    const int ctl = wave >> 2, ks = wave & 3, ct = blockIdx.x * 2 + ctl, r = lane & 15, quad = lane >> 4;
    const f32x4m acc = meta_mm(actm, W + (size_t)(ct * 16) * FF, FF, ks * 704, 22, lane);
    LAS f32x4m* red = (LAS f32x4m*)L;
    red[(ctl * 4 + ks) * 64 + lane] = acc;
    __syncthreads();
    if (ks == 0) {
        const f32x4m t = (red[(ctl * 4) * 64 + lane] + red[(ctl * 4 + 1) * 64 + lane]) + (red[(ctl * 4 + 2) * 64 + lane] + red[(ctl * 4 + 3) * 64 + lane]);
#pragma unroll
        for (int j = 0; j < 4; ++j) { const int row = quad * 4 + j, col = ct * 16 + r; const float v = P.in[1][(size_t)row * D + col] + 0.5f * t[j];
            hbm[(size_t)row * D + col] = (bf16)f2bf(v);
            float sq = v * v; sq += __shfl_xor(sq, 1); sq += __shfl_xor(sq, 2); sq += __shfl_xor(sq, 4); sq += __shfl_xor(sq, 8);
            if (r == 0) mssp[row * 64 + ct] = sq; }
    }
    __syncthreads();
}
__device__ __forceinline__ void meta_p3(const Params& P, int wave, int lane, int G) {
    const int mt = (G - 1 - (int)blockIdx.x) * 8 + wave; if (mt >= 65) return;
    unsigned char* ws = P.ws; const bf16* hbm = (const bf16*)(ws + WS_HB) + (size_t)NFR * D; const bf16* W = (const bf16*)(ws + WS_WIN);
    bf16* PBm = (bf16*)(ws + WS_R1) + (size_t)NFR * PBW; float* glowm = (float*)(ws + WS_GLOW) + (size_t)NFR * 16; const float* mssp = (const float*)(ws + WS_MSSP);
    const int col0 = mt < 16 ? 512 + 16 * mt : (mt < 32 ? 1024 + 16 * (mt - 16) : (mt < 64 ? 1280 + 16 * (mt - 32) : 4352)), r = lane & 15, quad = lane >> 4;
    const f32x4m acc = meta_mm(hbm, W + (size_t)col0 * D, D, 0, 32, lane);
#pragma unroll
    for (int j = 0; j < 4; ++j) { const int row = quad * 4 + j;
        const f32x4 p = *(const f32x4*)(mssp + row * 64 + 4 * r); float sq = (p[0] + p[1]) + (p[2] + p[3]);
        sq += __shfl_xor(sq, 1); sq += __shfl_xor(sq, 2); sq += __shfl_xor(sq, 4); sq += __shfl_xor(sq, 8);
        const float v = acc[j] * __builtin_amdgcn_rsqf(sq * (1.0f / 1024.0f) + 1e-6f);
        if (mt < 64) PBm[(size_t)row * PBW + col0 + r] = (bf16)f2bf(v); else glowm[row * 16 + r] = v; }
}

constexpr int A_KS = 0, A_VT = 32256, A_VTS = 228;
__device__ __forceinline__ void attn_item(const Params& P, LAS unsigned char* L, int item, int tid, int wave, int lane) {
    const bf16* PB = (const bf16*)(P.ws + WS_R1); bf16* ya = (bf16*)(P.ws + WS_YA);
    const int kvh = item & 1, c = (item >> 1) & 127, b = item >> 8;
#pragma unroll
    for (int i = 0; i < 4; ++i) {
        const int key = (tid & 63) + 64 * i;
        if (key < 224) {
            bool valid; int row;
            if (key < 16) { valid = true; row = NFR + key; }
            else if (key < 32) { valid = false; row = 0; }
            else { const int ki = c * 64 - 128 + (key - 32); valid = ki >= 0; row = b * 8192 + (valid ? ki : 0); }
            u32x4 kk = (u32x4){0u, 0u, 0u, 0u}, vv = (u32x4){0u, 0u, 0u, 0u};
            if (valid) { const bf16* p = PB + (size_t)row * PBW + 512 + kvh * 64 + wave * 8; kk = *(const u32x4*)p; vv = *(const u32x4*)(p + 128); }
            *(LAS u32x4*)(L + A_KS + key * 144 + wave * 16) = kk;
            LAS unsigned short* vt = (LAS unsigned short*)(L + A_VT) + (wave * 8) * A_VTS + key;
            vt[0 * A_VTS] = (unsigned short)(vv.x & 0xffffu); vt[1 * A_VTS] = (unsigned short)(vv.x >> 16);
            vt[2 * A_VTS] = (unsigned short)(vv.y & 0xffffu); vt[3 * A_VTS] = (unsigned short)(vv.y >> 16);
            vt[4 * A_VTS] = (unsigned short)(vv.z & 0xffffu); vt[5 * A_VTS] = (unsigned short)(vv.z >> 16);
            vt[6 * A_VTS] = (unsigned short)(vv.w & 0xffffu); vt[7 * A_VTS] = (unsigned short)(vv.w >> 16);
        }
    }
    __syncthreads();
    const int g = wave >> 1, pos0 = (wave & 1) * 32, h = kvh * 4 + g, r = lane & 31, hi = lane >> 5;
    const int qrow = b * 8192 + c * 64 + pos0 + r;
    bf16x8 q[4];
#pragma unroll
    for (int s = 0; s < 4; ++s) q[s] = *(const bf16x8*)(PB + (size_t)qrow * PBW + h * 64 + 16 * s + 8 * hi);
    f32x16 S[7];
#pragma unroll
    for (int kt = 0; kt < 7; ++kt) {
#pragma unroll
        for (int i = 0; i < 16; ++i) S[kt][i] = 0.f;
#pragma unroll
        for (int s = 0; s < 4; ++s) { const bf16x8 a = *(const LAS bf16x8*)(L + A_KS + (kt * 32 + r) * 144 + (16 * s + 8 * hi) * 2); S[kt] = MFMA32(a, q[s], S[kt]); }
        asm volatile("" ::: "memory");
    }
    __builtin_amdgcn_sched_barrier(0);
    const float slope = exp2f(-(float)(h + 1)), sink = P.in[11][h];
    const float NEG = -__builtin_inff();
    float m = sink;
#pragma unroll
    for (int i = 0; i < 16; ++i) { if (i >= 8) S[0][i] = NEG; else m = fmaxf(m, S[0][i]); }
    int oz; asm volatile("v_mov_b32 %0, 0" : "=v"(oz));
    const int smin = 128 - 64 * c, pq = pos0 + r + 128 + oz;
#pragma unroll
    for (int kt = 1; kt < 7; ++kt) {
#pragma unroll
        for (int i = 0; i < 16; ++i) { const int s = (kt - 1) * 32 + crow(i, hi); float v = S[kt][i] - slope * fabsf((float)(pq - s)); if (s < smin) v = NEG; S[kt][i] = v; m = fmaxf(m, v); }
        __builtin_amdgcn_sched_barrier(0);
    }
    m = fmaxf(m, __shfl_xor(m, 32));
    __builtin_amdgcn_sched_barrier(0);
    float sum = 0.f; const float ml = m * 1.44269504f;
    bf16x8 pbv[7][2];
#pragma unroll
    for (int kt = 0; kt < 7; ++kt) {
#pragma unroll
        for (int i = 0; i < 16; ++i) { const float p = __builtin_amdgcn_exp2f(S[kt][i] * 1.44269504f - ml); S[kt][i] = p; sum += p; }
        pbv[kt][0] = pack8(S[kt][0], S[kt][1], S[kt][2], S[kt][3], S[kt][4], S[kt][5], S[kt][6], S[kt][7]);
        pbv[kt][1] = pack8(S[kt][8], S[kt][9], S[kt][10], S[kt][11], S[kt][12], S[kt][13], S[kt][14], S[kt][15]);
    }
    __builtin_amdgcn_sched_barrier(0);
    sum += __shfl_xor(sum, 32); sum += exp2f(sink * 1.44269504f - ml);
    const float inv = 1.0f / sum;
    f32x16 O[2];
#pragma unroll
    for (int i = 0; i < 16; ++i) { O[0][i] = 0.f; O[1][i] = 0.f; }
#pragma unroll
    for (int kt = 0; kt < 7; ++kt)
#pragma unroll
        for (int s2 = 0; s2 < 2; ++s2) {
            const bf16x8 pb = pbv[kt][s2];
#pragma unroll
            for (int dt = 0; dt < 2; ++dt) {
                const LAS unsigned char* vp = L + A_VT + ((dt * 32 + r) * A_VTS + kt * 32 + 16 * s2 + 4 * hi) * 2;
                const s16x4 lo = *(const LAS s16x4*)vp, h4 = *(const LAS s16x4*)(vp + 16);
                const bf16x8 va = __builtin_shufflevector(lo, h4, 0, 1, 2, 3, 4, 5, 6, 7);
                O[dt] = MFMA32(va, pb, O[dt]);
            }
            asm volatile("" ::: "memory");
        }
#pragma unroll
    for (int dt = 0; dt < 2; ++dt)
#pragma unroll
        for (int g4 = 0; g4 < 4; ++g4) {
            u32x2 w; w.x = pk2(O[dt][4 * g4] * inv, O[dt][4 * g4 + 1] * inv); w.y = pk2(O[dt][4 * g4 + 2] * inv, O[dt][4 * g4 + 3] * inv);
            *(u32x2*)(ya + (size_t)qrow * 512 + h * 64 + dt * 32 + 8 * g4 + 4 * hi) = w;
        }
    __syncthreads();
}

constexpr int G_QE = 0, G_KE = 9216, G_K2T = 18432, G_VT = 27648, G_ST = 46080, G_SEG = 64512, G_SS = 66560, G_GL = 67584;
template <bool KV> __device__ __forceinline__ void gla_prep(const Params& P, LAS unsigned char* L, int b, int h, int j, int tid) {
    const bf16* PB = (const bf16*)(P.ws + WS_R1); const float* glow = (const float*)(P.ws + WS_GLOW);
    const int d = tid & 63, seg = tid >> 6;
    float gw[16];
#pragma unroll
    for (int r = 0; r < 16; ++r) gw[r] = P.in[8][r * 256 + h * 64 + d];
    const float bias = P.in[9][h * 64 + d];
    {
      const int pos = tid >> 3, e2 = (tid & 7) * 2; const bool valid = (j > 0) || (pos >= 48);
      const int row = valid ? (j == 0 ? NFR + pos - 48 : b * 8192 + (j - 1) * 64 + pos) : NFR;
      *(LAS f32x2m*)(L + G_GL + (pos * 16 + e2) * 4) = *(const f32x2m*)(glow + (size_t)row * 16 + e2); }
    __syncthreads();
    float cs[8], qv[8], kv[8]; float run = 0.f;
#pragma unroll
    for (int p = 0; p < 8; ++p) {
        const int pos = seg * 8 + p; const bool valid = (j > 0) || (pos >= 48);
        const int row = valid ? (j == 0 ? NFR + pos - 48 : b * 8192 + (j - 1) * 64 + pos) : NFR;
        const LAS f32x4* gl = (const LAS f32x4*)(L + G_GL + pos * 64);
        const f32x4 g0 = gl[0], g1 = gl[1], g2 = gl[2], g3 = gl[3];
        float z = bias;
#pragma unroll
        for (int e = 0; e < 4; ++e) { z += g0[e] * gw[e]; z += g1[e] * gw[4 + e]; z += g2[e] * gw[8 + e]; z += g3[e] * gw[12 + e]; }
        float la = (fminf(z, 0.f) - __logf(1.0f + __expf(-fabsf(z)))) * 0.0625f;
        if (!valid) la = 0.f;
        run += la; cs[p] = run;
        const bf16* pr = PB + (size_t)row * PBW + h * 64 + d;
        qv[p] = valid ? pg8::bf2f(pr[768]) : 0.f; kv[p] = valid ? pg8::bf2f(pr[1024]) : 0.f;
        if (p & 1) __builtin_amdgcn_sched_barrier(0);
    }
    LAS float* SEG = (LAS float*)(L + G_SEG);
    SEG[seg * 64 + d] = run;
    __syncthreads();
    float off = 0.f, tot = 0.f;
#pragma unroll
    for (int s = 0; s < 8; ++s) { const float v = SEG[s * 64 + d]; tot += v; if (s < seg) off += v; }
    LAS unsigned short* QE = (LAS unsigned short*)(L + G_QE); LAS unsigned short* KE = (LAS unsigned short*)(L + G_KE);
    float k2[8];
#pragma unroll
    for (int p = 0; p < 8; ++p) {
        const int pos = seg * 8 + p; const float bb = off + cs[p];
        QE[pos * 72 + d] = (unsigned short)f2bf(qv[p] * __expf(bb));
        KE[pos * 72 + d] = (unsigned short)f2bf(kv[p] * __expf(-bb));
        k2[p] = kv[p] * __expf(tot - bb);
    }
    if (KV) {
        *(LAS bf16x8*)(L + G_K2T + (d * 72 + seg * 8) * 2) = pack8(k2[0], k2[1], k2[2], k2[3], k2[4], k2[5], k2[6], k2[7]);
        if (seg == 0) ((float*)(P.ws + WS_DEC))[(size_t)((b * 4 + h) * 129 + j) * 64 + d] = __expf(tot);
    }
}
__device__ __forceinline__ void gla_stage_v(const Params& P, LAS unsigned char* L, int b, int h, int j, int tid) {
    const bf16* PB = (const bf16*)(P.ws + WS_R1);
    const int pos = tid & 63, dvg = tid >> 6; const bool valid = (j > 0) || (pos >= 48);
    const int row = valid ? (j == 0 ? NFR + pos - 48 : b * 8192 + (j - 1) * 64 + pos) : NFR;
    u32x4 a = (u32x4){0u, 0u, 0u, 0u}, c = a;
    if (valid) { const bf16* p = PB + (size_t)row * PBW + 1280 + h * 128 + dvg * 16; a = *(const u32x4*)p; c = *(const u32x4*)(p + 8); }
    LAS unsigned short* vt = (LAS unsigned short*)(L + G_VT) + (dvg * 16) * 72 + pos;
    vt[0 * 72] = (unsigned short)(a.x & 0xffffu); vt[1 * 72] = (unsigned short)(a.x >> 16); vt[2 * 72] = (unsigned short)(a.y & 0xffffu); vt[3 * 72] = (unsigned short)(a.y >> 16);
    vt[4 * 72] = (unsigned short)(a.z & 0xffffu); vt[5 * 72] = (unsigned short)(a.z >> 16); vt[6 * 72] = (unsigned short)(a.w & 0xffffu); vt[7 * 72] = (unsigned short)(a.w >> 16);
    vt[8 * 72] = (unsigned short)(c.x & 0xffffu); vt[9 * 72] = (unsigned short)(c.x >> 16); vt[10 * 72] = (unsigned short)(c.y & 0xffffu); vt[11 * 72] = (unsigned short)(c.y >> 16);
    vt[12 * 72] = (unsigned short)(c.z & 0xffffu); vt[13 * 72] = (unsigned short)(c.z >> 16); vt[14 * 72] = (unsigned short)(c.w & 0xffffu); vt[15 * 72] = (unsigned short)(c.w >> 16);
}
__device__ __forceinline__ void gla_kv_item(const Params& P, LAS unsigned char* L, int item, int tid, int wave, int lane) {
    const int j = item % 129, bh = item / 129, h = bh & 3, b = bh >> 2;
    gla_prep<true>(P, L, b, h, j, tid);
    gla_stage_v(P, L, b, h, j, tid);
    __syncthreads();
    const int dvt = wave >> 1, dkt = wave & 1, r = lane & 31, hi = lane >> 5;
    f32x16 acc;
#pragma unroll
    for (int i = 0; i < 16; ++i) acc[i] = 0.f;
#pragma unroll
    for (int s = 0; s < 4; ++s) {
        const bf16x8 a = *(const LAS bf16x8*)(L + G_VT + ((dvt * 32 + r) * 72 + 16 * s + 8 * hi) * 2);
        const bf16x8 bb = *(const LAS bf16x8*)(L + G_K2T + ((dkt * 32 + r) * 72 + 16 * s + 8 * hi) * 2);
        acc = MFMA32(a, bb, acc);
    }
    float* kvg = (float*)(P.ws + WS_KV) + (size_t)item * 8192;
#pragma unroll
    for (int i = 0; i < 16; ++i) kvg[(dvt * 32 + crow(i, hi)) * 64 + dkt * 32 + r] = acc[i];
    __syncthreads();
}
__device__ __forceinline__ void gla_scan(const Params& P, int wave, int lane, int G) {
    const float* kvg = (const float*)(P.ws + WS_KV); const float* dec = (const float*)(P.ws + WS_DEC); bf16* st = (bf16*)(P.ws + WS_ST);
    for (int wv = wave * G + blockIdx.x; wv < 1024; wv += G * 8) {
        const int gidx = wv * 64 + lane, bh = gidx >> 13, e = gidx & 8191, dk = e & 63;
        const size_t base = (size_t)bh * 129;
        float S = 0.f;
        for (int j0 = 0; j0 < 128; j0 += 8) {
            float kvv[8], dd[8];
#pragma unroll
            for (int u = 0; u < 8; ++u) { kvv[u] = kvg[(base + j0 + u) * 8192 + e]; dd[u] = dec[(base + j0 + u) * 64 + dk]; }
#pragma unroll
            for (int u = 0; u < 8; ++u) { S = dd[u] * S + kvv[u]; st[(base + j0 + u + 1) * 8192 + e] = (bf16)f2bf(S); }
        }
    }
}
__device__ __forceinline__ void gla_out_item(const Params& P, LAS unsigned char* L, int item  , int tid, int wave, int lane) {
    const int j = (item & 127) + 1, bh = item >> 7, h = bh & 3, b = bh >> 2;
    const bf16* PB = (const bf16*)(P.ws + WS_R1); bf16* yb = (bf16*)(P.ws + WS_YB);
    gla_prep<false>(P, L, b, h, j, tid);
    gla_stage_v(P, L, b, h, j, tid);
    { const bf16* sg = (const bf16*)(P.ws + WS_ST) + (size_t)(bh * 129 + j) * 8192; const int dv = tid >> 2, part = tid & 3;
      const u32x4 a = *(const u32x4*)(sg + dv * 64 + part * 16), c = *(const u32x4*)(sg + dv * 64 + part * 16 + 8);
      *(LAS u32x4*)(L + G_ST + (dv * 72 + part * 16) * 2) = a; *(LAS u32x4*)(L + G_ST + (dv * 72 + part * 16 + 8) * 2) = c; }
    __syncthreads();
    const int it = wave & 1, dvt = wave >> 1, r = lane & 31, hi = lane >> 5;
    bf16x8 qf[4];
#pragma unroll
    for (int s = 0; s < 4; ++s) qf[s] = *(const LAS bf16x8*)(L + G_QE + ((it * 32 + r) * 72 + 16 * s + 8 * hi) * 2);
    f32x16 o;
#pragma unroll
    for (int i = 0; i < 16; ++i) o[i] = 0.f;
#pragma unroll
    for (int jt = 0; jt < 2; ++jt) {
        if (jt <= it) {
            f32x16 at;
#pragma unroll
            for (int i = 0; i < 16; ++i) at[i] = 0.f;
#pragma unroll
            for (int s = 0; s < 4; ++s) { const bf16x8 a = *(const LAS bf16x8*)(L + G_KE + ((jt * 32 + r) * 72 + 16 * s + 8 * hi) * 2); at = MFMA32(a, qf[s], at); }
            if (jt == it) {
#pragma unroll
                for (int i = 0; i < 16; ++i) if (crow(i, hi) > r) at[i] = 0.f;
            }
#pragma unroll
            for (int s2 = 0; s2 < 2; ++s2) {
                const bf16x8 pb = pack8(at[8 * s2], at[8 * s2 + 1], at[8 * s2 + 2], at[8 * s2 + 3], at[8 * s2 + 4], at[8 * s2 + 5], at[8 * s2 + 6], at[8 * s2 + 7]);
                const LAS unsigned char* vp = L + G_VT + ((dvt * 32 + r) * 72 + jt * 32 + 16 * s2 + 4 * hi) * 2;
                const s16x4 lo = *(const LAS s16x4*)vp, h4 = *(const LAS s16x4*)(vp + 16);
                o = MFMA32(__builtin_shufflevector(lo, h4, 0, 1, 2, 3, 4, 5, 6, 7), pb, o);
            }
        }
    }
#pragma unroll
    for (int s = 0; s < 4; ++s) { const bf16x8 a = *(const LAS bf16x8*)(L + G_ST + ((dvt * 32 + r) * 72 + 16 * s + 8 * hi) * 2); o = MFMA32(a, qf[s], o); }
    float ss = 0.f;
#pragma unroll
    for (int i = 0; i < 16; ++i) ss += o[i] * o[i];
    ss += __shfl_xor(ss, 32);
    LAS float* SS = (LAS float*)(L + G_SS);
    if (hi == 0) SS[dvt * 64 + it * 32 + r] = ss;
    __syncthreads();
    const float tot = (SS[it * 32 + r] + SS[64 + it * 32 + r]) + (SS[128 + it * 32 + r] + SS[192 + it * 32 + r]);
    const float rstd = __builtin_amdgcn_rsqf(tot * (1.0f / 128.0f) + 1e-6f);
    const int row = b * 8192 + (j - 1) * 64 + it * 32 + r;
#pragma unroll
    for (int g4 = 0; g4 < 4; ++g4) {
        const int dv0 = dvt * 32 + 8 * g4 + 4 * hi;
        const f32x4 gn = *(const f32x4*)(P.in[10] + dv0);
        const u32x2 gr = *(const u32x2*)(PB + (size_t)row * PBW + 1792 + h * 128 + dv0);
        u32x2 w;
        w.x = pk2(o[4 * g4] * rstd * gn[0] * pg8::bflo(gr.x), o[4 * g4 + 1] * rstd * gn[1] * pg8::bfhi(gr.x));
        w.y = pk2(o[4 * g4 + 2] * rstd * gn[2] * pg8::bflo(gr.y), o[4 * g4 + 3] * rstd * gn[3] * pg8::bfhi(gr.y));
        *(u32x2*)(yb + (size_t)row * 512 + h * 128 + dv0) = w;
    }
    __syncthreads();
}

__global__ void __launch_bounds__(512, 2) mega_fwd(Params P) {
    extern __shared__ __attribute__((aligned(16))) unsigned char lds_raw[];
    LAS unsigned char* lds = (LAS unsigned char*)lds_raw;
    cg::grid_group grid = cg::this_grid();
    const int tid = threadIdx.x, lane = tid & 63, wave = __builtin_amdgcn_readfirstlane(tid >> 6), G = gridDim.x;
    unsigned char* ws = P.ws;
    const int lo = P.ph_lo, hi = P.ph_hi;
    if (tid < 32) ((LAS unsigned*)(lds + MISC_OFF))[tid] = 0u;
    __syncthreads();
    XcdBarrier bar = xcd_barrier_post((unsigned*)(ws + WS_CTL), (volatile LAS unsigned*)(lds + MISC_OFF) + 8);
#define IN(k) (lo <= (k) && (k) < hi)
#define GSYNC() do { if (P.cg_sync) grid.sync(); else xcd_barrier(bar); } while (0)
#define SEAM(k) do { if (IN(k) && IN((k) + 1)) GSYNC(); } while (0)
#define DUPQ(k) ((MK_DUP >> (k)) & 1)
    bf16* hb = (bf16*)(ws + WS_HB); float* ssp = (float*)(ws + WS_SSP); bf16* R1 = (bf16*)(ws + WS_R1);

    if (IN(0)) {
        p0_prep(P, lds, wave, lane, G);
#if (MK_DUP >> 0) & 1
        GSYNC();
        p0_prep(P, lds, wave, lane, G);
#endif
    }
    SEAM(0);
    if (IN(1)) {
        {
        meta_p1(P, wave, lane, G);
        pg8::Gemm g{hb, (const bf16*)(ws + WS_WGU1), NFR, NGU, D}; pg8::StaticOrder S; S.init(NFR, NGU, G, (int)blockIdx.x);
        pg8::EpiSwiglu E{R1, ssp};
        pg8::gemm_phase<pg8::EpiSwiglu, pg8::StaticOrder, true, true>(lds, g, S, E);
    }
#if (MK_DUP >> 1) & 1
        GSYNC();
        {
        meta_p1(P, wave, lane, G);
        pg8::Gemm g{hb, (const bf16*)(ws + WS_WGU1), NFR, NGU, D}; pg8::StaticOrder S; S.init(NFR, NGU, G, (int)blockIdx.x);
        pg8::EpiSwiglu E{R1, ssp};
        pg8::gemm_phase<pg8::EpiSwiglu, pg8::StaticOrder, true, true>(lds, g, S, E);
    }
#endif
    }
    SEAM(1);
    if (IN(2)) {
        {
        meta_p2(P, lds, wave, lane);
        pg8::Gemm g{R1, (const bf16*)(ws + WS_WD1), NFR, D, FF}; pg8::StaticOrder S; S.init(NFR, D, G, (int)blockIdx.x);
        pg8::EpiResid E{P.in[0], P.in[1], P.out, hb, ssp, 0.5f};
        pg8::gemm_phase<pg8::EpiResid, pg8::StaticOrder, true, true>(lds, g, S, E);
    }
#if (MK_DUP >> 2) & 1
        GSYNC();
        {
        meta_p2(P, lds, wave, lane);
        pg8::Gemm g{R1, (const bf16*)(ws + WS_WD1), NFR, D, FF}; pg8::StaticOrder S; S.init(NFR, D, G, (int)blockIdx.x);
        pg8::EpiResid E{P.in[0], P.in[1], P.out, hb, ssp, 0.5f};
        pg8::gemm_phase<pg8::EpiResid, pg8::StaticOrder, true, true>(lds, g, S, E);
    }
#endif
    }
    SEAM(2);
    if (IN(3)) {
        {
        meta_p3(P, wave, lane, G);
        pg8::Gemm g{hb, (const bf16*)(ws + WS_WIN), NFR, NIN, D}; pg8::StaticOrder S; S.init(NFR, NIN, G, (int)blockIdx.x);
        pg8::EpiIn E{R1, (float*)(ws + WS_GLOW), ssp};
        pg8::gemm_phase<pg8::EpiIn, pg8::StaticOrder, true, true>(lds, g, S, E);
    }
#if (MK_DUP >> 3) & 1
        GSYNC();
        {
        meta_p3(P, wave, lane, G);
        pg8::Gemm g{hb, (const bf16*)(ws + WS_WIN), NFR, NIN, D}; pg8::StaticOrder S; S.init(NFR, NIN, G, (int)blockIdx.x);
        pg8::EpiIn E{R1, (float*)(ws + WS_GLOW), ssp};
        pg8::gemm_phase<pg8::EpiIn, pg8::StaticOrder, true, true>(lds, g, S, E);
    }
#endif
    }
    SEAM(3);
    if (IN(4)) {
        {
        for (int it = blockIdx.x; it < 512; it += G) attn_item(P, lds, it, tid, wave, lane);
        for (int it = blockIdx.x; it < 1032; it += G) gla_kv_item(P, lds, it, tid, wave, lane);
    }
#if (MK_DUP >> 4) & 1
        GSYNC();
        {
        for (int it = blockIdx.x; it < 512; it += G) attn_item(P, lds, it, tid, wave, lane);
        for (int it = blockIdx.x; it < 1032; it += G) gla_kv_item(P, lds, it, tid, wave, lane);
    }
#endif
    }
    SEAM(4);
    if (IN(5)) {
        gla_scan(P, wave, lane, G);
#if (MK_DUP >> 5) & 1
        GSYNC();
        gla_scan(P, wave, lane, G);
#endif
    }
    SEAM(5);
    if (IN(6)) {
        { for (int it = blockIdx.x; it < 1024; it += G) gla_out_item(P, lds, it, tid, wave, lane); }
#if (MK_DUP >> 6) & 1
        GSYNC();
        { for (int it = blockIdx.x; it < 1024; it += G) gla_out_item(P, lds, it, tid, wave, lane); }
#endif
    }
    SEAM(6);
    if (IN(7)) {
        {
        bf16* mixed = (bf16*)(ws + WS_KV);
        { pg8::Gemm g{(const bf16*)(ws + WS_YA), (const bf16*)(ws + WS_WA), NFR, D, 512}; pg8::StaticOrder S; S.init(NFR, D, G, (int)blockIdx.x);
          pg8::EpiMix<false> E{R1 + 2304, mixed};
          pg8::gemm_phase<pg8::EpiMix<false>, pg8::StaticOrder, true, true>(lds, g, S, E); }
        { pg8::Gemm g{(const bf16*)(ws + WS_YB), (const bf16*)(ws + WS_WB), NFR, D, 512}; pg8::StaticOrder S; S.init(NFR, D, G, (int)blockIdx.x);
          pg8::EpiMix<true> E{R1 + 3328, mixed};
          pg8::gemm_phase<pg8::EpiMix<true>, pg8::StaticOrder, true, true>(lds, g, S, E); }
    }
#if (MK_DUP >> 7) & 1
        GSYNC();
        {
        bf16* mixed = (bf16*)(ws + WS_KV);
        { pg8::Gemm g{(const bf16*)(ws + WS_YA), (const bf16*)(ws + WS_WA), NFR, D, 512}; pg8::StaticOrder S; S.init(NFR, D, G, (int)blockIdx.x);
          pg8::EpiMix<false> E{R1 + 2304, mixed};
          pg8::gemm_phase<pg8::EpiMix<false>, pg8::StaticOrder, true, true>(lds, g, S, E); }
        { pg8::Gemm g{(const bf16*)(ws + WS_YB), (const bf16*)(ws + WS_WB), NFR, D, 512}; pg8::StaticOrder S; S.init(NFR, D, G, (int)blockIdx.x);
          pg8::EpiMix<true> E{R1 + 3328, mixed};
          pg8::gemm_phase<pg8::EpiMix<true>, pg8::StaticOrder, true, true>(lds, g, S, E); }
    }
#endif
    }
    SEAM(7);
    if (IN(8)) {
        {
        pg8::Gemm g{(const bf16*)(ws + WS_KV), (const bf16*)(ws + WS_WOUT), NFR, D, D}; pg8::StaticOrder S; S.init(NFR, D, G, (int)blockIdx.x);
        pg8::EpiResid E{P.out, P.in[1], P.out, hb, ssp, 1.0f};
        pg8::gemm_phase<pg8::EpiResid, pg8::StaticOrder, true, true>(lds, g, S, E);
    }
#if (MK_DUP >> 8) & 1
        GSYNC();
        {
        pg8::Gemm g{(const bf16*)(ws + WS_KV), (const bf16*)(ws + WS_WOUT), NFR, D, D}; pg8::StaticOrder S; S.init(NFR, D, G, (int)blockIdx.x);
        pg8::EpiResid E{P.out, P.in[1], P.out, hb, ssp, 1.0f};
        pg8::gemm_phase<pg8::EpiResid, pg8::StaticOrder, true, true>(lds, g, S, E);
    }
#endif
    }
    SEAM(8);
    if (IN(9)) {
        {
        pg8::Gemm g{hb, (const bf16*)(ws + WS_WGU2), NFR, NGU, D}; pg8::StaticOrder S; S.init(NFR, NGU, G, (int)blockIdx.x);
        pg8::EpiSwiglu E{R1, ssp};
        pg8::gemm_phase<pg8::EpiSwiglu, pg8::StaticOrder, true, true>(lds, g, S, E);
    }
#if (MK_DUP >> 9) & 1
        GSYNC();
        {
        pg8::Gemm g{hb, (const bf16*)(ws + WS_WGU2), NFR, NGU, D}; pg8::StaticOrder S; S.init(NFR, NGU, G, (int)blockIdx.x);
        pg8::EpiSwiglu E{R1, ssp};
        pg8::gemm_phase<pg8::EpiSwiglu, pg8::StaticOrder, true, true>(lds, g, S, E);
    }
#endif
    }
    SEAM(9);
    if (IN(10)) {
        {
        pg8::Gemm g{R1, (const bf16*)(ws + WS_WD2), NFR, D, FF}; pg8::StaticOrder S; S.init(NFR, D, G, (int)blockIdx.x);
        pg8::EpiResid E{P.out, P.in[1], P.out, nullptr, ssp, 0.5f};
        pg8::gemm_phase<pg8::EpiResid, pg8::StaticOrder, true, true>(lds, g, S, E);
    }
#if (MK_DUP >> 10) & 1
        GSYNC();
        {
        pg8::Gemm g{R1, (const bf16*)(ws + WS_WD2), NFR, D, FF}; pg8::StaticOrder S; S.init(NFR, D, G, (int)blockIdx.x);
        pg8::EpiResid E{P.out, P.in[1], P.out, nullptr, ssp, 0.5f};
        pg8::gemm_phase<pg8::EpiResid, pg8::StaticOrder, true, true>(lds, g, S, E);
    }
#endif
    }
    SEAM(10);
    if (IN(11)) {
        {
        const int gw = blockIdx.x * 8 + wave, NGW = G * 8;
        for (int m = gw; m < NFR; m += NGW) {
            f32x4* rowp = (f32x4*)(P.out + (size_t)m * D) + lane;
            float s = ssp[(size_t)m * 16 + (lane & 15)];
            s += __shfl_xor(s, 1); s += __shfl_xor(s, 2); s += __shfl_xor(s, 4); s += __shfl_xor(s, 8);
            const float rs = __builtin_amdgcn_rsqf(s * (1.0f / 1024.0f) + 1e-6f);
#pragma unroll
            for (int j = 0; j < 4; ++j) { const f32x4 gn = ((const f32x4*)P.in[19])[lane + 64 * j]; f32x4 v = rowp[64 * j]; rowp[64 * j] = v * rs * gn; }
        }
    }
#if (MK_DUP >> 11) & 1
        GSYNC();
        {
        const int gw = blockIdx.x * 8 + wave, NGW = G * 8;
        for (int m = gw; m < NFR; m += NGW) {
            f32x4* rowp = (f32x4*)(P.out + (size_t)m * D) + lane;
            float s = ssp[(size_t)m * 16 + (lane & 15)];
            s += __shfl_xor(s, 1); s += __shfl_xor(s, 2); s += __shfl_xor(s, 4); s += __shfl_xor(s, 8);
            const float rs = __builtin_amdgcn_rsqf(s * (1.0f / 1024.0f) + 1e-6f);
#pragma unroll
            for (int j = 0; j < 4; ++j) { const f32x4 gn = ((const f32x4*)P.in[19])[lane + 64 * j]; f32x4 v = rowp[64 * j]; rowp[64 * j] = v * rs * gn; }
        }
    }
#endif
    }
#if defined(MK_XSYNC)
    for (int xs_ = 0; xs_ < MK_XSYNC; ++xs_) GSYNC();
#endif
#undef IN
#undef SEAM
}

extern "C" void kernel_launch(void* const* d_in, const int* in_sizes, int n_in, void* d_out, int out_size, void* d_ws, size_t ws_size, hipStream_t stream) {
    static int grid = 0;
    if (grid == 0) {
        if (n_in != 20 || out_size != NFR * D || ws_size < WS_END) { fprintf(stderr, "kernel_launch: unexpected shapes (n_in %d out %d ws %zu)\n", n_in, out_size, ws_size); grid = -1; return; }
        int dev = 0, cus = 0, per_cu = 0;
        hipGetDevice(&dev); hipDeviceGetAttribute(&cus, hipDeviceAttributeMultiprocessorCount, dev);
        if (hipFuncSetAttribute((const void*)mega_fwd, hipFuncAttributeMaxDynamicSharedMemorySize, LDS_BYTES) != hipSuccess) { fprintf(stderr, "kernel_launch: hipFuncSetAttribute failed\n"); grid = -1; return; }
        if (hipOccupancyMaxActiveBlocksPerMultiprocessor(&per_cu, (const void*)mega_fwd, 512, LDS_BYTES) != hipSuccess || per_cu < 1) { fprintf(stderr, "kernel_launch: occupancy query failed (%d)\n", per_cu); (void)hipGetLastError(); grid = -1; return; }
        grid = cus * per_cu;
        fprintf(stderr, "kernel_launch: %d CUs x %d blocks -> grid %d\n", cus, per_cu, grid);
    }
    if (grid < 0) return;
    Params p{};
    for (int i = 0; i < 20; ++i) p.in[i] = (const float*)d_in[i];
    p.out = (float*)d_out; p.ws = (unsigned char*)d_ws; p.cg_sync = 0; p.pad = 0;
    if (hipMemsetAsync((char*)d_ws + WS_CTL, 0, CTL_BYTES, stream) != hipSuccess) { fprintf(stderr, "kernel_launch: hipMemsetAsync failed\n"); return; }
#if MK_PER_PHASE
    for (int ph = 0; ph < NPH; ++ph) { p.ph_lo = ph; p.ph_hi = ph + 1; hipLaunchKernelGGL(mega_fwd, dim3(grid), dim3(512), LDS_BYTES, stream, p); }
#else
    p.ph_lo = 0; p.ph_hi = NPH;
    void* args[] = {&p};
    hipError_t e = hipLaunchCooperativeKernel((const void*)mega_fwd, dim3(grid), dim3(512), args, LDS_BYTES, stream);
    if (e != hipSuccess) fprintf(stderr, "kernel_launch: cooperative launch failed: %s (grid %d)\n", hipGetErrorString(e), grid);
#endif
}
```

```cpp
#include <hip/hip_runtime.h>
#include <hip/hip_cooperative_groups.h>
#include <cstdio>
#include <cstdint>
namespace cg = cooperative_groups;
namespace pg8 {
#define PG8_LAS __attribute__((address_space(3)))
typedef unsigned short bf16_t;
typedef short bf16x8 __attribute__((ext_vector_type(8)));
typedef float f32x4 __attribute__((ext_vector_type(4)));
typedef unsigned u32x4 __attribute__((ext_vector_type(4)));
constexpr int BM = 256, BK = 64, HALF = 128, HTB = HALF * BK * 2  , STAGE_BYTES = 8 * HTB, NXCD = 8, WGM = 8;

__host__ __device__ __forceinline__ int lds_byte(int r, int c) { const int st = (r >> 4) * 2 + (c >> 5), rr = r & 15, cc = c & 31, ob = rr * 64 + cc * 2; return st * 1024 + (ob ^ (((ob >> 9) & 1) << 5)); }
__host__ __device__ __forceinline__ void stage_rc(int b, int& R, int& C) { const int st = b / 1024, sb = b % 1024, swz = sb ^ (((sb >> 9) & 1) << 5); R = (st >> 1) * 16 + swz / 64; C = (st & 1) * 32 + (swz % 64) / 2; }
__host__ __device__ __forceinline__ int perm32(int rho) { const int n = rho >> 4, i = rho & 15; return 8 * (i >> 2) + 4 * n + (i & 3); }

struct Unit { int pm, pn; };
struct Gemm { const bf16_t* A; const bf16_t* Bt; int M, N, K; };

struct StaticOrder {
    int nM, nN, nwg, G, c;
    __host__ __device__ void init(int M, int N, int G_, int c_) { nM = M / BM; nN = N / BM; nwg = nM * nN; G = G_; c = c_; }
    __host__ __device__ bool next(int i, Unit& u) const {
        const long L = (long)i * G + c; if (L >= nwg) return false;
        int wgid = (int)L; { const int q = nwg / NXCD, r = nwg % NXCD, xcd = wgid % NXCD, off = wgid / NXCD; wgid = (xcd < r ? xcd * (q + 1) : r * (q + 1) + (xcd - r) * q) + off; }
        const int nig = WGM * nN, gid = wgid / nig, fm = gid * WGM, gsz = (nM - fm) < WGM ? (nM - fm) : WGM;
        u.pm = fm + ((wgid % nig) % gsz); u.pn = (wgid % nig) / gsz; return true;
    }
    __device__ __forceinline__ void a_ready(const Unit&) const {}
    __device__ __forceinline__ void done(const Unit&) const {}
};

__device__ __forceinline__ unsigned cvt_pk_bf16(float lo, float hi) { unsigned r; asm volatile("v_cvt_pk_bf16_f32 %0, %1, %2" : "=v"(r) : "v"(lo), "v"(hi)); return r; }
typedef float f32x2 __attribute__((ext_vector_type(2)));
constexpr int XD = 1024, XFF = 2816, XPBW = 4352, XNFR = 16384;
__device__ __forceinline__ float row_rstd(const float* ssp, int row, int fq) {
    const f32x4 p = *(const f32x4*)(ssp + (size_t)row * 16 + 4 * fq);
    float s = (p[0] + p[1]) + (p[2] + p[3]);
    s += __shfl_xor(s, 16); s += __shfl_xor(s, 32);
    return __builtin_amdgcn_rsqf(s * (1.0f / 1024.0f) + 1e-6f);
}
__device__ __forceinline__ float sigm(float x) { return __builtin_amdgcn_rcpf(1.0f + __expf(-x)); }
__device__ __forceinline__ float bf2f(unsigned short b) { return __uint_as_float((unsigned)b << 16); }
__device__ __forceinline__ float bflo(unsigned w) { return __uint_as_float(w << 16); }
__device__ __forceinline__ float bfhi(unsigned w) { return __uint_as_float(w & 0xffff0000u); }

struct EpiSwiglu {
    static constexpr bool PERM = true, AFTER_DRAIN = false;
    bf16_t* O; const float* ssp;
    __device__ __forceinline__ void operator()(const f32x4 (&acc)[2][2][4][2], const Unit& u, int wr, int wc, int fr, int fq) const {
        const int row0 = u.pm * BM + wr * 64 + fr, col0 = u.pn * HALF + wc * 32 + 8 * fq;
#pragma unroll
        for (int ai = 0; ai < 2; ++ai)
#pragma unroll
            for (int m = 0; m < 4; ++m) {
                const int row = row0 + ai * HALF + m * 16; const float rs = row_rstd(ssp, row, fq);
                const f32x4 g0 = acc[ai][0][m][0] * rs, g1 = acc[ai][0][m][1] * rs, u0 = acc[ai][1][m][0] * rs, u1 = acc[ai][1][m][1] * rs;
                u32x4 w;
                w.x = cvt_pk_bf16(g0[0] * sigm(g0[0]) * u0[0], g0[1] * sigm(g0[1]) * u0[1]);
                w.y = cvt_pk_bf16(g0[2] * sigm(g0[2]) * u0[2], g0[3] * sigm(g0[3]) * u0[3]);
                w.z = cvt_pk_bf16(g1[0] * sigm(g1[0]) * u1[0], g1[1] * sigm(g1[1]) * u1[1]);
                w.w = cvt_pk_bf16(g1[2] * sigm(g1[2]) * u1[2], g1[3] * sigm(g1[3]) * u1[3]);
                *(u32x4*)(O + (size_t)row * XFF + col0) = w;
            }
    }
};

struct EpiResid {
    static constexpr bool PERM = false, AFTER_DRAIN = false;
    const float* base; const float* meta; float* out; bf16_t* hb; float* ssp; float scale;
    __device__ __forceinline__ void operator()(const f32x4 (&acc)[2][2][4][2], const Unit& u, int wr, int wc, int fr, int fq) const {
        typedef unsigned u32x2v __attribute__((ext_vector_type(2)));
        const int row0 = u.pm * BM + wr * 64 + fr, col0 = u.pn * BM + wc * 32 + 4 * fq;
#pragma unroll
        for (int ai = 0; ai < 2; ++ai)
#pragma unroll
            for (int m = 0; m < 4; ++m) {
                const int row = row0 + ai * HALF + m * 16;
                const bool fr_row = row < XNFR, has = row < XNFR + 16;
                const float* bp = fr_row ? base + (size_t)row * XD : meta + (size_t)(has ? row - XNFR : 0) * XD;
                float sq = 0.f;
#pragma unroll
                for (int bj = 0; bj < 2; ++bj)
#pragma unroll
                    for (int n = 0; n < 2; ++n) {
                        const int c = col0 + bj * HALF + n * 16;
                        f32x4 b = *(const f32x4*)(bp + c);
                        if (!has) b = (f32x4){0.f, 0.f, 0.f, 0.f};
                        const f32x4 v = b + acc[ai][bj][m][n] * scale;
                        sq += (v[0] * v[0] + v[1] * v[1]) + (v[2] * v[2] + v[3] * v[3]);
                        if (fr_row) *(f32x4*)(out + (size_t)row * XD + c) = v;
                        if (hb) { u32x2v w; w.x = cvt_pk_bf16(v[0], v[1]); w.y = cvt_pk_bf16(v[2], v[3]); *(u32x2v*)(hb + (size_t)row * XD + c) = w; }
                    }
                sq += __shfl_xor(sq, 16); sq += __shfl_xor(sq, 32);
                if (fq == 0) ssp[(size_t)row * 16 + u.pn * 4 + wc] = sq;
            }
    }
};

struct EpiIn {
    static constexpr bool PERM = true, AFTER_DRAIN = false;
    bf16_t* PB; float* glow; const float* ssp;
    __device__ __forceinline__ void operator()(const f32x4 (&acc)[2][2][4][2], const Unit& u, int wr, int wc, int fr, int fq) const {
        const int row0 = u.pm * BM + wr * 64 + fr, tile = u.pn;
        if (tile == 17) {
            if (wc == 0 && fq < 2) {
#pragma unroll
                for (int ai = 0; ai < 2; ++ai)
#pragma unroll
                    for (int m = 0; m < 4; ++m) {
                        const int row = row0 + ai * HALF + m * 16;
                        const f32x4 p = *(const f32x4*)(ssp + (size_t)row * 16), q = *(const f32x4*)(ssp + (size_t)row * 16 + 4), r = *(const f32x4*)(ssp + (size_t)row * 16 + 8), t = *(const f32x4*)(ssp + (size_t)row * 16 + 12);
                        const float s = (((p[0] + p[1]) + (p[2] + p[3])) + ((q[0] + q[1]) + (q[2] + q[3]))) + (((r[0] + r[1]) + (r[2] + r[3])) + ((t[0] + t[1]) + (t[2] + t[3])));
                        const float rs = __builtin_amdgcn_rsqf(s * (1.0f / 1024.0f) + 1e-6f);
                        *(f32x4*)(glow + (size_t)row * 16 + 8 * fq) = acc[ai][0][m][0] * rs;
                        *(f32x4*)(glow + (size_t)row * 16 + 8 * fq + 4) = acc[ai][0][m][1] * rs;
                    }
            }
            return;
        }
        const int mode = (tile <= 1 || tile == 3) ? 1 : (tile == 7 || tile == 8) ? 2 : (tile >= 9 ? 3 : 0);
        const int col0 = tile * BM + wc * 32 + 8 * fq;
#pragma unroll
        for (int ai = 0; ai < 2; ++ai)
#pragma unroll
            for (int m = 0; m < 4; ++m) {
                const int row = row0 + ai * HALF + m * 16; const float rs = row_rstd(ssp, row, fq);
#pragma unroll
                for (int bj = 0; bj < 2; ++bj) {
                    f32x4 v0 = acc[ai][bj][m][0] * rs, v1 = acc[ai][bj][m][1] * rs;
                    if (mode == 1) { v0 = v0 * 0.125f; v1 = v1 * 0.125f; }
                    else if (mode == 2) {
#pragma unroll
                        for (int j = 0; j < 4; ++j) { v0[j] = v0[j] * sigm(v0[j]); v1[j] = v1[j] * sigm(v1[j]); } }
                    else if (mode == 3) {
#pragma unroll
                        for (int j = 0; j < 4; ++j) { v0[j] = sigm(v0[j]); v1[j] = sigm(v1[j]); } }
                    u32x4 w; w.x = cvt_pk_bf16(v0[0], v0[1]); w.y = cvt_pk_bf16(v0[2], v0[3]); w.z = cvt_pk_bf16(v1[0], v1[1]); w.w = cvt_pk_bf16(v1[2], v1[3]);
                    *(u32x4*)(PB + (size_t)row * XPBW + col0 + bj * HALF) = w;
                }
            }
    }
};

template <bool ADD> struct EpiMix {
    static constexpr bool PERM = true, AFTER_DRAIN = false;
    const bf16_t* gate; bf16_t* mixed;
    __device__ __forceinline__ void operator()(const f32x4 (&acc)[2][2][4][2], const Unit& u, int wr, int wc, int fr, int fq) const {
        const int row0 = u.pm * BM + wr * 64 + fr, col0 = u.pn * BM + wc * 32 + 8 * fq;
#pragma unroll
        for (int ai = 0; ai < 2; ++ai)
#pragma unroll
            for (int m = 0; m < 4; ++m) {
                const int row = row0 + ai * HALF + m * 16;
#pragma unroll
                for (int bj = 0; bj < 2; ++bj) {
                    const int c = col0 + bj * HALF;
                    const u32x4 g = *(const u32x4*)(gate + (size_t)row * XPBW + c);
                    const f32x4 a0 = acc[ai][bj][m][0], a1 = acc[ai][bj][m][1];
                    float v[8] = {bflo(g.x) * a0[0], bfhi(g.x) * a0[1], bflo(g.y) * a0[2], bfhi(g.y) * a0[3], bflo(g.z) * a1[0], bfhi(g.z) * a1[1], bflo(g.w) * a1[2], bfhi(g.w) * a1[3]};
                    if (ADD) { const u32x4 o = *(const u32x4*)(mixed + (size_t)row * XD + c);
                        v[0] += bflo(o.x); v[1] += bfhi(o.x); v[2] += bflo(o.y); v[3] += bfhi(o.y); v[4] += bflo(o.z); v[5] += bfhi(o.z); v[6] += bflo(o.w); v[7] += bfhi(o.w); }
                    u32x4 w; w.x = cvt_pk_bf16(v[0], v[1]); w.y = cvt_pk_bf16(v[2], v[3]); w.z = cvt_pk_bf16(v[4], v[5]); w.w = cvt_pk_bf16(v[6], v[7]);
                    *(u32x4*)(mixed + (size_t)row * XD + c) = w;
                }
            }
    }
};

template <class Epi, class Sched, bool ALIGN_EPI = false, bool SP2 = false>
__device__ __forceinline__ void gemm_phase(PG8_LAS unsigned char* lds, const Gemm g, const Sched& S, const Epi& E) {
    const int tid = threadIdx.x, wid = __builtin_amdgcn_readfirstlane(tid >> 6), lane = tid & 63, wr = wid >> 2, wc = wid & 3, fr = lane & 15, fq = lane >> 4;
    const int K = g.K, nt = K / BK;
    unsigned voffA[2], voffB[2];
#pragma unroll
    for (int i = 0; i < 2; ++i) { int R, C; stage_rc(tid * 16 + i * 8192, R, C); const int Rb = Epi::PERM ? ((R & ~31) + perm32(R & 31)) : R;
        voffA[i] = (unsigned)(R * K + C) * 2u; voffB[i] = (unsigned)(Rb * K + C) * 2u; }
    const size_t kstep = (size_t)(BK * 2);
    const size_t hstep = (size_t)HALF * K * 2;
    const size_t tstep = 2 * hstep;
    const unsigned ldsw = (unsigned)wid * 1024u;
    const int aoff = lds_byte(wr * 64 + fr, fq * 8), boff = lds_byte(wc * 32 + fr, fq * 8);
#define PG8_SA(b, h) (((b) * 2 + (h)) * HTB)
#define PG8_SB(b, h) ((4 + (b) * 2 + (h)) * HTB)
#define PG8_STAGE(bufoff, gbase, voff) do { _Pragma("unroll") for (int _i = 0; _i < 2; ++_i) \
        __builtin_amdgcn_global_load_lds((const unsigned*)((const char*)(gbase) + (voff)[_i]), (PG8_LAS unsigned*)(lds + (bufoff) + ldsw + _i * 8192), 16, 0, 0); } while (0)
#define PG8_LDA(dst, b, h) do { _Pragma("unroll") for (int m = 0; m < 4; ++m) _Pragma("unroll") for (int k = 0; k < 2; ++k) dst[m][k] = *(const PG8_LAS bf16x8*)(lds + PG8_SA(b, h) + aoff + m * 2048 + k * 1024); } while (0)
#define PG8_LDB(dst, b, h) do { _Pragma("unroll") for (int n = 0; n < 2; ++n) _Pragma("unroll") for (int k = 0; k < 2; ++k) dst[n][k] = *(const PG8_LAS bf16x8*)(lds + PG8_SB(b, h) + boff + n * 2048 + k * 1024); } while (0)
#define PG8_MMA(ai, bj, At, Bt) do { __builtin_amdgcn_s_setprio(1); _Pragma("unroll") for (int m = 0; m < 4; ++m) _Pragma("unroll") for (int n = 0; n < 2; ++n) _Pragma("unroll") for (int k = 0; k < 2; ++k) \
        acc[ai][bj][m][n] = __builtin_amdgcn_mfma_f32_16x16x32_bf16(Bt[n][k], At[m][k], acc[ai][bj][m][n], 0, 0, 0); __builtin_amdgcn_s_setprio(0); } while (0)
#define PG8_WAIT_V(n) asm volatile("s_waitcnt vmcnt(" #n ")" ::: "memory")
#define PG8_WAIT_L(n) asm volatile("s_waitcnt lgkmcnt(" #n ")" ::: "memory")
#define PG8_BAR __builtin_amdgcn_s_barrier()
#define PG8_SCHED __builtin_amdgcn_sched_barrier(0)
    Unit cur, nxt; int ui = 0;
    if (!S.next(0, cur)) return;
    f32x4 acc[2][2][4][2];
#pragma unroll
    for (int a = 0; a < 2; ++a)
#pragma unroll
        for (int b = 0; b < 2; ++b)
#pragma unroll
            for (int m = 0; m < 4; ++m)
#pragma unroll
                for (int n = 0; n < 2; ++n) acc[a][b][m][n] = (f32x4){0.f, 0.f, 0.f, 0.f};
    bf16x8 At[4][2], B0[2][2], B1[2][2];
    const char* cA = (const char*)g.A + (size_t)cur.pm * tstep; const char* cB = (const char*)g.Bt + (size_t)cur.pn * tstep;
    S.a_ready(cur);
    if constexpr (SP2) {
        PG8_STAGE(PG8_SB(0, 0), cB, voffB); PG8_STAGE(PG8_SB(0, 1), cB + hstep, voffB); PG8_STAGE(PG8_SA(0, 0), cA, voffA); PG8_STAGE(PG8_SA(0, 1), cA + hstep, voffA);
        if (wr == 1) PG8_BAR;
        PG8_WAIT_V(2); PG8_BAR;
        PG8_STAGE(PG8_SB(1, 0), cB + kstep, voffB); PG8_STAGE(PG8_SA(1, 0), cA + kstep, voffA); PG8_STAGE(PG8_SB(1, 1), cB + hstep + kstep, voffB);
        PG8_WAIT_V(6); PG8_BAR;
    } else {
        PG8_STAGE(PG8_SB(0, 0), cB, voffB); PG8_STAGE(PG8_SA(0, 0), cA, voffA); PG8_STAGE(PG8_SB(0, 1), cB + hstep, voffB); PG8_STAGE(PG8_SA(0, 1), cA + hstep, voffA);
        if (wr == 1) PG8_BAR;
        PG8_WAIT_V(4); PG8_BAR;
        PG8_STAGE(PG8_SB(1, 0), cB + kstep, voffB); PG8_STAGE(PG8_SA(1, 0), cA + kstep, voffA); PG8_STAGE(PG8_SB(1, 1), cB + hstep + kstep, voffB);
        PG8_WAIT_V(6); PG8_BAR;
    }
    for (;;) {
        const bool has_next = S.next(ui + 1, nxt);
        const char* nA = has_next ? (const char*)g.A + (size_t)nxt.pm * tstep : cA; const char* nB = has_next ? (const char*)g.Bt + (size_t)nxt.pn * tstep : cB;
        for (int t = 0; t < nt; t += 2) {
            const bool last = (t == nt - 2);
            const char* a1 = cA + (size_t)(t + 1) * kstep;
            const char* a2 = last ? nA : cA + (size_t)(t + 2) * kstep; const char* b2 = last ? nB : cB + (size_t)(t + 2) * kstep;
            const char* a3 = a2 + kstep; const char* b3 = b2 + kstep;
            if (last && has_next) S.a_ready(nxt);
            if constexpr (SP2) {
            PG8_LDB(B0, 0, 0); PG8_LDB(B1, 0, 1); PG8_SCHED; PG8_LDA(At, 0, 0); PG8_STAGE(PG8_SA(1, 1), a1 + hstep, voffA);
            PG8_WAIT_V(8); PG8_WAIT_L(0); PG8_BAR; PG8_MMA(0, 0, At, B0); PG8_MMA(0, 1, At, B1); PG8_BAR; PG8_SCHED;
            PG8_LDA(At, 0, 1); PG8_STAGE(PG8_SB(0, 0), b2, voffB); PG8_STAGE(PG8_SB(0, 1), b2 + hstep, voffB); PG8_STAGE(PG8_SA(0, 0), a2, voffA);
            PG8_WAIT_V(8); PG8_WAIT_L(0); PG8_BAR; PG8_MMA(1, 0, At, B0); PG8_MMA(1, 1, At, B1); PG8_BAR; PG8_SCHED;
            PG8_LDB(B0, 1, 0); PG8_LDB(B1, 1, 1); PG8_SCHED; PG8_LDA(At, 1, 0); PG8_STAGE(PG8_SA(0, 1), a2 + hstep, voffA);
            PG8_WAIT_V(8); PG8_WAIT_L(0); PG8_BAR; PG8_MMA(0, 0, At, B0); PG8_MMA(0, 1, At, B1); PG8_BAR; PG8_SCHED;
            PG8_LDA(At, 1, 1); PG8_STAGE(PG8_SB(1, 0), b3, voffB); PG8_STAGE(PG8_SB(1, 1), b3 + hstep, voffB); PG8_STAGE(PG8_SA(1, 0), a3, voffA);
            PG8_WAIT_V(8); PG8_WAIT_L(0); PG8_BAR; PG8_MMA(1, 0, At, B0); PG8_MMA(1, 1, At, B1); PG8_BAR; PG8_SCHED;
            } else {
            PG8_LDB(B0, 0, 0); PG8_SCHED; PG8_LDA(At, 0, 0); PG8_STAGE(PG8_SA(1, 1), a1 + hstep, voffA);
            PG8_WAIT_L(8); PG8_BAR; PG8_WAIT_L(0); PG8_MMA(0, 0, At, B0); PG8_BAR; PG8_SCHED;
            PG8_LDB(B1, 0, 1); PG8_STAGE(PG8_SB(0, 0), b2, voffB);
            PG8_BAR; PG8_WAIT_L(0); PG8_MMA(0, 1, At, B1); PG8_BAR;
            PG8_LDA(At, 0, 1); PG8_STAGE(PG8_SA(0, 0), a2, voffA);
            PG8_BAR; PG8_WAIT_L(0); PG8_MMA(1, 0, At, B0); PG8_BAR; PG8_SCHED;
            PG8_STAGE(PG8_SB(0, 1), b2 + hstep, voffB);
            PG8_WAIT_V(6); PG8_BAR; PG8_MMA(1, 1, At, B1); PG8_BAR;
            PG8_LDB(B0, 1, 0); PG8_SCHED; PG8_LDA(At, 1, 0); PG8_STAGE(PG8_SA(0, 1), a2 + hstep, voffA);
            PG8_WAIT_L(8); PG8_BAR; PG8_WAIT_L(0); PG8_MMA(0, 0, At, B0); PG8_BAR; PG8_SCHED;
            PG8_LDB(B1, 1, 1); PG8_STAGE(PG8_SB(1, 0), b3, voffB);
            PG8_BAR; PG8_WAIT_L(0); PG8_MMA(0, 1, At, B1); PG8_BAR;
            PG8_LDA(At, 1, 1); PG8_STAGE(PG8_SA(1, 0), a3, voffA);
            PG8_BAR; PG8_WAIT_L(0); PG8_MMA(1, 0, At, B0); PG8_BAR; PG8_SCHED;
            PG8_STAGE(PG8_SB(1, 1), b3 + hstep, voffB);
            PG8_WAIT_V(6); PG8_BAR; PG8_MMA(1, 1, At, B1); PG8_BAR;
            }
        }
        if constexpr (ALIGN_EPI) { if (wr == 0) PG8_BAR; }
        if constexpr (!Epi::AFTER_DRAIN) { E(acc, cur, wr, wc, fr, fq); S.done(cur); }
        if (!has_next) break;
#pragma unroll
        for (int a = 0; a < 2; ++a)
#pragma unroll
            for (int b = 0; b < 2; ++b)
#pragma unroll
                for (int m = 0; m < 4; ++m)
#pragma unroll
                    for (int n = 0; n < 2; ++n) acc[a][b][m][n] = (f32x4){0.f, 0.f, 0.f, 0.f};
        cur = nxt; cA = nA; cB = nB; ++ui;
        if constexpr (ALIGN_EPI) { if (wr == 1) PG8_BAR; }
    }
    PG8_WAIT_V(0);
    if constexpr (!ALIGN_EPI) { if (wr == 0) PG8_BAR; }
    PG8_BAR;
    if constexpr (Epi::AFTER_DRAIN) { E.fused(acc, cur, wr, wc, fr, fq, lds, wid, lane); S.done(cur); }
#undef PG8_SA
#undef PG8_SB
#undef PG8_STAGE
#undef PG8_LDA
#undef PG8_LDB
#undef PG8_MMA
#undef PG8_WAIT_V
#undef PG8_WAIT_L
#undef PG8_BAR
#undef PG8_SCHED
}
}
#define LAS __attribute__((address_space(3)))
#define XB_TMO      128
#define XB_XCNT(j)  (256  + 64 * (j))
#define XB_XSUB(j)  (1280 + 64 * (j))
#define XB_XGEN(j)  (2304 + 64 * (j))
#define XB_TOP      3328
#define XB_TOPGEN   3392
#define XCD_BAR_WORDS 3456
#define XB_SPIN_CAP (1u << 18)

__device__ __forceinline__ unsigned xb_ld(unsigned* p)              { return __hip_atomic_load(p, __ATOMIC_RELAXED, __HIP_MEMORY_SCOPE_AGENT); }
__device__ __forceinline__ unsigned xb_add(unsigned* p, unsigned v) { return __hip_atomic_fetch_add(p, v, __ATOMIC_RELAXED, __HIP_MEMORY_SCOPE_AGENT); }
__device__ __forceinline__ unsigned xb_xcc_id() { return (unsigned)__builtin_amdgcn_s_getreg((3 << 11) | 20) & 0xFu; }
#define XB_SPIN(cond, bar) do { unsigned _sp = 0; while (cond) { __builtin_amdgcn_s_sleep(1); \
    if ((++_sp & 255u) == 0u) { if (xb_ld(&(bar)[XB_TMO])) break; if (_sp > XB_SPIN_CAP) { atomicAdd(&(bar)[XB_TMO], 1u); break; } } } } while (0)

struct XcdBarrier {
    unsigned* bar; unsigned x;
    volatile LAS unsigned* st;
};

__device__ __forceinline__ XcdBarrier xcd_barrier_post(unsigned* bar, volatile LAS unsigned* st) {
    XcdBarrier b; b.bar = bar; b.x = xb_xcc_id(); b.st = st;
    if (threadIdx.x == 0) (void)xb_add(&bar[XB_XCNT(b.x)], 1u);
    return b;
}
__device__ __forceinline__ void xcd_barrier_complete(unsigned* bar, unsigned x, unsigned& nloc, unsigned& nx) {
    const unsigned G = gridDim.x * gridDim.y * gridDim.z;
    unsigned sum, cnt, mine, sp = 0u;
    for (;;) {
        sum = 0u; cnt = 0u; mine = 0u;
#pragma unroll
        for (unsigned j = 0; j < 16; ++j) { const unsigned c = xb_ld(&bar[XB_XCNT(j)]); sum += c; cnt += (c > 0u) ? 1u : 0u; mine = (j == x) ? c : mine; }
        if (sum == G) break;
        __builtin_amdgcn_s_sleep(1);
        if ((++sp & 255u) == 0u) { if (xb_ld(&bar[XB_TMO])) break; if (sp > XB_SPIN_CAP) { atomicAdd(&bar[XB_TMO], 1u); break; } }
    }
    nloc = mine > 0u ? mine : 1u; nx = cnt > 0u ? cnt : 1u;
}

__device__ __forceinline__ void xcd_barrier(const XcdBarrier& b) {
    asm volatile("s_waitcnt vmcnt(0)" ::: "memory");
    __syncthreads();
    if (threadIdx.x == 0) {
        unsigned* bar = b.bar;
        __builtin_amdgcn_s_waitcnt(0);
        unsigned nloc = b.st[0], nx = b.st[1];
        if (nloc == 0u) { xcd_barrier_complete(bar, b.x, nloc, nx); b.st[0] = nloc; b.st[1] = nx; }
        const unsigned old = xb_add(&bar[XB_XSUB(b.x)], 1u);
        const unsigned gen = old / nloc;
        if (old + 1u == (gen + 1u) * nloc) {
            __builtin_amdgcn_fence(__ATOMIC_RELEASE, "agent");
            asm volatile("s_waitcnt vmcnt(0)" ::: "memory");
            const unsigned og = xb_add(&bar[XB_TOP], 1u);
            const unsigned tg = og / nx;
            if (og + 1u == (tg + 1u) * nx) xb_add(&bar[XB_TOPGEN], 1u);
            else XB_SPIN(xb_ld(&bar[XB_TOPGEN]) == tg, bar);
            __builtin_amdgcn_fence(__ATOMIC_ACQUIRE, "agent");
            xb_add(&bar[XB_XGEN(b.x)], 1u);
            asm volatile("s_waitcnt vmcnt(0)" ::: "memory");
        } else {
            XB_SPIN(xb_ld(&bar[XB_XGEN(b.x)]) == gen, bar);
            __builtin_amdgcn_fence(__ATOMIC_ACQUIRE, "agent");
            asm volatile("s_waitcnt vmcnt(0)" ::: "memory");
        }
    }
    __syncthreads();
}

#ifndef MK_DUP
#define MK_DUP 0
#endif
#ifndef MK_PER_PHASE
#define MK_PER_PHASE 0
#endif
#define LAS __attribute__((address_space(3)))
typedef unsigned short bf16;
typedef short bf16x8 __attribute__((ext_vector_type(8)));
typedef short s16x4 __attribute__((ext_vector_type(4)));
typedef float f32x4 __attribute__((ext_vector_type(4)));
typedef float f32x16 __attribute__((ext_vector_type(16)));
typedef unsigned u32x4 __attribute__((ext_vector_type(4)));
typedef unsigned u32x2 __attribute__((ext_vector_type(2)));
typedef float f32x2m __attribute__((ext_vector_type(2)));
#define MFMA32(a, b, c) __builtin_amdgcn_mfma_f32_32x32x16_bf16((a), (b), (c), 0, 0, 0)
#define LDS_WAIT() asm volatile("s_waitcnt lgkmcnt(0)" ::: "memory")

constexpr int NFR = 16384, MT = 16640, D = 1024, FF = 2816, NGU = 5632, NIN = 4608, PBW = 4352, DIN = 4368;
constexpr int NPH = 12;
constexpr int LDS_BYTES = 147456, MISC_OFF = 131072 + 320, CTL_BYTES = 16384;
constexpr size_t MiB = 1u << 20;
constexpr size_t WS_WGU1 = 0, WS_WD1 = 11 * MiB, WS_ST = 0  , WS_WGU2 = 17 * MiB, WS_WD2 = 28 * MiB, WS_WIN = 34 * MiB,
                 WS_WA = 43 * MiB, WS_WB = 44 * MiB, WS_WOUT = 45 * MiB, WS_SSP = 47 * MiB, WS_GLOW = 49 * MiB, WS_DEC = 51 * MiB, WS_CTL = 51 * MiB + MiB / 2  , WS_MSSP = 51 * MiB + 3 * MiB / 4  ,
                 WS_HB = 52 * MiB, WS_YA = 52 * MiB, WS_YB = 68 * MiB  , WS_R1 = 85 * MiB  ,
                 WS_KV = 223 * MiB + MiB / 2  , WS_END = 256 * MiB;
static_assert(WS_ST + (size_t)1032 * 8192 * 2 <= WS_WGU2 && WS_R1 + (size_t)MT * PBW * 2 <= WS_KV && WS_KV + (size_t)1032 * 8192 * 4 <= WS_END && WS_HB + (size_t)MT * D * 2 <= WS_R1, "d_ws map");

struct Params { const float* in[20]; float* out; unsigned char* ws; int ph_lo, ph_hi, cg_sync, pad; };

__device__ __forceinline__ int crow(int reg, int h) { return (reg & 3) + 8 * (reg >> 2) + 4 * h; }
__device__ __forceinline__ unsigned f2bf(float f) { unsigned u = __float_as_uint(f); return (u + 0x7fffu + ((u >> 16) & 1u)) >> 16; }
__device__ __forceinline__ unsigned pk2(float lo, float hi) { return f2bf(lo) | (f2bf(hi) << 16); }
__device__ __forceinline__ float wave_sum(float v) {
#pragma unroll
    for (int o = 1; o < 64; o <<= 1) v += __shfl_xor(v, o);
    return v;
}
__device__ __forceinline__ bf16x8 pack8(float a, float b, float c, float d, float e, float f, float g, float h) {
    u32x4 p; p.x = pk2(a, b); p.y = pk2(c, d); p.z = pk2(e, f); p.w = pk2(g, h); return __builtin_bit_cast(bf16x8, p);
}

__device__ __forceinline__ void tr_item64(const float* W, int K, int N, int k0, int sn0, int nvalid, const float* gain, bf16* WT, int drow0, LAS unsigned* T, int lane) {
    const int n4 = (lane & 15) * 4, kp = lane >> 4; const bool cv = n4 < nvalid;
    f32x4 a[8], b[8];
#pragma unroll
    for (int st = 0; st < 8; ++st) { const float* p = W + (size_t)(k0 + 8 * st + 2 * kp) * N + sn0 + n4;
        a[st] = cv ? *(const f32x4*)p : (f32x4){0.f, 0.f, 0.f, 0.f}; b[st] = cv ? *(const f32x4*)(p + N) : (f32x4){0.f, 0.f, 0.f, 0.f}; }
#pragma unroll
    for (int st = 0; st < 8; ++st) { const int k = k0 + 8 * st + 2 * kp; float g0 = 1.f, g1 = 1.f; if (gain) { g0 = gain[k]; g1 = gain[k + 1]; }
        LAS unsigned* t = T + n4 * 33 + 4 * st + kp;
        t[0] = pk2(a[st][0] * g0, b[st][0] * g1); t[33] = pk2(a[st][1] * g0, b[st][1] * g1); t[66] = pk2(a[st][2] * g0, b[st][2] * g1); t[99] = pk2(a[st][3] * g0, b[st][3] * g1); }
    LDS_WAIT(); asm volatile("" ::: "memory");
    const int c = lane & 7;
#pragma unroll
    for (int q = 0; q < 8; ++q) { const int n = (lane >> 3) + 8 * q; const LAS unsigned* t = T + n * 33 + 4 * c;
        u32x4 o; o.x = t[0]; o.y = t[1]; o.z = t[2]; o.w = t[3];
        *(u32x4*)(WT + (size_t)(drow0 + n) * K + k0 + 8 * c) = o; }
    LDS_WAIT(); asm volatile("" ::: "memory");
}
constexpr int I_GU = 16 * 44, I_DN = 44 * 16, I_IN = 16 * 72, I_BR = 8 * 16, I_WO = 16 * 16;
constexpr int IT_R1 = 2 * I_GU, IT_R2 = IT_R1 + I_DN + I_IN + 2 * I_BR + I_WO, IT_END = IT_R2 + 2 * I_GU + I_DN;
__device__ __forceinline__ void prep_item(const Params& P, int it, LAS unsigned* scr, int lane) {
    unsigned char* ws = P.ws; int r = it;
    if (r < 2 * I_GU) { const int up = r >= I_GU; r -= up * I_GU; const int kb = r / 44, n0 = (r % 44) * 64;
        tr_item64(up ? P.in[4] : P.in[3], D, FF, kb * 64, n0, 64, P.in[2], (bf16*)(ws + WS_WGU1), (n0 >> 7) * 256 + (n0 & 127) + up * 128, scr, lane); return; }
    r -= 2 * I_GU;
    if (r < I_DN) { tr_item64(P.in[5], FF, D, (r / 16) * 64, (r % 16) * 64, 64, nullptr, (bf16*)(ws + WS_WD1), (r % 16) * 64, scr, lane); return; }
    r -= I_DN;
    if (r < I_IN) { const int kb = r / 72, d0 = (r % 72) * 64; int sn0, nv;
        if (d0 < 2304) { sn0 = d0; nv = 64; } else if (d0 < 4352) { sn0 = d0 + 16; nv = 64; } else if (d0 == 4352) { sn0 = 2304; nv = 16; } else { sn0 = 0; nv = 0; }
        tr_item64(P.in[7], D, DIN, kb * 64, sn0, nv, P.in[6], (bf16*)(ws + WS_WIN), d0, scr, lane); return; }
    r -= I_IN;
    if (r < I_BR) { tr_item64(P.in[12], 512, D, (r / 16) * 64, (r % 16) * 64, 64, nullptr, (bf16*)(ws + WS_WA), (r % 16) * 64, scr, lane); return; }
    r -= I_BR;
    if (r < I_BR) { tr_item64(P.in[13], 512, D, (r / 16) * 64, (r % 16) * 64, 64, nullptr, (bf16*)(ws + WS_WB), (r % 16) * 64, scr, lane); return; }
    r -= I_BR;
    if (r < I_WO) { tr_item64(P.in[14], D, D, (r / 16) * 64, (r % 16) * 64, 64, nullptr, (bf16*)(ws + WS_WOUT), (r % 16) * 64, scr, lane); return; }
    r -= I_WO;
    if (r < 2 * I_GU) { const int up = r >= I_GU; r -= up * I_GU; const int kb = r / 44, n0 = (r % 44) * 64;
        tr_item64(up ? P.in[17] : P.in[16], D, FF, kb * 64, n0, 64, P.in[15], (bf16*)(ws + WS_WGU2), (n0 >> 7) * 256 + (n0 & 127) + up * 128, scr, lane); return; }
    r -= 2 * I_GU;
    tr_item64(P.in[18], FF, D, (r / 16) * 64, (r % 16) * 64, 64, nullptr, (bf16*)(ws + WS_WD2), (r % 16) * 64, scr, lane);
}
__device__ __forceinline__ void prep_in_slack(const Params& P, LAS unsigned char* lds, int lo, int hi, int nwg, int wave, int lane, int G) {
    const int rem = nwg % G, c = (int)blockIdx.x; int ns, si;
    if (rem == 0) { ns = G; si = c; } else { if (c < rem) return; ns = G - rem; si = c - rem; }
    LAS unsigned* scr = (LAS unsigned*)(lds + wave * 16384);
    for (int it = lo + wave * ns + si; it < hi; it += ns * 8) prep_item(P, it, scr, lane);
}
__device__ __forceinline__ void p0_prep(const Params& P, LAS unsigned char* lds, int wave, int lane, int G) {
    unsigned char* ws = P.ws;
    LAS unsigned* scr = (LAS unsigned*)(lds + wave * 16384);
    const int gw = blockIdx.x * 8 + wave, NGW = G * 8;
    for (int it = gw; it < IT_R1; it += NGW) prep_item(P, it, scr, lane);
    bf16* hb = (bf16*)(ws + WS_HB); float* ssp = (float*)(ws + WS_SSP);
    for (int m0 = gw; m0 < MT; m0 += 2 * NGW) {
        f32x4 v[2][4]; float s[2];
#pragma unroll
        for (int u = 0; u < 2; ++u) { const int m = m0 + u * NGW;
            const float* src = m < NFR ? P.in[0] + (size_t)m * D : (m < NFR + 16 ? P.in[1] + (size_t)(m - NFR) * D : nullptr);
#pragma unroll
            for (int j = 0; j < 4; ++j) v[u][j] = src ? ((const f32x4*)src)[lane + 64 * j] : (f32x4){0.f, 0.f, 0.f, 0.f}; }
#pragma unroll
        for (int u = 0; u < 2; ++u) { const int m = m0 + u * NGW; s[u] = 0.f;
#pragma unroll
            for (int j = 0; j < 4; ++j) s[u] += (v[u][j][0] * v[u][j][0] + v[u][j][1] * v[u][j][1]) + (v[u][j][2] * v[u][j][2] + v[u][j][3] * v[u][j][3]);
            s[u] = wave_sum(s[u]);
            if (m < MT) {
                u32x2* o8 = (u32x2*)(hb + (size_t)m * D) + lane;
#pragma unroll
                for (int j = 0; j < 4; ++j) { u32x2 w; w.x = pk2(v[u][j][0], v[u][j][1]); w.y = pk2(v[u][j][2], v[u][j][3]); o8[64 * j] = w; }
                if (lane < 16) ssp[(size_t)m * 16 + lane] = lane == 0 ? s[u] : 0.f; } }
    }
}

typedef float f32x4m __attribute__((ext_vector_type(4)));
#define MFMA16(a, b, c) __builtin_amdgcn_mfma_f32_16x16x32_bf16((a), (b), (c), 0, 0, 0)
__device__ __forceinline__ f32x4m meta_mm(const bf16* A, const bf16* Brow, int K, int k0, int nsteps, int lane) {
    const int r = lane & 15, quad = lane >> 4;
    const bf16* ap = A + (size_t)r * K + k0 + quad * 8; const bf16* bp = Brow + (size_t)r * K + k0 + quad * 8;
    f32x4m acc = (f32x4m){0.f, 0.f, 0.f, 0.f};
#pragma unroll 8
    for (int st = 0; st < nsteps; ++st) { const bf16x8 a = *(const bf16x8*)(ap + 32 * st), b = *(const bf16x8*)(bp + 32 * st); acc = MFMA16(a, b, acc); }
    return acc;
}
__device__ __forceinline__ float sum16(const float* p) { const f32x4 a = *(const f32x4*)p, b = *(const f32x4*)(p + 4), c = *(const f32x4*)(p + 8), d = *(const f32x4*)(p + 12);
    return (((a[0] + a[1]) + (a[2] + a[3])) + ((b[0] + b[1]) + (b[2] + b[3]))) + (((c[0] + c[1]) + (c[2] + c[3])) + ((d[0] + d[1]) + (d[2] + d[3]))); }
__device__ __forceinline__ void meta_p1(const Params& P, int wave, int lane, int G) {
    const int mt = (G - 1 - (int)blockIdx.x) * 8 + wave; if (mt >= 176) return;
    unsigned char* ws = P.ws; const bf16* hbm = (const bf16*)(ws + WS_HB) + (size_t)NFR * D; const bf16* W = (const bf16*)(ws + WS_WGU1);
    bf16* actm = (bf16*)(ws + WS_R1) + (size_t)NFR * FF; const float* ssp = (const float*)(ws + WS_SSP) + (size_t)NFR * 16;
    const int c0 = 16 * mt, grow = (c0 >> 7) * 256 + (c0 & 127), r = lane & 15, quad = lane >> 4;
    const f32x4m g = meta_mm(hbm, W + (size_t)grow * D, D, 0, 32, lane), u = meta_mm(hbm, W + (size_t)(grow + 128) * D, D, 0, 32, lane);
#pragma unroll
    for (int j = 0; j < 4; ++j) { const int row = quad * 4 + j; const float rs = __builtin_amdgcn_rsqf(sum16(ssp + row * 16) * (1.0f / 1024.0f) + 1e-6f);
        const float gv = g[j] * rs, uv = u[j] * rs; actm[(size_t)row * FF + c0 + r] = (bf16)f2bf(gv * pg8::sigm(gv) * uv); }
}
__device__ __forceinline__ void meta_p2(const Params& P, LAS unsigned char* L, int wave, int lane) {
    if (blockIdx.x >= 32) return;
    unsigned char* ws = P.ws; const bf16* actm = (const bf16*)(ws + WS_R1) + (size_t)NFR * FF; const bf16* W = (const bf16*)(ws + WS_WD1);
    bf16* hbm = (bf16*)(ws + WS_HB) + (size_t)NFR * D; float* mssp = (float*)(ws + WS_MSSP);
    const int ctl = wave >> 2, ks = wave & 3, ct = blockIdx.x * 2 + ctl, r = lane & 15, quad = lane >> 4;
    const f32x4m acc = meta_mm(actm, W + (size_t)(ct * 16) * FF, FF, ks * 704, 22, lane);
    LAS f32x4m* red = (LAS f32x4m*)L;
    red[(ctl * 4 + ks) * 64 + lane] = acc;
    __syncthreads();
    if (ks == 0) {
        const f32x4m t = (red[(ctl * 4) * 64 + lane] + red[(ctl * 4 + 1) * 64 + lane]) + (red[(ctl * 4 + 2) * 64 + lane] + red[(ctl * 4 + 3) * 64 + lane]);
#pragma unroll
        for (int j = 0; j < 4; ++j) { const int row = quad * 4 + j, col = ct * 16 + r; const float v = P.in[1][(size_t)row * D + col] + 0.5f * t[j];
            hbm[(size_t)row * D + col] = (bf16)f2bf(v);
            float sq = v * v; sq += __shfl_xor(sq, 1); sq += __shfl_xor(sq, 2); sq += __shfl_xor(sq, 4); sq += __shfl_xor(sq, 8);
            if (r == 0) mssp[row * 64 + ct] = sq; }
    }
    __syncthreads();
}
__device__ __forceinline__ void meta_p3(const Params& P, int wave, int lane, int G) {
    const int mt = (G - 1 - (int)blockIdx.x) * 8 + wave; if (mt >= 65) return;
    unsigned char* ws = P.ws; const bf16* hbm = (const bf16*)(ws + WS_HB) + (size_t)NFR * D; const bf16* W = (const bf16*)(ws + WS_WIN);
    bf16* PBm = (bf16*)(ws + WS_R1) + (size_t)NFR * PBW; float* glowm = (float*)(ws + WS_GLOW) + (size_t)NFR * 16; const float* mssp = (const float*)(ws + WS_MSSP);
    const int col0 = mt < 16 ? 512 + 16 * mt : (mt < 32 ? 1024 + 16 * (mt - 16) : (mt < 64 ? 1280 + 16 * (mt - 32) : 4352)), r = lane & 15, quad = lane >> 4;
    const f32x4m acc = meta_mm(hbm, W + (size_t)col0 * D, D, 0, 32, lane);
#pragma unroll
    for (int j = 0; j < 4; ++j) { const int row = quad * 4 + j;
        const f32x4 p = *(const f32x4*)(mssp + row * 64 + 4 * r); float sq = (p[0] + p[1]) + (p[2] + p[3]);
        sq += __shfl_xor(sq, 1); sq += __shfl_xor(sq, 2); sq += __shfl_xor(sq, 4); sq += __shfl_xor(sq, 8);
        const float v = acc[j] * __builtin_amdgcn_rsqf(sq * (1.0f / 1024.0f) + 1e-6f);
        if (mt < 64) PBm[(size_t)row * PBW + col0 + r] = (bf16)f2bf(v); else glowm[row * 16 + r] = v; }
}

constexpr int A_KS = 0, A_VT = 32256, A_VTS = 228;
__device__ __forceinline__ void attn_item(const Params& P, LAS unsigned char* L, int item, int tid, int wave, int lane) {
    const bf16* PB = (const bf16*)(P.ws + WS_R1); bf16* ya = (bf16*)(P.ws + WS_YA);
    const int kvh = item & 1, c = (item >> 1) & 127, b = item >> 8;
#pragma unroll
    for (int i = 0; i < 4; ++i) {
        const int key = (tid & 63) + 64 * i;
        if (key < 224) {
            bool valid; int row;
            if (key < 16) { valid = true; row = NFR + key; }
            else if (key < 32) { valid = false; row = 0; }
            else { const int ki = c * 64 - 128 + (key - 32); valid = ki >= 0; row = b * 8192 + (valid ? ki : 0); }
            u32x4 kk = (u32x4){0u, 0u, 0u, 0u}, vv = (u32x4){0u, 0u, 0u, 0u};
            if (valid) { const bf16* p = PB + (size_t)row * PBW + 512 + kvh * 64 + wave * 8; kk = *(const u32x4*)p; vv = *(const u32x4*)(p + 128); }
            *(LAS u32x4*)(L + A_KS + key * 144 + wave * 16) = kk;
            LAS unsigned short* vt = (LAS unsigned short*)(L + A_VT) + (wave * 8) * A_VTS + key;
            vt[0 * A_VTS] = (unsigned short)(vv.x & 0xffffu); vt[1 * A_VTS] = (unsigned short)(vv.x >> 16);
            vt[2 * A_VTS] = (unsigned short)(vv.y & 0xffffu); vt[3 * A_VTS] = (unsigned short)(vv.y >> 16);
            vt[4 * A_VTS] = (unsigned short)(vv.z & 0xffffu); vt[5 * A_VTS] = (unsigned short)(vv.z >> 16);
            vt[6 * A_VTS] = (unsigned short)(vv.w & 0xffffu); vt[7 * A_VTS] = (unsigned short)(vv.w >> 16);
        }
    }
    __syncthreads();
    const int g = wave >> 1, pos0 = (wave & 1) * 32, h = kvh * 4 + g, r = lane & 31, hi = lane >> 5;
    const int qrow = b * 8192 + c * 64 + pos0 + r;
    bf16x8 q[4];
#pragma unroll
    for (int s = 0; s < 4; ++s) q[s] = *(const bf16x8*)(PB + (size_t)qrow * PBW + h * 64 + 16 * s + 8 * hi);
    f32x16 S[7];
#pragma unroll
    for (int kt = 0; kt < 7; ++kt) {
#pragma unroll
        for (int i = 0; i < 16; ++i) S[kt][i] = 0.f;
#pragma unroll
        for (int s = 0; s < 4; ++s) { const bf16x8 a = *(const LAS bf16x8*)(L + A_KS + (kt * 32 + r) * 144 + (16 * s + 8 * hi) * 2); S[kt] = MFMA32(a, q[s], S[kt]); }
        asm volatile("" ::: "memory");
    }
    __builtin_amdgcn_sched_barrier(0);
    const float slope = exp2f(-(float)(h + 1)), sink = P.in[11][h];
    const float NEG = -__builtin_inff();
    float m = sink;
#pragma unroll
    for (int i = 0; i < 16; ++i) { if (i >= 8) S[0][i] = NEG; else m = fmaxf(m, S[0][i]); }
    int oz; asm volatile("v_mov_b32 %0, 0" : "=v"(oz));
    const int smin = 128 - 64 * c, pq = pos0 + r + 128 + oz;
#pragma unroll
    for (int kt = 1; kt < 7; ++kt) {
#pragma unroll
        for (int i = 0; i < 16; ++i) { const int s = (kt - 1) * 32 + crow(i, hi); float v = S[kt][i] - slope * fabsf((float)(pq - s)); if (s < smin) v = NEG; S[kt][i] = v; m = fmaxf(m, v); }
        __builtin_amdgcn_sched_barrier(0);
    }
    m = fmaxf(m, __shfl_xor(m, 32));
    __builtin_amdgcn_sched_barrier(0);
    float sum = 0.f; const float ml = m * 1.44269504f;
    bf16x8 pbv[7][2];
#pragma unroll
    for (int kt = 0; kt < 7; ++kt) {
#pragma unroll
        for (int i = 0; i < 16; ++i) { const float p = __builtin_amdgcn_exp2f(S[kt][i] * 1.44269504f - ml); S[kt][i] = p; sum += p; }
        pbv[kt][0] = pack8(S[kt][0], S[kt][1], S[kt][2], S[kt][3], S[kt][4], S[kt][5], S[kt][6], S[kt][7]);
        pbv[kt][1] = pack8(S[kt][8], S[kt][9], S[kt][10], S[kt][11], S[kt][12], S[kt][13], S[kt][14], S[kt][15]);
    }
    __builtin_amdgcn_sched_barrier(0);
    sum += __shfl_xor(sum, 32); sum += exp2f(sink * 1.44269504f - ml);
    const float inv = 1.0f / sum;
    f32x16 O[2];
#pragma unroll
    for (int i = 0; i < 16; ++i) { O[0][i] = 0.f; O[1][i] = 0.f; }
#pragma unroll
    for (int kt = 0; kt < 7; ++kt)
#pragma unroll
        for (int s2 = 0; s2 < 2; ++s2) {
            const bf16x8 pb = pbv[kt][s2];
#pragma unroll
            for (int dt = 0; dt < 2; ++dt) {
                const LAS unsigned char* vp = L + A_VT + ((dt * 32 + r) * A_VTS + kt * 32 + 16 * s2 + 4 * hi) * 2;
                const s16x4 lo = *(const LAS s16x4*)vp, h4 = *(const LAS s16x4*)(vp + 16);
                const bf16x8 va = __builtin_shufflevector(lo, h4, 0, 1, 2, 3, 4, 5, 6, 7);
                O[dt] = MFMA32(va, pb, O[dt]);
            }
            asm volatile("" ::: "memory");
        }
#pragma unroll
    for (int dt = 0; dt < 2; ++dt)
#pragma unroll
        for (int g4 = 0; g4 < 4; ++g4) {
            u32x2 w; w.x = pk2(O[dt][4 * g4] * inv, O[dt][4 * g4 + 1] * inv); w.y = pk2(O[dt][4 * g4 + 2] * inv, O[dt][4 * g4 + 3] * inv);
            *(u32x2*)(ya + (size_t)qrow * 512 + h * 64 + dt * 32 + 8 * g4 + 4 * hi) = w;
        }
    __syncthreads();
}

constexpr int G_QE = 0, G_KE = 9216, G_K2T = 18432, G_VT = 27648, G_ST = 46080, G_SEG = 64512, G_SS = 66560, G_GL = 67584;
template <bool KV> __device__ __forceinline__ void gla_prep(const Params& P, LAS unsigned char* L, int b, int h, int j, int tid) {
    const bf16* PB = (const bf16*)(P.ws + WS_R1); const float* glow = (const float*)(P.ws + WS_GLOW);
    const int d = tid & 63, seg = tid >> 6;
    const int posA = tid >> 3, sub = tid & 7; const bool vA = (j > 0) || (posA >= 48);
    const int rowA = vA ? (j == 0 ? NFR + posA - 48 : b * 8192 + (j - 1) * 64 + posA) : NFR;
    const f32x2m glv = *(const f32x2m*)(glow + (size_t)rowA * 16 + sub * 2);
    u32x4 qraw = (u32x4){0u, 0u, 0u, 0u}, kraw = qraw;
    if (vA) { const bf16* p = PB + (size_t)rowA * PBW + h * 64 + sub * 8; qraw = *(const u32x4*)(p + 768); kraw = *(const u32x4*)(p + 1024); }
    const int posC = tid & 63, dvg = tid >> 6; const bool vC = (j > 0) || (posC >= 48);
    const int rowC = vC ? (j == 0 ? NFR + posC - 48 : b * 8192 + (j - 1) * 64 + posC) : NFR;
    u32x4 va = (u32x4){0u, 0u, 0u, 0u}, vc = va;
    if (vC) { const bf16* p = PB + (size_t)rowC * PBW + 1280 + h * 128 + dvg * 16; va = *(const u32x4*)p; vc = *(const u32x4*)(p + 8); }
    u32x4 sa = (u32x4){0u, 0u, 0u, 0u}, sc = sa;
    if (!KV) { const bf16* sg = (const bf16*)(P.ws + WS_ST) + (size_t)((b * 4 + h) * 129 + j) * 8192 + (tid >> 2) * 64 + (tid & 3) * 16; sa = *(const u32x4*)sg; sc = *(const u32x4*)(sg + 8); }
    float gw[16];
#pragma unroll
    for (int r = 0; r < 16; ++r) gw[r] = P.in[8][r * 256 + h * 64 + d];
    const float bias = P.in[9][h * 64 + d];
    *(LAS f32x2m*)(L + G_GL + (posA * 16 + sub * 2) * 4) = glv;
    *(LAS u32x4*)(L + G_QE + (posA * 72 + sub * 8) * 2) = qraw; *(LAS u32x4*)(L + G_KE + (posA * 72 + sub * 8) * 2) = kraw;
    { LAS unsigned short* vt = (LAS unsigned short*)(L + G_VT) + (dvg * 16) * 72 + posC;
      vt[0 * 72] = (unsigned short)(va.x & 0xffffu); vt[1 * 72] = (unsigned short)(va.x >> 16); vt[2 * 72] = (unsigned short)(va.y & 0xffffu); vt[3 * 72] = (unsigned short)(va.y >> 16);
      vt[4 * 72] = (unsigned short)(va.z & 0xffffu); vt[5 * 72] = (unsigned short)(va.z >> 16); vt[6 * 72] = (unsigned short)(va.w & 0xffffu); vt[7 * 72] = (unsigned short)(va.w >> 16);
      vt[8 * 72] = (unsigned short)(vc.x & 0xffffu); vt[9 * 72] = (unsigned short)(vc.x >> 16); vt[10 * 72] = (unsigned short)(vc.y & 0xffffu); vt[11 * 72] = (unsigned short)(vc.y >> 16);
      vt[12 * 72] = (unsigned short)(vc.z & 0xffffu); vt[13 * 72] = (unsigned short)(vc.z >> 16); vt[14 * 72] = (unsigned short)(vc.w & 0xffffu); vt[15 * 72] = (unsigned short)(vc.w >> 16); }
    if (!KV) { const int dv = tid >> 2, part = tid & 3; *(LAS u32x4*)(L + G_ST + (dv * 72 + part * 16) * 2) = sa; *(LAS u32x4*)(L + G_ST + (dv * 72 + part * 16 + 8) * 2) = sc; }
    __syncthreads();
    LAS unsigned short* QE = (LAS unsigned short*)(L + G_QE); LAS unsigned short* KE = (LAS unsigned short*)(L + G_KE);
    float cs[8], qv[8], kv[8]; float run = 0.f;
#pragma unroll
    for (int p = 0; p < 8; ++p) {
        const int pos = seg * 8 + p; const bool valid = (j > 0) || (pos >= 48);
        const LAS f32x4* gl = (const LAS f32x4*)(L + G_GL + pos * 64);
        const f32x4 g0 = gl[0], g1 = gl[1], g2 = gl[2], g3 = gl[3];
        float z = bias;
#pragma unroll
        for (int e = 0; e < 4; ++e) { z += g0[e] * gw[e]; z += g1[e] * gw[4 + e]; z += g2[e] * gw[8 + e]; z += g3[e] * gw[12 + e]; }
        float la = (fminf(z, 0.f) - __logf(1.0f + __expf(-fabsf(z)))) * 0.0625f;
        if (!valid) la = 0.f;
        run += la; cs[p] = run;
        qv[p] = pg8::bf2f(QE[pos * 72 + d]); kv[p] = pg8::bf2f(KE[pos * 72 + d]);
        if (p & 1) __builtin_amdgcn_sched_barrier(0);
    }
    LAS float* SEG = (LAS float*)(L + G_SEG);
    SEG[seg * 64 + d] = run;
    __syncthreads();
    float off = 0.f, tot = 0.f;
#pragma unroll
    for (int s = 0; s < 8; ++s) { const float v = SEG[s * 64 + d]; tot += v; if (s < seg) off += v; }
    float k2[8];
#pragma unroll
    for (int p = 0; p < 8; ++p) {
        const int pos = seg * 8 + p; const float bb = off + cs[p];
        QE[pos * 72 + d] = (unsigned short)f2bf(qv[p] * __expf(bb));
        KE[pos * 72 + d] = (unsigned short)f2bf(kv[p] * __expf(-bb));
        k2[p] = kv[p] * __expf(tot - bb);
    }
    if (KV) {
        *(LAS bf16x8*)(L + G_K2T + (d * 72 + seg * 8) * 2) = pack8(k2[0], k2[1], k2[2], k2[3], k2[4], k2[5], k2[6], k2[7]);
        if (seg == 0) ((float*)(P.ws + WS_DEC))[(size_t)((b * 4 + h) * 129 + j) * 64 + d] = __expf(tot);
    }
}
__device__ __forceinline__ void gla_kv_item(const Params& P, LAS unsigned char* L, int item, int tid, int wave, int lane) {
    const int j = item % 129, bh = item / 129, h = bh & 3, b = bh >> 2;
    gla_prep<true>(P, L, b, h, j, tid);
    __syncthreads();
    const int dvt = wave >> 1, dkt = wave & 1, r = lane & 31, hi = lane >> 5;
    f32x16 acc;
#pragma unroll
    for (int i = 0; i < 16; ++i) acc[i] = 0.f;
#pragma unroll
    for (int s = 0; s < 4; ++s) {
        const bf16x8 a = *(const LAS bf16x8*)(L + G_VT + ((dvt * 32 + r) * 72 + 16 * s + 8 * hi) * 2);
        const bf16x8 bb = *(const LAS bf16x8*)(L + G_K2T + ((dkt * 32 + r) * 72 + 16 * s + 8 * hi) * 2);
        acc = MFMA32(a, bb, acc);
    }
    float* kvg = (float*)(P.ws + WS_KV) + (size_t)item * 8192;
#pragma unroll
    for (int i = 0; i < 16; ++i) kvg[(dvt * 32 + crow(i, hi)) * 64 + dkt * 32 + r] = acc[i];
    __syncthreads();
}
__device__ __forceinline__ void gla_scan(const Params& P, int wave, int lane, int G) {
    const float* kvg = (const float*)(P.ws + WS_KV); const float* dec = (const float*)(P.ws + WS_DEC); bf16* st = (bf16*)(P.ws + WS_ST);
    for (int wv = wave * G + blockIdx.x; wv < 1024; wv += G * 8) {
        const int gidx = wv * 64 + lane, bh = gidx >> 13, e = gidx & 8191, dk = e & 63;
        const size_t base = (size_t)bh * 129;
        float S = 0.f;
        for (int j0 = 0; j0 < 128; j0 += 8) {
            float kvv[8], dd[8];
#pragma unroll
            for (int u = 0; u < 8; ++u) { kvv[u] = kvg[(base + j0 + u) * 8192 + e]; dd[u] = dec[(base + j0 + u) * 64 + dk]; }
#pragma unroll
            for (int u = 0; u < 8; ++u) { S = dd[u] * S + kvv[u]; st[(base + j0 + u + 1) * 8192 + e] = (bf16)f2bf(S); }
        }
    }
}
__device__ __forceinline__ void gla_out_item(const Params& P, LAS unsigned char* L, int item  , int tid, int wave, int lane) {
    const int j = (item & 127) + 1, bh = item >> 7, h = bh & 3, b = bh >> 2;
    const bf16* PB = (const bf16*)(P.ws + WS_R1); bf16* yb = (bf16*)(P.ws + WS_YB);
    gla_prep<false>(P, L, b, h, j, tid);
    __syncthreads();
    const int it = wave & 1, dvt = wave >> 1, r = lane & 31, hi = lane >> 5;
    bf16x8 qf[4];
#pragma unroll
    for (int s = 0; s < 4; ++s) qf[s] = *(const LAS bf16x8*)(L + G_QE + ((it * 32 + r) * 72 + 16 * s + 8 * hi) * 2);
    f32x16 o;
#pragma unroll
    for (int i = 0; i < 16; ++i) o[i] = 0.f;
#pragma unroll
    for (int jt = 0; jt < 2; ++jt) {
        if (jt <= it) {
            f32x16 at;
#pragma unroll
            for (int i = 0; i < 16; ++i) at[i] = 0.f;
#pragma unroll
            for (int s = 0; s < 4; ++s) { const bf16x8 a = *(const LAS bf16x8*)(L + G_KE + ((jt * 32 + r) * 72 + 16 * s + 8 * hi) * 2); at = MFMA32(a, qf[s], at); }
            if (jt == it) {
#pragma unroll
                for (int i = 0; i < 16; ++i) if (crow(i, hi) > r) at[i] = 0.f;
            }
#pragma unroll
            for (int s2 = 0; s2 < 2; ++s2) {
                const bf16x8 pb = pack8(at[8 * s2], at[8 * s2 + 1], at[8 * s2 + 2], at[8 * s2 + 3], at[8 * s2 + 4], at[8 * s2 + 5], at[8 * s2 + 6], at[8 * s2 + 7]);
                const LAS unsigned char* vp = L + G_VT + ((dvt * 32 + r) * 72 + jt * 32 + 16 * s2 + 4 * hi) * 2;
                const s16x4 lo = *(const LAS s16x4*)vp, h4 = *(const LAS s16x4*)(vp + 16);
                o = MFMA32(__builtin_shufflevector(lo, h4, 0, 1, 2, 3, 4, 5, 6, 7), pb, o);
            }
        }
    }
#pragma unroll
    for (int s = 0; s < 4; ++s) { const bf16x8 a = *(const LAS bf16x8*)(L + G_ST + ((dvt * 32 + r) * 72 + 16 * s + 8 * hi) * 2); o = MFMA32(a, qf[s], o); }
    float ss = 0.f;
#pragma unroll
    for (int i = 0; i < 16; ++i) ss += o[i] * o[i];
    ss += __shfl_xor(ss, 32);
    LAS float* SS = (LAS float*)(L + G_SS);
    if (hi == 0) SS[dvt * 64 + it * 32 + r] = ss;
    __syncthreads();
    const float tot = (SS[it * 32 + r] + SS[64 + it * 32 + r]) + (SS[128 + it * 32 + r] + SS[192 + it * 32 + r]);
    const float rstd = __builtin_amdgcn_rsqf(tot * (1.0f / 128.0f) + 1e-6f);
    const int row = b * 8192 + (j - 1) * 64 + it * 32 + r;
#pragma unroll
    for (int g4 = 0; g4 < 4; ++g4) {
        const int dv0 = dvt * 32 + 8 * g4 + 4 * hi;
        const f32x4 gn = *(const f32x4*)(P.in[10] + dv0);
        const u32x2 gr = *(const u32x2*)(PB + (size_t)row * PBW + 1792 + h * 128 + dv0);
        u32x2 w;
        w.x = pk2(o[4 * g4] * rstd * gn[0] * pg8::bflo(gr.x), o[4 * g4 + 1] * rstd * gn[1] * pg8::bfhi(gr.x));
        w.y = pk2(o[4 * g4 + 2] * rstd * gn[2] * pg8::bflo(gr.y), o[4 * g4 + 3] * rstd * gn[3] * pg8::bfhi(gr.y));
        *(u32x2*)(yb + (size_t)row * 512 + h * 128 + dv0) = w;
    }
    __syncthreads();
}

__global__ void __launch_bounds__(512, 2) mega_fwd(Params P) {
    extern __shared__ __attribute__((aligned(16))) unsigned char lds_raw[];
    LAS unsigned char* lds = (LAS unsigned char*)lds_raw;
    cg::grid_group grid = cg::this_grid();
    const int tid = threadIdx.x, lane = tid & 63, wave = __builtin_amdgcn_readfirstlane(tid >> 6), G = gridDim.x;
    unsigned char* ws = P.ws;
    const int lo = P.ph_lo, hi = P.ph_hi;
    if (tid < 32) ((LAS unsigned*)(lds + MISC_OFF))[tid] = 0u;
    __syncthreads();
    XcdBarrier bar = xcd_barrier_post((unsigned*)(ws + WS_CTL), (volatile LAS unsigned*)(lds + MISC_OFF) + 8);
#define IN(k) (lo <= (k) && (k) < hi)
#define GSYNC() do { if (P.cg_sync) grid.sync(); else xcd_barrier(bar); } while (0)
#define SEAM(k) do { if (IN(k) && IN((k) + 1)) GSYNC(); } while (0)
#define DUPQ(k) ((MK_DUP >> (k)) & 1)
    bf16* hb = (bf16*)(ws + WS_HB); float* ssp = (float*)(ws + WS_SSP); bf16* R1 = (bf16*)(ws + WS_R1);

    if (IN(0)) {
        p0_prep(P, lds, wave, lane, G);
#if (MK_DUP >> 0) & 1
        GSYNC();
        p0_prep(P, lds, wave, lane, G);
#endif
    }
    SEAM(0);
    if (IN(1)) {
        {
        meta_p1(P, wave, lane, G);
        pg8::Gemm g{hb, (const bf16*)(ws + WS_WGU1), NFR, NGU, D}; pg8::StaticOrder S; S.init(NFR, NGU, G, (int)blockIdx.x);
        pg8::EpiSwiglu E{R1, ssp};
        pg8::gemm_phase<pg8::EpiSwiglu, pg8::StaticOrder, true, true>(lds, g, S, E);
        prep_in_slack(P, lds, IT_R1, IT_R2, S.nwg, wave, lane, G);
    }
#if (MK_DUP >> 1) & 1
        GSYNC();
        {
        meta_p1(P, wave, lane, G);
        pg8::Gemm g{hb, (const bf16*)(ws + WS_WGU1), NFR, NGU, D}; pg8::StaticOrder S; S.init(NFR, NGU, G, (int)blockIdx.x);
        pg8::EpiSwiglu E{R1, ssp};
        pg8::gemm_phase<pg8::EpiSwiglu, pg8::StaticOrder, true, true>(lds, g, S, E);
    }
#endif
    }
    SEAM(1);
    if (IN(2)) {
        {
        meta_p2(P, lds, wave, lane);
        pg8::Gemm g{R1, (const bf16*)(ws + WS_WD1), NFR, D, FF}; pg8::StaticOrder S; S.init(NFR, D, G, (int)blockIdx.x);
        pg8::EpiResid E{P.in[0], P.in[1], P.out, hb, ssp, 0.5f};
        pg8::gemm_phase<pg8::EpiResid, pg8::StaticOrder, true, true>(lds, g, S, E);
    }
#if (MK_DUP >> 2) & 1
        GSYNC();
        {
        meta_p2(P, lds, wave, lane);
        pg8::Gemm g{R1, (const bf16*)(ws + WS_WD1), NFR, D, FF}; pg8::StaticOrder S; S.init(NFR, D, G, (int)blockIdx.x);
        pg8::EpiResid E{P.in[0], P.in[1], P.out, hb, ssp, 0.5f};
        pg8::gemm_phase<pg8::EpiResid, pg8::StaticOrder, true, true>(lds, g, S, E);
    }
#endif
    }
    SEAM(2);
    if (IN(3)) {
        {
        meta_p3(P, wave, lane, G);
        pg8::Gemm g{hb, (const bf16*)(ws + WS_WIN), NFR, NIN, D}; pg8::StaticOrder S; S.init(NFR, NIN, G, (int)blockIdx.x);
        pg8::EpiIn E{R1, (float*)(ws + WS_GLOW), ssp};
        pg8::gemm_phase<pg8::EpiIn, pg8::StaticOrder, true, true>(lds, g, S, E);
        prep_in_slack(P, lds, IT_R2, IT_END, S.nwg, wave, lane, G);
    }
#if (MK_DUP >> 3) & 1
        GSYNC();
        {
        meta_p3(P, wave, lane, G);
        pg8::Gemm g{hb, (const bf16*)(ws + WS_WIN), NFR, NIN, D}; pg8::StaticOrder S; S.init(NFR, NIN, G, (int)blockIdx.x);
        pg8::EpiIn E{R1, (float*)(ws + WS_GLOW), ssp};
        pg8::gemm_phase<pg8::EpiIn, pg8::StaticOrder, true, true>(lds, g, S, E);
        prep_in_slack(P, lds, IT_R2, IT_END, S.nwg, wave, lane, G);
    }
#endif
    }
    SEAM(3);
    if (IN(4)) {
        {
        for (int it = blockIdx.x; it < 512; it += G) attn_item(P, lds, it, tid, wave, lane);
#if defined(MK_DUPA)
        for (int it = blockIdx.x; it < 512; it += G) attn_item(P, lds, it, tid, wave, lane);
#endif
        for (int it = blockIdx.x; it < 1032; it += G) gla_kv_item(P, lds, it, tid, wave, lane);
    }
#if (MK_DUP >> 4) & 1
        GSYNC();
        {
        for (int it = blockIdx.x; it < 512; it += G) attn_item(P, lds, it, tid, wave, lane);
        for (int it = blockIdx.x; it < 1032; it += G) gla_kv_item(P, lds, it, tid, wave, lane);
    }
#endif
    }
    SEAM(4);
    if (IN(5)) {
        gla_scan(P, wave, lane, G);
#if (MK_DUP >> 5) & 1
        GSYNC();
        gla_scan(P, wave, lane, G);
#endif
    }
    SEAM(5);
    if (IN(6)) {
        { for (int it = blockIdx.x; it < 1024; it += G) gla_out_item(P, lds, it, tid, wave, lane); }
#if (MK_DUP >> 6) & 1
        GSYNC();
        { for (int it = blockIdx.x; it < 1024; it += G) gla_out_item(P, lds, it, tid, wave, lane); }
#endif
    }
    SEAM(6);
    if (IN(7)) {
        {
        bf16* mixed = (bf16*)(ws + WS_KV);
        { pg8::Gemm g{(const bf16*)(ws + WS_YA), (const bf16*)(ws + WS_WA), NFR, D, 512}; pg8::StaticOrder S; S.init(NFR, D, G, (int)blockIdx.x);
          pg8::EpiMix<false> E{R1 + 2304, mixed};
          pg8::gemm_phase<pg8::EpiMix<false>, pg8::StaticOrder, true, true>(lds, g, S, E); }
        { pg8::Gemm g{(const bf16*)(ws + WS_YB), (const bf16*)(ws + WS_WB), NFR, D, 512}; pg8::StaticOrder S; S.init(NFR, D, G, (int)blockIdx.x);
          pg8::EpiMix<true> E{R1 + 3328, mixed};
          pg8::gemm_phase<pg8::EpiMix<true>, pg8::StaticOrder, true, true>(lds, g, S, E); }
    }
#if (MK_DUP >> 7) & 1
        GSYNC();
        {
        bf16* mixed = (bf16*)(ws + WS_KV);
        { pg8::Gemm g{(const bf16*)(ws + WS_YA), (const bf16*)(ws + WS_WA), NFR, D, 512}; pg8::StaticOrder S; S.init(NFR, D, G, (int)blockIdx.x);
          pg8::EpiMix<false> E{R1 + 2304, mixed};
          pg8::gemm_phase<pg8::EpiMix<false>, pg8::StaticOrder, true, true>(lds, g, S, E); }
        { pg8::Gemm g{(const bf16*)(ws + WS_YB), (const bf16*)(ws + WS_WB), NFR, D, 512}; pg8::StaticOrder S; S.init(NFR, D, G, (int)blockIdx.x);
          pg8::EpiMix<true> E{R1 + 3328, mixed};
          pg8::gemm_phase<pg8::EpiMix<true>, pg8::StaticOrder, true, true>(lds, g, S, E); }
    }
#endif
    }
    SEAM(7);
    if (IN(8)) {
        {
        pg8::Gemm g{(const bf16*)(ws + WS_KV), (const bf16*)(ws + WS_WOUT), NFR, D, D}; pg8::StaticOrder S; S.init(NFR, D, G, (int)blockIdx.x);
        pg8::EpiResid E{P.out, P.in[1], P.out, hb, ssp, 1.0f};
        pg8::gemm_phase<pg8::EpiResid, pg8::StaticOrder, true, true>(lds, g, S, E);
    }
#if (MK_DUP >> 8) & 1
        GSYNC();
        {
        pg8::Gemm g{(const bf16*)(ws + WS_KV), (const bf16*)(ws + WS_WOUT), NFR, D, D}; pg8::StaticOrder S; S.init(NFR, D, G, (int)blockIdx.x);
        pg8::EpiResid E{P.out, P.in[1], P.out, hb, ssp, 1.0f};
        pg8::gemm_phase<pg8::EpiResid, pg8::StaticOrder, true, true>(lds, g, S, E);
    }
#endif
    }
    SEAM(8);
    if (IN(9)) {
        {
        pg8::Gemm g{hb, (const bf16*)(ws + WS_WGU2), NFR, NGU, D}; pg8::StaticOrder S; S.init(NFR, NGU, G, (int)blockIdx.x);
        pg8::EpiSwiglu E{R1, ssp};
        pg8::gemm_phase<pg8::EpiSwiglu, pg8::StaticOrder, true, true>(lds, g, S, E);
    }
#if (MK_DUP >> 9) & 1
        GSYNC();
        {
        pg8::Gemm g{hb, (const bf16*)(ws + WS_WGU2), NFR, NGU, D}; pg8::StaticOrder S; S.init(NFR, NGU, G, (int)blockIdx.x);
        pg8::EpiSwiglu E{R1, ssp};
        pg8::gemm_phase<pg8::EpiSwiglu, pg8::StaticOrder, true, true>(lds, g, S, E);
    }
#endif
    }
    SEAM(9);
    if (IN(10)) {
        {
        pg8::Gemm g{R1, (const bf16*)(ws + WS_WD2), NFR, D, FF}; pg8::StaticOrder S; S.init(NFR, D, G, (int)blockIdx.x);
        pg8::EpiResid E{P.out, P.in[1], P.out, nullptr, ssp, 0.5f};
        pg8::gemm_phase<pg8::EpiResid, pg8::StaticOrder, true, true>(lds, g, S, E);
    }
#if (MK_DUP >> 10) & 1
        GSYNC();
        {
        pg8::Gemm g{R1, (const bf16*)(ws + WS_WD2), NFR, D, FF}; pg8::StaticOrder S; S.init(NFR, D, G, (int)blockIdx.x);
        pg8::EpiResid E{P.out, P.in[1], P.out, nullptr, ssp, 0.5f};
        pg8::gemm_phase<pg8::EpiResid, pg8::StaticOrder, true, true>(lds, g, S, E);
    }
#endif
    }
    SEAM(10);
    if (IN(11)) {
        {
        const int gw = blockIdx.x * 8 + wave, NGW = G * 8;
        for (int m = gw; m < NFR; m += NGW) {
            f32x4* rowp = (f32x4*)(P.out + (size_t)m * D) + lane;
            float s = ssp[(size_t)m * 16 + (lane & 15)];
            s += __shfl_xor(s, 1); s += __shfl_xor(s, 2); s += __shfl_xor(s, 4); s += __shfl_xor(s, 8);
            const float rs = __builtin_amdgcn_rsqf(s * (1.0f / 1024.0f) + 1e-6f);
#pragma unroll
            for (int j = 0; j < 4; ++j) { const f32x4 gn = ((const f32x4*)P.in[19])[lane + 64 * j]; f32x4 v = rowp[64 * j]; rowp[64 * j] = v * rs * gn; }
        }
    }
#if (MK_DUP >> 11) & 1
        GSYNC();
        {
        const int gw = blockIdx.x * 8 + wave, NGW = G * 8;
        for (int m = gw; m < NFR; m += NGW) {
            f32x4* rowp = (f32x4*)(P.out + (size_t)m * D) + lane;
            float s = ssp[(size_t)m * 16 + (lane & 15)];
            s += __shfl_xor(s, 1); s += __shfl_xor(s, 2); s += __shfl_xor(s, 4); s += __shfl_xor(s, 8);
            const float rs = __builtin_amdgcn_rsqf(s * (1.0f / 1024.0f) + 1e-6f);
#pragma unroll
            for (int j = 0; j < 4; ++j) { const f32x4 gn = ((const f32x4*)P.in[19])[lane + 64 * j]; f32x4 v = rowp[64 * j]; rowp[64 * j] = v * rs * gn; }
        }
    }
#endif
    }
#if defined(MK_XSYNC)
    for (int xs_ = 0; xs_ < MK_XSYNC; ++xs_) GSYNC();
#endif
#undef IN
#undef SEAM
}

extern "C" void kernel_launch(void* const* d_in, const int* in_sizes, int n_in, void* d_out, int out_size, void* d_ws, size_t ws_size, hipStream_t stream) {
    static int grid = 0;
    if (grid == 0) {
        if (n_in != 20 || out_size != NFR * D || ws_size < WS_END) { fprintf(stderr, "kernel_launch: unexpected shapes (n_in %d out %d ws %zu)\n", n_in, out_size, ws_size); grid = -1; return; }
        int dev = 0, cus = 0, per_cu = 0;
        hipGetDevice(&dev); hipDeviceGetAttribute(&cus, hipDeviceAttributeMultiprocessorCount, dev);
        if (hipFuncSetAttribute((const void*)mega_fwd, hipFuncAttributeMaxDynamicSharedMemorySize, LDS_BYTES) != hipSuccess) { fprintf(stderr, "kernel_launch: hipFuncSetAttribute failed\n"); grid = -1; return; }
        if (hipOccupancyMaxActiveBlocksPerMultiprocessor(&per_cu, (const void*)mega_fwd, 512, LDS_BYTES) != hipSuccess || per_cu < 1) { fprintf(stderr, "kernel_launch: occupancy query failed (%d)\n", per_cu); (void)hipGetLastError(); grid = -1; return; }
        grid = cus * per_cu;
        fprintf(stderr, "kernel_launch: %d CUs x %d blocks -> grid %d\n", cus, per_cu, grid);
    }
    if (grid < 0) return;
    Params p{};
    for (int i = 0; i < 20; ++i) p.in[i] = (const float*)d_in[i];
    p.out = (float*)d_out; p.ws = (unsigned char*)d_ws; p.cg_sync = 0; p.pad = 0;
    if (hipMemsetAsync((char*)d_ws + WS_CTL, 0, CTL_BYTES, stream) != hipSuccess) { fprintf(stderr, "kernel_launch: hipMemsetAsync failed\n"); return; }
#if MK_PER_PHASE
    for (int ph = 0; ph < NPH; ++ph) { p.ph_lo = ph; p.ph_hi = ph + 1; hipLaunchKernelGGL(mega_fwd, dim3(grid), dim3(512), LDS_BYTES, stream, p); }
#else
    p.ph_lo = 0; p.ph_hi = NPH;
    void* args[] = {&p};
    hipError_t e = hipLaunchCooperativeKernel((const void*)mega_fwd, dim3(grid), dim3(512), args, LDS_BYTES, stream);
    if (e != hipSuccess) fprintf(stderr, "kernel_launch: cooperative launch failed: %s (grid %d)\n", hipGetErrorString(e), grid);
#endif
}
```

```cpp
#include <hip/hip_runtime.h>
#include <hip/hip_cooperative_groups.h>
#include <cstdio>
#include <cstdint>
namespace cg = cooperative_groups;
namespace pg8 {
#define PG8_LAS __attribute__((address_space(3)))
typedef unsigned short bf16_t;
typedef short bf16x8 __attribute__((ext_vector_type(8)));
typedef float f32x4 __attribute__((ext_vector_type(4)));
typedef unsigned u32x4 __attribute__((ext_vector_type(4)));
constexpr int BM = 256, BK = 64, HALF = 128, HTB = HALF * BK * 2  , STAGE_BYTES = 8 * HTB, NXCD = 8, WGM = 8;

__host__ __device__ __forceinline__ int lds_byte(int r, int c) { const int st = (r >> 4) * 2 + (c >> 5), rr = r & 15, cc = c & 31, ob = rr * 64 + cc * 2; return st * 1024 + (ob ^ (((ob >> 9) & 1) << 5)); }
__host__ __device__ __forceinline__ void stage_rc(int b, int& R, int& C) { const int st = b / 1024, sb = b % 1024, swz = sb ^ (((sb >> 9) & 1) << 5); R = (st >> 1) * 16 + swz / 64; C = (st & 1) * 32 + (swz % 64) / 2; }
__host__ __device__ __forceinline__ int perm32(int rho) { const int n = rho >> 4, i = rho & 15; return 8 * (i >> 2) + 4 * n + (i & 3); }

struct Unit { int pm, pn; };
struct Gemm { const bf16_t* A; const bf16_t* Bt; int M, N, K; };

struct StaticOrder {
    int nM, nN, nwg, G, c;
    __host__ __device__ void init(int M, int N, int G_, int c_) { nM = M / BM; nN = N / BM; nwg = nM * nN; G = G_; c = c_; }
    __host__ __device__ bool next(int i, Unit& u) const {
        const long L = (long)i * G + c; if (L >= nwg) return false;
        int wgid = (int)L; { const int q = nwg / NXCD, r = nwg % NXCD, xcd = wgid % NXCD, off = wgid / NXCD; wgid = (xcd < r ? xcd * (q + 1) : r * (q + 1) + (xcd - r) * q) + off; }
        const int nig = WGM * nN, gid = wgid / nig, fm = gid * WGM, gsz = (nM - fm) < WGM ? (nM - fm) : WGM;
        u.pm = fm + ((wgid % nig) % gsz); u.pn = (wgid % nig) / gsz; return true;
    }
    __device__ __forceinline__ void a_ready(const Unit&) const {}
    __device__ __forceinline__ void done(const Unit&) const {}
};

__device__ __forceinline__ unsigned cvt_pk_bf16(float lo, float hi) { unsigned r; asm volatile("v_cvt_pk_bf16_f32 %0, %1, %2" : "=v"(r) : "v"(lo), "v"(hi)); return r; }
typedef float f32x2 __attribute__((ext_vector_type(2)));
constexpr int XD = 1024, XFF = 2816, XPBW = 4352, XNFR = 16384;
__device__ __forceinline__ float row_rstd(const float* ssp, int row, int fq) {
    const f32x4 p = *(const f32x4*)(ssp + (size_t)row * 16 + 4 * fq);
    float s = (p[0] + p[1]) + (p[2] + p[3]);
    s += __shfl_xor(s, 16); s += __shfl_xor(s, 32);
    return __builtin_amdgcn_rsqf(s * (1.0f / 1024.0f) + 1e-6f);
}
__device__ __forceinline__ float sigm(float x) { return __builtin_amdgcn_rcpf(1.0f + __expf(-x)); }
__device__ __forceinline__ float bf2f(unsigned short b) { return __uint_as_float((unsigned)b << 16); }
__device__ __forceinline__ float bflo(unsigned w) { return __uint_as_float(w << 16); }
__device__ __forceinline__ float bfhi(unsigned w) { return __uint_as_float(w & 0xffff0000u); }

struct EpiSwiglu {
    static constexpr bool PERM = true, AFTER_DRAIN = false;
    bf16_t* O; const float* ssp;
    __device__ __forceinline__ void operator()(const f32x4 (&acc)[2][2][4][2], const Unit& u, int wr, int wc, int fr, int fq) const {
        const int row0 = u.pm * BM + wr * 64 + fr, col0 = u.pn * HALF + wc * 32 + 8 * fq;
#pragma unroll
        for (int ai = 0; ai < 2; ++ai)
#pragma unroll
            for (int m = 0; m < 4; ++m) {
                const int row = row0 + ai * HALF + m * 16; const float rs = row_rstd(ssp, row, fq);
                const f32x4 g0 = acc[ai][0][m][0] * rs, g1 = acc[ai][0][m][1] * rs, u0 = acc[ai][1][m][0] * rs, u1 = acc[ai][1][m][1] * rs;
                u32x4 w;
                w.x = cvt_pk_bf16(g0[0] * sigm(g0[0]) * u0[0], g0[1] * sigm(g0[1]) * u0[1]);
                w.y = cvt_pk_bf16(g0[2] * sigm(g0[2]) * u0[2], g0[3] * sigm(g0[3]) * u0[3]);
                w.z = cvt_pk_bf16(g1[0] * sigm(g1[0]) * u1[0], g1[1] * sigm(g1[1]) * u1[1]);
                w.w = cvt_pk_bf16(g1[2] * sigm(g1[2]) * u1[2], g1[3] * sigm(g1[3]) * u1[3]);
                *(u32x4*)(O + (size_t)row * XFF + col0) = w;
            }
    }
};

template <bool FOUT> struct EpiResid {
    static constexpr bool PERM = false, AFTER_DRAIN = false;
    bf16_t* hb; float* out; float* ssp; float scale;
    __device__ __forceinline__ void operator()(const f32x4 (&acc)[2][2][4][2], const Unit& u, int wr, int wc, int fr, int fq) const {
        typedef unsigned u32x2v __attribute__((ext_vector_type(2)));
        const int row0 = u.pm * BM + wr * 64 + fr, col0 = u.pn * BM + wc * 32 + 4 * fq;
#pragma unroll
        for (int ai = 0; ai < 2; ++ai)
#pragma unroll
            for (int m = 0; m < 4; ++m) {
                const int row = row0 + ai * HALF + m * 16;
                float sq = 0.f;
#pragma unroll
                for (int bj = 0; bj < 2; ++bj)
#pragma unroll
                    for (int n = 0; n < 2; ++n) {
                        const int c = col0 + bj * HALF + n * 16;
                        const u32x2v b = *(const u32x2v*)(hb + (size_t)row * XD + c);
                        const f32x4 v = (f32x4){bflo(b.x), bfhi(b.x), bflo(b.y), bfhi(b.y)} + acc[ai][bj][m][n] * scale;
                        sq += (v[0] * v[0] + v[1] * v[1]) + (v[2] * v[2] + v[3] * v[3]);
                        if (FOUT) *(f32x4*)(out + (size_t)row * XD + c) = v;
                        else { u32x2v w; w.x = cvt_pk_bf16(v[0], v[1]); w.y = cvt_pk_bf16(v[2], v[3]); *(u32x2v*)(hb + (size_t)row * XD + c) = w; }
                    }
                sq += __shfl_xor(sq, 16); sq += __shfl_xor(sq, 32);
                if (fq == 0) ssp[(size_t)row * 16 + u.pn * 4 + wc] = sq;
            }
    }
};
struct EpiFinal {
    static constexpr bool PERM = false, AFTER_DRAIN = true;
    const bf16_t* hb; float* out; float* ssp; unsigned* cnt; const float* gain; float scale;
    __device__ __forceinline__ void operator()(const f32x4 (&)[2][2][4][2], const Unit&, int, int, int, int) const {}
    __device__ __forceinline__ void fused(f32x4 (&acc)[2][2][4][2], const Unit& u, int wr, int wc, int fr, int fq, PG8_LAS unsigned char*, int, int lane) const {
        typedef unsigned u32x2v __attribute__((ext_vector_type(2)));
        const int row0 = u.pm * BM + wr * 64 + fr, col0 = u.pn * BM + wc * 32 + 4 * fq;
#pragma unroll
        for (int ai = 0; ai < 2; ++ai)
#pragma unroll
            for (int m = 0; m < 4; ++m) {
                const int row = row0 + ai * HALF + m * 16;
                float sq = 0.f;
#pragma unroll
                for (int bj = 0; bj < 2; ++bj)
#pragma unroll
                    for (int n = 0; n < 2; ++n) {
                        const u32x2v b = *(const u32x2v*)(hb + (size_t)row * XD + col0 + bj * HALF + n * 16);
                        const f32x4 v = (f32x4){bflo(b.x), bfhi(b.x), bflo(b.y), bfhi(b.y)} + acc[ai][bj][m][n] * scale;
                        sq += (v[0] * v[0] + v[1] * v[1]) + (v[2] * v[2] + v[3] * v[3]);
                        acc[ai][bj][m][n] = v;
                    }
                sq += __shfl_xor(sq, 16); sq += __shfl_xor(sq, 32);
                if (fq == 0) __hip_atomic_store(ssp + (size_t)row * 16 + u.pn * 4 + wc, sq, __ATOMIC_RELAXED, __HIP_MEMORY_SCOPE_AGENT);
            }
        asm volatile("s_waitcnt vmcnt(0)" ::: "memory");
        unsigned* c = cnt + 64 * u.pm;
        if (lane == 0) __hip_atomic_fetch_add(c, 1u, __ATOMIC_RELAXED, __HIP_MEMORY_SCOPE_AGENT);
        for (unsigned sp = 0; sp < (1u << 20); ++sp) {
            if ((unsigned)__builtin_amdgcn_readfirstlane((int)__hip_atomic_load(c, __ATOMIC_RELAXED, __HIP_MEMORY_SCOPE_AGENT)) >= 32u) break;
            __builtin_amdgcn_s_sleep(2);
        }
        __builtin_amdgcn_fence(__ATOMIC_ACQUIRE, "agent");
        f32x4 gn[2][2];
#pragma unroll
        for (int bj = 0; bj < 2; ++bj)
#pragma unroll
            for (int n = 0; n < 2; ++n) gn[bj][n] = *(const f32x4*)(gain + col0 + bj * HALF + n * 16);
#pragma unroll
        for (int ai = 0; ai < 2; ++ai)
#pragma unroll
            for (int m = 0; m < 4; ++m) {
                const int row = row0 + ai * HALF + m * 16;
                const float* sp4 = ssp + (size_t)row * 16 + 4 * fq;
                float s = (__hip_atomic_load(sp4, __ATOMIC_RELAXED, __HIP_MEMORY_SCOPE_AGENT) + __hip_atomic_load(sp4 + 1, __ATOMIC_RELAXED, __HIP_MEMORY_SCOPE_AGENT))
                        + (__hip_atomic_load(sp4 + 2, __ATOMIC_RELAXED, __HIP_MEMORY_SCOPE_AGENT) + __hip_atomic_load(sp4 + 3, __ATOMIC_RELAXED, __HIP_MEMORY_SCOPE_AGENT));
                s += __shfl_xor(s, 16); s += __shfl_xor(s, 32);
                const float rs = __builtin_amdgcn_rsqf(s * (1.0f / 1024.0f) + 1e-6f);
#pragma unroll
                for (int bj = 0; bj < 2; ++bj)
#pragma unroll
                    for (int n = 0; n < 2; ++n) *(f32x4*)(out + (size_t)row * XD + col0 + bj * HALF + n * 16) = acc[ai][bj][m][n] * rs * gn[bj][n];
            }
    }
};

struct EpiIn {
    static constexpr bool PERM = true, AFTER_DRAIN = false;
    bf16_t* PB; float* glow; const float* ssp;
    __device__ __forceinline__ void operator()(const f32x4 (&acc)[2][2][4][2], const Unit& u, int wr, int wc, int fr, int fq) const {
        const int row0 = u.pm * BM + wr * 64 + fr, tile = u.pn;
        if (tile == 17) {
            if (wc == 0 && fq < 2) {
#pragma unroll
                for (int ai = 0; ai < 2; ++ai)
#pragma unroll
                    for (int m = 0; m < 4; ++m) {
                        const int row = row0 + ai * HALF + m * 16;
                        const f32x4 p = *(const f32x4*)(ssp + (size_t)row * 16), q = *(const f32x4*)(ssp + (size_t)row * 16 + 4), r = *(const f32x4*)(ssp + (size_t)row * 16 + 8), t = *(const f32x4*)(ssp + (size_t)row * 16 + 12);
                        const float s = (((p[0] + p[1]) + (p[2] + p[3])) + ((q[0] + q[1]) + (q[2] + q[3]))) + (((r[0] + r[1]) + (r[2] + r[3])) + ((t[0] + t[1]) + (t[2] + t[3])));
                        const float rs = __builtin_amdgcn_rsqf(s * (1.0f / 1024.0f) + 1e-6f);
                        *(f32x4*)(glow + (size_t)row * 16 + 8 * fq) = acc[ai][0][m][0] * rs;
                        *(f32x4*)(glow + (size_t)row * 16 + 8 * fq + 4) = acc[ai][0][m][1] * rs;
                    }
            }
            return;
        }
        const int mode = (tile <= 1 || tile == 3) ? 1 : (tile == 7 || tile == 8) ? 2 : (tile >= 9 ? 3 : 0);
        const int col0 = tile * BM + wc * 32 + 8 * fq;
#pragma unroll
        for (int ai = 0; ai < 2; ++ai)
#pragma unroll
            for (int m = 0; m < 4; ++m) {
                const int row = row0 + ai * HALF + m * 16; const float rs = row_rstd(ssp, row, fq);
#pragma unroll
                for (int bj = 0; bj < 2; ++bj) {
                    f32x4 v0 = acc[ai][bj][m][0] * rs, v1 = acc[ai][bj][m][1] * rs;
                    if (mode == 1) { v0 = v0 * 0.125f; v1 = v1 * 0.125f; }
                    else if (mode == 2) {
#pragma unroll
                        for (int j = 0; j < 4; ++j) { v0[j] = v0[j] * sigm(v0[j]); v1[j] = v1[j] * sigm(v1[j]); } }
                    else if (mode == 3) {
#pragma unroll
                        for (int j = 0; j < 4; ++j) { v0[j] = sigm(v0[j]); v1[j] = sigm(v1[j]); } }
                    u32x4 w; w.x = cvt_pk_bf16(v0[0], v0[1]); w.y = cvt_pk_bf16(v0[2], v0[3]); w.z = cvt_pk_bf16(v1[0], v1[1]); w.w = cvt_pk_bf16(v1[2], v1[3]);
                    *(u32x4*)(PB + (size_t)row * XPBW + col0 + bj * HALF) = w;
                }
            }
    }
};

template <bool ADD> struct EpiMix {
    static constexpr bool PERM = true, AFTER_DRAIN = false;
    const bf16_t* gate; bf16_t* mixed;
    __device__ __forceinline__ void operator()(const f32x4 (&acc)[2][2][4][2], const Unit& u, int wr, int wc, int fr, int fq) const {
        const int row0 = u.pm * BM + wr * 64 + fr, col0 = u.pn * BM + wc * 32 + 8 * fq;
#pragma unroll
        for (int ai = 0; ai < 2; ++ai)
#pragma unroll
            for (int m = 0; m < 4; ++m) {
                const int row = row0 + ai * HALF + m * 16;
#pragma unroll
                for (int bj = 0; bj < 2; ++bj) {
                    const int c = col0 + bj * HALF;
                    const u32x4 g = *(const u32x4*)(gate + (size_t)row * XPBW + c);
                    const f32x4 a0 = acc[ai][bj][m][0], a1 = acc[ai][bj][m][1];
                    float v[8] = {bflo(g.x) * a0[0], bfhi(g.x) * a0[1], bflo(g.y) * a0[2], bfhi(g.y) * a0[3], bflo(g.z) * a1[0], bfhi(g.z) * a1[1], bflo(g.w) * a1[2], bfhi(g.w) * a1[3]};
                    if (ADD) { const u32x4 o = *(const u32x4*)(mixed + (size_t)row * XD + c);
                        v[0] += bflo(o.x); v[1] += bfhi(o.x); v[2] += bflo(o.y); v[3] += bfhi(o.y); v[4] += bflo(o.z); v[5] += bfhi(o.z); v[6] += bflo(o.w); v[7] += bfhi(o.w); }
                    u32x4 w; w.x = cvt_pk_bf16(v[0], v[1]); w.y = cvt_pk_bf16(v[2], v[3]); w.z = cvt_pk_bf16(v[4], v[5]); w.w = cvt_pk_bf16(v[6], v[7]);
                    *(u32x4*)(mixed + (size_t)row * XD + c) = w;
                }
            }
    }
};

template <class Epi, class Sched, bool ALIGN_EPI = false, bool SP2 = false>
__device__ __forceinline__ void gemm_phase(PG8_LAS unsigned char* lds, const Gemm g, const Sched& S, const Epi& E) {
    const int tid = threadIdx.x, wid = __builtin_amdgcn_readfirstlane(tid >> 6), lane = tid & 63, wr = wid >> 2, wc = wid & 3, fr = lane & 15, fq = lane >> 4;
    const int K = g.K, nt = K / BK;
    unsigned voffA[2], voffB[2];
#pragma unroll
    for (int i = 0; i < 2; ++i) { int R, C; stage_rc(tid * 16 + i * 8192, R, C); const int Rb = Epi::PERM ? ((R & ~31) + perm32(R & 31)) : R;
        voffA[i] = (unsigned)(R * K + C) * 2u; voffB[i] = (unsigned)(Rb * K + C) * 2u; }
    const size_t kstep = (size_t)(BK * 2);
    const size_t hstep = (size_t)HALF * K * 2;
    const size_t tstep = 2 * hstep;
    const unsigned ldsw = (unsigned)wid * 1024u;
    const int aoff = lds_byte(wr * 64 + fr, fq * 8), boff = lds_byte(wc * 32 + fr, fq * 8);
#define PG8_SA(b, h) (((b) * 2 + (h)) * HTB)
#define PG8_SB(b, h) ((4 + (b) * 2 + (h)) * HTB)
#define PG8_STAGE(bufoff, gbase, voff) do { _Pragma("unroll") for (int _i = 0; _i < 2; ++_i) \
        __builtin_amdgcn_global_load_lds((const unsigned*)((const char*)(gbase) + (voff)[_i]), (PG8_LAS unsigned*)(lds + (bufoff) + ldsw + _i * 8192), 16, 0, 0); } while (0)
#define PG8_LDA(dst, b, h) do { _Pragma("unroll") for (int m = 0; m < 4; ++m) _Pragma("unroll") for (int k = 0; k < 2; ++k) dst[m][k] = *(const PG8_LAS bf16x8*)(lds + PG8_SA(b, h) + aoff + m * 2048 + k * 1024); } while (0)
#define PG8_LDB(dst, b, h) do { _Pragma("unroll") for (int n = 0; n < 2; ++n) _Pragma("unroll") for (int k = 0; k < 2; ++k) dst[n][k] = *(const PG8_LAS bf16x8*)(lds + PG8_SB(b, h) + boff + n * 2048 + k * 1024); } while (0)
#define PG8_MMA(ai, bj, At, Bt) do { __builtin_amdgcn_s_setprio(1); _Pragma("unroll") for (int m = 0; m < 4; ++m) _Pragma("unroll") for (int n = 0; n < 2; ++n) _Pragma("unroll") for (int k = 0; k < 2; ++k) \
        acc[ai][bj][m][n] = __builtin_amdgcn_mfma_f32_16x16x32_bf16(Bt[n][k], At[m][k], acc[ai][bj][m][n], 0, 0, 0); __builtin_amdgcn_s_setprio(0); } while (0)
#define PG8_WAIT_V(n) asm volatile("s_waitcnt vmcnt(" #n ")" ::: "memory")
#define PG8_WAIT_L(n) asm volatile("s_waitcnt lgkmcnt(" #n ")" ::: "memory")
#define PG8_BAR __builtin_amdgcn_s_barrier()
#define PG8_SCHED __builtin_amdgcn_sched_barrier(0)
    Unit cur, nxt; int ui = 0;
    if (!S.next(0, cur)) return;
    f32x4 acc[2][2][4][2];
#pragma unroll
    for (int a = 0; a < 2; ++a)
#pragma unroll
        for (int b = 0; b < 2; ++b)
#pragma unroll
            for (int m = 0; m < 4; ++m)
#pragma unroll
                for (int n = 0; n < 2; ++n) acc[a][b][m][n] = (f32x4){0.f, 0.f, 0.f, 0.f};
    bf16x8 At[4][2], B0[2][2], B1[2][2];
    const char* cA = (const char*)g.A + (size_t)cur.pm * tstep; const char* cB = (const char*)g.Bt + (size_t)cur.pn * tstep;
    S.a_ready(cur);
    if constexpr (SP2) {
        PG8_STAGE(PG8_SB(0, 0), cB, voffB); PG8_STAGE(PG8_SB(0, 1), cB + hstep, voffB); PG8_STAGE(PG8_SA(0, 0), cA, voffA); PG8_STAGE(PG8_SA(0, 1), cA + hstep, voffA);
        if (wr == 1) PG8_BAR;
        PG8_WAIT_V(2); PG8_BAR;
        PG8_STAGE(PG8_SB(1, 0), cB + kstep, voffB); PG8_STAGE(PG8_SA(1, 0), cA + kstep, voffA); PG8_STAGE(PG8_SB(1, 1), cB + hstep + kstep, voffB);
        PG8_WAIT_V(6); PG8_BAR;
    } else {
        PG8_STAGE(PG8_SB(0, 0), cB, voffB); PG8_STAGE(PG8_SA(0, 0), cA, voffA); PG8_STAGE(PG8_SB(0, 1), cB + hstep, voffB); PG8_STAGE(PG8_SA(0, 1), cA + hstep, voffA);
        if (wr == 1) PG8_BAR;
        PG8_WAIT_V(4); PG8_BAR;
        PG8_STAGE(PG8_SB(1, 0), cB + kstep, voffB); PG8_STAGE(PG8_SA(1, 0), cA + kstep, voffA); PG8_STAGE(PG8_SB(1, 1), cB + hstep + kstep, voffB);
        PG8_WAIT_V(6); PG8_BAR;
    }
    for (;;) {
        const bool has_next = S.next(ui + 1, nxt);
        const char* nA = has_next ? (const char*)g.A + (size_t)nxt.pm * tstep : cA; const char* nB = has_next ? (const char*)g.Bt + (size_t)nxt.pn * tstep : cB;
        for (int t = 0; t < nt; t += 2) {
            const bool last = (t == nt - 2);
            const char* a1 = cA + (size_t)(t + 1) * kstep;
            const char* a2 = last ? nA : cA + (size_t)(t + 2) * kstep; const char* b2 = last ? nB : cB + (size_t)(t + 2) * kstep;
            const char* a3 = a2 + kstep; const char* b3 = b2 + kstep;
            if (last && has_next) S.a_ready(nxt);
            if constexpr (SP2) {
            PG8_LDB(B0, 0, 0); PG8_LDB(B1, 0, 1); PG8_SCHED; PG8_LDA(At, 0, 0); PG8_STAGE(PG8_SA(1, 1), a1 + hstep, voffA);
            PG8_WAIT_V(8); PG8_WAIT_L(0); PG8_BAR; PG8_MMA(0, 0, At, B0); PG8_MMA(0, 1, At, B1); PG8_BAR; PG8_SCHED;
            PG8_LDA(At, 0, 1); PG8_STAGE(PG8_SB(0, 0), b2, voffB); PG8_STAGE(PG8_SB(0, 1), b2 + hstep, voffB); PG8_STAGE(PG8_SA(0, 0), a2, voffA);
            PG8_WAIT_V(8); PG8_WAIT_L(0); PG8_BAR; PG8_MMA(1, 0, At, B0); PG8_MMA(1, 1, At, B1); PG8_BAR; PG8_SCHED;
            PG8_LDB(B0, 1, 0); PG8_LDB(B1, 1, 1); PG8_SCHED; PG8_LDA(At, 1, 0); PG8_STAGE(PG8_SA(0, 1), a2 + hstep, voffA);
            PG8_WAIT_V(8); PG8_WAIT_L(0); PG8_BAR; PG8_MMA(0, 0, At, B0); PG8_MMA(0, 1, At, B1); PG8_BAR; PG8_SCHED;
            PG8_LDA(At, 1, 1); PG8_STAGE(PG8_SB(1, 0), b3, voffB); PG8_STAGE(PG8_SB(1, 1), b3 + hstep, voffB); PG8_STAGE(PG8_SA(1, 0), a3, voffA);
            PG8_WAIT_V(8); PG8_WAIT_L(0); PG8_BAR; PG8_MMA(1, 0, At, B0); PG8_MMA(1, 1, At, B1); PG8_BAR; PG8_SCHED;
            } else {
            PG8_LDB(B0, 0, 0); PG8_SCHED; PG8_LDA(At, 0, 0); PG8_STAGE(PG8_SA(1, 1), a1 + hstep, voffA);
            PG8_WAIT_L(8); PG8_BAR; PG8_WAIT_L(0); PG8_MMA(0, 0, At, B0); PG8_BAR; PG8_SCHED;
            PG8_LDB(B1, 0, 1); PG8_STAGE(PG8_SB(0, 0), b2, voffB);
            PG8_BAR; PG8_WAIT_L(0); PG8_MMA(0, 1, At, B1); PG8_BAR;
            PG8_LDA(At, 0, 1); PG8_STAGE(PG8_SA(0, 0), a2, voffA);
            PG8_BAR; PG8_WAIT_L(0); PG8_MMA(1, 0, At, B0); PG8_BAR; PG8_SCHED;
            PG8_STAGE(PG8_SB(0, 1), b2 + hstep, voffB);
            PG8_WAIT_V(6); PG8_BAR; PG8_MMA(1, 1, At, B1); PG8_BAR;
            PG8_LDB(B0, 1, 0); PG8_SCHED; PG8_LDA(At, 1, 0); PG8_STAGE(PG8_SA(0, 1), a2 + hstep, voffA);
            PG8_WAIT_L(8); PG8_BAR; PG8_WAIT_L(0); PG8_MMA(0, 0, At, B0); PG8_BAR; PG8_SCHED;
            PG8_LDB(B1, 1, 1); PG8_STAGE(PG8_SB(1, 0), b3, voffB);
            PG8_BAR; PG8_WAIT_L(0); PG8_MMA(0, 1, At, B1); PG8_BAR;
            PG8_LDA(At, 1, 1); PG8_STAGE(PG8_SA(1, 0), a3, voffA);
            PG8_BAR; PG8_WAIT_L(0); PG8_MMA(1, 0, At, B0); PG8_BAR; PG8_SCHED;
            PG8_STAGE(PG8_SB(1, 1), b3 + hstep, voffB);
            PG8_WAIT_V(6); PG8_BAR; PG8_MMA(1, 1, At, B1); PG8_BAR;
            }
        }
        if constexpr (ALIGN_EPI) { if (wr == 0) PG8_BAR; }
        if constexpr (!Epi::AFTER_DRAIN) { E(acc, cur, wr, wc, fr, fq); S.done(cur); }
        if (!has_next) break;
#pragma unroll
        for (int a = 0; a < 2; ++a)
#pragma unroll
            for (int b = 0; b < 2; ++b)
#pragma unroll
                for (int m = 0; m < 4; ++m)
#pragma unroll
                    for (int n = 0; n < 2; ++n) acc[a][b][m][n] = (f32x4){0.f, 0.f, 0.f, 0.f};
        cur = nxt; cA = nA; cB = nB; ++ui;
        if constexpr (ALIGN_EPI) { if (wr == 1) PG8_BAR; }
    }
    PG8_WAIT_V(0);
    if constexpr (!ALIGN_EPI) { if (wr == 0) PG8_BAR; }
    PG8_BAR;
    if constexpr (Epi::AFTER_DRAIN) { E.fused(acc, cur, wr, wc, fr, fq, lds, wid, lane); S.done(cur); }
#undef PG8_SA
#undef PG8_SB
#undef PG8_STAGE
#undef PG8_LDA
#undef PG8_LDB
#undef PG8_MMA
#undef PG8_WAIT_V
#undef PG8_WAIT_L
#undef PG8_BAR
#undef PG8_SCHED
}
}
#define LAS __attribute__((address_space(3)))
#define XB_TMO      128
#define XB_XCNT(j)  (256  + 64 * (j))
#define XB_XSUB(j)  (1280 + 64 * (j))
#define XB_XGEN(j)  (2304 + 64 * (j))
#define XB_TOP      3328
#define XB_TOPGEN   3392
#define XCD_BAR_WORDS 3456
#define XB_SPIN_CAP (1u << 18)

__device__ __forceinline__ unsigned xb_ld(unsigned* p)              { return __hip_atomic_load(p, __ATOMIC_RELAXED, __HIP_MEMORY_SCOPE_AGENT); }
__device__ __forceinline__ unsigned xb_add(unsigned* p, unsigned v) { return __hip_atomic_fetch_add(p, v, __ATOMIC_RELAXED, __HIP_MEMORY_SCOPE_AGENT); }
__device__ __forceinline__ unsigned xb_xcc_id() { return (unsigned)__builtin_amdgcn_s_getreg((3 << 11) | 20) & 0xFu; }
#define XB_SPIN(cond, bar) do { unsigned _sp = 0; while (cond) { __builtin_amdgcn_s_sleep(1); \
    if ((++_sp & 255u) == 0u) { if (xb_ld(&(bar)[XB_TMO])) break; if (_sp > XB_SPIN_CAP) { atomicAdd(&(bar)[XB_TMO], 1u); break; } } } } while (0)

struct XcdBarrier {
    unsigned* bar; unsigned x;
    volatile LAS unsigned* st;
};

__device__ __forceinline__ XcdBarrier xcd_barrier_post(unsigned* bar, volatile LAS unsigned* st) {
    XcdBarrier b; b.bar = bar; b.x = xb_xcc_id(); b.st = st;
    if (threadIdx.x == 0) (void)xb_add(&bar[XB_XCNT(b.x)], 1u);
    return b;
}
__device__ __forceinline__ void xcd_barrier_complete(unsigned* bar, unsigned x, unsigned& nloc, unsigned& nx) {
    const unsigned G = gridDim.x * gridDim.y * gridDim.z;
    unsigned sum, cnt, mine, sp = 0u;
    for (;;) {
        sum = 0u; cnt = 0u; mine = 0u;
#pragma unroll
        for (unsigned j = 0; j < 16; ++j) { const unsigned c = xb_ld(&bar[XB_XCNT(j)]); sum += c; cnt += (c > 0u) ? 1u : 0u; mine = (j == x) ? c : mine; }
        if (sum == G) break;
        __builtin_amdgcn_s_sleep(1);
        if ((++sp & 255u) == 0u) { if (xb_ld(&bar[XB_TMO])) break; if (sp > XB_SPIN_CAP) { atomicAdd(&bar[XB_TMO], 1u); break; } }
    }
    nloc = mine > 0u ? mine : 1u; nx = cnt > 0u ? cnt : 1u;
}

__device__ __forceinline__ void xcd_barrier(const XcdBarrier& b) {
    asm volatile("s_waitcnt vmcnt(0)" ::: "memory");
    __syncthreads();
    if (threadIdx.x == 0) {
        unsigned* bar = b.bar;
        __builtin_amdgcn_s_waitcnt(0);
        unsigned nloc = b.st[0], nx = b.st[1];
        if (nloc == 0u) { xcd_barrier_complete(bar, b.x, nloc, nx); b.st[0] = nloc; b.st[1] = nx; }
        const unsigned old = xb_add(&bar[XB_XSUB(b.x)], 1u);
        const unsigned gen = old / nloc;
        if (old + 1u == (gen + 1u) * nloc) {
            __builtin_amdgcn_fence(__ATOMIC_RELEASE, "agent");
            asm volatile("s_waitcnt vmcnt(0)" ::: "memory");
            const unsigned og = xb_add(&bar[XB_TOP], 1u);
            const unsigned tg = og / nx;
            if (og + 1u == (tg + 1u) * nx) xb_add(&bar[XB_TOPGEN], 1u);
            else XB_SPIN(xb_ld(&bar[XB_TOPGEN]) == tg, bar);
            __builtin_amdgcn_fence(__ATOMIC_ACQUIRE, "agent");
            xb_add(&bar[XB_XGEN(b.x)], 1u);
            asm volatile("s_waitcnt vmcnt(0)" ::: "memory");
        } else {
            XB_SPIN(xb_ld(&bar[XB_XGEN(b.x)]) == gen, bar);
            __builtin_amdgcn_fence(__ATOMIC_ACQUIRE, "agent");
            asm volatile("s_waitcnt vmcnt(0)" ::: "memory");
        }
    }
    __syncthreads();
}

#ifndef MK_DUP
#define MK_DUP 0
#endif
#ifndef MK_PER_PHASE
#define MK_PER_PHASE 0
#endif
#define LAS __attribute__((address_space(3)))
typedef unsigned short bf16;
typedef short bf16x8 __attribute__((ext_vector_type(8)));
typedef short s16x4 __attribute__((ext_vector_type(4)));
typedef float f32x4 __attribute__((ext_vector_type(4)));
typedef float f32x16 __attribute__((ext_vector_type(16)));
typedef unsigned u32x4 __attribute__((ext_vector_type(4)));
typedef unsigned u32x2 __attribute__((ext_vector_type(2)));
typedef float f32x2m __attribute__((ext_vector_type(2)));
#define MFMA32(a, b, c) __builtin_amdgcn_mfma_f32_32x32x16_bf16((a), (b), (c), 0, 0, 0)
#define LDS_WAIT() asm volatile("s_waitcnt lgkmcnt(0)" ::: "memory")

constexpr int NFR = 16384, MT = 16640, D = 1024, FF = 2816, NGU = 5632, NIN = 4608, PBW = 4352, DIN = 4368;
constexpr int NPH = 12;
constexpr int LDS_BYTES = 147456, MISC_OFF = 131072 + 320, CTL_BYTES = 32768;
constexpr size_t MiB = 1u << 20;
constexpr size_t WS_WGU1 = 0, WS_WD1 = 11 * MiB, WS_ST = 0  , WS_WGU2 = 17 * MiB, WS_WD2 = 28 * MiB, WS_WIN = 34 * MiB,
                 WS_WA = 43 * MiB, WS_WB = 44 * MiB, WS_WOUT = 45 * MiB, WS_SSP = 47 * MiB, WS_GLOW = 49 * MiB, WS_DEC = 51 * MiB, WS_CTL = 51 * MiB + MiB / 2  , WS_MSSP = 51 * MiB + 3 * MiB / 4  ,
                 WS_HB = 52 * MiB, WS_YA = 52 * MiB, WS_YB = 68 * MiB  , WS_R1 = 85 * MiB  ,
                 WS_KV = 223 * MiB + MiB / 2  , WS_END = 256 * MiB;
static_assert(WS_ST + (size_t)1032 * 8192 * 2 <= WS_WGU2 && WS_R1 + (size_t)MT * PBW * 2 <= WS_KV && WS_KV + (size_t)1032 * 8192 * 4 <= WS_END && WS_HB + (size_t)MT * D * 2 <= WS_R1, "d_ws map");

struct Params { const float* in[20]; float* out; unsigned char* ws; int ph_lo, ph_hi, cg_sync, pad; };

__device__ __forceinline__ int crow(int reg, int h) { return (reg & 3) + 8 * (reg >> 2) + 4 * h; }
__device__ __forceinline__ unsigned f2bf(float f) { unsigned u = __float_as_uint(f); return (u + 0x7fffu + ((u >> 16) & 1u)) >> 16; }
__device__ __forceinline__ unsigned pk2(float lo, float hi) { return f2bf(lo) | (f2bf(hi) << 16); }
__device__ __forceinline__ float wave_sum(float v) {
#pragma unroll
    for (int o = 1; o < 64; o <<= 1) v += __shfl_xor(v, o);
    return v;
}
__device__ __forceinline__ bf16x8 pack8(float a, float b, float c, float d, float e, float f, float g, float h) {
    u32x4 p; p.x = pk2(a, b); p.y = pk2(c, d); p.z = pk2(e, f); p.w = pk2(g, h); return __builtin_bit_cast(bf16x8, p);
}

__device__ __forceinline__ void tr_item64(const float* W, int K, int N, int k0, int sn0, int nvalid, const float* gain, bf16* WT, int drow0, LAS unsigned* T, int lane) {
    const int n4 = (lane & 15) * 4, kp = lane >> 4; const bool cv = n4 < nvalid;
    f32x4 a[8], b[8];
#pragma unroll
    for (int st = 0; st < 8; ++st) { const float* p = W + (size_t)(k0 + 8 * st + 2 * kp) * N + sn0 + n4;
        a[st] = cv ? *(const f32x4*)p : (f32x4){0.f, 0.f, 0.f, 0.f}; b[st] = cv ? *(const f32x4*)(p + N) : (f32x4){0.f, 0.f, 0.f, 0.f}; }
#pragma unroll
    for (int st = 0; st < 8; ++st) { const int k = k0 + 8 * st + 2 * kp; float g0 = 1.f, g1 = 1.f; if (gain) { g0 = gain[k]; g1 = gain[k + 1]; }
        LAS unsigned* t = T + n4 * 33 + 4 * st + kp;
        t[0] = pk2(a[st][0] * g0, b[st][0] * g1); t[33] = pk2(a[st][1] * g0, b[st][1] * g1); t[66] = pk2(a[st][2] * g0, b[st][2] * g1); t[99] = pk2(a[st][3] * g0, b[st][3] * g1); }
    LDS_WAIT(); asm volatile("" ::: "memory");
    const int c = lane & 7;
#pragma unroll
    for (int q = 0; q < 8; ++q) { const int n = (lane >> 3) + 8 * q; const LAS unsigned* t = T + n * 33 + 4 * c;
        u32x4 o; o.x = t[0]; o.y = t[1]; o.z = t[2]; o.w = t[3];
        *(u32x4*)(WT + (size_t)(drow0 + n) * K + k0 + 8 * c) = o; }
    LDS_WAIT(); asm volatile("" ::: "memory");
}
constexpr int I_GU = 16 * 44, I_DN = 44 * 16, I_IN = 16 * 72, I_BR = 8 * 16, I_WO = 16 * 16;
constexpr int IT_R1 = 2 * I_GU, IT_R2 = IT_R1 + I_DN + I_IN + 2 * I_BR + I_WO, IT_END = IT_R2 + 2 * I_GU + I_DN;
__device__ __forceinline__ void prep_item(const Params& P, int it, LAS unsigned* scr, int lane) {
    unsigned char* ws = P.ws; int r = it;
    if (r < 2 * I_GU) { const int up = r >= I_GU; r -= up * I_GU; const int kb = r / 44, n0 = (r % 44) * 64;
        tr_item64(up ? P.in[4] : P.in[3], D, FF, kb * 64, n0, 64, P.in[2], (bf16*)(ws + WS_WGU1), (n0 >> 7) * 256 + (n0 & 127) + up * 128, scr, lane); return; }
    r -= 2 * I_GU;
    if (r < I_DN) { tr_item64(P.in[5], FF, D, (r / 16) * 64, (r % 16) * 64, 64, nullptr, (bf16*)(ws + WS_WD1), (r % 16) * 64, scr, lane); return; }
    r -= I_DN;
    if (r < I_IN) { const int kb = r / 72, d0 = (r % 72) * 64; int sn0, nv;
        if (d0 < 2304) { sn0 = d0; nv = 64; } else if (d0 < 4352) { sn0 = d0 + 16; nv = 64; } else if (d0 == 4352) { sn0 = 2304; nv = 16; } else { sn0 = 0; nv = 0; }
        tr_item64(P.in[7], D, DIN, kb * 64, sn0, nv, P.in[6], (bf16*)(ws + WS_WIN), d0, scr, lane); return; }
    r -= I_IN;
    if (r < I_BR) { tr_item64(P.in[12], 512, D, (r / 16) * 64, (r % 16) * 64, 64, nullptr, (bf16*)(ws + WS_WA), (r % 16) * 64, scr, lane); return; }
    r -= I_BR;
    if (r < I_BR) { tr_item64(P.in[13], 512, D, (r / 16) * 64, (r % 16) * 64, 64, nullptr, (bf16*)(ws + WS_WB), (r % 16) * 64, scr, lane); return; }
    r -= I_BR;
    if (r < I_WO) { tr_item64(P.in[14], D, D, (r / 16) * 64, (r % 16) * 64, 64, nullptr, (bf16*)(ws + WS_WOUT), (r % 16) * 64, scr, lane); return; }
    r -= I_WO;
    if (r < 2 * I_GU) { const int up = r >= I_GU; r -= up * I_GU; const int kb = r / 44, n0 = (r % 44) * 64;
        tr_item64(up ? P.in[17] : P.in[16], D, FF, kb * 64, n0, 64, P.in[15], (bf16*)(ws + WS_WGU2), (n0 >> 7) * 256 + (n0 & 127) + up * 128, scr, lane); return; }
    r -= 2 * I_GU;
    tr_item64(P.in[18], FF, D, (r / 16) * 64, (r % 16) * 64, 64, nullptr, (bf16*)(ws + WS_WD2), (r % 16) * 64, scr, lane);
}
__device__ __forceinline__ void prep_in_slack(const Params& P, LAS unsigned char* lds, int lo, int hi, int nwg, int wave, int lane, int G) {
    const int rem = nwg % G, c = (int)blockIdx.x; int ns, si;
    if (rem == 0) { ns = G; si = c; } else { if (c < rem) return; ns = G - rem; si = c - rem; }
    LAS unsigned* scr = (LAS unsigned*)(lds + wave * 16384);
    for (int it = lo + wave * ns + si; it < hi; it += ns * 8) prep_item(P, it, scr, lane);
}
__device__ __forceinline__ void p0_prep(const Params& P, LAS unsigned char* lds, int wave, int lane, int G) {
    unsigned char* ws = P.ws;
    LAS unsigned* scr = (LAS unsigned*)(lds + wave * 16384);
    const int gw = blockIdx.x * 8 + wave, NGW = G * 8;
    for (int it = gw; it < IT_R1; it += NGW) prep_item(P, it, scr, lane);
    bf16* hb = (bf16*)(ws + WS_HB); float* ssp = (float*)(ws + WS_SSP);
    for (int m0 = gw; m0 < MT; m0 += 2 * NGW) {
        f32x4 v[2][4]; float s[2];
#pragma unroll
        for (int u = 0; u < 2; ++u) { const int m = m0 + u * NGW;
            const float* src = m < NFR ? P.in[0] + (size_t)m * D : (m < NFR + 16 ? P.in[1] + (size_t)(m - NFR) * D : nullptr);
#pragma unroll
            for (int j = 0; j < 4; ++j) v[u][j] = src ? ((const f32x4*)src)[lane + 64 * j] : (f32x4){0.f, 0.f, 0.f, 0.f}; }
#pragma unroll
        for (int u = 0; u < 2; ++u) { const int m = m0 + u * NGW; s[u] = 0.f;
#pragma unroll
            for (int j = 0; j < 4; ++j) s[u] += (v[u][j][0] * v[u][j][0] + v[u][j][1] * v[u][j][1]) + (v[u][j][2] * v[u][j][2] + v[u][j][3] * v[u][j][3]);
            s[u] = wave_sum(s[u]);
            if (m < MT) {
                u32x2* o8 = (u32x2*)(hb + (size_t)m * D) + lane;
#pragma unroll
                for (int j = 0; j < 4; ++j) { u32x2 w; w.x = pk2(v[u][j][0], v[u][j][1]); w.y = pk2(v[u][j][2], v[u][j][3]); o8[64 * j] = w; }
                if (lane < 16) ssp[(size_t)m * 16 + lane] = lane == 0 ? s[u] : 0.f; } }
    }
}

typedef float f32x4m __attribute__((ext_vector_type(4)));
#define MFMA16(a, b, c) __builtin_amdgcn_mfma_f32_16x16x32_bf16((a), (b), (c), 0, 0, 0)
__device__ __forceinline__ f32x4m meta_mm(const bf16* A, const bf16* Brow, int K, int k0, int nsteps, int lane) {
    const int r = lane & 15, quad = lane >> 4;
    const bf16* ap = A + (size_t)r * K + k0 + quad * 8; const bf16* bp = Brow + (size_t)r * K + k0 + quad * 8;
    f32x4m acc = (f32x4m){0.f, 0.f, 0.f, 0.f};
#pragma unroll 8
    for (int st = 0; st < nsteps; ++st) { const bf16x8 a = *(const bf16x8*)(ap + 32 * st), b = *(const bf16x8*)(bp + 32 * st); acc = MFMA16(a, b, acc); }
    return acc;
}
__device__ __forceinline__ float sum16(const float* p) { const f32x4 a = *(const f32x4*)p, b = *(const f32x4*)(p + 4), c = *(const f32x4*)(p + 8), d = *(const f32x4*)(p + 12);
    return (((a[0] + a[1]) + (a[2] + a[3])) + ((b[0] + b[1]) + (b[2] + b[3]))) + (((c[0] + c[1]) + (c[2] + c[3])) + ((d[0] + d[1]) + (d[2] + d[3]))); }
__device__ __forceinline__ void meta_p1(const Params& P, int wave, int lane, int G) {
    const int mt = (G - 1 - (int)blockIdx.x) * 8 + wave; if (mt >= 176) return;
    unsigned char* ws = P.ws; const bf16* hbm = (const bf16*)(ws + WS_HB) + (size_t)NFR * D; const bf16* W = (const bf16*)(ws + WS_WGU1);
    bf16* actm = (bf16*)(ws + WS_R1) + (size_t)NFR * FF; const float* ssp = (const float*)(ws + WS_SSP) + (size_t)NFR * 16;
    const int c0 = 16 * mt, grow = (c0 >> 7) * 256 + (c0 & 127), r = lane & 15, quad = lane >> 4;
    const f32x4m g = meta_mm(hbm, W + (size_t)grow * D, D, 0, 32, lane), u = meta_mm(hbm, W + (size_t)(grow + 128) * D, D, 0, 32, lane);
#pragma unroll
    for (int j = 0; j < 4; ++j) { const int row = quad * 4 + j; const float rs = __builtin_amdgcn_rsqf(sum16(ssp + row * 16) * (1.0f / 1024.0f) + 1e-6f);
        const float gv = g[j] * rs, uv = u[j] * rs; actm[(size_t)row * FF + c0 + r] = (bf16)f2bf(gv * pg8::sigm(gv) * uv); }
}
__device__ __forceinline__ void meta_p2(const Params& P, LAS unsigned char* L, int wave, int lane) {
    if (blockIdx.x >= 32) return;
    unsigned char* ws = P.ws; const bf16* actm = (const bf16*)(ws + WS_R1) + (size_t)NFR * FF; const bf16* W = (const bf16*)(ws + WS_WD1);
    bf16* hbm = (bf16*)(ws + WS_HB) + (size_t)NFR * D; float* mssp = (float*)(ws + WS_MSSP);
    const int ctl = wave >> 2, ks = wave & 3, ct = blockIdx.x * 2 + ctl, r = lane & 15, quad = lane >> 4;
    const f32x4m acc = meta_mm(actm, W + (size_t)(ct * 16) * FF, FF, ks * 704, 22, lane);
    LAS f32x4m* red = (LAS f32x4m*)L;
    red[(ctl * 4 + ks) * 64 + lane] = acc;
    __syncthreads();
    if (ks == 0) {
        const f32x4m t = (red[(ctl * 4) * 64 + lane] + red[(ctl * 4 + 1) * 64 + lane]) + (red[(ctl * 4 + 2) * 64 + lane] + red[(ctl * 4 + 3) * 64 + lane]);
#pragma unroll
        for (int j = 0; j < 4; ++j) { const int row = quad * 4 + j, col = ct * 16 + r; const float v = P.in[1][(size_t)row * D + col] + 0.5f * t[j];
            hbm[(size_t)row * D + col] = (bf16)f2bf(v);
            float sq = v * v; sq += __shfl_xor(sq, 1); sq += __shfl_xor(sq, 2); sq += __shfl_xor(sq, 4); sq += __shfl_xor(sq, 8);
            if (r == 0) mssp[row * 64 + ct] = sq; }
    }
    __syncthreads();
}
__device__ __forceinline__ void meta_p3(const Params& P, int wave, int lane, int G) {
    const int mt = (G - 1 - (int)blockIdx.x) * 8 + wave; if (mt >= 65) return;
    unsigned char* ws = P.ws; const bf16* hbm = (const bf16*)(ws + WS_HB) + (size_t)NFR * D; const bf16* W = (const bf16*)(ws + WS_WIN);
    bf16* PBm = (bf16*)(ws + WS_R1) + (size_t)NFR * PBW; float* glowm = (float*)(ws + WS_GLOW) + (size_t)NFR * 16; const float* mssp = (const float*)(ws + WS_MSSP);
    const int col0 = mt < 16 ? 512 + 16 * mt : (mt < 32 ? 1024 + 16 * (mt - 16) : (mt < 64 ? 1280 + 16 * (mt - 32) : 4352)), r = lane & 15, quad = lane >> 4;
    const f32x4m acc = meta_mm(hbm, W + (size_t)col0 * D, D, 0, 32, lane);
#pragma unroll
    for (int j = 0; j < 4; ++j) { const int row = quad * 4 + j;
        const f32x4 p = *(const f32x4*)(mssp + row * 64 + 4 * r); float sq = (p[0] + p[1]) + (p[2] + p[3]);
        sq += __shfl_xor(sq, 1); sq += __shfl_xor(sq, 2); sq += __shfl_xor(sq, 4); sq += __shfl_xor(sq, 8);
        const float v = acc[j] * __builtin_amdgcn_rsqf(sq * (1.0f / 1024.0f) + 1e-6f);
        if (mt < 64) PBm[(size_t)row * PBW + col0 + r] = (bf16)f2bf(v); else glowm[row * 16 + r] = v; }
}

constexpr int A_KS = 0, A_VT = 32256, A_VTS = 228;
__device__ __forceinline__ void attn_item(const Params& P, LAS unsigned char* L, int item, int tid, int wave, int lane) {
    const bf16* PB = (const bf16*)(P.ws + WS_R1); bf16* ya = (bf16*)P.out;
    const int kvh = item & 1, c = (item >> 1) & 127, b = item >> 8;
#pragma unroll
    for (int i = 0; i < 4; ++i) {
        const int key = (tid & 63) + 64 * i;
        if (key < 224) {
            bool valid; int row;
            if (key < 16) { valid = true; row = NFR + key; }
            else if (key < 32) { valid = false; row = 0; }
            else { const int ki = c * 64 - 128 + (key - 32); valid = ki >= 0; row = b * 8192 + (valid ? ki : 0); }
            u32x4 kk = (u32x4){0u, 0u, 0u, 0u}, vv = (u32x4){0u, 0u, 0u, 0u};
            if (valid) { const bf16* p = PB + (size_t)row * PBW + 512 + kvh * 64 + wave * 8; kk = *(const u32x4*)p; vv = *(const u32x4*)(p + 128); }
            *(LAS u32x4*)(L + A_KS + key * 144 + wave * 16) = kk;
            LAS unsigned short* vt = (LAS unsigned short*)(L + A_VT) + (wave * 8) * A_VTS + key;
            vt[0 * A_VTS] = (unsigned short)(vv.x & 0xffffu); vt[1 * A_VTS] = (unsigned short)(vv.x >> 16);
            vt[2 * A_VTS] = (unsigned short)(vv.y & 0xffffu); vt[3 * A_VTS] = (unsigned short)(vv.y >> 16);
            vt[4 * A_VTS] = (unsigned short)(vv.z & 0xffffu); vt[5 * A_VTS] = (unsigned short)(vv.z >> 16);
            vt[6 * A_VTS] = (unsigned short)(vv.w & 0xffffu); vt[7 * A_VTS] = (unsigned short)(vv.w >> 16);
        }
    }
    __syncthreads();
    const int g = wave >> 1, pos0 = (wave & 1) * 32, h = kvh * 4 + g, r = lane & 31, hi = lane >> 5;
    const int qrow = b * 8192 + c * 64 + pos0 + r;
    bf16x8 q[4];
#pragma unroll
    for (int s = 0; s < 4; ++s) q[s] = *(const bf16x8*)(PB + (size_t)qrow * PBW + h * 64 + 16 * s + 8 * hi);
    f32x16 S[7];
#pragma unroll
    for (int kt = 0; kt < 7; ++kt) {
#pragma unroll
        for (int i = 0; i < 16; ++i) S[kt][i] = 0.f;
#pragma unroll
        for (int s = 0; s < 4; ++s) { const bf16x8 a = *(const LAS bf16x8*)(L + A_KS + (kt * 32 + r) * 144 + (16 * s + 8 * hi) * 2); S[kt] = MFMA32(a, q[s], S[kt]); }
        asm volatile("" ::: "memory");
    }
    __builtin_amdgcn_sched_barrier(0);
    const float slope = exp2f(-(float)(h + 1)), sink = P.in[11][h];
    const float NEG = -__builtin_inff();
    float m = sink;
#pragma unroll
    for (int i = 0; i < 16; ++i) { if (i >= 8) S[0][i] = NEG; else m = fmaxf(m, S[0][i]); }
    int oz; asm volatile("v_mov_b32 %0, 0" : "=v"(oz));
    const int smin = 128 - 64 * c, pq = pos0 + r + 128 + oz;
#pragma unroll
    for (int kt = 1; kt < 7; ++kt) {
#pragma unroll
        for (int i = 0; i < 16; ++i) { const int s = (kt - 1) * 32 + crow(i, hi); float v = S[kt][i] - slope * fabsf((float)(pq - s)); if (s < smin) v = NEG; S[kt][i] = v; m = fmaxf(m, v); }
        __builtin_amdgcn_sched_barrier(0);
    }
    m = fmaxf(m, __shfl_xor(m, 32));
    __builtin_amdgcn_sched_barrier(0);
    float sum = 0.f; const float ml = m * 1.44269504f;
    bf16x8 pbv[7][2];
#pragma unroll
    for (int kt = 0; kt < 7; ++kt) {
#pragma unroll
        for (int i = 0; i < 16; ++i) { const float p = __builtin_amdgcn_exp2f(S[kt][i] * 1.44269504f - ml); S[kt][i] = p; sum += p; }
        pbv[kt][0] = pack8(S[kt][0], S[kt][1], S[kt][2], S[kt][3], S[kt][4], S[kt][5], S[kt][6], S[kt][7]);
        pbv[kt][1] = pack8(S[kt][8], S[kt][9], S[kt][10], S[kt][11], S[kt][12], S[kt][13], S[kt][14], S[kt][15]);
    }
    __builtin_amdgcn_sched_barrier(0);
    sum += __shfl_xor(sum, 32); sum += exp2f(sink * 1.44269504f - ml);
    const float inv = 1.0f / sum;
    f32x16 O[2];
#pragma unroll
    for (int i = 0; i < 16; ++i) { O[0][i] = 0.f; O[1][i] = 0.f; }
#pragma unroll
    for (int kt = 0; kt < 7; ++kt)
#pragma unroll
        for (int s2 = 0; s2 < 2; ++s2) {
            const bf16x8 pb = pbv[kt][s2];
#pragma unroll
            for (int dt = 0; dt < 2; ++dt) {
                const LAS unsigned char* vp = L + A_VT + ((dt * 32 + r) * A_VTS + kt * 32 + 16 * s2 + 4 * hi) * 2;
                const s16x4 lo = *(const LAS s16x4*)vp, h4 = *(const LAS s16x4*)(vp + 16);
                const bf16x8 va = __builtin_shufflevector(lo, h4, 0, 1, 2, 3, 4, 5, 6, 7);
                O[dt] = MFMA32(va, pb, O[dt]);
            }
            asm volatile("" ::: "memory");
        }
#pragma unroll
    for (int dt = 0; dt < 2; ++dt)
#pragma unroll
        for (int g4 = 0; g4 < 4; ++g4) {
            u32x2 w; w.x = pk2(O[dt][4 * g4] * inv, O[dt][4 * g4 + 1] * inv); w.y = pk2(O[dt][4 * g4 + 2] * inv, O[dt][4 * g4 + 3] * inv);
            *(u32x2*)(ya + (size_t)qrow * 512 + h * 64 + dt * 32 + 8 * g4 + 4 * hi) = w;
        }
    __syncthreads();
}

constexpr int G_QE = 0, G_KE = 9216, G_K2T = 18432, G_VT = 27648, G_ST = 46080, G_SEG = 64512, G_SS = 66560, G_GL = 67584;
template <bool KV> __device__ __forceinline__ void gla_prep(const Params& P, LAS unsigned char* L, int b, int h, int j, int tid) {
    const bf16* PB = (const bf16*)(P.ws + WS_R1); const float* glow = (const float*)(P.ws + WS_GLOW);
    const int d = tid & 63, seg = tid >> 6;
    const int posA = tid >> 3, sub = tid & 7; const bool vA = (j > 0) || (posA >= 48);
    const int rowA = vA ? (j == 0 ? NFR + posA - 48 : b * 8192 + (j - 1) * 64 + posA) : NFR;
    const f32x2m glv = *(const f32x2m*)(glow + (size_t)rowA * 16 + sub * 2);
    u32x4 qraw = (u32x4){0u, 0u, 0u, 0u}, kraw = qraw;
    if (vA) { const bf16* p = PB + (size_t)rowA * PBW + h * 64 + sub * 8; qraw = *(const u32x4*)(p + 768); kraw = *(const u32x4*)(p + 1024); }
    const int posC = tid & 63, dvg = tid >> 6; const bool vC = (j > 0) || (posC >= 48);
    const int rowC = vC ? (j == 0 ? NFR + posC - 48 : b * 8192 + (j - 1) * 64 + posC) : NFR;
    u32x4 va = (u32x4){0u, 0u, 0u, 0u}, vc = va;
    if (vC) { const bf16* p = PB + (size_t)rowC * PBW + 1280 + h * 128 + dvg * 16; va = *(const u32x4*)p; vc = *(const u32x4*)(p + 8); }
    u32x4 sa = (u32x4){0u, 0u, 0u, 0u}, sc = sa;
    if (!KV) { const bf16* sg = (const bf16*)(P.ws + WS_ST) + (size_t)((b * 4 + h) * 129 + j) * 8192 + (tid >> 2) * 64 + (tid & 3) * 16; sa = *(const u32x4*)sg; sc = *(const u32x4*)(sg + 8); }
    float gw[16];
#pragma unroll
    for (int r = 0; r < 16; ++r) gw[r] = P.in[8][r * 256 + h * 64 + d];
    const float bias = P.in[9][h * 64 + d];
    *(LAS f32x2m*)(L + G_GL + (posA * 16 + sub * 2) * 4) = glv;
    *(LAS u32x4*)(L + G_QE + (posA * 72 + sub * 8) * 2) = qraw; *(LAS u32x4*)(L + G_KE + (posA * 72 + sub * 8) * 2) = kraw;
    { LAS unsigned short* vt = (LAS unsigned short*)(L + G_VT) + (dvg * 16) * 72 + posC;
      vt[0 * 72] = (unsigned short)(va.x & 0xffffu); vt[1 * 72] = (unsigned short)(va.x >> 16); vt[2 * 72] = (unsigned short)(va.y & 0xffffu); vt[3 * 72] = (unsigned short)(va.y >> 16);
      vt[4 * 72] = (unsigned short)(va.z & 0xffffu); vt[5 * 72] = (unsigned short)(va.z >> 16); vt[6 * 72] = (unsigned short)(va.w & 0xffffu); vt[7 * 72] = (unsigned short)(va.w >> 16);
      vt[8 * 72] = (unsigned short)(vc.x & 0xffffu); vt[9 * 72] = (unsigned short)(vc.x >> 16); vt[10 * 72] = (unsigned short)(vc.y & 0xffffu); vt[11 * 72] = (unsigned short)(vc.y >> 16);
      vt[12 * 72] = (unsigned short)(vc.z & 0xffffu); vt[13 * 72] = (unsigned short)(vc.z >> 16); vt[14 * 72] = (unsigned short)(vc.w & 0xffffu); vt[15 * 72] = (unsigned short)(vc.w >> 16); }
    if (!KV) { const int dv = tid >> 2, part = tid & 3; *(LAS u32x4*)(L + G_ST + (dv * 72 + part * 16) * 2) = sa; *(LAS u32x4*)(L + G_ST + (dv * 72 + part * 16 + 8) * 2) = sc; }
    __syncthreads();
    LAS unsigned short* QE = (LAS unsigned short*)(L + G_QE); LAS unsigned short* KE = (LAS unsigned short*)(L + G_KE);
    float cs[8], qv[8], kv[8]; float run = 0.f;
#pragma unroll
    for (int p = 0; p < 8; ++p) {
        const int pos = seg * 8 + p; const bool valid = (j > 0) || (pos >= 48);
        const LAS f32x4* gl = (const LAS f32x4*)(L + G_GL + pos * 64);
        const f32x4 g0 = gl[0], g1 = gl[1], g2 = gl[2], g3 = gl[3];
        float z = bias;
#pragma unroll
        for (int e = 0; e < 4; ++e) { z += g0[e] * gw[e]; z += g1[e] * gw[4 + e]; z += g2[e] * gw[8 + e]; z += g3[e] * gw[12 + e]; }
        float la = (fminf(z, 0.f) - __logf(1.0f + __expf(-fabsf(z)))) * 0.0625f;
        if (!valid) la = 0.f;
        run += la; cs[p] = run;
        qv[p] = pg8::bf2f(QE[pos * 72 + d]); kv[p] = pg8::bf2f(KE[pos * 72 + d]);
        if (p & 1) __builtin_amdgcn_sched_barrier(0);
    }
    LAS float* SEG = (LAS float*)(L + G_SEG);
    SEG[seg * 64 + d] = run;
    __syncthreads();
    float off = 0.f, tot = 0.f;
#pragma unroll
    for (int s = 0; s < 8; ++s) { const float v = SEG[s * 64 + d]; tot += v; if (s < seg) off += v; }
    float k2[8];
#pragma unroll
    for (int p = 0; p < 8; ++p) {
        const int pos = seg * 8 + p; const float bb = off + cs[p];
        QE[pos * 72 + d] = (unsigned short)f2bf(qv[p] * __expf(bb));
        KE[pos * 72 + d] = (unsigned short)f2bf(kv[p] * __expf(-bb));
        k2[p] = kv[p] * __expf(tot - bb);
    }
    if (KV) {
        *(LAS bf16x8*)(L + G_K2T + (d * 72 + seg * 8) * 2) = pack8(k2[0], k2[1], k2[2], k2[3], k2[4], k2[5], k2[6], k2[7]);
        if (seg == 0) ((float*)(P.ws + WS_DEC))[(size_t)((b * 4 + h) * 129 + j) * 64 + d] = __expf(tot);
    }
}
__device__ __forceinline__ void gla_kv_item(const Params& P, LAS unsigned char* L, int item, int tid, int wave, int lane) {
    const int j = item % 129, bh = item / 129, h = bh & 3, b = bh >> 2;
    gla_prep<true>(P, L, b, h, j, tid);
    __syncthreads();
    const int dvt = wave >> 1, dkt = wave & 1, r = lane & 31, hi = lane >> 5;
    f32x16 acc;
#pragma unroll
    for (int i = 0; i < 16; ++i) acc[i] = 0.f;
#pragma unroll
    for (int s = 0; s < 4; ++s) {
        const bf16x8 a = *(const LAS bf16x8*)(L + G_VT + ((dvt * 32 + r) * 72 + 16 * s + 8 * hi) * 2);
        const bf16x8 bb = *(const LAS bf16x8*)(L + G_K2T + ((dkt * 32 + r) * 72 + 16 * s + 8 * hi) * 2);
        acc = MFMA32(a, bb, acc);
    }
    float* kvg = (float*)(P.ws + WS_KV) + (size_t)item * 8192;
#pragma unroll
    for (int i = 0; i < 16; ++i) kvg[(dvt * 32 + crow(i, hi)) * 64 + dkt * 32 + r] = acc[i];
    __syncthreads();
}
__device__ __forceinline__ void gla_scan(const Params& P, int wave, int lane, int G) {
    const float* kvg = (const float*)(P.ws + WS_KV); const float* dec = (const float*)(P.ws + WS_DEC); bf16* st = (bf16*)(P.ws + WS_ST);
    for (int wv = wave * G + blockIdx.x; wv < 1024; wv += G * 8) {
        const int gidx = wv * 64 + lane, bh = gidx >> 13, e = gidx & 8191, dk = e & 63;
        const size_t base = (size_t)bh * 129;
        float S = 0.f;
        for (int j0 = 0; j0 < 128; j0 += 8) {
            float kvv[8], dd[8];
#pragma unroll
            for (int u = 0; u < 8; ++u) { kvv[u] = kvg[(base + j0 + u) * 8192 + e]; dd[u] = dec[(base + j0 + u) * 64 + dk]; }
#pragma unroll
            for (int u = 0; u < 8; ++u) { S = dd[u] * S + kvv[u]; st[(base + j0 + u + 1) * 8192 + e] = (bf16)f2bf(S); }
        }
    }
}
__device__ __forceinline__ void gla_out_item(const Params& P, LAS unsigned char* L, int item  , int tid, int wave, int lane) {
    const int j = (item & 127) + 1, bh = item >> 7, h = bh & 3, b = bh >> 2;
    const bf16* PB = (const bf16*)(P.ws + WS_R1); bf16* yb = (bf16*)P.out + (size_t)NFR * 512;
    gla_prep<false>(P, L, b, h, j, tid);
    __syncthreads();
    const int it = wave & 1, dvt = wave >> 1, r = lane & 31, hi = lane >> 5;
    bf16x8 qf[4];
#pragma unroll
    for (int s = 0; s < 4; ++s) qf[s] = *(const LAS bf16x8*)(L + G_QE + ((it * 32 + r) * 72 + 16 * s + 8 * hi) * 2);
    f32x16 o;
#pragma unroll
    for (int i = 0; i < 16; ++i) o[i] = 0.f;
#pragma unroll
    for (int jt = 0; jt < 2; ++jt) {
        if (jt <= it) {
            f32x16 at;
#pragma unroll
            for (int i = 0; i < 16; ++i) at[i] = 0.f;
#pragma unroll
            for (int s = 0; s < 4; ++s) { const bf16x8 a = *(const LAS bf16x8*)(L + G_KE + ((jt * 32 + r) * 72 + 16 * s + 8 * hi) * 2); at = MFMA32(a, qf[s], at); }
            if (jt == it) {
#pragma unroll
                for (int i = 0; i < 16; ++i) if (crow(i, hi) > r) at[i] = 0.f;
            }
#pragma unroll
            for (int s2 = 0; s2 < 2; ++s2) {
                const bf16x8 pb = pack8(at[8 * s2], at[8 * s2 + 1], at[8 * s2 + 2], at[8 * s2 + 3], at[8 * s2 + 4], at[8 * s2 + 5], at[8 * s2 + 6], at[8 * s2 + 7]);
                const LAS unsigned char* vp = L + G_VT + ((dvt * 32 + r) * 72 + jt * 32 + 16 * s2 + 4 * hi) * 2;
                const s16x4 lo = *(const LAS s16x4*)vp, h4 = *(const LAS s16x4*)(vp + 16);
                o = MFMA32(__builtin_shufflevector(lo, h4, 0, 1, 2, 3, 4, 5, 6, 7), pb, o);
            }
        }
    }
#pragma unroll
    for (int s = 0; s < 4; ++s) { const bf16x8 a = *(const LAS bf16x8*)(L + G_ST + ((dvt * 32 + r) * 72 + 16 * s + 8 * hi) * 2); o = MFMA32(a, qf[s], o); }
    float ss = 0.f;
#pragma unroll
    for (int i = 0; i < 16; ++i) ss += o[i] * o[i];
    ss += __shfl_xor(ss, 32);
    LAS float* SS = (LAS float*)(L + G_SS);
    if (hi == 0) SS[dvt * 64 + it * 32 + r] = ss;
    __syncthreads();
    const float tot = (SS[it * 32 + r] + SS[64 + it * 32 + r]) + (SS[128 + it * 32 + r] + SS[192 + it * 32 + r]);
    const float rstd = __builtin_amdgcn_rsqf(tot * (1.0f / 128.0f) + 1e-6f);
    const int row = b * 8192 + (j - 1) * 64 + it * 32 + r;
#pragma unroll
    for (int g4 = 0; g4 < 4; ++g4) {
        const int dv0 = dvt * 32 + 8 * g4 + 4 * hi;
        const f32x4 gn = *(const f32x4*)(P.in[10] + dv0);
        const u32x2 gr = *(const u32x2*)(PB + (size_t)row * PBW + 1792 + h * 128 + dv0);
        u32x2 w;
        w.x = pk2(o[4 * g4] * rstd * gn[0] * pg8::bflo(gr.x), o[4 * g4 + 1] * rstd * gn[1] * pg8::bfhi(gr.x));
        w.y = pk2(o[4 * g4 + 2] * rstd * gn[2] * pg8::bflo(gr.y), o[4 * g4 + 3] * rstd * gn[3] * pg8::bfhi(gr.y));
        *(u32x2*)(yb + (size_t)row * 512 + h * 128 + dv0) = w;
    }
    __syncthreads();
}

__global__ void __launch_bounds__(512, 2) mega_fwd(Params P) {
    extern __shared__ __attribute__((aligned(16))) unsigned char lds_raw[];
    LAS unsigned char* lds = (LAS unsigned char*)lds_raw;
    cg::grid_group grid = cg::this_grid();
    const int tid = threadIdx.x, lane = tid & 63, wave = __builtin_amdgcn_readfirstlane(tid >> 6), G = gridDim.x;
    unsigned char* ws = P.ws;
    const int lo = P.ph_lo, hi = P.ph_hi;
    if (tid < 32) ((LAS unsigned*)(lds + MISC_OFF))[tid] = 0u;
    __syncthreads();
    XcdBarrier bar = xcd_barrier_post((unsigned*)(ws + WS_CTL), (volatile LAS unsigned*)(lds + MISC_OFF) + 8);
#define IN(k) (lo <= (k) && (k) < hi)
#define GSYNC() do { if (P.cg_sync) grid.sync(); else xcd_barrier(bar); } while (0)
#define SEAM(k) do { if (IN(k) && IN((k) + 1)) GSYNC(); } while (0)
#define DUPQ(k) ((MK_DUP >> (k)) & 1)
    bf16* hb = (bf16*)(ws + WS_HB); float* ssp = (float*)(ws + WS_SSP); bf16* R1 = (bf16*)(ws + WS_R1);

    if (IN(0)) {
        p0_prep(P, lds, wave, lane, G);
#if (MK_DUP >> 0) & 1
        GSYNC();
        p0_prep(P, lds, wave, lane, G);
#endif
    }
    SEAM(0);
    if (IN(1)) {
        {
        meta_p1(P, wave, lane, G);
        pg8::Gemm g{hb, (const bf16*)(ws + WS_WGU1), NFR, NGU, D}; pg8::StaticOrder S; S.init(NFR, NGU, G, (int)blockIdx.x);
        pg8::EpiSwiglu E{R1, ssp};
        pg8::gemm_phase<pg8::EpiSwiglu, pg8::StaticOrder, true, true>(lds, g, S, E);
        prep_in_slack(P, lds, IT_R1, IT_R2, S.nwg, wave, lane, G);
    }
#if (MK_DUP >> 1) & 1
        GSYNC();
        {
        meta_p1(P, wave, lane, G);
        pg8::Gemm g{hb, (const bf16*)(ws + WS_WGU1), NFR, NGU, D}; pg8::StaticOrder S; S.init(NFR, NGU, G, (int)blockIdx.x);
        pg8::EpiSwiglu E{R1, ssp};
        pg8::gemm_phase<pg8::EpiSwiglu, pg8::StaticOrder, true, true>(lds, g, S, E);
    }
#endif
    }
    SEAM(1);
    if (IN(2)) {
        {
        meta_p2(P, lds, wave, lane);
        pg8::Gemm g{R1, (const bf16*)(ws + WS_WD1), NFR, D, FF}; pg8::StaticOrder S; S.init(NFR, D, G, (int)blockIdx.x);
        pg8::EpiResid<false> E{hb, nullptr, ssp, 0.5f};
        pg8::gemm_phase<pg8::EpiResid<false>, pg8::StaticOrder, true, true>(lds, g, S, E);
    }
#if (MK_DUP >> 2) & 1
        GSYNC();
        {
        meta_p2(P, lds, wave, lane);
        pg8::Gemm g{R1, (const bf16*)(ws + WS_WD1), NFR, D, FF}; pg8::StaticOrder S; S.init(NFR, D, G, (int)blockIdx.x);
        pg8::EpiResid<false> E{hb, nullptr, ssp, 0.5f};
        pg8::gemm_phase<pg8::EpiResid<false>, pg8::StaticOrder, true, true>(lds, g, S, E);
    }
#endif
    }
    SEAM(2);
    if (IN(3)) {
        {
        meta_p3(P, wave, lane, G);
        pg8::Gemm g{hb, (const bf16*)(ws + WS_WIN), NFR, NIN, D}; pg8::StaticOrder S; S.init(NFR, NIN, G, (int)blockIdx.x);
        pg8::EpiIn E{R1, (float*)(ws + WS_GLOW), ssp};
        pg8::gemm_phase<pg8::EpiIn, pg8::StaticOrder, true, true>(lds, g, S, E);
        prep_in_slack(P, lds, IT_R2, IT_END, S.nwg, wave, lane, G);
    }
#if (MK_DUP >> 3) & 1
        GSYNC();
        {
        meta_p3(P, wave, lane, G);
        pg8::Gemm g{hb, (const bf16*)(ws + WS_WIN), NFR, NIN, D}; pg8::StaticOrder S; S.init(NFR, NIN, G, (int)blockIdx.x);
        pg8::EpiIn E{R1, (float*)(ws + WS_GLOW), ssp};
        pg8::gemm_phase<pg8::EpiIn, pg8::StaticOrder, true, true>(lds, g, S, E);
        prep_in_slack(P, lds, IT_R2, IT_END, S.nwg, wave, lane, G);
    }
#endif
    }
    SEAM(3);
    if (IN(4)) {
        {
        for (int it = blockIdx.x; it < 512; it += G) attn_item(P, lds, it, tid, wave, lane);
#if defined(MK_DUPA)
        for (int it = blockIdx.x; it < 512; it += G) attn_item(P, lds, it, tid, wave, lane);
#endif
        for (int it = blockIdx.x; it < 1032; it += G) gla_kv_item(P, lds, it, tid, wave, lane);
    }
#if (MK_DUP >> 4) & 1
        GSYNC();
        {
        for (int it = blockIdx.x; it < 512; it += G) attn_item(P, lds, it, tid, wave, lane);
        for (int it = blockIdx.x; it < 1032; it += G) gla_kv_item(P, lds, it, tid, wave, lane);
    }
#endif
    }
    SEAM(4);
    if (IN(5)) {
        gla_scan(P, wave, lane, G);
#if (MK_DUP >> 5) & 1
        GSYNC();
        gla_scan(P, wave, lane, G);
#endif
    }
    SEAM(5);
    if (IN(6)) {
        { for (int it = blockIdx.x; it < 1024; it += G) gla_out_item(P, lds, it, tid, wave, lane); }
#if (MK_DUP >> 6) & 1
        GSYNC();
        { for (int it = blockIdx.x; it < 1024; it += G) gla_out_item(P, lds, it, tid, wave, lane); }
#endif
    }
    SEAM(6);
    if (IN(7)) {
        {
        bf16* mixed = (bf16*)(ws + WS_KV);
        { pg8::Gemm g{(const bf16*)P.out, (const bf16*)(ws + WS_WA), NFR, D, 512}; pg8::StaticOrder S; S.init(NFR, D, G, (int)blockIdx.x);
          pg8::EpiMix<false> E{R1 + 2304, mixed};
          pg8::gemm_phase<pg8::EpiMix<false>, pg8::StaticOrder, true, true>(lds, g, S, E); }
        { pg8::Gemm g{(const bf16*)P.out + (size_t)NFR * 512, (const bf16*)(ws + WS_WB), NFR, D, 512}; pg8::StaticOrder S; S.init(NFR, D, G, (int)blockIdx.x);
          pg8::EpiMix<true> E{R1 + 3328, mixed};
          pg8::gemm_phase<pg8::EpiMix<true>, pg8::StaticOrder, true, true>(lds, g, S, E); }
    }
#if (MK_DUP >> 7) & 1
        GSYNC();
        {
        bf16* mixed = (bf16*)(ws + WS_KV);
        { pg8::Gemm g{(const bf16*)P.out, (const bf16*)(ws + WS_WA), NFR, D, 512}; pg8::StaticOrder S; S.init(NFR, D, G, (int)blockIdx.x);
          pg8::EpiMix<false> E{R1 + 2304, mixed};
          pg8::gemm_phase<pg8::EpiMix<false>, pg8::StaticOrder, true, true>(lds, g, S, E); }
        { pg8::Gemm g{(const bf16*)P.out + (size_t)NFR * 512, (const bf16*)(ws + WS_WB), NFR, D, 512}; pg8::StaticOrder S; S.init(NFR, D, G, (int)blockIdx.x);
          pg8::EpiMix<true> E{R1 + 3328, mixed};
          pg8::gemm_phase<pg8::EpiMix<true>, pg8::StaticOrder, true, true>(lds, g, S, E); }
    }
#endif
    }
    SEAM(7);
    if (IN(8)) {
        {
        pg8::Gemm g{(const bf16*)(ws + WS_KV), (const bf16*)(ws + WS_WOUT), NFR, D, D}; pg8::StaticOrder S; S.init(NFR, D, G, (int)blockIdx.x);
        pg8::EpiResid<false> E{hb, nullptr, ssp, 1.0f};
        pg8::gemm_phase<pg8::EpiResid<false>, pg8::StaticOrder, true, true>(lds, g, S, E);
    }
#if (MK_DUP >> 8) & 1
        GSYNC();
        {
        pg8::Gemm g{(const bf16*)(ws + WS_KV), (const bf16*)(ws + WS_WOUT), NFR, D, D}; pg8::StaticOrder S; S.init(NFR, D, G, (int)blockIdx.x);
        pg8::EpiResid<false> E{hb, nullptr, ssp, 1.0f};
        pg8::gemm_phase<pg8::EpiResid<false>, pg8::StaticOrder, true, true>(lds, g, S, E);
    }
#endif
    }
    SEAM(8);
    if (IN(9)) {
        {
        pg8::Gemm g{hb, (const bf16*)(ws + WS_WGU2), NFR, NGU, D}; pg8::StaticOrder S; S.init(NFR, NGU, G, (int)blockIdx.x);
        pg8::EpiSwiglu E{R1, ssp};
        pg8::gemm_phase<pg8::EpiSwiglu, pg8::StaticOrder, true, true>(lds, g, S, E);
    }
#if (MK_DUP >> 9) & 1
        GSYNC();
        {
        pg8::Gemm g{hb, (const bf16*)(ws + WS_WGU2), NFR, NGU, D}; pg8::StaticOrder S; S.init(NFR, NGU, G, (int)blockIdx.x);
        pg8::EpiSwiglu E{R1, ssp};
        pg8::gemm_phase<pg8::EpiSwiglu, pg8::StaticOrder, true, true>(lds, g, S, E);
    }
#endif
    }
    SEAM(9);
    if (IN(10)) {
        {
        pg8::Gemm g{R1, (const bf16*)(ws + WS_WD2), NFR, D, FF}; pg8::StaticOrder S; S.init(NFR, D, G, (int)blockIdx.x);
        if (S.nwg == G) { pg8::EpiFinal E{hb, P.out, ssp, (unsigned*)(ws + WS_CTL) + 4096, P.in[19], 0.5f};
            pg8::gemm_phase<pg8::EpiFinal, pg8::StaticOrder, false, true>(lds, g, S, E); }
        else { pg8::EpiResid<true> E{hb, P.out, ssp, 0.5f};
            pg8::gemm_phase<pg8::EpiResid<true>, pg8::StaticOrder, true, true>(lds, g, S, E); }
    }
#if (MK_DUP >> 10) & 1
        GSYNC();
        {
        pg8::Gemm g{R1, (const bf16*)(ws + WS_WD2), NFR, D, FF}; pg8::StaticOrder S; S.init(NFR, D, G, (int)blockIdx.x);
        if (S.nwg == G) { pg8::EpiFinal E{hb, P.out, ssp, (unsigned*)(ws + WS_CTL) + 4096, P.in[19], 0.5f};
            pg8::gemm_phase<pg8::EpiFinal, pg8::StaticOrder, false, true>(lds, g, S, E); }
        else { pg8::EpiResid<true> E{hb, P.out, ssp, 0.5f};
            pg8::gemm_phase<pg8::EpiResid<true>, pg8::StaticOrder, true, true>(lds, g, S, E); }
    }
#endif
    }
    if (G != 256) SEAM(10);
    if (IN(11)) {
        {
        const int gw = blockIdx.x * 8 + wave, NGW = G * 8;
        for (int m = gw; m < (G == 256 ? 0 : NFR); m += NGW) {
            f32x4* rowp = (f32x4*)(P.out + (size_t)m * D) + lane;
            float s = ssp[(size_t)m * 16 + (lane & 15)];
            s += __shfl_xor(s, 1); s += __shfl_xor(s, 2); s += __shfl_xor(s, 4); s += __shfl_xor(s, 8);
            const float rs = __builtin_amdgcn_rsqf(s * (1.0f / 1024.0f) + 1e-6f);
#pragma unroll
            for (int j = 0; j < 4; ++j) { const f32x4 gn = ((const f32x4*)P.in[19])[lane + 64 * j]; f32x4 v = rowp[64 * j]; rowp[64 * j] = v * rs * gn; }
        }
    }
#if (MK_DUP >> 11) & 1
        GSYNC();
        {
        const int gw = blockIdx.x * 8 + wave, NGW = G * 8;
        for (int m = gw; m < (G == 256 ? 0 : NFR); m += NGW) {
            f32x4* rowp = (f32x4*)(P.out + (size_t)m * D) + lane;
            float s = ssp[(size_t)m * 16 + (lane & 15)];
            s += __shfl_xor(s, 1); s += __shfl_xor(s, 2); s += __shfl_xor(s, 4); s += __shfl_xor(s, 8);
            const float rs = __builtin_amdgcn_rsqf(s * (1.0f / 1024.0f) + 1e-6f);
#pragma unroll
            for (int j = 0; j < 4; ++j) { const f32x4 gn = ((const f32x4*)P.in[19])[lane + 64 * j]; f32x4 v = rowp[64 * j]; rowp[64 * j] = v * rs * gn; }
        }
    }
#endif
    }
#if defined(MK_XSYNC)
    for (int xs_ = 0; xs_ < MK_XSYNC; ++xs_) GSYNC();
#endif
#undef IN
#undef SEAM
}

extern "C" void kernel_launch(void* const* d_in, const int* in_sizes, int n_in, void* d_out, int out_size, void* d_ws, size_t ws_size, hipStream_t stream) {
    static int grid = 0;
    if (grid == 0) {
        if (n_in != 20 || out_size != NFR * D || ws_size < WS_END) { fprintf(stderr, "kernel_launch: unexpected shapes (n_in %d out %d ws %zu)\n", n_in, out_size, ws_size); grid = -1; return; }
        int dev = 0, cus = 0, per_cu = 0;
        hipGetDevice(&dev); hipDeviceGetAttribute(&cus, hipDeviceAttributeMultiprocessorCount, dev);
        if (hipFuncSetAttribute((const void*)mega_fwd, hipFuncAttributeMaxDynamicSharedMemorySize, LDS_BYTES) != hipSuccess) { fprintf(stderr, "kernel_launch: hipFuncSetAttribute failed\n"); grid = -1; return; }
        if (hipOccupancyMaxActiveBlocksPerMultiprocessor(&per_cu, (const void*)mega_fwd, 512, LDS_BYTES) != hipSuccess || per_cu < 1) { fprintf(stderr, "kernel_launch: occupancy query failed (%d)\n", per_cu); (void)hipGetLastError(); grid = -1; return; }
        grid = cus * per_cu;
        fprintf(stderr, "kernel_launch: %d CUs x %d blocks -> grid %d\n", cus, per_cu, grid);
    }
    if (grid < 0) return;
    Params p{};
    for (int i = 0; i < 20; ++i) p.in[i] = (const float*)d_in[i];
    p.out = (float*)d_out; p.ws = (unsigned char*)d_ws; p.cg_sync = 0; p.pad = 0;
    if (hipMemsetAsync((char*)d_ws + WS_CTL, 0, CTL_BYTES, stream) != hipSuccess) { fprintf(stderr, "kernel_launch: hipMemsetAsync failed\n"); return; }
#if MK_PER_PHASE
    for (int ph = 0; ph < NPH; ++ph) { p.ph_lo = ph; p.ph_hi = ph + 1; hipLaunchKernelGGL(mega_fwd, dim3(grid), dim3(512), LDS_BYTES, stream, p); }
#else
    p.ph_lo = 0; p.ph_hi = NPH;
    void* args[] = {&p};
    hipError_t e = hipLaunchCooperativeKernel((const void*)mega_fwd, dim3(grid), dim3(512), args, LDS_BYTES, stream);
    if (e != hipSuccess) fprintf(stderr, "kernel_launch: cooperative launch failed: %s (grid %d)\n", hipGetErrorString(e), grid);
#endif
}
```

```cpp
#include <hip/hip_runtime.h>
#include <hip/hip_cooperative_groups.h>
#include <cstdio>
#include <cstdint>
namespace cg = cooperative_groups;
namespace pg8 {
#define PG8_LAS __attribute__((address_space(3)))
typedef unsigned short bf16_t;
typedef short bf16x8 __attribute__((ext_vector_type(8)));
typedef float f32x4 __attribute__((ext_vector_type(4)));
typedef unsigned u32x4 __attribute__((ext_vector_type(4)));
constexpr int BM = 256, BK = 64, HALF = 128, HTB = HALF * BK * 2  , STAGE_BYTES = 8 * HTB, NXCD = 8, WGM = 8;

__host__ __device__ __forceinline__ int lds_byte(int r, int c) { const int st = (r >> 4) * 2 + (c >> 5), rr = r & 15, cc = c & 31, ob = rr * 64 + cc * 2; return st * 1024 + (ob ^ (((ob >> 9) & 1) << 5)); }
__host__ __device__ __forceinline__ void stage_rc(int b, int& R, int& C) { const int st = b / 1024, sb = b % 1024, swz = sb ^ (((sb >> 9) & 1) << 5); R = (st >> 1) * 16 + swz / 64; C = (st & 1) * 32 + (swz % 64) / 2; }
__host__ __device__ __forceinline__ int perm32(int rho) { const int n = rho >> 4, i = rho & 15; return 8 * (i >> 2) + 4 * n + (i & 3); }

struct Unit { int pm, pn; };
struct Gemm { const bf16_t* A; const bf16_t* Bt; int M, N, K; };

struct StaticOrder {
    int nM, nN, nwg, G, c, wgm;
    __host__ __device__ void init(int M, int N, int G_, int c_, int wgm_ = 4) { nM = M / BM; nN = N / BM; nwg = nM * nN; G = G_; c = c_; wgm = wgm_; }
    __host__ __device__ __forceinline__ bool next(int i, Unit& u) const {
        const long L = (long)i * G + c; if (L >= nwg) return false;
        int wgid = (int)L; { const int q = nwg / NXCD, r = nwg % NXCD, xcd = wgid % NXCD, off = wgid / NXCD; wgid = (xcd < r ? xcd * (q + 1) : r * (q + 1) + (xcd - r) * q) + off; }
        const int nig = wgm * nN, gid = wgid / nig, fm = gid * wgm, gsz = (nM - fm) < wgm ? (nM - fm) : wgm;
        u.pm = fm + ((wgid % nig) % gsz); u.pn = (wgid % nig) / gsz; return true;
    }
    __device__ __forceinline__ void a_ready(const Unit&) const {}
    __device__ __forceinline__ void done(const Unit&) const {}
};

__device__ __forceinline__ unsigned cvt_pk_bf16(float lo, float hi) { unsigned r; asm volatile("v_cvt_pk_bf16_f32 %0, %1, %2" : "=v"(r) : "v"(lo), "v"(hi)); return r; }
typedef float f32x2 __attribute__((ext_vector_type(2)));
constexpr int XD = 1024, XFF = 2816, XPBW = 4352, XNFR = 16384;
__device__ __forceinline__ float row_rstd(const float* ssp, int row, int fq) {
    const f32x4 p = *(const f32x4*)(ssp + (size_t)row * 16 + 4 * fq);
    float s = (p[0] + p[1]) + (p[2] + p[3]);
    s += __shfl_xor(s, 16); s += __shfl_xor(s, 32);
    return __builtin_amdgcn_rsqf(s * (1.0f / 1024.0f) + 1e-6f);
}
__device__ __forceinline__ float sigm(float x) { return __builtin_amdgcn_rcpf(1.0f + __expf(-x)); }
__device__ __forceinline__ float bf2f(unsigned short b) { return __uint_as_float((unsigned)b << 16); }
__device__ __forceinline__ float bflo(unsigned w) { return __uint_as_float(w << 16); }
__device__ __forceinline__ float bfhi(unsigned w) { return __uint_as_float(w & 0xffff0000u); }

struct EpiSwiglu {
    static constexpr bool PERM = true, AFTER_DRAIN = false;
    bf16_t* O; const float* ssp;
    __device__ __forceinline__ void operator()(const f32x4 (&acc)[2][2][4][2], const Unit& u, int wr, int wc, int fr, int fq) const {
        const int row0 = u.pm * BM + wr * 64 + fr, col0 = u.pn * HALF + wc * 32 + 8 * fq;
        float rsv[2][4];
#pragma unroll
        for (int ai = 0; ai < 2; ++ai)
#pragma unroll
            for (int m = 0; m < 4; ++m) rsv[ai][m] = row_rstd(ssp, row0 + ai * HALF + m * 16, fq);
#pragma unroll
        for (int ai = 0; ai < 2; ++ai)
#pragma unroll
            for (int m = 0; m < 4; ++m) {
                const int row = row0 + ai * HALF + m * 16; const float rs = rsv[ai][m], rsn = rs * -1.44269504f, rs2 = rs * rs;
                const f32x4 ga = acc[ai][0][m][0], gb = acc[ai][0][m][1];
                const f32x4 p0 = ga * acc[ai][1][m][0] * rs2, p1 = gb * acc[ai][1][m][1] * rs2, t0 = ga * rsn, t1 = gb * rsn;
                float o0[4], o1[4];
#pragma unroll
                for (int j = 0; j < 4; ++j) { o0[j] = p0[j] * __builtin_amdgcn_rcpf(1.0f + __builtin_amdgcn_exp2f(t0[j])); o1[j] = p1[j] * __builtin_amdgcn_rcpf(1.0f + __builtin_amdgcn_exp2f(t1[j])); }
                u32x4 w;
                w.x = cvt_pk_bf16(o0[0], o0[1]); w.y = cvt_pk_bf16(o0[2], o0[3]); w.z = cvt_pk_bf16(o1[0], o1[1]); w.w = cvt_pk_bf16(o1[2], o1[3]);
                *(u32x4*)(O + (size_t)row * XFF + col0) = w;
            }
    }
};

template <bool FOUT> struct EpiResid {
    static constexpr bool PERM = false, AFTER_DRAIN = false;
    bf16_t* hb; float* out; float* ssp; float scale;
    __device__ __forceinline__ void operator()(const f32x4 (&acc)[2][2][4][2], const Unit& u, int wr, int wc, int fr, int fq) const {
        typedef unsigned u32x2v __attribute__((ext_vector_type(2)));
        const int row0 = u.pm * BM + wr * 64 + fr, col0 = u.pn * BM + wc * 32 + 4 * fq;
#pragma unroll
        for (int ai = 0; ai < 2; ++ai)
#pragma unroll
            for (int m = 0; m < 4; ++m) {
                const int row = row0 + ai * HALF + m * 16;
                float sq = 0.f;
#pragma unroll
                for (int bj = 0; bj < 2; ++bj)
#pragma unroll
                    for (int n = 0; n < 2; ++n) {
                        const int c = col0 + bj * HALF + n * 16;
                        const u32x2v b = *(const u32x2v*)(hb + (size_t)row * XD + c);
                        const f32x4 v = (f32x4){bflo(b.x), bfhi(b.x), bflo(b.y), bfhi(b.y)} + acc[ai][bj][m][n] * scale;
                        sq += (v[0] * v[0] + v[1] * v[1]) + (v[2] * v[2] + v[3] * v[3]);
                        if (FOUT) *(f32x4*)(out + (size_t)row * XD + c) = v;
                        else { u32x2v w; w.x = cvt_pk_bf16(v[0], v[1]); w.y = cvt_pk_bf16(v[2], v[3]); *(u32x2v*)(hb + (size_t)row * XD + c) = w; }
                    }
                sq += __shfl_xor(sq, 16); sq += __shfl_xor(sq, 32);
                if (fq == 0) ssp[(size_t)row * 16 + u.pn * 4 + wc] = sq;
            }
    }
};
struct EpiFinal {
    static constexpr bool PERM = false, AFTER_DRAIN = true;
    const bf16_t* hb; float* out; float* ssp; unsigned* cnt; const float* gain; float scale;
    __device__ __forceinline__ void operator()(const f32x4 (&)[2][2][4][2], const Unit&, int, int, int, int) const {}
    __device__ __forceinline__ void fused(f32x4 (&acc)[2][2][4][2], const Unit& u, int wr, int wc, int fr, int fq, PG8_LAS unsigned char*, int, int lane) const {
        typedef unsigned u32x2v __attribute__((ext_vector_type(2)));
        const int row0 = u.pm * BM + wr * 64 + fr, col0 = u.pn * BM + wc * 32 + 4 * fq;
#pragma unroll
        for (int ai = 0; ai < 2; ++ai)
#pragma unroll
            for (int m = 0; m < 4; ++m) {
                const int row = row0 + ai * HALF + m * 16;
                float sq = 0.f;
#pragma unroll
                for (int bj = 0; bj < 2; ++bj)
#pragma unroll
                    for (int n = 0; n < 2; ++n) {
                        const u32x2v b = *(const u32x2v*)(hb + (size_t)row * XD + col0 + bj * HALF + n * 16);
                        const f32x4 v = (f32x4){bflo(b.x), bfhi(b.x), bflo(b.y), bfhi(b.y)} + acc[ai][bj][m][n] * scale;
                        sq += (v[0] * v[0] + v[1] * v[1]) + (v[2] * v[2] + v[3] * v[3]);
                        acc[ai][bj][m][n] = v;
                    }
                sq += __shfl_xor(sq, 16); sq += __shfl_xor(sq, 32);
                if (fq == 0) __hip_atomic_store(ssp + (size_t)row * 16 + u.pn * 4 + wc, sq, __ATOMIC_RELAXED, __HIP_MEMORY_SCOPE_AGENT);
            }
        asm volatile("s_waitcnt vmcnt(0)" ::: "memory");
        unsigned* c = cnt + 64 * u.pm;
        if (lane == 0) __hip_atomic_fetch_add(c, 1u, __ATOMIC_RELAXED, __HIP_MEMORY_SCOPE_AGENT);
        for (unsigned sp = 0; sp < (1u << 20); ++sp) {
            if ((unsigned)__builtin_amdgcn_readfirstlane((int)__hip_atomic_load(c, __ATOMIC_RELAXED, __HIP_MEMORY_SCOPE_AGENT)) >= 32u) break;
            __builtin_amdgcn_s_sleep(2);
        }
        __builtin_amdgcn_fence(__ATOMIC_ACQUIRE, "agent");
        f32x4 gn[2][2];
#pragma unroll
        for (int bj = 0; bj < 2; ++bj)
#pragma unroll
            for (int n = 0; n < 2; ++n) gn[bj][n] = *(const f32x4*)(gain + col0 + bj * HALF + n * 16);
#pragma unroll
        for (int ai = 0; ai < 2; ++ai)
#pragma unroll
            for (int m = 0; m < 4; ++m) {
                const int row = row0 + ai * HALF + m * 16;
                const float* sp4 = ssp + (size_t)row * 16 + 4 * fq;
                float s = (__hip_atomic_load(sp4, __ATOMIC_RELAXED, __HIP_MEMORY_SCOPE_AGENT) + __hip_atomic_load(sp4 + 1, __ATOMIC_RELAXED, __HIP_MEMORY_SCOPE_AGENT))
                        + (__hip_atomic_load(sp4 + 2, __ATOMIC_RELAXED, __HIP_MEMORY_SCOPE_AGENT) + __hip_atomic_load(sp4 + 3, __ATOMIC_RELAXED, __HIP_MEMORY_SCOPE_AGENT));
                s += __shfl_xor(s, 16); s += __shfl_xor(s, 32);
                const float rs = __builtin_amdgcn_rsqf(s * (1.0f / 1024.0f) + 1e-6f);
#pragma unroll
                for (int bj = 0; bj < 2; ++bj)
#pragma unroll
                    for (int n = 0; n < 2; ++n) __builtin_nontemporal_store(acc[ai][bj][m][n] * rs * gn[bj][n], (f32x4*)(out + (size_t)row * XD + col0 + bj * HALF + n * 16));
            }
    }
};

struct EpiIn {
    static constexpr bool PERM = true, AFTER_DRAIN = false;
    bf16_t* PB; float* glow; const float* ssp;
    __device__ __forceinline__ void operator()(const f32x4 (&acc)[2][2][4][2], const Unit& u, int wr, int wc, int fr, int fq) const {
        const int row0 = u.pm * BM + wr * 64 + fr, tile = u.pn;
        if (tile == 17) {
            if (wc == 0 && fq < 2) {
#pragma unroll
                for (int ai = 0; ai < 2; ++ai)
#pragma unroll
                    for (int m = 0; m < 4; ++m) {
                        const int row = row0 + ai * HALF + m * 16;
                        const f32x4 p = *(const f32x4*)(ssp + (size_t)row * 16), q = *(const f32x4*)(ssp + (size_t)row * 16 + 4), r = *(const f32x4*)(ssp + (size_t)row * 16 + 8), t = *(const f32x4*)(ssp + (size_t)row * 16 + 12);
                        const float s = (((p[0] + p[1]) + (p[2] + p[3])) + ((q[0] + q[1]) + (q[2] + q[3]))) + (((r[0] + r[1]) + (r[2] + r[3])) + ((t[0] + t[1]) + (t[2] + t[3])));
                        const float rs = __builtin_amdgcn_rsqf(s * (1.0f / 1024.0f) + 1e-6f);
                        *(f32x4*)(glow + (size_t)row * 16 + 8 * fq) = acc[ai][0][m][0] * rs;
                        *(f32x4*)(glow + (size_t)row * 16 + 8 * fq + 4) = acc[ai][0][m][1] * rs;
                    }
            }
            return;
        }
        const int mode = (tile <= 1 || tile == 3) ? 1 : (tile == 7 || tile == 8) ? 2 : (tile >= 9 ? 3 : 0);
        const int col0 = tile * BM + wc * 32 + 8 * fq;
        float rsv[2][4];
#pragma unroll
        for (int ai = 0; ai < 2; ++ai)
#pragma unroll
            for (int m = 0; m < 4; ++m) rsv[ai][m] = row_rstd(ssp, row0 + ai * HALF + m * 16, fq);
#pragma unroll
        for (int ai = 0; ai < 2; ++ai)
#pragma unroll
            for (int m = 0; m < 4; ++m) {
                const int row = row0 + ai * HALF + m * 16; const float rs = rsv[ai][m];
#pragma unroll
                for (int bj = 0; bj < 2; ++bj) {
                    const f32x4 a0 = acc[ai][bj][m][0], a1 = acc[ai][bj][m][1];
                    const float rsn = rs * -1.44269504f;
                    f32x4 v0, v1;
                    if (mode == 1) { v0 = a0 * (rs * 0.125f); v1 = a1 * (rs * 0.125f); }
                    else if (mode == 2) { const f32x4 t0 = a0 * rsn, t1 = a1 * rsn; v0 = a0 * rs; v1 = a1 * rs;
#pragma unroll
                        for (int j = 0; j < 4; ++j) { v0[j] = v0[j] * __builtin_amdgcn_rcpf(1.0f + __builtin_amdgcn_exp2f(t0[j])); v1[j] = v1[j] * __builtin_amdgcn_rcpf(1.0f + __builtin_amdgcn_exp2f(t1[j])); } }
                    else if (mode == 0) { v0 = a0 * rs; v1 = a1 * rs; }
                    else {
                        typedef unsigned u32x2v __attribute__((ext_vector_type(2)));
                        unsigned q[8];
                        const f32x4 t0 = a0 * rsn, t1 = a1 * rsn;
#pragma unroll
                        for (int j = 0; j < 4; ++j) { q[j] = (unsigned)(255.0f * __builtin_amdgcn_rcpf(1.0f + __builtin_amdgcn_exp2f(t0[j])) + 0.5f); q[4 + j] = (unsigned)(255.0f * __builtin_amdgcn_rcpf(1.0f + __builtin_amdgcn_exp2f(t1[j])) + 0.5f); }
                        u32x2v w8; w8.x = q[0] | (q[1] << 8) | (q[2] << 16) | (q[3] << 24); w8.y = q[4] | (q[5] << 8) | (q[6] << 16) | (q[7] << 24);
                        *(u32x2v*)((unsigned char*)(PB + (size_t)row * XPBW) + 4608 + (tile - 9) * BM + bj * HALF + wc * 32 + 8 * fq) = w8;
                        continue; }
                    u32x4 w; w.x = cvt_pk_bf16(v0[0], v0[1]); w.y = cvt_pk_bf16(v0[2], v0[3]); w.z = cvt_pk_bf16(v1[0], v1[1]); w.w = cvt_pk_bf16(v1[2], v1[3]);
                    *(u32x4*)(PB + (size_t)row * XPBW + col0 + bj * HALF) = w;
                }
            }
    }
};

template <bool ADD> struct EpiMix {
    static constexpr bool PERM = true, AFTER_DRAIN = false;
    const unsigned char* gate; bf16_t* mixed;
    __device__ __forceinline__ void operator()(const f32x4 (&acc)[2][2][4][2], const Unit& u, int wr, int wc, int fr, int fq) const {
        const int row0 = u.pm * BM + wr * 64 + fr, col0 = u.pn * BM + wc * 32 + 8 * fq;
#pragma unroll
        for (int ai = 0; ai < 2; ++ai)
#pragma unroll
            for (int m = 0; m < 4; ++m) {
                const int row = row0 + ai * HALF + m * 16;
#pragma unroll
                for (int bj = 0; bj < 2; ++bj) {
                    const int c = col0 + bj * HALF;
                    typedef unsigned u32x2v __attribute__((ext_vector_type(2)));
                    const u32x2v g = *(const u32x2v*)(gate + (size_t)row * (XPBW * 2) + c);
                    const f32x4 a0 = acc[ai][bj][m][0] * (1.0f / 255.0f), a1 = acc[ai][bj][m][1] * (1.0f / 255.0f);
                    float v[8] = {(float)(g.x & 0xffu) * a0[0], (float)((g.x >> 8) & 0xffu) * a0[1], (float)((g.x >> 16) & 0xffu) * a0[2], (float)(g.x >> 24) * a0[3],
                                  (float)(g.y & 0xffu) * a1[0], (float)((g.y >> 8) & 0xffu) * a1[1], (float)((g.y >> 16) & 0xffu) * a1[2], (float)(g.y >> 24) * a1[3]};
                    if (ADD) { const u32x4 o = *(const u32x4*)(mixed + (size_t)row * XD + c);
                        v[0] += bflo(o.x); v[1] += bfhi(o.x); v[2] += bflo(o.y); v[3] += bfhi(o.y); v[4] += bflo(o.z); v[5] += bfhi(o.z); v[6] += bflo(o.w); v[7] += bfhi(o.w); }
                    u32x4 w; w.x = cvt_pk_bf16(v[0], v[1]); w.y = cvt_pk_bf16(v[2], v[3]); w.z = cvt_pk_bf16(v[4], v[5]); w.w = cvt_pk_bf16(v[6], v[7]);
                    *(u32x4*)(mixed + (size_t)row * XD + c) = w;
                }
            }
    }
};


template <class Epi, class Sched, bool ALIGN_EPI = false, bool SP2 = false>
__device__ __forceinline__ void gemm_phase(PG8_LAS unsigned char* lds, const Gemm g, const Sched& S, const Epi& E) {
    const int tid = threadIdx.x, wid = __builtin_amdgcn_readfirstlane(tid >> 6), lane = tid & 63, wr = wid >> 2, wc = wid & 3, fr = lane & 15, fq = lane >> 4;
    const int K = g.K, nt = K / BK;
    unsigned voffA[2], voffB[2];
#pragma unroll
    for (int i = 0; i < 2; ++i) { int R, C; stage_rc(tid * 16 + i * 8192, R, C); const int Rb = Epi::PERM ? ((R & ~31) + perm32(R & 31)) : R;
        voffA[i] = (unsigned)(R * K + C) * 2u; voffB[i] = (unsigned)(Rb * K + C) * 2u; }
    const size_t kstep = (size_t)(BK * 2);
    const size_t hstep = (size_t)HALF * K * 2;
    const size_t tstep = 2 * hstep;
    const unsigned ldsw = (unsigned)wid * 1024u;
    const int aoff = lds_byte(wr * 64 + fr, fq * 8), boff = lds_byte(wc * 32 + fr, fq * 8);
#define PG8_SA(b, h) (((b) * 2 + (h)) * HTB)
#define PG8_SB(b, h) ((4 + (b) * 2 + (h)) * HTB)
#define PG8_STAGE(bufoff, gbase, voff) do { _Pragma("unroll") for (int _i = 0; _i < 2; ++_i) \
        __builtin_amdgcn_global_load_lds((const unsigned*)((const char*)(gbase) + (voff)[_i]), (PG8_LAS unsigned*)(lds + (bufoff) + ldsw + _i * 8192), 16, 0, 0); } while (0)
#define PG8_LDA(dst, b, h) do { _Pragma("unroll") for (int m = 0; m < 4; ++m) _Pragma("unroll") for (int k = 0; k < 2; ++k) dst[m][k] = *(const PG8_LAS bf16x8*)(lds + PG8_SA(b, h) + aoff + m * 2048 + k * 1024); } while (0)
#define PG8_LDB(dst, b, h) do { _Pragma("unroll") for (int n = 0; n < 2; ++n) _Pragma("unroll") for (int k = 0; k < 2; ++k) dst[n][k] = *(const PG8_LAS bf16x8*)(lds + PG8_SB(b, h) + boff + n * 2048 + k * 1024); } while (0)
#define PG8_MMA(ai, bj, At, Bt) do { __builtin_amdgcn_s_setprio(1); _Pragma("unroll") for (int m = 0; m < 4; ++m) _Pragma("unroll") for (int n = 0; n < 2; ++n) _Pragma("unroll") for (int k = 0; k < 2; ++k) \
        acc[ai][bj][m][n] = __builtin_amdgcn_mfma_f32_16x16x32_bf16(Bt[n][k], At[m][k], acc[ai][bj][m][n], 0, 0, 0); __builtin_amdgcn_s_setprio(0); } while (0)
#define PG8_WAIT_V(n) asm volatile("s_waitcnt vmcnt(" #n ")" ::: "memory")
#define PG8_WAIT_L(n) asm volatile("s_waitcnt lgkmcnt(" #n ")" ::: "memory")
#define PG8_BAR __builtin_amdgcn_s_barrier()
#define PG8_SCHED __builtin_amdgcn_sched_barrier(0)
    Unit cur, nxt; int ui = 0;
    if (!S.next(0, cur)) return;
    f32x4 acc[2][2][4][2];
#pragma unroll
    for (int a = 0; a < 2; ++a)
#pragma unroll
        for (int b = 0; b < 2; ++b)
#pragma unroll
            for (int m = 0; m < 4; ++m)
#pragma unroll
                for (int n = 0; n < 2; ++n) acc[a][b][m][n] = (f32x4){0.f, 0.f, 0.f, 0.f};
    bf16x8 At[4][2], B0[2][2], B1[2][2];
    const char* cA = (const char*)g.A + (size_t)cur.pm * tstep; const char* cB = (const char*)g.Bt + (size_t)cur.pn * tstep;
    S.a_ready(cur);
    if constexpr (SP2) {
        PG8_STAGE(PG8_SB(0, 0), cB, voffB); PG8_STAGE(PG8_SB(0, 1), cB + hstep, voffB); PG8_STAGE(PG8_SA(0, 0), cA, voffA); PG8_STAGE(PG8_SA(0, 1), cA + hstep, voffA);
        if (wr == 1) PG8_BAR;
        PG8_WAIT_V(2); PG8_BAR;
        PG8_STAGE(PG8_SB(1, 0), cB + kstep, voffB); PG8_STAGE(PG8_SA(1, 0), cA + kstep, voffA); PG8_STAGE(PG8_SB(1, 1), cB + hstep + kstep, voffB);
        PG8_WAIT_V(6); PG8_BAR;
    } else {
        PG8_STAGE(PG8_SB(0, 0), cB, voffB); PG8_STAGE(PG8_SA(0, 0), cA, voffA); PG8_STAGE(PG8_SB(0, 1), cB + hstep, voffB); PG8_STAGE(PG8_SA(0, 1), cA + hstep, voffA);
        if (wr == 1) PG8_BAR;
        PG8_WAIT_V(4); PG8_BAR;
        PG8_STAGE(PG8_SB(1, 0), cB + kstep, voffB); PG8_STAGE(PG8_SA(1, 0), cA + kstep, voffA); PG8_STAGE(PG8_SB(1, 1), cB + hstep + kstep, voffB);
        PG8_WAIT_V(6); PG8_BAR;
    }
    for (;;) {
        const bool has_next = S.next(ui + 1, nxt);
        const char* nA = has_next ? (const char*)g.A + (size_t)nxt.pm * tstep : cA; const char* nB = has_next ? (const char*)g.Bt + (size_t)nxt.pn * tstep : cB;
        for (int t = 0; t < nt; t += 2) {
            const bool last = (t == nt - 2);
            const char* a1 = cA + (size_t)(t + 1) * kstep;
            const char* a2 = last ? nA : cA + (size_t)(t + 2) * kstep; const char* b2 = last ? nB : cB + (size_t)(t + 2) * kstep;
            const char* a3 = a2 + kstep; const char* b3 = b2 + kstep;
            if (last && has_next) S.a_ready(nxt);
            if constexpr (SP2) {
            PG8_LDB(B0, 0, 0); PG8_LDB(B1, 0, 1); PG8_SCHED; PG8_LDA(At, 0, 0); PG8_STAGE(PG8_SA(1, 1), a1 + hstep, voffA);
            PG8_WAIT_V(8); PG8_WAIT_L(0); PG8_BAR; PG8_MMA(0, 0, At, B0); PG8_MMA(0, 1, At, B1); PG8_BAR; PG8_SCHED;
            PG8_LDA(At, 0, 1); PG8_STAGE(PG8_SB(0, 0), b2, voffB); PG8_STAGE(PG8_SB(0, 1), b2 + hstep, voffB); PG8_STAGE(PG8_SA(0, 0), a2, voffA);
            PG8_WAIT_V(8); PG8_WAIT_L(0); PG8_BAR; PG8_MMA(1, 0, At, B0); PG8_MMA(1, 1, At, B1); PG8_BAR; PG8_SCHED;
            PG8_LDB(B0, 1, 0); PG8_LDB(B1, 1, 1); PG8_SCHED; PG8_LDA(At, 1, 0); PG8_STAGE(PG8_SA(0, 1), a2 + hstep, voffA);
            PG8_WAIT_V(8); PG8_WAIT_L(0); PG8_BAR; PG8_MMA(0, 0, At, B0); PG8_MMA(0, 1, At, B1); PG8_BAR; PG8_SCHED;
            PG8_LDA(At, 1, 1); PG8_STAGE(PG8_SB(1, 0), b3, voffB); PG8_STAGE(PG8_SB(1, 1), b3 + hstep, voffB); PG8_STAGE(PG8_SA(1, 0), a3, voffA);
            PG8_WAIT_V(8); PG8_WAIT_L(0); PG8_BAR; PG8_MMA(1, 0, At, B0); PG8_MMA(1, 1, At, B1); PG8_BAR; PG8_SCHED;
            } else {
            PG8_LDB(B0, 0, 0); PG8_SCHED; PG8_LDA(At, 0, 0); PG8_STAGE(PG8_SA(1, 1), a1 + hstep, voffA);
            PG8_WAIT_L(8); PG8_BAR; PG8_WAIT_L(0); PG8_MMA(0, 0, At, B0); PG8_BAR; PG8_SCHED;
            PG8_LDB(B1, 0, 1); PG8_STAGE(PG8_SB(0, 0), b2, voffB);
            PG8_BAR; PG8_WAIT_L(0); PG8_MMA(0, 1, At, B1); PG8_BAR;
            PG8_LDA(At, 0, 1); PG8_STAGE(PG8_SA(0, 0), a2, voffA);
            PG8_BAR; PG8_WAIT_L(0); PG8_MMA(1, 0, At, B0); PG8_BAR; PG8_SCHED;
            PG8_STAGE(PG8_SB(0, 1), b2 + hstep, voffB);
            PG8_WAIT_V(6); PG8_BAR; PG8_MMA(1, 1, At, B1); PG8_BAR;
            PG8_LDB(B0, 1, 0); PG8_SCHED; PG8_LDA(At, 1, 0); PG8_STAGE(PG8_SA(0, 1), a2 + hstep, voffA);
            PG8_WAIT_L(8); PG8_BAR; PG8_WAIT_L(0); PG8_MMA(0, 0, At, B0); PG8_BAR; PG8_SCHED;
            PG8_LDB(B1, 1, 1); PG8_STAGE(PG8_SB(1, 0), b3, voffB);
            PG8_BAR; PG8_WAIT_L(0); PG8_MMA(0, 1, At, B1); PG8_BAR;
            PG8_LDA(At, 1, 1); PG8_STAGE(PG8_SA(1, 0), a3, voffA);
            PG8_BAR; PG8_WAIT_L(0); PG8_MMA(1, 0, At, B0); PG8_BAR; PG8_SCHED;
            PG8_STAGE(PG8_SB(1, 1), b3 + hstep, voffB);
            PG8_WAIT_V(6); PG8_BAR; PG8_MMA(1, 1, At, B1); PG8_BAR;
            }
        }
        if constexpr (ALIGN_EPI) { if (wr == 0) PG8_BAR; }
        if constexpr (!Epi::AFTER_DRAIN) { E(acc, cur, wr, wc, fr, fq); S.done(cur); }
        if (!has_next) break;
#pragma unroll
        for (int a = 0; a < 2; ++a)
#pragma unroll
            for (int b = 0; b < 2; ++b)
#pragma unroll
                for (int m = 0; m < 4; ++m)
#pragma unroll
                    for (int n = 0; n < 2; ++n) acc[a][b][m][n] = (f32x4){0.f, 0.f, 0.f, 0.f};
        cur = nxt; cA = nA; cB = nB; ++ui;
        if constexpr (ALIGN_EPI) { if (wr == 1) PG8_BAR; }
    }
    PG8_WAIT_V(0);
    if constexpr (!ALIGN_EPI) { if (wr == 0) PG8_BAR; }
    PG8_BAR;
    if constexpr (Epi::AFTER_DRAIN) { E.fused(acc, cur, wr, wc, fr, fq, lds, wid, lane); S.done(cur); }
#undef PG8_SA
#undef PG8_SB
#undef PG8_STAGE
#undef PG8_LDA
#undef PG8_LDB
#undef PG8_MMA
#undef PG8_WAIT_V
#undef PG8_WAIT_L
#undef PG8_BAR
#undef PG8_SCHED
}
}
#define LAS __attribute__((address_space(3)))
#define XB_TMO      128
#define XB_XCNT(j)  (256  + 64 * (j))
#define XB_XSUB(j)  (1280 + 64 * (j))
#define XB_XGEN(j)  (2304 + 64 * (j))
#define XB_TOP      3328
#define XB_TOPGEN   3392
#define XCD_BAR_WORDS 3456
#define XB_SPIN_CAP (1u << 18)

__device__ __forceinline__ unsigned xb_ld(unsigned* p)              { return __hip_atomic_load(p, __ATOMIC_RELAXED, __HIP_MEMORY_SCOPE_AGENT); }
__device__ __forceinline__ unsigned xb_add(unsigned* p, unsigned v) { return __hip_atomic_fetch_add(p, v, __ATOMIC_RELAXED, __HIP_MEMORY_SCOPE_AGENT); }
__device__ __forceinline__ unsigned xb_xcc_id() { return (unsigned)__builtin_amdgcn_s_getreg((3 << 11) | 20) & 0xFu; }
#define XB_SPIN(cond, bar) do { unsigned _sp = 0; while (cond) { __builtin_amdgcn_s_sleep(1); \
    if ((++_sp & 255u) == 0u) { if (xb_ld(&(bar)[XB_TMO])) break; if (_sp > XB_SPIN_CAP) { atomicAdd(&(bar)[XB_TMO], 1u); break; } } } } while (0)

struct XcdBarrier {
    unsigned* bar; unsigned x;
    volatile LAS unsigned* st;
};

__device__ __forceinline__ XcdBarrier xcd_barrier_post(unsigned* bar, volatile LAS unsigned* st) {
    XcdBarrier b; b.bar = bar; b.x = xb_xcc_id(); b.st = st;
    if (threadIdx.x == 0) (void)xb_add(&bar[XB_XCNT(b.x)], 1u);
    return b;
}
__device__ __forceinline__ void xcd_barrier_complete(unsigned* bar, unsigned x, unsigned& nloc, unsigned& nx) {
    const unsigned G = gridDim.x * gridDim.y * gridDim.z;
    unsigned sum, cnt, mine, sp = 0u;
    for (;;) {
        sum = 0u; cnt = 0u; mine = 0u;
#pragma unroll
        for (unsigned j = 0; j < 16; ++j) { const unsigned c = xb_ld(&bar[XB_XCNT(j)]); sum += c; cnt += (c > 0u) ? 1u : 0u; mine = (j == x) ? c : mine; }
        if (sum == G) break;
        __builtin_amdgcn_s_sleep(1);
        if ((++sp & 255u) == 0u) { if (xb_ld(&bar[XB_TMO])) break; if (sp > XB_SPIN_CAP) { atomicAdd(&bar[XB_TMO], 1u); break; } }
    }
    nloc = mine > 0u ? mine : 1u; nx = cnt > 0u ? cnt : 1u;
}

__device__ __forceinline__ void xcd_barrier(const XcdBarrier& b) {
    asm volatile("s_waitcnt vmcnt(0)" ::: "memory");
    __syncthreads();
    if (threadIdx.x == 0) {
        unsigned* bar = b.bar;
        __builtin_amdgcn_s_waitcnt(0);
        unsigned nloc = b.st[0], nx = b.st[1];
        if (nloc == 0u) { xcd_barrier_complete(bar, b.x, nloc, nx); b.st[0] = nloc; b.st[1] = nx; }
        const unsigned old = xb_add(&bar[XB_XSUB(b.x)], 1u);
        const unsigned gen = old / nloc;
        if (old + 1u == (gen + 1u) * nloc) {
            __builtin_amdgcn_fence(__ATOMIC_RELEASE, "agent");
            asm volatile("s_waitcnt vmcnt(0)" ::: "memory");
            const unsigned og = xb_add(&bar[XB_TOP], 1u);
            const unsigned tg = og / nx;
            if (og + 1u == (tg + 1u) * nx) xb_add(&bar[XB_TOPGEN], 1u);
            else XB_SPIN(xb_ld(&bar[XB_TOPGEN]) == tg, bar);
            __builtin_amdgcn_fence(__ATOMIC_ACQUIRE, "agent");
            xb_add(&bar[XB_XGEN(b.x)], 1u);
            asm volatile("s_waitcnt vmcnt(0)" ::: "memory");
        } else {
            XB_SPIN(xb_ld(&bar[XB_XGEN(b.x)]) == gen, bar);
            __builtin_amdgcn_fence(__ATOMIC_ACQUIRE, "agent");
            asm volatile("s_waitcnt vmcnt(0)" ::: "memory");
        }
    }
    __syncthreads();
}

#ifndef MK_DUP
#define MK_DUP 0
#endif
#ifndef MK_PER_PHASE
#define MK_PER_PHASE 0
#endif
#define LAS __attribute__((address_space(3)))
typedef unsigned short bf16;
typedef short bf16x8 __attribute__((ext_vector_type(8)));
typedef short s16x4 __attribute__((ext_vector_type(4)));
typedef float f32x4 __attribute__((ext_vector_type(4)));
typedef float f32x16 __attribute__((ext_vector_type(16)));
typedef unsigned u32x4 __attribute__((ext_vector_type(4)));
typedef unsigned u32x2 __attribute__((ext_vector_type(2)));
typedef float f32x2m __attribute__((ext_vector_type(2)));
#define MFMA32(a, b, c) __builtin_amdgcn_mfma_f32_32x32x16_bf16((a), (b), (c), 0, 0, 0)
#define LDS_WAIT() asm volatile("s_waitcnt lgkmcnt(0)" ::: "memory")

constexpr int NFR = 16384, MT = 16640, D = 1024, FF = 2816, NGU = 5632, NIN = 4608, PBW = 4352, DIN = 4368;
constexpr int NPH = 12;
constexpr int LDS_BYTES = 147456, MISC_OFF = 131072 + 320, CTL_BYTES = 32768;
constexpr size_t MiB = 1u << 20;
constexpr size_t WS_WGU1 = 0, WS_WD1 = 11 * MiB, WS_ST = 0  , WS_WGU2 = 17 * MiB, WS_WD2 = 28 * MiB, WS_WIN = 34 * MiB,
                 WS_WA = 43 * MiB, WS_WB = 44 * MiB, WS_WOUT = 45 * MiB, WS_SSP = 47 * MiB, WS_GLOW = 49 * MiB, WS_DEC = 51 * MiB, WS_CTL = 51 * MiB + MiB / 2  , WS_MSSP = 51 * MiB + 3 * MiB / 4  ,
                 WS_HB = 52 * MiB, WS_YA = 52 * MiB, WS_YB = 68 * MiB  , WS_R1 = 85 * MiB  ,
                 WS_KV = 223 * MiB + MiB / 2  , WS_END = 256 * MiB;
static_assert(WS_ST + (size_t)1032 * 8192 * 2 <= WS_WGU2 && WS_R1 + (size_t)MT * PBW * 2 <= WS_KV && WS_KV + (size_t)NFR * D * 2 <= WS_END && WS_HB + (size_t)MT * D * 2 <= WS_R1, "d_ws map");

struct Params { const float* in[20]; float* out; unsigned char* ws; int ph_lo, ph_hi, cg_sync, pad; };

__device__ __forceinline__ int crow(int reg, int h) { return (reg & 3) + 8 * (reg >> 2) + 4 * h; }
__device__ __forceinline__ unsigned f2bf(float f) { unsigned u = __float_as_uint(f); return (u + 0x7fffu + ((u >> 16) & 1u)) >> 16; }
__device__ __forceinline__ unsigned pk2(float lo, float hi) { return f2bf(lo) | (f2bf(hi) << 16); }
__device__ __forceinline__ float wave_sum(float v) {
#pragma unroll
    for (int o = 1; o < 64; o <<= 1) v += __shfl_xor(v, o);
    return v;
}
__device__ __forceinline__ bf16x8 pack8(float a, float b, float c, float d, float e, float f, float g, float h) {
    u32x4 p; p.x = pk2(a, b); p.y = pk2(c, d); p.z = pk2(e, f); p.w = pk2(g, h); return __builtin_bit_cast(bf16x8, p);
}

struct TrDesc { const float* W; const float* gain; bf16* WT; int K, N, k0, sn0, nvalid, drow0; };
__device__ __forceinline__ void tr_load(const TrDesc& d, f32x4 (&a)[8], f32x4 (&b)[8], int lane) {
    const int n4 = (lane & 15) * 4, kp = lane >> 4; const bool cv = n4 < d.nvalid;
#pragma unroll
    for (int st = 0; st < 8; ++st) { const float* p = d.W + (size_t)(d.k0 + 8 * st + 2 * kp) * d.N + d.sn0 + n4;
        a[st] = cv ? __builtin_nontemporal_load((const f32x4*)p) : (f32x4){0.f, 0.f, 0.f, 0.f}; b[st] = cv ? __builtin_nontemporal_load((const f32x4*)(p + d.N)) : (f32x4){0.f, 0.f, 0.f, 0.f}; }
}
__device__ __forceinline__ void tr_store(const TrDesc& d, const f32x4 (&a)[8], const f32x4 (&b)[8], LAS unsigned* T, int lane) {
    const int n4 = (lane & 15) * 4, kp = lane >> 4;
#pragma unroll
    for (int st = 0; st < 8; ++st) { const int k = d.k0 + 8 * st + 2 * kp; float g0 = 1.f, g1 = 1.f; if (d.gain) { g0 = d.gain[k]; g1 = d.gain[k + 1]; }
        LAS unsigned* t = T + n4 * 33 + 4 * st + kp;
        t[0] = pk2(a[st][0] * g0, b[st][0] * g1); t[33] = pk2(a[st][1] * g0, b[st][1] * g1); t[66] = pk2(a[st][2] * g0, b[st][2] * g1); t[99] = pk2(a[st][3] * g0, b[st][3] * g1); }
    LDS_WAIT(); asm volatile("" ::: "memory");
    const int c = lane & 7;
#pragma unroll
    for (int q = 0; q < 8; ++q) { const int n = (lane >> 3) + 8 * q; const LAS unsigned* t = T + n * 33 + 4 * c;
        u32x4 o; o.x = t[0]; o.y = t[1]; o.z = t[2]; o.w = t[3];
        *(u32x4*)(d.WT + (size_t)(d.drow0 + n) * d.K + d.k0 + 8 * c) = o; }
    LDS_WAIT(); asm volatile("" ::: "memory");
}
constexpr int I_GU = 16 * 44, I_DN = 44 * 16, I_IN = 16 * 72, I_BR = 8 * 16, I_WO = 16 * 16;
constexpr int IT_P0 = 2 * I_GU + I_DN + I_IN, IT_END = IT_P0 + 2 * I_BR + I_WO + 2 * I_GU + I_DN;
__device__ __forceinline__ TrDesc prep_desc(const Params& P, int it) {
    unsigned char* ws = P.ws; int r = it; TrDesc d;
    if (r < 2 * I_GU) { const int up = r >= I_GU; r -= up * I_GU; const int kb = r / 44, n0 = (r % 44) * 64;
        d = TrDesc{up ? P.in[4] : P.in[3], P.in[2], (bf16*)(ws + WS_WGU1), D, FF, kb * 64, n0, 64, (n0 >> 7) * 256 + (n0 & 127) + up * 128}; return d; }
    r -= 2 * I_GU;
    if (r < I_DN) { d = TrDesc{P.in[5], nullptr, (bf16*)(ws + WS_WD1), FF, D, (r / 16) * 64, (r % 16) * 64, 64, (r % 16) * 64}; return d; }
    r -= I_DN;
    if (r < I_IN) { const int kb = r / 72, d0 = (r % 72) * 64; int sn0, nv;
        if (d0 < 2304) { sn0 = d0; nv = 64; } else if (d0 < 4352) { sn0 = d0 + 16; nv = 64; } else if (d0 == 4352) { sn0 = 2304; nv = 16; } else { sn0 = 0; nv = 0; }
        d = TrDesc{P.in[7], P.in[6], (bf16*)(ws + WS_WIN), D, DIN, kb * 64, sn0, nv, d0}; return d; }
    r -= I_IN;
    if (r < I_BR) { d = TrDesc{P.in[12], nullptr, (bf16*)(ws + WS_WA), 512, D, (r / 16) * 64, (r % 16) * 64, 64, (r % 16) * 64}; return d; }
    r -= I_BR;
    if (r < I_BR) { d = TrDesc{P.in[13], nullptr, (bf16*)(ws + WS_WB), 512, D, (r / 16) * 64, (r % 16) * 64, 64, (r % 16) * 64}; return d; }
    r -= I_BR;
    if (r < I_WO) { d = TrDesc{P.in[14], nullptr, (bf16*)(ws + WS_WOUT), D, D, (r / 16) * 64, (r % 16) * 64, 64, (r % 16) * 64}; return d; }
    r -= I_WO;
    if (r < 2 * I_GU) { const int up = r >= I_GU; r -= up * I_GU; const int kb = r / 44, n0 = (r % 44) * 64;
        d = TrDesc{up ? P.in[17] : P.in[16], P.in[15], (bf16*)(ws + WS_WGU2), D, FF, kb * 64, n0, 64, (n0 >> 7) * 256 + (n0 & 127) + up * 128}; return d; }
    r -= 2 * I_GU;
    d = TrDesc{P.in[18], nullptr, (bf16*)(ws + WS_WD2), FF, D, (r / 16) * 64, (r % 16) * 64, 64, (r % 16) * 64}; return d;
}
__device__ __forceinline__ void prep_items(const Params& P, int first, int hi, int stride, LAS unsigned* scr, int lane) {
    for (int it = first; it < hi; it += 2 * stride) {
        const bool two = it + stride < hi;
        const TrDesc d0 = prep_desc(P, it), d1 = prep_desc(P, two ? it + stride : it);
        f32x4 a0[8], b0[8], a1[8], b1[8];
        tr_load(d0, a0, b0, lane);
        if (two) tr_load(d1, a1, b1, lane);
        tr_store(d0, a0, b0, scr, lane);
        if (two) tr_store(d1, a1, b1, scr, lane);
    }
}
__device__ __forceinline__ void prep_in_slack(const Params& P, LAS unsigned char* lds, int lo, int hi, int nwg, int wave, int lane, int G) {
    const int rem = nwg % G, c = (int)blockIdx.x; int ns, si;
    if (rem == 0) { ns = G; si = c; } else { if (c < rem) return; ns = G - rem; si = c - rem; }
    prep_items(P, lo + wave * ns + si, hi, ns * 8, (LAS unsigned*)(lds + wave * 16384), lane);
}
__device__ __forceinline__ void p0_prep(const Params& P, LAS unsigned char* lds, int wave, int lane, int G) {
    unsigned char* ws = P.ws;
    LAS unsigned* scr = (LAS unsigned*)(lds + wave * 16384);
    const int gw = blockIdx.x * 8 + wave, NGW = G * 8;
    prep_items(P, gw, 2 * I_GU, NGW, scr, lane);
    bf16* hb = (bf16*)(ws + WS_HB); float* ssp = (float*)(ws + WS_SSP);
    for (int m0 = gw; m0 < MT; m0 += 2 * NGW) {
        f32x4 v[2][4]; float s[2];
#pragma unroll
        for (int u = 0; u < 2; ++u) { const int m = m0 + u * NGW;
            const float* src = m < NFR ? P.in[0] + (size_t)m * D : (m < NFR + 16 ? P.in[1] + (size_t)(m - NFR) * D : nullptr);
#pragma unroll
            for (int j = 0; j < 4; ++j) v[u][j] = src ? __builtin_nontemporal_load((const f32x4*)src + lane + 64 * j) : (f32x4){0.f, 0.f, 0.f, 0.f}; }
#pragma unroll
        for (int u = 0; u < 2; ++u) { const int m = m0 + u * NGW; s[u] = 0.f;
#pragma unroll
            for (int j = 0; j < 4; ++j) s[u] += (v[u][j][0] * v[u][j][0] + v[u][j][1] * v[u][j][1]) + (v[u][j][2] * v[u][j][2] + v[u][j][3] * v[u][j][3]);
            s[u] = wave_sum(s[u]);
            if (m < MT) {
                u32x2* o8 = (u32x2*)(hb + (size_t)m * D) + lane;
#pragma unroll
                for (int j = 0; j < 4; ++j) { u32x2 w; w.x = pk2(v[u][j][0], v[u][j][1]); w.y = pk2(v[u][j][2], v[u][j][3]); o8[64 * j] = w; }
                if (lane < 16) ssp[(size_t)m * 16 + lane] = lane == 0 ? s[u] : 0.f; } }
    }
}

typedef float f32x4m __attribute__((ext_vector_type(4)));
#define MFMA16(a, b, c) __builtin_amdgcn_mfma_f32_16x16x32_bf16((a), (b), (c), 0, 0, 0)
__device__ __forceinline__ f32x4m meta_mm(const bf16* A, const bf16* Brow, int K, int k0, int nsteps, int lane) {
    const int r = lane & 15, quad = lane >> 4;
    const bf16* ap = A + (size_t)r * K + k0 + quad * 8; const bf16* bp = Brow + (size_t)r * K + k0 + quad * 8;
    f32x4m acc = (f32x4m){0.f, 0.f, 0.f, 0.f};
#pragma unroll 8
    for (int st = 0; st < nsteps; ++st) { const bf16x8 a = *(const bf16x8*)(ap + 32 * st), b = *(const bf16x8*)(bp + 32 * st); acc = MFMA16(a, b, acc); }
    return acc;
}
__device__ __forceinline__ float sum16(const float* p) { const f32x4 a = *(const f32x4*)p, b = *(const f32x4*)(p + 4), c = *(const f32x4*)(p + 8), d = *(const f32x4*)(p + 12);
    return (((a[0] + a[1]) + (a[2] + a[3])) + ((b[0] + b[1]) + (b[2] + b[3]))) + (((c[0] + c[1]) + (c[2] + c[3])) + ((d[0] + d[1]) + (d[2] + d[3]))); }
__device__ __forceinline__ void meta_p1(const Params& P, int wave, int lane, int G) {
    const int mt = (G - 1 - (int)blockIdx.x) * 8 + wave; if (mt >= 176) return;
    unsigned char* ws = P.ws; const bf16* hbm = (const bf16*)(ws + WS_HB) + (size_t)NFR * D; const bf16* W = (const bf16*)(ws + WS_WGU1);
    bf16* actm = (bf16*)(ws + WS_R1) + (size_t)NFR * FF; const float* ssp = (const float*)(ws + WS_SSP) + (size_t)NFR * 16;
    const int c0 = 16 * mt, grow = (c0 >> 7) * 256 + (c0 & 127), r = lane & 15, quad = lane >> 4;
    const f32x4m g = meta_mm(hbm, W + (size_t)grow * D, D, 0, 32, lane), u = meta_mm(hbm, W + (size_t)(grow + 128) * D, D, 0, 32, lane);
#pragma unroll
    for (int j = 0; j < 4; ++j) { const int row = quad * 4 + j; const float rs = __builtin_amdgcn_rsqf(sum16(ssp + row * 16) * (1.0f / 1024.0f) + 1e-6f);
        const float gv = g[j] * rs, uv = u[j] * rs; actm[(size_t)row * FF + c0 + r] = (bf16)f2bf(gv * pg8::sigm(gv) * uv); }
}
__device__ __forceinline__ void meta_p2(const Params& P, LAS unsigned char* L, int wave, int lane) {
    if (blockIdx.x >= 64) return;
    unsigned char* ws = P.ws; const bf16* actm = (const bf16*)(ws + WS_R1) + (size_t)NFR * FF; const bf16* W = (const bf16*)(ws + WS_WD1);
    bf16* hbm = (bf16*)(ws + WS_HB) + (size_t)NFR * D; float* mssp = (float*)(ws + WS_MSSP);
    const int ct = blockIdx.x, r = lane & 15, quad = lane >> 4;
    const bf16* ap = actm + (size_t)r * FF + wave * 352 + quad * 8; const bf16* bp = W + (size_t)(ct * 16 + r) * FF + wave * 352 + quad * 8;
    bf16x8 av[11], bv[11];
#pragma unroll
    for (int st = 0; st < 11; ++st) { av[st] = *(const bf16x8*)(ap + 32 * st); bv[st] = *(const bf16x8*)(bp + 32 * st); }
    f32x4m acc = (f32x4m){0.f, 0.f, 0.f, 0.f};
#pragma unroll
    for (int st = 0; st < 11; ++st) acc = MFMA16(av[st], bv[st], acc);
    LAS f32x4m* red = (LAS f32x4m*)L;
    red[wave * 64 + lane] = acc;
    __syncthreads();
    if (wave == 0) {
        f32x4m t = red[lane];
#pragma unroll
        for (int w = 1; w < 8; ++w) t = t + red[w * 64 + lane];
#pragma unroll
        for (int j = 0; j < 4; ++j) { const int row = quad * 4 + j, col = ct * 16 + r; const float v = P.in[1][(size_t)row * D + col] + 0.5f * t[j];
            hbm[(size_t)row * D + col] = (bf16)f2bf(v);
            float sq = v * v; sq += __shfl_xor(sq, 1); sq += __shfl_xor(sq, 2); sq += __shfl_xor(sq, 4); sq += __shfl_xor(sq, 8);
            if (r == 0) mssp[row * 64 + ct] = sq; }
    }
    __syncthreads();
}
__device__ __forceinline__ void meta_p3(const Params& P, int wave, int lane, int G) {
    const int mt = (G - 1 - (int)blockIdx.x) * 8 + wave; if (mt >= 65) return;
    unsigned char* ws = P.ws; const bf16* hbm = (const bf16*)(ws + WS_HB) + (size_t)NFR * D; const bf16* W = (const bf16*)(ws + WS_WIN);
    bf16* PBm = (bf16*)(ws + WS_R1) + (size_t)NFR * PBW; float* glowm = (float*)(ws + WS_GLOW) + (size_t)NFR * 16; const float* mssp = (const float*)(ws + WS_MSSP);
    const int col0 = mt < 16 ? 512 + 16 * mt : (mt < 32 ? 1024 + 16 * (mt - 16) : (mt < 64 ? 1280 + 16 * (mt - 32) : 4352)), r = lane & 15, quad = lane >> 4;
    const f32x4m acc = meta_mm(hbm, W + (size_t)col0 * D, D, 0, 32, lane);
#pragma unroll
    for (int j = 0; j < 4; ++j) { const int row = quad * 4 + j;
        const f32x4 p = *(const f32x4*)(mssp + row * 64 + 4 * r); float sq = (p[0] + p[1]) + (p[2] + p[3]);
        sq += __shfl_xor(sq, 1); sq += __shfl_xor(sq, 2); sq += __shfl_xor(sq, 4); sq += __shfl_xor(sq, 8);
        const float v = acc[j] * __builtin_amdgcn_rsqf(sq * (1.0f / 1024.0f) + 1e-6f);
        if (mt < 64) PBm[(size_t)row * PBW + col0 + r] = (bf16)f2bf(v); else glowm[row * 16 + r] = v; }
}

constexpr int A_KS = 0, A_VT = 32256, A_VTS = 228;
__device__ __forceinline__ void attn_item(const Params& P, LAS unsigned char* L, int item, int tid, int wave, int lane) {
    const bf16* PB = (const bf16*)(P.ws + WS_R1); bf16* ya = (bf16*)P.out;
    const int kvh = item & 1, c = (item >> 1) & 127, b = item >> 8;
#pragma unroll
    for (int i = 0; i < 4; ++i) {
        const int key = (tid & 63) + 64 * i;
        if (key < 224) {
            bool valid; int row;
            if (key < 16) { valid = true; row = NFR + key; }
            else if (key < 32) { valid = false; row = 0; }
            else { const int ki = c * 64 - 128 + (key - 32); valid = ki >= 0; row = b * 8192 + (valid ? ki : 0); }
            u32x4 kk = (u32x4){0u, 0u, 0u, 0u}, vv = (u32x4){0u, 0u, 0u, 0u};
            if (valid) { const bf16* p = PB + (size_t)row * PBW + 512 + kvh * 64 + wave * 8; kk = *(const u32x4*)p; vv = *(const u32x4*)(p + 128); }
            *(LAS u32x4*)(L + A_KS + key * 144 + wave * 16) = kk;
            LAS unsigned short* vt = (LAS unsigned short*)(L + A_VT) + (wave * 8) * A_VTS + key;
            vt[0 * A_VTS] = (unsigned short)(vv.x & 0xffffu); vt[1 * A_VTS] = (unsigned short)(vv.x >> 16);
            vt[2 * A_VTS] = (unsigned short)(vv.y & 0xffffu); vt[3 * A_VTS] = (unsigned short)(vv.y >> 16);
            vt[4 * A_VTS] = (unsigned short)(vv.z & 0xffffu); vt[5 * A_VTS] = (unsigned short)(vv.z >> 16);
            vt[6 * A_VTS] = (unsigned short)(vv.w & 0xffffu); vt[7 * A_VTS] = (unsigned short)(vv.w >> 16);
        }
    }
    __syncthreads();
    const int g = wave >> 1, pos0 = (wave & 1) * 32, h = kvh * 4 + g, r = lane & 31, hi = lane >> 5;
    const int qrow = b * 8192 + c * 64 + pos0 + r;
    bf16x8 q[4];
#pragma unroll
    for (int s = 0; s < 4; ++s) q[s] = *(const bf16x8*)(PB + (size_t)qrow * PBW + h * 64 + 16 * s + 8 * hi);
    f32x16 S[7];
#pragma unroll
    for (int kt = 0; kt < 7; ++kt) {
#pragma unroll
        for (int i = 0; i < 16; ++i) S[kt][i] = 0.f;
#pragma unroll
        for (int s = 0; s < 4; ++s) { const bf16x8 a = *(const LAS bf16x8*)(L + A_KS + (kt * 32 + r) * 144 + (16 * s + 8 * hi) * 2); S[kt] = MFMA32(a, q[s], S[kt]); }
        asm volatile("" ::: "memory");
    }
    __builtin_amdgcn_sched_barrier(0);
    const float slope = exp2f(-(float)(h + 1)), sink = P.in[11][h];
    const float NEG = -__builtin_inff();
    float m = sink;
#pragma unroll
    for (int i = 0; i < 16; ++i) { if (i >= 8) S[0][i] = NEG; else m = fmaxf(m, S[0][i]); }
    int oz; asm volatile("v_mov_b32 %0, 0" : "=v"(oz));
    const int smin = 128 - 64 * c, pq = pos0 + r + 128 + oz;
#pragma unroll
    for (int kt = 1; kt < 7; ++kt) {
#pragma unroll
        for (int i = 0; i < 16; ++i) { const int s = (kt - 1) * 32 + crow(i, hi); float v = S[kt][i] - slope * fabsf((float)(pq - s)); if (s < smin) v = NEG; S[kt][i] = v; m = fmaxf(m, v); }
        __builtin_amdgcn_sched_barrier(0);
    }
    m = fmaxf(m, __shfl_xor(m, 32));
    __builtin_amdgcn_sched_barrier(0);
    float sum = 0.f; const float ml = m * 1.44269504f;
    bf16x8 pbv[7][2];
#pragma unroll
    for (int kt = 0; kt < 7; ++kt) {
#pragma unroll
        for (int i = 0; i < 16; ++i) { const float p = __builtin_amdgcn_exp2f(S[kt][i] * 1.44269504f - ml); S[kt][i] = p; sum += p; }
        pbv[kt][0] = pack8(S[kt][0], S[kt][1], S[kt][2], S[kt][3], S[kt][4], S[kt][5], S[kt][6], S[kt][7]);
        pbv[kt][1] = pack8(S[kt][8], S[kt][9], S[kt][10], S[kt][11], S[kt][12], S[kt][13], S[kt][14], S[kt][15]);
    }
    __builtin_amdgcn_sched_barrier(0);
    sum += __shfl_xor(sum, 32); sum += exp2f(sink * 1.44269504f - ml);
    const float inv = 1.0f / sum;
    f32x16 O[2];
#pragma unroll
    for (int i = 0; i < 16; ++i) { O[0][i] = 0.f; O[1][i] = 0.f; }
#pragma unroll
    for (int kt = 0; kt < 7; ++kt)
#pragma unroll
        for (int s2 = 0; s2 < 2; ++s2) {
            const bf16x8 pb = pbv[kt][s2];
#pragma unroll
            for (int dt = 0; dt < 2; ++dt) {
                const LAS unsigned char* vp = L + A_VT + ((dt * 32 + r) * A_VTS + kt * 32 + 16 * s2 + 4 * hi) * 2;
                const s16x4 lo = *(const LAS s16x4*)vp, h4 = *(const LAS s16x4*)(vp + 16);
                const bf16x8 va = __builtin_shufflevector(lo, h4, 0, 1, 2, 3, 4, 5, 6, 7);
                O[dt] = MFMA32(va, pb, O[dt]);
            }
            asm volatile("" ::: "memory");
        }
#pragma unroll
    for (int dt = 0; dt < 2; ++dt)
#pragma unroll
        for (int g4 = 0; g4 < 4; ++g4) {
            u32x2 w; w.x = pk2(O[dt][4 * g4] * inv, O[dt][4 * g4 + 1] * inv); w.y = pk2(O[dt][4 * g4 + 2] * inv, O[dt][4 * g4 + 3] * inv);
            *(u32x2*)(ya + (size_t)qrow * 512 + h * 64 + dt * 32 + 8 * g4 + 4 * hi) = w;
        }
    __syncthreads();
}

constexpr int G_QE = 0, G_KE = 9216, G_K2T = 18432, G_VT = 27648, G_ST = 46080, G_SEG = 64512, G_SS = 66560, G_GL = 67584;
struct GlaLd { f32x2m glv; u32x4 qraw, kraw, va, vc, sa, sc; float gw[16]; float bias; };
template <bool KV> __device__ __forceinline__ void gla_load(const Params& P, GlaLd& g, int b, int h, int j, int tid) {
    const bf16* PB = (const bf16*)(P.ws + WS_R1); const float* glow = (const float*)(P.ws + WS_GLOW);
    const int d = tid & 63;
    const int posA = tid >> 3, sub = tid & 7; const bool vA = (j > 0) || (posA >= 48);
    const int rowA = vA ? (j == 0 ? NFR + posA - 48 : b * 8192 + (j - 1) * 64 + posA) : NFR;
    g.glv = *(const f32x2m*)(glow + (size_t)rowA * 16 + sub * 2);
    g.qraw = (u32x4){0u, 0u, 0u, 0u}; g.kraw = g.qraw;
    if (vA) { const bf16* p = PB + (size_t)rowA * PBW + h * 64 + sub * 8;
        if (!KV) { g.qraw = __builtin_nontemporal_load((const u32x4*)(p + 768)); g.kraw = __builtin_nontemporal_load((const u32x4*)(p + 1024)); } else g.kraw = *(const u32x4*)(p + 1024); }
    const int posC = tid & 63, dvg = tid >> 6; const bool vC = (j > 0) || (posC >= 48);
    const int rowC = vC ? (j == 0 ? NFR + posC - 48 : b * 8192 + (j - 1) * 64 + posC) : NFR;
    g.va = (u32x4){0u, 0u, 0u, 0u}; g.vc = g.va;
    if (vC) { const bf16* p = PB + (size_t)rowC * PBW + 1280 + h * 128 + dvg * 16; g.va = *(const u32x4*)p; g.vc = *(const u32x4*)(p + 8); }
    g.sa = (u32x4){0u, 0u, 0u, 0u}; g.sc = g.sa;
    if (!KV) { const bf16* sg = (const bf16*)(P.ws + WS_ST) + (size_t)((b * 4 + h) * 129 + j) * 8192 + (tid >> 2) * 64 + (tid & 3) * 16; g.sa = __builtin_nontemporal_load((const u32x4*)sg); g.sc = __builtin_nontemporal_load((const u32x4*)(sg + 8)); }
#pragma unroll
    for (int r = 0; r < 16; ++r) g.gw[r] = P.in[8][r * 256 + h * 64 + d];
    g.bias = P.in[9][h * 64 + d];
}
template <bool KV> __device__ __forceinline__ void gla_stage(LAS unsigned char* L, const GlaLd& g, int tid) {
    const int posA = tid >> 3, sub = tid & 7, posC = tid & 63, dvg = tid >> 6;
    *(LAS f32x2m*)(L + G_GL + (posA * 16 + sub * 2) * 4) = g.glv;
    if (!KV) *(LAS u32x4*)(L + G_QE + (posA * 72 + sub * 8) * 2) = g.qraw;
    *(LAS u32x4*)(L + G_KE + (posA * 72 + sub * 8) * 2) = g.kraw;
    { const u32x4 va = g.va, vc = g.vc; LAS unsigned short* vt = (LAS unsigned short*)(L + G_VT) + (dvg * 16) * 72 + posC;
      vt[0 * 72] = (unsigned short)(va.x & 0xffffu); vt[1 * 72] = (unsigned short)(va.x >> 16); vt[2 * 72] = (unsigned short)(va.y & 0xffffu); vt[3 * 72] = (unsigned short)(va.y >> 16);
      vt[4 * 72] = (unsigned short)(va.z & 0xffffu); vt[5 * 72] = (unsigned short)(va.z >> 16); vt[6 * 72] = (unsigned short)(va.w & 0xffffu); vt[7 * 72] = (unsigned short)(va.w >> 16);
      vt[8 * 72] = (unsigned short)(vc.x & 0xffffu); vt[9 * 72] = (unsigned short)(vc.x >> 16); vt[10 * 72] = (unsigned short)(vc.y & 0xffffu); vt[11 * 72] = (unsigned short)(vc.y >> 16);
      vt[12 * 72] = (unsigned short)(vc.z & 0xffffu); vt[13 * 72] = (unsigned short)(vc.z >> 16); vt[14 * 72] = (unsigned short)(vc.w & 0xffffu); vt[15 * 72] = (unsigned short)(vc.w >> 16); }
    if (!KV) { const int dv = tid >> 2, part = tid & 3; *(LAS u32x4*)(L + G_ST + (dv * 72 + part * 16) * 2) = g.sa; *(LAS u32x4*)(L + G_ST + (dv * 72 + part * 16 + 8) * 2) = g.sc; }
}
template <bool KV> __device__ __forceinline__ void gla_prep(const Params& P, LAS unsigned char* L, const float (&gw)[16], float bias, int b, int h, int j, int tid) {
    const int d = tid & 63, seg = tid >> 6;
    LAS unsigned short* QE = (LAS unsigned short*)(L + G_QE); LAS unsigned short* KE = (LAS unsigned short*)(L + G_KE);
    float cs[8], qv[8], kv[8]; float run = 0.f;
#pragma unroll
    for (int p = 0; p < 8; ++p) {
        const int pos = seg * 8 + p; const bool valid = (j > 0) || (pos >= 48);
        const LAS f32x4* gl = (const LAS f32x4*)(L + G_GL + pos * 64);
        const f32x4 g0 = gl[0], g1 = gl[1], g2 = gl[2], g3 = gl[3];
        float z = bias;
#pragma unroll
        for (int e = 0; e < 4; ++e) { z += g0[e] * gw[e]; z += g1[e] * gw[4 + e]; z += g2[e] * gw[8 + e]; z += g3[e] * gw[12 + e]; }
        float la = (fminf(z, 0.f) - __logf(1.0f + __expf(-fabsf(z)))) * 0.0625f;
        if (!valid) la = 0.f;
        run += la; cs[p] = run;
        qv[p] = KV ? 0.f : pg8::bf2f(QE[pos * 72 + d]); kv[p] = pg8::bf2f(KE[pos * 72 + d]);
        if (p & 1) __builtin_amdgcn_sched_barrier(0);
    }
    LAS float* SEG = (LAS float*)(L + G_SEG);
    SEG[seg * 64 + d] = run;
    __syncthreads();
    float off = 0.f, tot = 0.f;
#pragma unroll
    for (int s = 0; s < 8; ++s) { const float v = SEG[s * 64 + d]; tot += v; if (s < seg) off += v; }
    float k2[8];
#pragma unroll
    for (int p = 0; p < 8; ++p) {
        const int pos = seg * 8 + p; const float bb = off + cs[p];
        if (!KV) { QE[pos * 72 + d] = (unsigned short)f2bf(qv[p] * __expf(bb)); KE[pos * 72 + d] = (unsigned short)f2bf(kv[p] * __expf(-bb)); }
        k2[p] = kv[p] * __expf(tot - bb);
    }
    if (KV) {
        *(LAS bf16x8*)(L + G_K2T + (d * 72 + seg * 8) * 2) = pack8(k2[0], k2[1], k2[2], k2[3], k2[4], k2[5], k2[6], k2[7]);
        if (seg == 0) ((float*)(P.ws + WS_DEC))[(size_t)((b * 4 + h) * 129 + j) * 64 + d] = __expf(tot);
    }
}
__device__ __forceinline__ void gla_kv_item(const Params& P, LAS unsigned char* L, int item, const float (&gw)[16], float bias, int tid, int wave, int lane) {
    const int j = item % 129, bh = item / 129, h = bh & 3, b = bh >> 2;
    gla_prep<true>(P, L, gw, bias, b, h, j, tid);
    __syncthreads();
    const int dvt = wave >> 1, dkt = wave & 1, r = lane & 31, hi = lane >> 5;
    f32x16 acc;
#pragma unroll
    for (int i = 0; i < 16; ++i) acc[i] = 0.f;
#pragma unroll
    for (int s = 0; s < 4; ++s) {
        const bf16x8 a = *(const LAS bf16x8*)(L + G_VT + ((dvt * 32 + r) * 72 + 16 * s + 8 * hi) * 2);
        const bf16x8 bb = *(const LAS bf16x8*)(L + G_K2T + ((dkt * 32 + r) * 72 + 16 * s + 8 * hi) * 2);
        acc = MFMA32(a, bb, acc);
    }
    bf16* kvg = (bf16*)(P.ws + WS_KV) + (size_t)item * 8192;
#pragma unroll
    for (int i = 0; i < 16; ++i) kvg[(dvt * 32 + crow(i, hi)) * 64 + dkt * 32 + r] = (bf16)f2bf(acc[i]);
    __syncthreads();
}
__device__ __forceinline__ void gla_scan(const Params& P, int wave, int lane, int G) {
    const bf16* kvg = (const bf16*)(P.ws + WS_KV); const float* dec = (const float*)(P.ws + WS_DEC); bf16* st = (bf16*)(P.ws + WS_ST);
    if (wave >= 4) return;
    for (int wv = wave * G + blockIdx.x; wv < 1024; wv += G * 4) {
        const int gidx = wv * 64 + lane, bh = gidx >> 13, e = gidx & 8191, dk = e & 63;
        const size_t base = (size_t)bh * 129;
        float S = 0.f;
        for (int j0 = 0; j0 < 128; j0 += 8) {
            float kvv[8], dd[8];
#pragma unroll
            for (int u = 0; u < 8; ++u) { kvv[u] = pg8::bf2f(__builtin_nontemporal_load(kvg + (base + j0 + u) * 8192 + e)); dd[u] = dec[(base + j0 + u) * 64 + dk]; }
#pragma unroll
            for (int u = 0; u < 8; ++u) { S = dd[u] * S + kvv[u]; st[(base + j0 + u + 1) * 8192 + e] = (bf16)f2bf(S); }
        }
    }
}
__device__ __forceinline__ void gla_out_item(const Params& P, LAS unsigned char* L, int item  , const float (&gw)[16], float bias, int tid, int wave, int lane) {
    const int j = (item & 127) + 1, bh = item >> 7, h = bh & 3, b = bh >> 2;
    const bf16* PB = (const bf16*)(P.ws + WS_R1); bf16* yb = (bf16*)P.out + (size_t)NFR * 512;
    gla_prep<false>(P, L, gw, bias, b, h, j, tid);
    __syncthreads();
    const int it = wave & 1, dvt = wave >> 1, r = lane & 31, hi = lane >> 5;
    bf16x8 qf[4];
#pragma unroll
    for (int s = 0; s < 4; ++s) qf[s] = *(const LAS bf16x8*)(L + G_QE + ((it * 32 + r) * 72 + 16 * s + 8 * hi) * 2);
    f32x16 o;
#pragma unroll
    for (int i = 0; i < 16; ++i) o[i] = 0.f;
#pragma unroll
    for (int jt = 0; jt < 2; ++jt) {
        if (jt <= it) {
            f32x16 at;
#pragma unroll
            for (int i = 0; i < 16; ++i) at[i] = 0.f;
#pragma unroll
            for (int s = 0; s < 4; ++s) { const bf16x8 a = *(const LAS bf16x8*)(L + G_KE + ((jt * 32 + r) * 72 + 16 * s + 8 * hi) * 2); at = MFMA32(a, qf[s], at); }
            if (jt == it) {
#pragma unroll
                for (int i = 0; i < 16; ++i) if (crow(i, hi) > r) at[i] = 0.f;
            }
#pragma unroll
            for (int s2 = 0; s2 < 2; ++s2) {
                const bf16x8 pb = pack8(at[8 * s2], at[8 * s2 + 1], at[8 * s2 + 2], at[8 * s2 + 3], at[8 * s2 + 4], at[8 * s2 + 5], at[8 * s2 + 6], at[8 * s2 + 7]);
                const LAS unsigned char* vp = L + G_VT + ((dvt * 32 + r) * 72 + jt * 32 + 16 * s2 + 4 * hi) * 2;
                const s16x4 lo = *(const LAS s16x4*)vp, h4 = *(const LAS s16x4*)(vp + 16);
                o = MFMA32(__builtin_shufflevector(lo, h4, 0, 1, 2, 3, 4, 5, 6, 7), pb, o);
            }
        }
    }
#pragma unroll
    for (int s = 0; s < 4; ++s) { const bf16x8 a = *(const LAS bf16x8*)(L + G_ST + ((dvt * 32 + r) * 72 + 16 * s + 8 * hi) * 2); o = MFMA32(a, qf[s], o); }
    const int row = b * 8192 + (j - 1) * 64 + it * 32 + r;
    u32x2 grv[4]; f32x4 gnv[4];
#pragma unroll
    for (int g4 = 0; g4 < 4; ++g4) { const int dv0 = dvt * 32 + 8 * g4 + 4 * hi; gnv[g4] = *(const f32x4*)(P.in[10] + dv0); grv[g4] = *(const u32x2*)(PB + (size_t)row * PBW + 1792 + h * 128 + dv0); }
    float ss = 0.f;
#pragma unroll
    for (int i = 0; i < 16; ++i) ss += o[i] * o[i];
    ss += __shfl_xor(ss, 32);
    LAS float* SS = (LAS float*)(L + G_SS);
    if (hi == 0) SS[dvt * 64 + it * 32 + r] = ss;
    __syncthreads();
    const float tot = (SS[it * 32 + r] + SS[64 + it * 32 + r]) + (SS[128 + it * 32 + r] + SS[192 + it * 32 + r]);
    const float rstd = __builtin_amdgcn_rsqf(tot * (1.0f / 128.0f) + 1e-6f);
#pragma unroll
    for (int g4 = 0; g4 < 4; ++g4) {
        const int dv0 = dvt * 32 + 8 * g4 + 4 * hi;
        const f32x4 gn = gnv[g4];
        const u32x2 gr = grv[g4];
        u32x2 w;
        w.x = pk2(o[4 * g4] * rstd * gn[0] * pg8::bflo(gr.x), o[4 * g4 + 1] * rstd * gn[1] * pg8::bfhi(gr.x));
        w.y = pk2(o[4 * g4 + 2] * rstd * gn[2] * pg8::bflo(gr.y), o[4 * g4 + 3] * rstd * gn[3] * pg8::bfhi(gr.y));
        *(u32x2*)(yb + (size_t)row * 512 + h * 128 + dv0) = w;
    }
    __syncthreads();
}

constexpr int DUMP_OFF = 131072 + 2048;
__device__ __forceinline__ void prefetch_tile(const bf16* base, int ld, int pm, int pn, LAS unsigned char* lds, int wave, int lane) {
    const bf16* p = base + (size_t)(pm * 256 + wave * 32 + (lane >> 5)) * ld + pn * 256 + (lane & 31) * 8;
#pragma unroll 2
    for (int i = 0; i < 16; ++i, p += 2 * (size_t)ld)
        __builtin_amdgcn_global_load_lds((const unsigned*)p, (LAS unsigned*)(lds + DUMP_OFF + wave * 1024), 16, 0, 0);
}

__global__ void __launch_bounds__(512, 2) mega_fwd(Params P) {
    extern __shared__ __attribute__((aligned(16))) unsigned char lds_raw[];
    LAS unsigned char* lds = (LAS unsigned char*)lds_raw;
    cg::grid_group grid = cg::this_grid();
    const int tid = threadIdx.x, lane = tid & 63, wave = __builtin_amdgcn_readfirstlane(tid >> 6), G = gridDim.x;
    unsigned char* ws = P.ws;
    const int lo = P.ph_lo, hi = P.ph_hi;
    if (tid < 64) ((LAS unsigned*)(lds + MISC_OFF))[tid] = 0u;
    __syncthreads();
    XcdBarrier bar = xcd_barrier_post((unsigned*)(ws + WS_CTL), (volatile LAS unsigned*)(lds + MISC_OFF) + 8);
#define IN(k) (lo <= (k) && (k) < hi)
#define GSYNC() do { if (P.cg_sync) grid.sync(); else xcd_barrier(bar); } while (0)
#if defined(MK_TPROBE)
#define STAMP(i) do { if (blockIdx.x == 0 && tid == 0) ((volatile LAS unsigned long long*)(lds + MISC_OFF + 64))[(i)] = __builtin_amdgcn_s_memrealtime(); } while (0)
#else
#define STAMP(i) do { } while (0)
#endif
#define SEAM(k) do { if (IN(k) && IN((k) + 1)) GSYNC(); STAMP((k) + 1); } while (0)
#define DUPQ(k) ((MK_DUP >> (k)) & 1)
    bf16* hb = (bf16*)(ws + WS_HB); float* ssp = (float*)(ws + WS_SSP); bf16* R1 = (bf16*)(ws + WS_R1);

    STAMP(0);
    if (IN(0)) {
        p0_prep(P, lds, wave, lane, G);
#if (MK_DUP >> 0) & 1
        GSYNC();
        p0_prep(P, lds, wave, lane, G);
#endif
    }
    SEAM(0);
    if (IN(1)) {
        {
        meta_p1(P, wave, lane, G);
        prep_items(P, 2 * I_GU + (int)blockIdx.x * 8 + wave, IT_P0, G * 8, (LAS unsigned*)(lds + wave * 16384), lane); __syncthreads();
        pg8::Gemm g{hb, (const bf16*)(ws + WS_WGU1), NFR, NGU, D}; pg8::StaticOrder S; S.init(NFR, NGU, G, (int)blockIdx.x);
        pg8::EpiSwiglu E{R1, ssp};
        pg8::gemm_phase<pg8::EpiSwiglu, pg8::StaticOrder, true, true>(lds, g, S, E);
    }
#if (MK_DUP >> 1) & 1
        GSYNC();
        {
        meta_p1(P, wave, lane, G);
        prep_items(P, 2 * I_GU + (int)blockIdx.x * 8 + wave, IT_P0, G * 8, (LAS unsigned*)(lds + wave * 16384), lane); __syncthreads();
        pg8::Gemm g{hb, (const bf16*)(ws + WS_WGU1), NFR, NGU, D}; pg8::StaticOrder S; S.init(NFR, NGU, G, (int)blockIdx.x);
        pg8::EpiSwiglu E{R1, ssp};
        pg8::gemm_phase<pg8::EpiSwiglu, pg8::StaticOrder, true, true>(lds, g, S, E);
    }
#endif
    }
    SEAM(1);
    if (IN(2)) {
        {
        meta_p2(P, lds, wave, lane);
        pg8::Gemm g{R1, (const bf16*)(ws + WS_WD1), NFR, D, FF}; pg8::StaticOrder S; S.init(NFR, D, G, (int)blockIdx.x);
        pg8::EpiResid<false> E{hb, nullptr, ssp, 0.5f};
        pg8::gemm_phase<pg8::EpiResid<false>, pg8::StaticOrder, true, true>(lds, g, S, E);
    }
#if (MK_DUP >> 2) & 1
        GSYNC();
        {
        meta_p2(P, lds, wave, lane);
        pg8::Gemm g{R1, (const bf16*)(ws + WS_WD1), NFR, D, FF}; pg8::StaticOrder S; S.init(NFR, D, G, (int)blockIdx.x);
        pg8::EpiResid<false> E{hb, nullptr, ssp, 0.5f};
        pg8::gemm_phase<pg8::EpiResid<false>, pg8::StaticOrder, true, true>(lds, g, S, E);
    }
#endif
    }
    SEAM(2);
    if (IN(3)) {
        {
        meta_p3(P, wave, lane, G);
        pg8::Gemm g{hb, (const bf16*)(ws + WS_WIN), NFR, NIN, D}; pg8::StaticOrder S; S.init(NFR, NIN, G, (int)blockIdx.x);
        pg8::EpiIn E{R1, (float*)(ws + WS_GLOW), ssp};
        pg8::gemm_phase<pg8::EpiIn, pg8::StaticOrder, true, true>(lds, g, S, E);
    }
#if (MK_DUP >> 3) & 1
        GSYNC();
        {
        meta_p3(P, wave, lane, G);
        pg8::Gemm g{hb, (const bf16*)(ws + WS_WIN), NFR, NIN, D}; pg8::StaticOrder S; S.init(NFR, NIN, G, (int)blockIdx.x);
        pg8::EpiIn E{R1, (float*)(ws + WS_GLOW), ssp};
        pg8::gemm_phase<pg8::EpiIn, pg8::StaticOrder, true, true>(lds, g, S, E);
    }
#endif
    }
    SEAM(3);
    if (IN(4)) {
        {
        { GlaLd gl; int it = blockIdx.x;
          if (it < 1032) gla_load<true>(P, gl, (it / 129) >> 2, (it / 129) & 3, it % 129, tid);
          while (it < 1032) { const int nx = it + G, ld = nx < 1032 ? nx : it;
              gla_stage<true>(lds, gl, tid); float gw[16];
#pragma unroll
              for (int q = 0; q < 16; ++q) gw[q] = gl.gw[q];
              const float bias = gl.bias;
              __syncthreads();
              gla_load<true>(P, gl, (ld / 129) >> 2, (ld / 129) & 3, ld % 129, tid);
              gla_kv_item(P, lds, it, gw, bias, tid, wave, lane); it = nx; } }
        { const int bx = blockIdx.x, vcu = (G % 8 == 0) ? (bx % 8) * (G / 8) + bx / 8 : bx;
          for (int it = vcu; it < 512; it += G) attn_item(P, lds, it, tid, wave, lane); }
#if defined(MK_DUPA)
        for (int it = blockIdx.x; it < 512; it += G) attn_item(P, lds, it, tid, wave, lane);
#endif
    }
#if (MK_DUP >> 4) & 1
        GSYNC();
        {
        { const int bx = blockIdx.x, vcu = (G % 8 == 0) ? (bx % 8) * (G / 8) + bx / 8 : bx;
          for (int it = vcu; it < 512; it += G) attn_item(P, lds, it, tid, wave, lane); }
        { GlaLd gl; int it = blockIdx.x;
          if (it < 1032) gla_load<true>(P, gl, (it / 129) >> 2, (it / 129) & 3, it % 129, tid);
          while (it < 1032) { const int nx = it + G, ld = nx < 1032 ? nx : it;
              gla_stage<true>(lds, gl, tid); float gw[16];
#pragma unroll
              for (int q = 0; q < 16; ++q) gw[q] = gl.gw[q];
              const float bias = gl.bias;
              __syncthreads();
              gla_load<true>(P, gl, (ld / 129) >> 2, (ld / 129) & 3, ld % 129, tid);
              gla_kv_item(P, lds, it, gw, bias, tid, wave, lane); it = nx; } }
    }
#endif
    }
    SEAM(4);
    if (IN(5)) {
        { gla_scan(P, wave, lane, G);
          if (wave >= 4) prep_items(P, IT_P0 + (wave - 4) * G + (int)blockIdx.x, IT_END, 4 * G, (LAS unsigned*)(lds + wave * 16384), lane); }
#if (MK_DUP >> 5) & 1
        GSYNC();
        { gla_scan(P, wave, lane, G);
          if (wave >= 4) prep_items(P, IT_P0 + (wave - 4) * G + (int)blockIdx.x, IT_END, 4 * G, (LAS unsigned*)(lds + wave * 16384), lane); }
#endif
    }
    SEAM(5);
    if (IN(6)) {
        { GlaLd gl; int it = blockIdx.x;
          if (it < 1024) gla_load<false>(P, gl, (it >> 7) >> 2, (it >> 7) & 3, (it & 127) + 1, tid);
          while (it < 1024) { const int nx = it + G, ld = nx < 1024 ? nx : it;
              gla_stage<false>(lds, gl, tid); float gw[16];
#pragma unroll
              for (int q = 0; q < 16; ++q) gw[q] = gl.gw[q];
              const float bias = gl.bias;
              __syncthreads();
              gla_load<false>(P, gl, (ld >> 7) >> 2, (ld >> 7) & 3, (ld & 127) + 1, tid);
              gla_out_item(P, lds, it, gw, bias, tid, wave, lane); it = nx; } }
#if (MK_DUP >> 6) & 1
        GSYNC();
        { GlaLd gl; int it = blockIdx.x;
          if (it < 1024) gla_load<false>(P, gl, (it >> 7) >> 2, (it >> 7) & 3, (it & 127) + 1, tid);
          while (it < 1024) { const int nx = it + G, ld = nx < 1024 ? nx : it;
              gla_stage<false>(lds, gl, tid); float gw[16];
#pragma unroll
              for (int q = 0; q < 16; ++q) gw[q] = gl.gw[q];
              const float bias = gl.bias;
              __syncthreads();
              gla_load<false>(P, gl, (ld >> 7) >> 2, (ld >> 7) & 3, (ld & 127) + 1, tid);
              gla_out_item(P, lds, it, gw, bias, tid, wave, lane); it = nx; } }
#endif
    }
    SEAM(6);
    if (IN(7)) {
        {
        bf16* mixed = (bf16*)(ws + WS_KV);
        { pg8::Gemm g{(const bf16*)P.out, (const bf16*)(ws + WS_WA), NFR, D, 512}; pg8::StaticOrder S; S.init(NFR, D, G, (int)blockIdx.x);
          pg8::EpiMix<false> E{(const unsigned char*)R1 + 4608, mixed};
          pg8::gemm_phase<pg8::EpiMix<false>, pg8::StaticOrder, true, true>(lds, g, S, E); }
        { pg8::Gemm g{(const bf16*)P.out + (size_t)NFR * 512, (const bf16*)(ws + WS_WB), NFR, D, 512}; pg8::StaticOrder S; S.init(NFR, D, G, (int)blockIdx.x);
          pg8::EpiMix<true> E{(const unsigned char*)R1 + 4608 + 1024, mixed};
          pg8::gemm_phase<pg8::EpiMix<true>, pg8::StaticOrder, true, true>(lds, g, S, E); }
    }
#if (MK_DUP >> 7) & 1
        GSYNC();
        {
        bf16* mixed = (bf16*)(ws + WS_KV);
        { pg8::Gemm g{(const bf16*)P.out, (const bf16*)(ws + WS_WA), NFR, D, 512}; pg8::StaticOrder S; S.init(NFR, D, G, (int)blockIdx.x);
          pg8::EpiMix<false> E{(const unsigned char*)R1 + 4608, mixed};
          pg8::gemm_phase<pg8::EpiMix<false>, pg8::StaticOrder, true, true>(lds, g, S, E); }
        { pg8::Gemm g{(const bf16*)P.out + (size_t)NFR * 512, (const bf16*)(ws + WS_WB), NFR, D, 512}; pg8::StaticOrder S; S.init(NFR, D, G, (int)blockIdx.x);
          pg8::EpiMix<true> E{(const unsigned char*)R1 + 4608 + 1024, mixed};
          pg8::gemm_phase<pg8::EpiMix<true>, pg8::StaticOrder, true, true>(lds, g, S, E); }
    }
#endif
    }
    SEAM(7);
    if (IN(8)) {
        {
        pg8::Gemm g{(const bf16*)(ws + WS_KV), (const bf16*)(ws + WS_WOUT), NFR, D, D}; pg8::StaticOrder S; S.init(NFR, D, G, (int)blockIdx.x);
#if defined(MK_DRY8)
        { pg8::EpiResid<false> E0{hb, nullptr, ssp, 0.0f}; pg8::gemm_phase<pg8::EpiResid<false>, pg8::StaticOrder, true, true>(lds, g, S, E0); GSYNC(); }
#endif
        pg8::EpiResid<false> E{hb, nullptr, ssp, 1.0f};
        pg8::gemm_phase<pg8::EpiResid<false>, pg8::StaticOrder, true, true>(lds, g, S, E);
    }
#if (MK_DUP >> 8) & 1
        GSYNC();
        {
        pg8::Gemm g{(const bf16*)(ws + WS_KV), (const bf16*)(ws + WS_WOUT), NFR, D, D}; pg8::StaticOrder S; S.init(NFR, D, G, (int)blockIdx.x);
        pg8::EpiResid<false> E{hb, nullptr, ssp, 1.0f};
        pg8::gemm_phase<pg8::EpiResid<false>, pg8::StaticOrder, true, true>(lds, g, S, E);
    }
#endif
    }
    SEAM(8);
    if (IN(9)) {
        {
        pg8::Gemm g{hb, (const bf16*)(ws + WS_WGU2), NFR, NGU, D}; pg8::StaticOrder S; S.init(NFR, NGU, G, (int)blockIdx.x);
        pg8::EpiSwiglu E{R1, ssp};
        pg8::gemm_phase<pg8::EpiSwiglu, pg8::StaticOrder, true, true>(lds, g, S, E);
    }
#if (MK_DUP >> 9) & 1
        GSYNC();
        {
        pg8::Gemm g{hb, (const bf16*)(ws + WS_WGU2), NFR, NGU, D}; pg8::StaticOrder S; S.init(NFR, NGU, G, (int)blockIdx.x);
        pg8::EpiSwiglu E{R1, ssp};
        pg8::gemm_phase<pg8::EpiSwiglu, pg8::StaticOrder, true, true>(lds, g, S, E);
    }
#endif
    }
    SEAM(9);
    if (IN(10)) {
        {
        pg8::Gemm g{R1, (const bf16*)(ws + WS_WD2), NFR, D, FF}; pg8::StaticOrder S; S.init(NFR, D, G, (int)blockIdx.x);
#if defined(MK_DRY10)
        { pg8::EpiResid<false> E0{hb, nullptr, ssp, 0.0f}; pg8::gemm_phase<pg8::EpiResid<false>, pg8::StaticOrder, true, true>(lds, g, S, E0); GSYNC(); }
#endif
        if (S.nwg == G) { pg8::EpiFinal E{hb, P.out, ssp, (unsigned*)(ws + WS_CTL) + 4096, P.in[19], 0.5f};
            pg8::gemm_phase<pg8::EpiFinal, pg8::StaticOrder, false, true>(lds, g, S, E); }
        else { pg8::EpiResid<true> E{hb, P.out, ssp, 0.5f};
            pg8::gemm_phase<pg8::EpiResid<true>, pg8::StaticOrder, true, true>(lds, g, S, E); }
    }
#if (MK_DUP >> 10) & 1
        GSYNC();
        {
        pg8::Gemm g{R1, (const bf16*)(ws + WS_WD2), NFR, D, FF}; pg8::StaticOrder S; S.init(NFR, D, G, (int)blockIdx.x);
        if (S.nwg == G) { pg8::EpiFinal E{hb, P.out, ssp, (unsigned*)(ws + WS_CTL) + 4096, P.in[19], 0.5f};
            pg8::gemm_phase<pg8::EpiFinal, pg8::StaticOrder, false, true>(lds, g, S, E); }
        else { pg8::EpiResid<true> E{hb, P.out, ssp, 0.5f};
            pg8::gemm_phase<pg8::EpiResid<true>, pg8::StaticOrder, true, true>(lds, g, S, E); }
    }
#endif
    }
    if (G != 256) SEAM(10); else STAMP(11);
    if (IN(11)) {
        {
        const int gw = blockIdx.x * 8 + wave, NGW = G * 8;
        for (int m = gw; m < (G == 256 ? 0 : NFR); m += NGW) {
            f32x4* rowp = (f32x4*)(P.out + (size_t)m * D) + lane;
            float s = ssp[(size_t)m * 16 + (lane & 15)];
            s += __shfl_xor(s, 1); s += __shfl_xor(s, 2); s += __shfl_xor(s, 4); s += __shfl_xor(s, 8);
            const float rs = __builtin_amdgcn_rsqf(s * (1.0f / 1024.0f) + 1e-6f);
#pragma unroll
            for (int j = 0; j < 4; ++j) { const f32x4 gn = ((const f32x4*)P.in[19])[lane + 64 * j]; f32x4 v = rowp[64 * j]; rowp[64 * j] = v * rs * gn; }
        }
    }
#if (MK_DUP >> 11) & 1
        GSYNC();
        {
        const int gw = blockIdx.x * 8 + wave, NGW = G * 8;
        for (int m = gw; m < (G == 256 ? 0 : NFR); m += NGW) {
            f32x4* rowp = (f32x4*)(P.out + (size_t)m * D) + lane;
            float s = ssp[(size_t)m * 16 + (lane & 15)];
            s += __shfl_xor(s, 1); s += __shfl_xor(s, 2); s += __shfl_xor(s, 4); s += __shfl_xor(s, 8);
            const float rs = __builtin_amdgcn_rsqf(s * (1.0f / 1024.0f) + 1e-6f);
#pragma unroll
            for (int j = 0; j < 4; ++j) { const f32x4 gn = ((const f32x4*)P.in[19])[lane + 64 * j]; f32x4 v = rowp[64 * j]; rowp[64 * j] = v * rs * gn; }
        }
    }
#endif
    }
#if defined(MK_TPROBE)
    STAMP(12);
    if (blockIdx.x == 0 && tid == 0) { volatile LAS unsigned long long* ts = (volatile LAS unsigned long long*)(lds + MISC_OFF + 64);
        const unsigned long long dt = ts[MK_TPROBE + 1] - ts[MK_TPROBE], t0 = __builtin_amdgcn_s_memrealtime();
        while (__builtin_amdgcn_s_memrealtime() - t0 < dt) __builtin_amdgcn_s_sleep(4); }
#endif
#if defined(MK_XSYNC)
    for (int xs_ = 0; xs_ < MK_XSYNC; ++xs_) GSYNC();
#endif
#undef IN
#undef SEAM
}

extern "C" void kernel_launch(void* const* d_in, const int* in_sizes, int n_in, void* d_out, int out_size, void* d_ws, size_t ws_size, hipStream_t stream) {
    static int grid = 0;
    if (grid == 0) {
        if (n_in != 20 || out_size != NFR * D || ws_size < WS_END) { fprintf(stderr, "kernel_launch: unexpected shapes (n_in %d out %d ws %zu)\n", n_in, out_size, ws_size); grid = -1; return; }
        int dev = 0, cus = 0, per_cu = 0;
        hipGetDevice(&dev); hipDeviceGetAttribute(&cus, hipDeviceAttributeMultiprocessorCount, dev);
        if (hipFuncSetAttribute((const void*)mega_fwd, hipFuncAttributeMaxDynamicSharedMemorySize, LDS_BYTES) != hipSuccess) { fprintf(stderr, "kernel_launch: hipFuncSetAttribute failed\n"); grid = -1; return; }
        if (hipOccupancyMaxActiveBlocksPerMultiprocessor(&per_cu, (const void*)mega_fwd, 512, LDS_BYTES) != hipSuccess || per_cu < 1) { fprintf(stderr, "kernel_launch: occupancy query failed (%d)\n", per_cu); (void)hipGetLastError(); grid = -1; return; }
        grid = cus * per_cu;
        fprintf(stderr, "kernel_launch: %d CUs x %d blocks -> grid %d\n", cus, per_cu, grid);
    }
    if (grid < 0) return;
    Params p{};
    for (int i = 0; i < 20; ++i) p.in[i] = (const float*)d_in[i];
    p.out = (float*)d_out; p.ws = (unsigned char*)d_ws; p.cg_sync = 0; p.pad = 0;
    if (hipMemsetAsync((char*)d_ws + WS_CTL, 0, CTL_BYTES, stream) != hipSuccess) { fprintf(stderr, "kernel_launch: hipMemsetAsync failed\n"); return; }
#if MK_PER_PHASE
    for (int ph = 0; ph < NPH; ++ph) { p.ph_lo = ph; p.ph_hi = ph + 1; hipLaunchKernelGGL(mega_fwd, dim3(grid), dim3(512), LDS_BYTES, stream, p); }
#else
    p.ph_lo = 0; p.ph_hi = NPH;
    void* args[] = {&p};
    hipError_t e = hipLaunchCooperativeKernel((const void*)mega_fwd, dim3(grid), dim3(512), args, LDS_BYTES, stream);
    if (e != hipSuccess) fprintf(stderr, "kernel_launch: cooperative launch failed: %s (grid %d)\n", hipGetErrorString(e), grid);
#endif
}
```

```cpp
#include <hip/hip_runtime.h>
#include <hip/hip_cooperative_groups.h>
#include <cstdio>
#include <cstdint>
namespace cg = cooperative_groups;
namespace pg8 {
#define PG8_LAS __attribute__((address_space(3)))
typedef unsigned short bf16_t;
typedef short bf16x8 __attribute__((ext_vector_type(8)));
typedef float f32x4 __attribute__((ext_vector_type(4)));
typedef unsigned u32x4 __attribute__((ext_vector_type(4)));
constexpr int BM = 256, BK = 64, HALF = 128, HTB = HALF * BK * 2  , STAGE_BYTES = 8 * HTB, NXCD = 8, WGM = 8;

__host__ __device__ __forceinline__ int lds_byte(int r, int c) { const int st = (r >> 4) * 2 + (c >> 5), rr = r & 15, cc = c & 31, ob = rr * 64 + cc * 2; return st * 1024 + (ob ^ (((ob >> 9) & 1) << 5)); }
__host__ __device__ __forceinline__ void stage_rc(int b, int& R, int& C) { const int st = b / 1024, sb = b % 1024, swz = sb ^ (((sb >> 9) & 1) << 5); R = (st >> 1) * 16 + swz / 64; C = (st & 1) * 32 + (swz % 64) / 2; }
__host__ __device__ __forceinline__ int perm32(int rho) { const int n = rho >> 4, i = rho & 15; return 8 * (i >> 2) + 4 * n + (i & 3); }

struct Unit { int pm, pn; };
struct Gemm { const bf16_t* A; const bf16_t* Bt; int M, N, K; };

struct StaticOrder {
    int nM, nN, nwg, G, c, wgm;
    __host__ __device__ void init(int M, int N, int G_, int c_, int wgm_ = 4) { nM = M / BM; nN = N / BM; nwg = nM * nN; G = G_; c = c_; wgm = wgm_; }
    __host__ __device__ __forceinline__ bool next(int i, Unit& u) const {
        const long L = (long)i * G + c; if (L >= nwg) return false;
        int wgid = (int)L; { const int q = nwg / NXCD, r = nwg % NXCD, xcd = wgid % NXCD, off = wgid / NXCD; wgid = (xcd < r ? xcd * (q + 1) : r * (q + 1) + (xcd - r) * q) + off; }
        const int nig = wgm * nN, gid = wgid / nig, fm = gid * wgm, gsz = (nM - fm) < wgm ? (nM - fm) : wgm;
        u.pm = fm + ((wgid % nig) % gsz); u.pn = (wgid % nig) / gsz; return true;
    }
    __device__ __forceinline__ void a_ready(const Unit&) const {}
    __device__ __forceinline__ void done(const Unit&) const {}
};

__device__ __forceinline__ unsigned cvt_pk_bf16(float lo, float hi) { unsigned r; asm volatile("v_cvt_pk_bf16_f32 %0, %1, %2" : "=v"(r) : "v"(lo), "v"(hi)); return r; }
typedef float f32x2 __attribute__((ext_vector_type(2)));
constexpr int XD = 1024, XFF = 2816, XPBW = 4352, XNFR = 16384;
__device__ __forceinline__ float row_rstd(const float* ssp, int row, int fq) {
    const f32x4 p = *(const f32x4*)(ssp + (size_t)row * 16 + 4 * fq);
    float s = (p[0] + p[1]) + (p[2] + p[3]);
    s += __shfl_xor(s, 16); s += __shfl_xor(s, 32);
    return __builtin_amdgcn_rsqf(s * (1.0f / 1024.0f) + 1e-6f);
}
__device__ __forceinline__ float sigm(float x) { return __builtin_amdgcn_rcpf(1.0f + __expf(-x)); }
__device__ __forceinline__ float bf2f(unsigned short b) { return __uint_as_float((unsigned)b << 16); }
__device__ __forceinline__ float bflo(unsigned w) { return __uint_as_float(w << 16); }
__device__ __forceinline__ float bfhi(unsigned w) { return __uint_as_float(w & 0xffff0000u); }

struct EpiSwiglu {
    static constexpr bool PERM = true, AFTER_DRAIN = false;
    bf16_t* O; const float* ssp;
    __device__ __forceinline__ void operator()(const f32x4 (&acc)[2][2][4][2], const Unit& u, int wr, int wc, int fr, int fq) const {
        const int row0 = u.pm * BM + wr * 64 + fr, col0 = u.pn * HALF + wc * 32 + 8 * fq;
        float rsv[2][4];
#pragma unroll
        for (int ai = 0; ai < 2; ++ai)
#pragma unroll
            for (int m = 0; m < 4; ++m) rsv[ai][m] = row_rstd(ssp, row0 + ai * HALF + m * 16, fq);
#pragma unroll
        for (int ai = 0; ai < 2; ++ai)
#pragma unroll
            for (int m = 0; m < 4; ++m) {
                const int row = row0 + ai * HALF + m * 16; const float rs = rsv[ai][m];
                const f32x4 g0 = acc[ai][0][m][0] * rs, g1 = acc[ai][0][m][1] * rs, u0 = acc[ai][1][m][0] * rs, u1 = acc[ai][1][m][1] * rs;
                u32x4 w;
                w.x = cvt_pk_bf16(g0[0] * sigm(g0[0]) * u0[0], g0[1] * sigm(g0[1]) * u0[1]);
                w.y = cvt_pk_bf16(g0[2] * sigm(g0[2]) * u0[2], g0[3] * sigm(g0[3]) * u0[3]);
                w.z = cvt_pk_bf16(g1[0] * sigm(g1[0]) * u1[0], g1[1] * sigm(g1[1]) * u1[1]);
                w.w = cvt_pk_bf16(g1[2] * sigm(g1[2]) * u1[2], g1[3] * sigm(g1[3]) * u1[3]);
                *(u32x4*)(O + (size_t)row * XFF + col0) = w;
            }
    }
};

template <bool FOUT> struct EpiResid {
    static constexpr bool PERM = false, AFTER_DRAIN = false;
    bf16_t* hb; float* out; float* ssp; float scale;
    __device__ __forceinline__ void operator()(const f32x4 (&acc)[2][2][4][2], const Unit& u, int wr, int wc, int fr, int fq) const {
        typedef unsigned u32x2v __attribute__((ext_vector_type(2)));
        const int row0 = u.pm * BM + wr * 64 + fr, col0 = u.pn * BM + wc * 32 + 4 * fq;
#pragma unroll
        for (int ai = 0; ai < 2; ++ai)
#pragma unroll
            for (int m = 0; m < 4; ++m) {
                const int row = row0 + ai * HALF + m * 16;
                float sq = 0.f;
#pragma unroll
                for (int bj = 0; bj < 2; ++bj)
#pragma unroll
                    for (int n = 0; n < 2; ++n) {
                        const int c = col0 + bj * HALF + n * 16;
                        const u32x2v b = *(const u32x2v*)(hb + (size_t)row * XD + c);
                        const f32x4 v = (f32x4){bflo(b.x), bfhi(b.x), bflo(b.y), bfhi(b.y)} + acc[ai][bj][m][n] * scale;
                        sq += (v[0] * v[0] + v[1] * v[1]) + (v[2] * v[2] + v[3] * v[3]);
                        if (FOUT) *(f32x4*)(out + (size_t)row * XD + c) = v;
                        else { u32x2v w; w.x = cvt_pk_bf16(v[0], v[1]); w.y = cvt_pk_bf16(v[2], v[3]); *(u32x2v*)(hb + (size_t)row * XD + c) = w; }
                    }
                sq += __shfl_xor(sq, 16); sq += __shfl_xor(sq, 32);
                if (fq == 0) ssp[(size_t)row * 16 + u.pn * 4 + wc] = sq;
            }
    }
};
struct EpiFinal {
    static constexpr bool PERM = false, AFTER_DRAIN = true;
    const bf16_t* hb; float* out; float* ssp; unsigned* cnt; const float* gain; float scale;
    __device__ __forceinline__ void operator()(const f32x4 (&)[2][2][4][2], const Unit&, int, int, int, int) const {}
    __device__ __forceinline__ void fused(f32x4 (&acc)[2][2][4][2], const Unit& u, int wr, int wc, int fr, int fq, PG8_LAS unsigned char*, int, int lane) const {
        typedef unsigned u32x2v __attribute__((ext_vector_type(2)));
        const int row0 = u.pm * BM + wr * 64 + fr, col0 = u.pn * BM + wc * 32 + 4 * fq;
#pragma unroll
        for (int ai = 0; ai < 2; ++ai)
#pragma unroll
            for (int m = 0; m < 4; ++m) {
                const int row = row0 + ai * HALF + m * 16;
                float sq = 0.f;
#pragma unroll
                for (int bj = 0; bj < 2; ++bj)
#pragma unroll
                    for (int n = 0; n < 2; ++n) {
                        const u32x2v b = *(const u32x2v*)(hb + (size_t)row * XD + col0 + bj * HALF + n * 16);
                        const f32x4 v = (f32x4){bflo(b.x), bfhi(b.x), bflo(b.y), bfhi(b.y)} + acc[ai][bj][m][n] * scale;
                        sq += (v[0] * v[0] + v[1] * v[1]) + (v[2] * v[2] + v[3] * v[3]);
                        acc[ai][bj][m][n] = v;
                    }
                sq += __shfl_xor(sq, 16); sq += __shfl_xor(sq, 32);
                if (fq == 0) __hip_atomic_store(ssp + (size_t)row * 16 + u.pn * 4 + wc, sq, __ATOMIC_RELAXED, __HIP_MEMORY_SCOPE_AGENT);
            }
        asm volatile("s_waitcnt vmcnt(0)" ::: "memory");
        unsigned* c = cnt + 64 * u.pm;
        if (lane == 0) __hip_atomic_fetch_add(c, 1u, __ATOMIC_RELAXED, __HIP_MEMORY_SCOPE_AGENT);
        for (unsigned sp = 0; sp < (1u << 20); ++sp) {
            if ((unsigned)__builtin_amdgcn_readfirstlane((int)__hip_atomic_load(c, __ATOMIC_RELAXED, __HIP_MEMORY_SCOPE_AGENT)) >= 32u) break;
            __builtin_amdgcn_s_sleep(2);
        }
        __builtin_amdgcn_fence(__ATOMIC_ACQUIRE, "agent");
        f32x4 gn[2][2];
#pragma unroll
        for (int bj = 0; bj < 2; ++bj)
#pragma unroll
            for (int n = 0; n < 2; ++n) gn[bj][n] = *(const f32x4*)(gain + col0 + bj * HALF + n * 16);
#pragma unroll
        for (int ai = 0; ai < 2; ++ai)
#pragma unroll
            for (int m = 0; m < 4; ++m) {
                const int row = row0 + ai * HALF + m * 16;
                const float* sp4 = ssp + (size_t)row * 16 + 4 * fq;
                float s = (__hip_atomic_load(sp4, __ATOMIC_RELAXED, __HIP_MEMORY_SCOPE_AGENT) + __hip_atomic_load(sp4 + 1, __ATOMIC_RELAXED, __HIP_MEMORY_SCOPE_AGENT))
                        + (__hip_atomic_load(sp4 + 2, __ATOMIC_RELAXED, __HIP_MEMORY_SCOPE_AGENT) + __hip_atomic_load(sp4 + 3, __ATOMIC_RELAXED, __HIP_MEMORY_SCOPE_AGENT));
                s += __shfl_xor(s, 16); s += __shfl_xor(s, 32);
                const float rs = __builtin_amdgcn_rsqf(s * (1.0f / 1024.0f) + 1e-6f);
#pragma unroll
                for (int bj = 0; bj < 2; ++bj)
#pragma unroll
                    for (int n = 0; n < 2; ++n) __builtin_nontemporal_store(acc[ai][bj][m][n] * rs * gn[bj][n], (f32x4*)(out + (size_t)row * XD + col0 + bj * HALF + n * 16));
            }
    }
};

struct EpiIn {
    static constexpr bool PERM = true, AFTER_DRAIN = false;
    bf16_t* PB; float* glow; const float* ssp;
    __device__ __forceinline__ void operator()(const f32x4 (&acc)[2][2][4][2], const Unit& u, int wr, int wc, int fr, int fq) const {
        const int row0 = u.pm * BM + wr * 64 + fr, tile = u.pn;
        if (tile == 17) {
            if (wc == 0 && fq < 2) {
#pragma unroll
                for (int ai = 0; ai < 2; ++ai)
#pragma unroll
                    for (int m = 0; m < 4; ++m) {
                        const int row = row0 + ai * HALF + m * 16;
                        const f32x4 p = *(const f32x4*)(ssp + (size_t)row * 16), q = *(const f32x4*)(ssp + (size_t)row * 16 + 4), r = *(const f32x4*)(ssp + (size_t)row * 16 + 8), t = *(const f32x4*)(ssp + (size_t)row * 16 + 12);
                        const float s = (((p[0] + p[1]) + (p[2] + p[3])) + ((q[0] + q[1]) + (q[2] + q[3]))) + (((r[0] + r[1]) + (r[2] + r[3])) + ((t[0] + t[1]) + (t[2] + t[3])));
                        const float rs = __builtin_amdgcn_rsqf(s * (1.0f / 1024.0f) + 1e-6f);
                        *(f32x4*)(glow + (size_t)row * 16 + 8 * fq) = acc[ai][0][m][0] * rs;
                        *(f32x4*)(glow + (size_t)row * 16 + 8 * fq + 4) = acc[ai][0][m][1] * rs;
                    }
            }
            return;
        }
        const int mode = (tile <= 1 || tile == 3) ? 1 : (tile == 7 || tile == 8) ? 2 : (tile >= 9 ? 3 : 0);
        const int col0 = tile * BM + wc * 32 + 8 * fq;
        float rsv[2][4];
#pragma unroll
        for (int ai = 0; ai < 2; ++ai)
#pragma unroll
            for (int m = 0; m < 4; ++m) rsv[ai][m] = row_rstd(ssp, row0 + ai * HALF + m * 16, fq);
#pragma unroll
        for (int ai = 0; ai < 2; ++ai)
#pragma unroll
            for (int m = 0; m < 4; ++m) {
                const int row = row0 + ai * HALF + m * 16; const float rs = rsv[ai][m];
#pragma unroll
                for (int bj = 0; bj < 2; ++bj) {
                    f32x4 v0 = acc[ai][bj][m][0] * rs, v1 = acc[ai][bj][m][1] * rs;
                    if (mode == 1) { v0 = v0 * 0.125f; v1 = v1 * 0.125f; }
                    else if (mode == 2) {
#pragma unroll
                        for (int j = 0; j < 4; ++j) { v0[j] = v0[j] * sigm(v0[j]); v1[j] = v1[j] * sigm(v1[j]); } }
                    else if (mode == 3) {
                        typedef unsigned u32x2v __attribute__((ext_vector_type(2)));
                        unsigned q[8];
#pragma unroll
                        for (int j = 0; j < 4; ++j) { q[j] = (unsigned)(sigm(v0[j]) * 255.0f + 0.5f); q[4 + j] = (unsigned)(sigm(v1[j]) * 255.0f + 0.5f); }
                        u32x2v w8; w8.x = q[0] | (q[1] << 8) | (q[2] << 16) | (q[3] << 24); w8.y = q[4] | (q[5] << 8) | (q[6] << 16) | (q[7] << 24);
                        *(u32x2v*)((unsigned char*)(PB + (size_t)row * XPBW) + 4608 + (tile - 9) * BM + bj * HALF + wc * 32 + 8 * fq) = w8;
                        continue; }
                    u32x4 w; w.x = cvt_pk_bf16(v0[0], v0[1]); w.y = cvt_pk_bf16(v0[2], v0[3]); w.z = cvt_pk_bf16(v1[0], v1[1]); w.w = cvt_pk_bf16(v1[2], v1[3]);
                    *(u32x4*)(PB + (size_t)row * XPBW + col0 + bj * HALF) = w;
                }
            }
    }
};

template <bool ADD> struct EpiMix {
    static constexpr bool PERM = true, AFTER_DRAIN = false;
    const unsigned char* gate; bf16_t* mixed;
    __device__ __forceinline__ void operator()(const f32x4 (&acc)[2][2][4][2], const Unit& u, int wr, int wc, int fr, int fq) const {
        const int row0 = u.pm * BM + wr * 64 + fr, col0 = u.pn * BM + wc * 32 + 8 * fq;
#pragma unroll
        for (int ai = 0; ai < 2; ++ai)
#pragma unroll
            for (int m = 0; m < 4; ++m) {
                const int row = row0 + ai * HALF + m * 16;
#pragma unroll
                for (int bj = 0; bj < 2; ++bj) {
                    const int c = col0 + bj * HALF;
                    typedef unsigned u32x2v __attribute__((ext_vector_type(2)));
                    const u32x2v g = *(const u32x2v*)(gate + (size_t)row * (XPBW * 2) + c);
                    const f32x4 a0 = acc[ai][bj][m][0] * (1.0f / 255.0f), a1 = acc[ai][bj][m][1] * (1.0f / 255.0f);
                    float v[8] = {(float)(g.x & 0xffu) * a0[0], (float)((g.x >> 8) & 0xffu) * a0[1], (float)((g.x >> 16) & 0xffu) * a0[2], (float)(g.x >> 24) * a0[3],
                                  (float)(g.y & 0xffu) * a1[0], (float)((g.y >> 8) & 0xffu) * a1[1], (float)((g.y >> 16) & 0xffu) * a1[2], (float)(g.y >> 24) * a1[3]};
                    if (ADD) { const u32x4 o = *(const u32x4*)(mixed + (size_t)row * XD + c);
                        v[0] += bflo(o.x); v[1] += bfhi(o.x); v[2] += bflo(o.y); v[3] += bfhi(o.y); v[4] += bflo(o.z); v[5] += bfhi(o.z); v[6] += bflo(o.w); v[7] += bfhi(o.w); }
                    u32x4 w; w.x = cvt_pk_bf16(v[0], v[1]); w.y = cvt_pk_bf16(v[2], v[3]); w.z = cvt_pk_bf16(v[4], v[5]); w.w = cvt_pk_bf16(v[6], v[7]);
                    *(u32x4*)(mixed + (size_t)row * XD + c) = w;
                }
            }
    }
};


template <class Epi, class Sched, bool ALIGN_EPI = false, bool SP2 = false>
__device__ __forceinline__ void gemm_phase(PG8_LAS unsigned char* lds, const Gemm g, const Sched& S, const Epi& E) {
    const int tid = threadIdx.x, wid = __builtin_amdgcn_readfirstlane(tid >> 6), lane = tid & 63, wr = wid >> 2, wc = wid & 3, fr = lane & 15, fq = lane >> 4;
    const int K = g.K, nt = K / BK;
    unsigned voffA[2], voffB[2];
#pragma unroll
    for (int i = 0; i < 2; ++i) { int R, C; stage_rc(tid * 16 + i * 8192, R, C); const int Rb = Epi::PERM ? ((R & ~31) + perm32(R & 31)) : R;
        voffA[i] = (unsigned)(R * K + C) * 2u; voffB[i] = (unsigned)(Rb * K + C) * 2u; }
    const size_t kstep = (size_t)(BK * 2);
    const size_t hstep = (size_t)HALF * K * 2;
    const size_t tstep = 2 * hstep;
    const unsigned ldsw = (unsigned)wid * 1024u;
    const int aoff = lds_byte(wr * 64 + fr, fq * 8), boff = lds_byte(wc * 32 + fr, fq * 8);
#define PG8_SA(b, h) (((b) * 2 + (h)) * HTB)
#define PG8_SB(b, h) ((4 + (b) * 2 + (h)) * HTB)
#define PG8_STAGE(bufoff, gbase, voff) do { _Pragma("unroll") for (int _i = 0; _i < 2; ++_i) \
        __builtin_amdgcn_global_load_lds((const unsigned*)((const char*)(gbase) + (voff)[_i]), (PG8_LAS unsigned*)(lds + (bufoff) + ldsw + _i * 8192), 16, 0, 0); } while (0)
#define PG8_LDA(dst, b, h) do { _Pragma("unroll") for (int m = 0; m < 4; ++m) _Pragma("unroll") for (int k = 0; k < 2; ++k) dst[m][k] = *(const PG8_LAS bf16x8*)(lds + PG8_SA(b, h) + aoff + m * 2048 + k * 1024); } while (0)
#define PG8_LDB(dst, b, h) do { _Pragma("unroll") for (int n = 0; n < 2; ++n) _Pragma("unroll") for (int k = 0; k < 2; ++k) dst[n][k] = *(const PG8_LAS bf16x8*)(lds + PG8_SB(b, h) + boff + n * 2048 + k * 1024); } while (0)
#define PG8_MMA(ai, bj, At, Bt) do { __builtin_amdgcn_s_setprio(1); _Pragma("unroll") for (int m = 0; m < 4; ++m) _Pragma("unroll") for (int n = 0; n < 2; ++n) _Pragma("unroll") for (int k = 0; k < 2; ++k) \
        acc[ai][bj][m][n] = __builtin_amdgcn_mfma_f32_16x16x32_bf16(Bt[n][k], At[m][k], acc[ai][bj][m][n], 0, 0, 0); __builtin_amdgcn_s_setprio(0); } while (0)
#define PG8_WAIT_V(n) asm volatile("s_waitcnt vmcnt(" #n ")" ::: "memory")
#define PG8_WAIT_L(n) asm volatile("s_waitcnt lgkmcnt(" #n ")" ::: "memory")
#define PG8_BAR __builtin_amdgcn_s_barrier()
#define PG8_SCHED __builtin_amdgcn_sched_barrier(0)
    Unit cur, nxt; int ui = 0;
    if (!S.next(0, cur)) return;
    f32x4 acc[2][2][4][2];
#pragma unroll
    for (int a = 0; a < 2; ++a)
#pragma unroll
        for (int b = 0; b < 2; ++b)
#pragma unroll
            for (int m = 0; m < 4; ++m)
#pragma unroll
                for (int n = 0; n < 2; ++n) acc[a][b][m][n] = (f32x4){0.f, 0.f, 0.f, 0.f};
    bf16x8 At[4][2], B0[2][2], B1[2][2];
    const char* cA = (const char*)g.A + (size_t)cur.pm * tstep; const char* cB = (const char*)g.Bt + (size_t)cur.pn * tstep;
    S.a_ready(cur);
    if constexpr (SP2) {
        PG8_STAGE(PG8_SB(0, 0), cB, voffB); PG8_STAGE(PG8_SB(0, 1), cB + hstep, voffB); PG8_STAGE(PG8_SA(0, 0), cA, voffA); PG8_STAGE(PG8_SA(0, 1), cA + hstep, voffA);
        if (wr == 1) PG8_BAR;
        PG8_WAIT_V(2); PG8_BAR;
        PG8_STAGE(PG8_SB(1, 0), cB + kstep, voffB); PG8_STAGE(PG8_SA(1, 0), cA + kstep, voffA); PG8_STAGE(PG8_SB(1, 1), cB + hstep + kstep, voffB);
        PG8_WAIT_V(6); PG8_BAR;
    } else {
        PG8_STAGE(PG8_SB(0, 0), cB, voffB); PG8_STAGE(PG8_SA(0, 0), cA, voffA); PG8_STAGE(PG8_SB(0, 1), cB + hstep, voffB); PG8_STAGE(PG8_SA(0, 1), cA + hstep, voffA);
        if (wr == 1) PG8_BAR;
        PG8_WAIT_V(4); PG8_BAR;
        PG8_STAGE(PG8_SB(1, 0), cB + kstep, voffB); PG8_STAGE(PG8_SA(1, 0), cA + kstep, voffA); PG8_STAGE(PG8_SB(1, 1), cB + hstep + kstep, voffB);
        PG8_WAIT_V(6); PG8_BAR;
    }
    for (;;) {
        const bool has_next = S.next(ui + 1, nxt);
        const char* nA = has_next ? (const char*)g.A + (size_t)nxt.pm * tstep : cA; const char* nB = has_next ? (const char*)g.Bt + (size_t)nxt.pn * tstep : cB;
        for (int t = 0; t < nt; t += 2) {
            const bool last = (t == nt - 2);
            const char* a1 = cA + (size_t)(t + 1) * kstep;
            const char* a2 = last ? nA : cA + (size_t)(t + 2) * kstep; const char* b2 = last ? nB : cB + (size_t)(t + 2) * kstep;
            const char* a3 = a2 + kstep; const char* b3 = b2 + kstep;
            if (last && has_next) S.a_ready(nxt);
            if constexpr (SP2) {
            PG8_LDB(B0, 0, 0); PG8_LDB(B1, 0, 1); PG8_SCHED; PG8_LDA(At, 0, 0); PG8_STAGE(PG8_SA(1, 1), a1 + hstep, voffA);
            PG8_WAIT_V(8); PG8_WAIT_L(0); PG8_BAR; PG8_MMA(0, 0, At, B0); PG8_MMA(0, 1, At, B1); PG8_BAR; PG8_SCHED;
            PG8_LDA(At, 0, 1); PG8_STAGE(PG8_SB(0, 0), b2, voffB); PG8_STAGE(PG8_SB(0, 1), b2 + hstep, voffB); PG8_STAGE(PG8_SA(0, 0), a2, voffA);
            PG8_WAIT_V(8); PG8_WAIT_L(0); PG8_BAR; PG8_MMA(1, 0, At, B0); PG8_MMA(1, 1, At, B1); PG8_BAR; PG8_SCHED;
            PG8_LDB(B0, 1, 0); PG8_LDB(B1, 1, 1); PG8_SCHED; PG8_LDA(At, 1, 0); PG8_STAGE(PG8_SA(0, 1), a2 + hstep, voffA);
            PG8_WAIT_V(8); PG8_WAIT_L(0); PG8_BAR; PG8_MMA(0, 0, At, B0); PG8_MMA(0, 1, At, B1); PG8_BAR; PG8_SCHED;
            PG8_LDA(At, 1, 1); PG8_STAGE(PG8_SB(1, 0), b3, voffB); PG8_STAGE(PG8_SB(1, 1), b3 + hstep, voffB); PG8_STAGE(PG8_SA(1, 0), a3, voffA);
            PG8_WAIT_V(8); PG8_WAIT_L(0); PG8_BAR; PG8_MMA(1, 0, At, B0); PG8_MMA(1, 1, At, B1); PG8_BAR; PG8_SCHED;
            } else {
            PG8_LDB(B0, 0, 0); PG8_SCHED; PG8_LDA(At, 0, 0); PG8_STAGE(PG8_SA(1, 1), a1 + hstep, voffA);
            PG8_WAIT_L(8); PG8_BAR; PG8_WAIT_L(0); PG8_MMA(0, 0, At, B0); PG8_BAR; PG8_SCHED;
            PG8_LDB(B1, 0, 1); PG8_STAGE(PG8_SB(0, 0), b2, voffB);
            PG8_BAR; PG8_WAIT_L(0); PG8_MMA(0, 1, At, B1); PG8_BAR;
            PG8_LDA(At, 0, 1); PG8_STAGE(PG8_SA(0, 0), a2, voffA);
            PG8_BAR; PG8_WAIT_L(0); PG8_MMA(1, 0, At, B0); PG8_BAR; PG8_SCHED;
            PG8_STAGE(PG8_SB(0, 1), b2 + hstep, voffB);
            PG8_WAIT_V(6); PG8_BAR; PG8_MMA(1, 1, At, B1); PG8_BAR;
            PG8_LDB(B0, 1, 0); PG8_SCHED; PG8_LDA(At, 1, 0); PG8_STAGE(PG8_SA(0, 1), a2 + hstep, voffA);
            PG8_WAIT_L(8); PG8_BAR; PG8_WAIT_L(0); PG8_MMA(0, 0, At, B0); PG8_BAR; PG8_SCHED;
            PG8_LDB(B1, 1, 1); PG8_STAGE(PG8_SB(1, 0), b3, voffB);
            PG8_BAR; PG8_WAIT_L(0); PG8_MMA(0, 1, At, B1); PG8_BAR;
            PG8_LDA(At, 1, 1); PG8_STAGE(PG8_SA(1, 0), a3, voffA);
            PG8_BAR; PG8_WAIT_L(0); PG8_MMA(1, 0, At, B0); PG8_BAR; PG8_SCHED;
            PG8_STAGE(PG8_SB(1, 1), b3 + hstep, voffB);
            PG8_WAIT_V(6); PG8_BAR; PG8_MMA(1, 1, At, B1); PG8_BAR;
            }
        }
        if constexpr (ALIGN_EPI) { if (wr == 0) PG8_BAR; }
        if constexpr (!Epi::AFTER_DRAIN) { E(acc, cur, wr, wc, fr, fq); S.done(cur); }
        if (!has_next) break;
#pragma unroll
        for (int a = 0; a < 2; ++a)
#pragma unroll
            for (int b = 0; b < 2; ++b)
#pragma unroll
                for (int m = 0; m < 4; ++m)
#pragma unroll
                    for (int n = 0; n < 2; ++n) acc[a][b][m][n] = (f32x4){0.f, 0.f, 0.f, 0.f};
        cur = nxt; cA = nA; cB = nB; ++ui;
        if constexpr (ALIGN_EPI) { if (wr == 1) PG8_BAR; }
    }
    PG8_WAIT_V(0);
    if constexpr (!ALIGN_EPI) { if (wr == 0) PG8_BAR; }
    PG8_BAR;
    if constexpr (Epi::AFTER_DRAIN) { E.fused(acc, cur, wr, wc, fr, fq, lds, wid, lane); S.done(cur); }
#undef PG8_SA
#undef PG8_SB
#undef PG8_STAGE
#undef PG8_LDA
#undef PG8_LDB
#undef PG8_MMA
#undef PG8_WAIT_V
#undef PG8_WAIT_L
#undef PG8_BAR
#undef PG8_SCHED
}
}
#define LAS __attribute__((address_space(3)))
#define XB_TMO      128
#define XB_XCNT(j)  (256  + 64 * (j))
#define XB_XSUB(j)  (1280 + 64 * (j))
#define XB_XGEN(j)  (2304 + 64 * (j))
#define XB_TOP      3328
#define XB_TOPGEN   3392
#define XCD_BAR_WORDS 3456
#define XB_SPIN_CAP (1u << 18)

__device__ __forceinline__ unsigned xb_ld(unsigned* p)              { return __hip_atomic_load(p, __ATOMIC_RELAXED, __HIP_MEMORY_SCOPE_AGENT); }
__device__ __forceinline__ unsigned xb_add(unsigned* p, unsigned v) { return __hip_atomic_fetch_add(p, v, __ATOMIC_RELAXED, __HIP_MEMORY_SCOPE_AGENT); }
__device__ __forceinline__ unsigned xb_xcc_id() { return (unsigned)__builtin_amdgcn_s_getreg((3 << 11) | 20) & 0xFu; }
#define XB_SPIN(cond, bar) do { unsigned _sp = 0; while (cond) { __builtin_amdgcn_s_sleep(6);   \
    if ((++_sp & 255u) == 0u) { if (xb_ld(&(bar)[XB_TMO])) break; if (_sp > XB_SPIN_CAP) { atomicAdd(&(bar)[XB_TMO], 1u); break; } } } } while (0)

struct XcdBarrier {
    unsigned* bar; unsigned x;
    volatile LAS unsigned* st;
};

__device__ __forceinline__ XcdBarrier xcd_barrier_post(unsigned* bar, volatile LAS unsigned* st) {
    XcdBarrier b; b.bar = bar; b.x = xb_xcc_id(); b.st = st;
    if (threadIdx.x == 0) (void)xb_add(&bar[XB_XCNT(b.x)], 1u);
    return b;
}
__device__ __forceinline__ void xcd_barrier_complete(unsigned* bar, unsigned x, unsigned& nloc, unsigned& nx) {
    const unsigned G = gridDim.x * gridDim.y * gridDim.z;
    unsigned sum, cnt, mine, sp = 0u;
    for (;;) {
        sum = 0u; cnt = 0u; mine = 0u;
#pragma unroll
        for (unsigned j = 0; j < 16; ++j) { const unsigned c = xb_ld(&bar[XB_XCNT(j)]); sum += c; cnt += (c > 0u) ? 1u : 0u; mine = (j == x) ? c : mine; }
        if (sum == G) break;
        __builtin_amdgcn_s_sleep(1);
        if ((++sp & 255u) == 0u) { if (xb_ld(&bar[XB_TMO])) break; if (sp > XB_SPIN_CAP) { atomicAdd(&bar[XB_TMO], 1u); break; } }
    }
    nloc = mine > 0u ? mine : 1u; nx = cnt > 0u ? cnt : 1u;
}

__device__ __forceinline__ void xcd_barrier(const XcdBarrier& b) {
    asm volatile("s_waitcnt vmcnt(0)" ::: "memory");
    __syncthreads();
    if (threadIdx.x == 0) {
        unsigned* bar = b.bar;
        __builtin_amdgcn_s_waitcnt(0);
        unsigned nloc = b.st[0], nx = b.st[1];
        if (nloc == 0u) { xcd_barrier_complete(bar, b.x, nloc, nx); b.st[0] = nloc; b.st[1] = nx; }
        const unsigned old = xb_add(&bar[XB_XSUB(b.x)], 1u);
        const unsigned gen = old / nloc;
        if (old + 1u == (gen + 1u) * nloc) {
            __builtin_amdgcn_fence(__ATOMIC_RELEASE, "agent");
            asm volatile("s_waitcnt vmcnt(0)" ::: "memory");
            const unsigned og = xb_add(&bar[XB_TOP], 1u);
            const unsigned tg = og / nx;
            if (og + 1u == (tg + 1u) * nx) xb_add(&bar[XB_TOPGEN], 1u);
            else XB_SPIN(xb_ld(&bar[XB_TOPGEN]) == tg, bar);
            __builtin_amdgcn_fence(__ATOMIC_ACQUIRE, "agent");
            xb_add(&bar[XB_XGEN(b.x)], 1u);
            asm volatile("s_waitcnt vmcnt(0)" ::: "memory");
        } else {
            XB_SPIN(xb_ld(&bar[XB_XGEN(b.x)]) == gen, bar);
            __builtin_amdgcn_fence(__ATOMIC_ACQUIRE, "agent");
            asm volatile("s_waitcnt vmcnt(0)" ::: "memory");
        }
    }
    __syncthreads();
}

#ifndef MK_DUP
#define MK_DUP 0
#endif
#ifndef MK_PER_PHASE
#define MK_PER_PHASE 0
#endif
#define LAS __attribute__((address_space(3)))
typedef unsigned short bf16;
typedef short bf16x8 __attribute__((ext_vector_type(8)));
typedef short s16x4 __attribute__((ext_vector_type(4)));
typedef float f32x4 __attribute__((ext_vector_type(4)));
typedef float f32x16 __attribute__((ext_vector_type(16)));
typedef unsigned u32x4 __attribute__((ext_vector_type(4)));
typedef unsigned u32x2 __attribute__((ext_vector_type(2)));
typedef float f32x2m __attribute__((ext_vector_type(2)));
#define MFMA32(a, b, c) __builtin_amdgcn_mfma_f32_32x32x16_bf16((a), (b), (c), 0, 0, 0)
#define LDS_WAIT() asm volatile("s_waitcnt lgkmcnt(0)" ::: "memory")

constexpr int NFR = 16384, MT = 16640, D = 1024, FF = 2816, NGU = 5632, NIN = 4608, PBW = 4352, DIN = 4368;
constexpr int NPH = 12;
constexpr int LDS_BYTES = 147456, MISC_OFF = 131072 + 320, CTL_BYTES = 32768;
constexpr size_t MiB = 1u << 20;
constexpr size_t WS_WGU1 = 0, WS_WD1 = 11 * MiB, WS_ST = 0  , WS_WGU2 = 17 * MiB, WS_WD2 = 28 * MiB, WS_WIN = 34 * MiB,
                 WS_WA = 43 * MiB, WS_WB = 44 * MiB, WS_WOUT = 45 * MiB, WS_SSP = 47 * MiB, WS_GLOW = 49 * MiB, WS_DEC = 51 * MiB, WS_CTL = 51 * MiB + MiB / 2  , WS_MSSP = 51 * MiB + 3 * MiB / 4  ,
                 WS_HB = 52 * MiB, WS_YA = 52 * MiB, WS_YB = 68 * MiB  , WS_R1 = 85 * MiB  ,
                 WS_KV = 223 * MiB + MiB / 2  , WS_END = 256 * MiB;
static_assert(WS_ST + (size_t)1032 * 8192 * 2 <= WS_WGU2 && WS_R1 + (size_t)MT * PBW * 2 <= WS_KV && WS_KV + (size_t)NFR * D * 2 <= WS_END && WS_HB + (size_t)MT * D * 2 <= WS_R1, "d_ws map");

struct Params { const float* in[20]; float* out; unsigned char* ws; int ph_lo, ph_hi, cg_sync, pad; };

__device__ __forceinline__ int crow(int reg, int h) { return (reg & 3) + 8 * (reg >> 2) + 4 * h; }
__device__ __forceinline__ unsigned f2bf(float f) { unsigned u = __float_as_uint(f); return (u + 0x7fffu + ((u >> 16) & 1u)) >> 16; }
__device__ __forceinline__ unsigned pk2(float lo, float hi) { return f2bf(lo) | (f2bf(hi) << 16); }
__device__ __forceinline__ float wave_sum(float v) {
#pragma unroll
    for (int o = 1; o < 64; o <<= 1) v += __shfl_xor(v, o);
    return v;
}
__device__ __forceinline__ bf16x8 pack8(float a, float b, float c, float d, float e, float f, float g, float h) {
    u32x4 p; p.x = pk2(a, b); p.y = pk2(c, d); p.z = pk2(e, f); p.w = pk2(g, h); return __builtin_bit_cast(bf16x8, p);
}

struct TrDesc { const float* W; const float* gain; bf16* WT; int K, N, k0, sn0, nvalid, drow0; };
__device__ __forceinline__ void tr_load(const TrDesc& d, f32x4 (&a)[8], f32x4 (&b)[8], int lane) {
    const int n4 = (lane & 15) * 4, kp = lane >> 4; const bool cv = n4 < d.nvalid;
#pragma unroll
    for (int st = 0; st < 8; ++st) { const float* p = d.W + (size_t)(d.k0 + 8 * st + 2 * kp) * d.N + d.sn0 + n4;
        a[st] = cv ? __builtin_nontemporal_load((const f32x4*)p) : (f32x4){0.f, 0.f, 0.f, 0.f}; b[st] = cv ? __builtin_nontemporal_load((const f32x4*)(p + d.N)) : (f32x4){0.f, 0.f, 0.f, 0.f}; }
}
__device__ __forceinline__ void tr_store(const TrDesc& d, const f32x4 (&a)[8], const f32x4 (&b)[8], LAS unsigned* T, int lane) {
    const int n4 = (lane & 15) * 4, kp = lane >> 4;
#pragma unroll
    for (int st = 0; st < 8; ++st) { const int k = d.k0 + 8 * st + 2 * kp; float g0 = 1.f, g1 = 1.f; if (d.gain) { g0 = d.gain[k]; g1 = d.gain[k + 1]; }
        LAS unsigned* t = T + n4 * 33 + 4 * st + kp;
        t[0] = pk2(a[st][0] * g0, b[st][0] * g1); t[33] = pk2(a[st][1] * g0, b[st][1] * g1); t[66] = pk2(a[st][2] * g0, b[st][2] * g1); t[99] = pk2(a[st][3] * g0, b[st][3] * g1); }
    LDS_WAIT(); asm volatile("" ::: "memory");
    const int c = lane & 7;
#pragma unroll
    for (int q = 0; q < 8; ++q) { const int n = (lane >> 3) + 8 * q; const LAS unsigned* t = T + n * 33 + 4 * c;
        u32x4 o; o.x = t[0]; o.y = t[1]; o.z = t[2]; o.w = t[3];
        *(u32x4*)(d.WT + (size_t)(d.drow0 + n) * d.K + d.k0 + 8 * c) = o; }
    LDS_WAIT(); asm volatile("" ::: "memory");
}
constexpr int I_GU = 16 * 44, I_DN = 44 * 16, I_IN = 16 * 72, I_BR = 8 * 16, I_WO = 16 * 16;
constexpr int IT_P0 = 2 * I_GU + I_DN + I_IN, IT_END = IT_P0 + 2 * I_BR + I_WO + 2 * I_GU + I_DN;
__device__ __forceinline__ TrDesc prep_desc(const Params& P, int it) {
    unsigned char* ws = P.ws; int r = it; TrDesc d;
    if (r < 2 * I_GU) { const int up = r >= I_GU; r -= up * I_GU; const int kb = r / 44, n0 = (r % 44) * 64;
        d = TrDesc{up ? P.in[4] : P.in[3], P.in[2], (bf16*)(ws + WS_WGU1), D, FF, kb * 64, n0, 64, (n0 >> 7) * 256 + (n0 & 127) + up * 128}; return d; }
    r -= 2 * I_GU;
    if (r < I_DN) { d = TrDesc{P.in[5], nullptr, (bf16*)(ws + WS_WD1), FF, D, (r / 16) * 64, (r % 16) * 64, 64, (r % 16) * 64}; return d; }
    r -= I_DN;
    if (r < I_IN) { const int kb = r / 72, d0 = (r % 72) * 64; int sn0, nv;
        if (d0 < 2304) { sn0 = d0; nv = 64; } else if (d0 < 4352) { sn0 = d0 + 16; nv = 64; } else if (d0 == 4352) { sn0 = 2304; nv = 16; } else { sn0 = 0; nv = 0; }
        d = TrDesc{P.in[7], P.in[6], (bf16*)(ws + WS_WIN), D, DIN, kb * 64, sn0, nv, d0}; return d; }
    r -= I_IN;
    if (r < I_BR) { d = TrDesc{P.in[12], nullptr, (bf16*)(ws + WS_WA), 512, D, (r / 16) * 64, (r % 16) * 64, 64, (r % 16) * 64}; return d; }
    r -= I_BR;
    if (r < I_BR) { d = TrDesc{P.in[13], nullptr, (bf16*)(ws + WS_WB), 512, D, (r / 16) * 64, (r % 16) * 64, 64, (r % 16) * 64}; return d; }
    r -= I_BR;
    if (r < I_WO) { d = TrDesc{P.in[14], nullptr, (bf16*)(ws + WS_WOUT), D, D, (r / 16) * 64, (r % 16) * 64, 64, (r % 16) * 64}; return d; }
    r -= I_WO;
    if (r < 2 * I_GU) { const int up = r >= I_GU; r -= up * I_GU; const int kb = r / 44, n0 = (r % 44) * 64;
        d = TrDesc{up ? P.in[17] : P.in[16], P.in[15], (bf16*)(ws + WS_WGU2), D, FF, kb * 64, n0, 64, (n0 >> 7) * 256 + (n0 & 127) + up * 128}; return d; }
    r -= 2 * I_GU;
    d = TrDesc{P.in[18], nullptr, (bf16*)(ws + WS_WD2), FF, D, (r / 16) * 64, (r % 16) * 64, 64, (r % 16) * 64}; return d;
}
__device__ __forceinline__ void prep_items(const Params& P, int first, int hi, int stride, LAS unsigned* scr, int lane) {
    for (int it = first; it < hi; it += 2 * stride) {
        const bool two = it + stride < hi;
        const TrDesc d0 = prep_desc(P, it), d1 = prep_desc(P, two ? it + stride : it);
        f32x4 a0[8], b0[8], a1[8], b1[8];
        tr_load(d0, a0, b0, lane);
        if (two) tr_load(d1, a1, b1, lane);
        tr_store(d0, a0, b0, scr, lane);
        if (two) tr_store(d1, a1, b1, scr, lane);
    }
}
__device__ __forceinline__ void prep_in_slack(const Params& P, LAS unsigned char* lds, int lo, int hi, int nwg, int wave, int lane, int G) {
    const int rem = nwg % G, c = (int)blockIdx.x; int ns, si;
    if (rem == 0) { ns = G; si = c; } else { if (c < rem) return; ns = G - rem; si = c - rem; }
    prep_items(P, lo + wave * ns + si, hi, ns * 8, (LAS unsigned*)(lds + wave * 16384), lane);
}
__device__ __forceinline__ void p0_prep(const Params& P, LAS unsigned char* lds, int wave, int lane, int G) {
    unsigned char* ws = P.ws;
    LAS unsigned* scr = (LAS unsigned*)(lds + wave * 16384);
    const int gw = blockIdx.x * 8 + wave, NGW = G * 8;
    prep_items(P, gw, 2 * I_GU, NGW, scr, lane);
    bf16* hb = (bf16*)(ws + WS_HB); float* ssp = (float*)(ws + WS_SSP);
    for (int m0 = gw; m0 < MT; m0 += 2 * NGW) {
        f32x4 v[2][4]; float s[2];
#pragma unroll
        for (int u = 0; u < 2; ++u) { const int m = m0 + u * NGW;
            const float* src = m < NFR ? P.in[0] + (size_t)m * D : (m < NFR + 16 ? P.in[1] + (size_t)(m - NFR) * D : nullptr);
#pragma unroll
            for (int j = 0; j < 4; ++j) v[u][j] = src ? __builtin_nontemporal_load((const f32x4*)src + lane + 64 * j) : (f32x4){0.f, 0.f, 0.f, 0.f}; }
#pragma unroll
        for (int u = 0; u < 2; ++u) { const int m = m0 + u * NGW; s[u] = 0.f;
#pragma unroll
            for (int j = 0; j < 4; ++j) s[u] += (v[u][j][0] * v[u][j][0] + v[u][j][1] * v[u][j][1]) + (v[u][j][2] * v[u][j][2] + v[u][j][3] * v[u][j][3]);
            s[u] = wave_sum(s[u]);
            if (m < MT) {
                u32x2* o8 = (u32x2*)(hb + (size_t)m * D) + lane;
#pragma unroll
                for (int j = 0; j < 4; ++j) { u32x2 w; w.x = pk2(v[u][j][0], v[u][j][1]); w.y = pk2(v[u][j][2], v[u][j][3]); o8[64 * j] = w; }
                if (lane < 16) ssp[(size_t)m * 16 + lane] = lane == 0 ? s[u] : 0.f; } }
    }
}

typedef float f32x4m __attribute__((ext_vector_type(4)));
#define MFMA16(a, b, c) __builtin_amdgcn_mfma_f32_16x16x32_bf16((a), (b), (c), 0, 0, 0)
__device__ __forceinline__ f32x4m meta_mm(const bf16* A, const bf16* Brow, int K, int k0, int nsteps, int lane) {
    const int r = lane & 15, quad = lane >> 4;
    const bf16* ap = A + (size_t)r * K + k0 + quad * 8; const bf16* bp = Brow + (size_t)r * K + k0 + quad * 8;
    f32x4m acc = (f32x4m){0.f, 0.f, 0.f, 0.f};
#pragma unroll 8
    for (int st = 0; st < nsteps; ++st) { const bf16x8 a = *(const bf16x8*)(ap + 32 * st), b = *(const bf16x8*)(bp + 32 * st); acc = MFMA16(a, b, acc); }
    return acc;
}
__device__ __forceinline__ float sum16(const float* p) { const f32x4 a = *(const f32x4*)p, b = *(const f32x4*)(p + 4), c = *(const f32x4*)(p + 8), d = *(const f32x4*)(p + 12);
    return (((a[0] + a[1]) + (a[2] + a[3])) + ((b[0] + b[1]) + (b[2] + b[3]))) + (((c[0] + c[1]) + (c[2] + c[3])) + ((d[0] + d[1]) + (d[2] + d[3]))); }
__device__ __forceinline__ void meta_p1(const Params& P, int wave, int lane, int G) {
    const int mt = (G - 1 - (int)blockIdx.x) * 8 + wave; if (mt >= 176) return;
    unsigned char* ws = P.ws; const bf16* hbm = (const bf16*)(ws + WS_HB) + (size_t)NFR * D; const bf16* W = (const bf16*)(ws + WS_WGU1);
    bf16* actm = (bf16*)(ws + WS_R1) + (size_t)NFR * FF; const float* ssp = (const float*)(ws + WS_SSP) + (size_t)NFR * 16;
    const int c0 = 16 * mt, grow = (c0 >> 7) * 256 + (c0 & 127), r = lane & 15, quad = lane >> 4;
    const f32x4m g = meta_mm(hbm, W + (size_t)grow * D, D, 0, 32, lane), u = meta_mm(hbm, W + (size_t)(grow + 128) * D, D, 0, 32, lane);
#pragma unroll
    for (int j = 0; j < 4; ++j) { const int row = quad * 4 + j; const float rs = __builtin_amdgcn_rsqf(sum16(ssp + row * 16) * (1.0f / 1024.0f) + 1e-6f);
        const float gv = g[j] * rs, uv = u[j] * rs; actm[(size_t)row * FF + c0 + r] = (bf16)f2bf(gv * pg8::sigm(gv) * uv); }
}
__device__ __forceinline__ void meta_p2(const Params& P, LAS unsigned char* L, int wave, int lane) {
    if (blockIdx.x >= 64) return;
    unsigned char* ws = P.ws; const bf16* actm = (const bf16*)(ws + WS_R1) + (size_t)NFR * FF; const bf16* W = (const bf16*)(ws + WS_WD1);
    bf16* hbm = (bf16*)(ws + WS_HB) + (size_t)NFR * D; float* mssp = (float*)(ws + WS_MSSP);
    const int ct = blockIdx.x, r = lane & 15, quad = lane >> 4;
    const bf16* ap = actm + (size_t)r * FF + wave * 352 + quad * 8; const bf16* bp = W + (size_t)(ct * 16 + r) * FF + wave * 352 + quad * 8;
    bf16x8 av[11], bv[11];
#pragma unroll
    for (int st = 0; st < 11; ++st) { av[st] = *(const bf16x8*)(ap + 32 * st); bv[st] = *(const bf16x8*)(bp + 32 * st); }
    f32x4m acc = (f32x4m){0.f, 0.f, 0.f, 0.f};
#pragma unroll
    for (int st = 0; st < 11; ++st) acc = MFMA16(av[st], bv[st], acc);
    LAS f32x4m* red = (LAS f32x4m*)L;
    red[wave * 64 + lane] = acc;
    __syncthreads();
    if (wave == 0) {
        f32x4m t = red[lane];
#pragma unroll
        for (int w = 1; w < 8; ++w) t = t + red[w * 64 + lane];
#pragma unroll
        for (int j = 0; j < 4; ++j) { const int row = quad * 4 + j, col = ct * 16 + r; const float v = P.in[1][(size_t)row * D + col] + 0.5f * t[j];
            hbm[(size_t)row * D + col] = (bf16)f2bf(v);
            float sq = v * v; sq += __shfl_xor(sq, 1); sq += __shfl_xor(sq, 2); sq += __shfl_xor(sq, 4); sq += __shfl_xor(sq, 8);
            if (r == 0) mssp[row * 64 + ct] = sq; }
    }
    __syncthreads();
}
__device__ __forceinline__ void meta_p3(const Params& P, int wave, int lane, int G) {
    const int mt = (G - 1 - (int)blockIdx.x) * 8 + wave; if (mt >= 65) return;
    unsigned char* ws = P.ws; const bf16* hbm = (const bf16*)(ws + WS_HB) + (size_t)NFR * D; const bf16* W = (const bf16*)(ws + WS_WIN);
    bf16* PBm = (bf16*)(ws + WS_R1) + (size_t)NFR * PBW; float* glowm = (float*)(ws + WS_GLOW) + (size_t)NFR * 16; const float* mssp = (const float*)(ws + WS_MSSP);
    const int col0 = mt < 16 ? 512 + 16 * mt : (mt < 32 ? 1024 + 16 * (mt - 16) : (mt < 64 ? 1280 + 16 * (mt - 32) : 4352)), r = lane & 15, quad = lane >> 4;
    const f32x4m acc = meta_mm(hbm, W + (size_t)col0 * D, D, 0, 32, lane);
#pragma unroll
    for (int j = 0; j < 4; ++j) { const int row = quad * 4 + j;
        const f32x4 p = *(const f32x4*)(mssp + row * 64 + 4 * r); float sq = (p[0] + p[1]) + (p[2] + p[3]);
        sq += __shfl_xor(sq, 1); sq += __shfl_xor(sq, 2); sq += __shfl_xor(sq, 4); sq += __shfl_xor(sq, 8);
        const float v = acc[j] * __builtin_amdgcn_rsqf(sq * (1.0f / 1024.0f) + 1e-6f);
        if (mt < 64) PBm[(size_t)row * PBW + col0 + r] = (bf16)f2bf(v); else glowm[row * 16 + r] = v; }
}

constexpr int A_KS = 0, A_VT = 32256, A_VTS = 228;
__device__ __forceinline__ void attn_item(const Params& P, LAS unsigned char* L, int item, int tid, int wave, int lane) {
    const bf16* PB = (const bf16*)(P.ws + WS_R1); bf16* ya = (bf16*)P.out;
    const int kvh = item & 1, c = (item >> 1) & 127, b = item >> 8;
#pragma unroll
    for (int i = 0; i < 4; ++i) {
        const int key = (tid & 63) + 64 * i;
        if (key < 224) {
            bool valid; int row;
            if (key < 16) { valid = true; row = NFR + key; }
            else if (key < 32) { valid = false; row = 0; }
            else { const int ki = c * 64 - 128 + (key - 32); valid = ki >= 0; row = b * 8192 + (valid ? ki : 0); }
            u32x4 kk = (u32x4){0u, 0u, 0u, 0u}, vv = (u32x4){0u, 0u, 0u, 0u};
            if (valid) { const bf16* p = PB + (size_t)row * PBW + 512 + kvh * 64 + wave * 8; kk = *(const u32x4*)p; vv = *(const u32x4*)(p + 128); }
            *(LAS u32x4*)(L + A_KS + key * 144 + wave * 16) = kk;
            LAS unsigned short* vt = (LAS unsigned short*)(L + A_VT) + (wave * 8) * A_VTS + key;
            vt[0 * A_VTS] = (unsigned short)(vv.x & 0xffffu); vt[1 * A_VTS] = (unsigned short)(vv.x >> 16);
            vt[2 * A_VTS] = (unsigned short)(vv.y & 0xffffu); vt[3 * A_VTS] = (unsigned short)(vv.y >> 16);
            vt[4 * A_VTS] = (unsigned short)(vv.z & 0xffffu); vt[5 * A_VTS] = (unsigned short)(vv.z >> 16);
            vt[6 * A_VTS] = (unsigned short)(vv.w & 0xffffu); vt[7 * A_VTS] = (unsigned short)(vv.w >> 16);
        }
    }
    __syncthreads();
    const int g = wave >> 1, pos0 = (wave & 1) * 32, h = kvh * 4 + g, r = lane & 31, hi = lane >> 5;
    const int qrow = b * 8192 + c * 64 + pos0 + r;
    bf16x8 q[4];
#pragma unroll
    for (int s = 0; s < 4; ++s) q[s] = *(const bf16x8*)(PB + (size_t)qrow * PBW + h * 64 + 16 * s + 8 * hi);
    f32x16 S[7];
#pragma unroll
    for (int kt = 0; kt < 7; ++kt) {
#pragma unroll
        for (int i = 0; i < 16; ++i) S[kt][i] = 0.f;
#pragma unroll
        for (int s = 0; s < 4; ++s) { const bf16x8 a = *(const LAS bf16x8*)(L + A_KS + (kt * 32 + r) * 144 + (16 * s + 8 * hi) * 2); S[kt] = MFMA32(a, q[s], S[kt]); }
        asm volatile("" ::: "memory");
    }
    __builtin_amdgcn_sched_barrier(0);
    const float slope = exp2f(-(float)(h + 1)), sink = P.in[11][h];
    const float NEG = -__builtin_inff();
    float m = sink;
#pragma unroll
    for (int i = 0; i < 16; ++i) { if (i >= 8) S[0][i] = NEG; else m = fmaxf(m, S[0][i]); }
    int oz; asm volatile("v_mov_b32 %0, 0" : "=v"(oz));
    const int smin = 128 - 64 * c, pq = pos0 + r + 128 + oz;
#pragma unroll
    for (int kt = 1; kt < 7; ++kt) {
#pragma unroll
        for (int i = 0; i < 16; ++i) { const int s = (kt - 1) * 32 + crow(i, hi); float v = S[kt][i] - slope * fabsf((float)(pq - s)); if (s < smin) v = NEG; S[kt][i] = v; m = fmaxf(m, v); }
        __builtin_amdgcn_sched_barrier(0);
    }
    m = fmaxf(m, __shfl_xor(m, 32));
    __builtin_amdgcn_sched_barrier(0);
    float sum = 0.f; const float ml = m * 1.44269504f;
    bf16x8 pbv[7][2];
#pragma unroll
    for (int kt = 0; kt < 7; ++kt) {
#pragma unroll
        for (int i = 0; i < 16; ++i) { const float p = __builtin_amdgcn_exp2f(S[kt][i] * 1.44269504f - ml); S[kt][i] = p; sum += p; }
        pbv[kt][0] = pack8(S[kt][0], S[kt][1], S[kt][2], S[kt][3], S[kt][4], S[kt][5], S[kt][6], S[kt][7]);
        pbv[kt][1] = pack8(S[kt][8], S[kt][9], S[kt][10], S[kt][11], S[kt][12], S[kt][13], S[kt][14], S[kt][15]);
    }
    __builtin_amdgcn_sched_barrier(0);
    sum += __shfl_xor(sum, 32); sum += exp2f(sink * 1.44269504f - ml);
    const float inv = 1.0f / sum;
    f32x16 O[2];
#pragma unroll
    for (int i = 0; i < 16; ++i) { O[0][i] = 0.f; O[1][i] = 0.f; }
#pragma unroll
    for (int kt = 0; kt < 7; ++kt)
#pragma unroll
        for (int s2 = 0; s2 < 2; ++s2) {
            const bf16x8 pb = pbv[kt][s2];
#pragma unroll
            for (int dt = 0; dt < 2; ++dt) {
                const LAS unsigned char* vp = L + A_VT + ((dt * 32 + r) * A_VTS + kt * 32 + 16 * s2 + 4 * hi) * 2;
                const s16x4 lo = *(const LAS s16x4*)vp, h4 = *(const LAS s16x4*)(vp + 16);
                const bf16x8 va = __builtin_shufflevector(lo, h4, 0, 1, 2, 3, 4, 5, 6, 7);
                O[dt] = MFMA32(va, pb, O[dt]);
            }
            asm volatile("" ::: "memory");
        }
#pragma unroll
    for (int dt = 0; dt < 2; ++dt)
#pragma unroll
        for (int g4 = 0; g4 < 4; ++g4) {
            u32x2 w; w.x = pk2(O[dt][4 * g4] * inv, O[dt][4 * g4 + 1] * inv); w.y = pk2(O[dt][4 * g4 + 2] * inv, O[dt][4 * g4 + 3] * inv);
            *(u32x2*)(ya + (size_t)qrow * 512 + h * 64 + dt * 32 + 8 * g4 + 4 * hi) = w;
        }
    __syncthreads();
}

constexpr int G_QE = 0, G_KE = 9216, G_K2T = 18432, G_VT = 27648, G_ST = 46080, G_SEG = 64512, G_SS = 66560, G_GL = 67584;
struct GlaLd { f32x2m glv; u32x4 qraw, kraw, va, vc, sa, sc; float gw[16]; float bias; };
template <bool KV> __device__ __forceinline__ void gla_load(const Params& P, GlaLd& g, int b, int h, int j, int tid) {
    const bf16* PB = (const bf16*)(P.ws + WS_R1); const float* glow = (const float*)(P.ws + WS_GLOW);
    const int d = tid & 63;
    const int posA = tid >> 3, sub = tid & 7; const bool vA = (j > 0) || (posA >= 48);
    const int rowA = vA ? (j == 0 ? NFR + posA - 48 : b * 8192 + (j - 1) * 64 + posA) : NFR;
    g.glv = *(const f32x2m*)(glow + (size_t)rowA * 16 + sub * 2);
    g.qraw = (u32x4){0u, 0u, 0u, 0u}; g.kraw = g.qraw;
    if (vA) { const bf16* p = PB + (size_t)rowA * PBW + h * 64 + sub * 8;
        if (!KV) { g.qraw = __builtin_nontemporal_load((const u32x4*)(p + 768)); g.kraw = __builtin_nontemporal_load((const u32x4*)(p + 1024)); } else g.kraw = *(const u32x4*)(p + 1024); }
    const int posC = tid & 63, dvg = tid >> 6; const bool vC = (j > 0) || (posC >= 48);
    const int rowC = vC ? (j == 0 ? NFR + posC - 48 : b * 8192 + (j - 1) * 64 + posC) : NFR;
    g.va = (u32x4){0u, 0u, 0u, 0u}; g.vc = g.va;
    if (vC) { const bf16* p = PB + (size_t)rowC * PBW + 1280 + h * 128 + dvg * 16; g.va = *(const u32x4*)p; g.vc = *(const u32x4*)(p + 8); }
    g.sa = (u32x4){0u, 0u, 0u, 0u}; g.sc = g.sa;
    if (!KV) { const bf16* sg = (const bf16*)(P.ws + WS_ST) + (size_t)((b * 4 + h) * 129 + j) * 8192 + (tid >> 2) * 64 + (tid & 3) * 16; g.sa = __builtin_nontemporal_load((const u32x4*)sg); g.sc = __builtin_nontemporal_load((const u32x4*)(sg + 8)); }
#pragma unroll
    for (int r = 0; r < 16; ++r) g.gw[r] = P.in[8][r * 256 + h * 64 + d];
    g.bias = P.in[9][h * 64 + d];
}
template <bool KV> __device__ __forceinline__ void gla_stage(LAS unsigned char* L, const GlaLd& g, int tid) {
    const int posA = tid >> 3, sub = tid & 7, posC = tid & 63, dvg = tid >> 6;
    *(LAS f32x2m*)(L + G_GL + (posA * 16 + sub * 2) * 4) = g.glv;
    if (!KV) *(LAS u32x4*)(L + G_QE + (posA * 72 + sub * 8) * 2) = g.qraw;
    *(LAS u32x4*)(L + G_KE + (posA * 72 + sub * 8) * 2) = g.kraw;
    { const u32x4 va = g.va, vc = g.vc; LAS unsigned short* vt = (LAS unsigned short*)(L + G_VT) + (dvg * 16) * 72 + posC;
      vt[0 * 72] = (unsigned short)(va.x & 0xffffu); vt[1 * 72] = (unsigned short)(va.x >> 16); vt[2 * 72] = (unsigned short)(va.y & 0xffffu); vt[3 * 72] = (unsigned short)(va.y >> 16);
      vt[4 * 72] = (unsigned short)(va.z & 0xffffu); vt[5 * 72] = (unsigned short)(va.z >> 16); vt[6 * 72] = (unsigned short)(va.w & 0xffffu); vt[7 * 72] = (unsigned short)(va.w >> 16);
      vt[8 * 72] = (unsigned short)(vc.x & 0xffffu); vt[9 * 72] = (unsigned short)(vc.x >> 16); vt[10 * 72] = (unsigned short)(vc.y & 0xffffu); vt[11 * 72] = (unsigned short)(vc.y >> 16);
      vt[12 * 72] = (unsigned short)(vc.z & 0xffffu); vt[13 * 72] = (unsigned short)(vc.z >> 16); vt[14 * 72] = (unsigned short)(vc.w & 0xffffu); vt[15 * 72] = (unsigned short)(vc.w >> 16); }
    if (!KV) { const int dv = tid >> 2, part = tid & 3; *(LAS u32x4*)(L + G_ST + (dv * 72 + part * 16) * 2) = g.sa; *(LAS u32x4*)(L + G_ST + (dv * 72 + part * 16 + 8) * 2) = g.sc; }
}
template <bool KV> __device__ __forceinline__ void gla_prep(const Params& P, LAS unsigned char* L, const float (&gw)[16], float bias, int b, int h, int j, int tid) {
    const int d = tid & 63, seg = tid >> 6;
    LAS unsigned short* QE = (LAS unsigned short*)(L + G_QE); LAS unsigned short* KE = (LAS unsigned short*)(L + G_KE);
    float cs[8], qv[8], kv[8]; float run = 0.f;
#pragma unroll
    for (int p = 0; p < 8; ++p) {
        const int pos = seg * 8 + p; const bool valid = (j > 0) || (pos >= 48);
        const LAS f32x4* gl = (const LAS f32x4*)(L + G_GL + pos * 64);
        const f32x4 g0 = gl[0], g1 = gl[1], g2 = gl[2], g3 = gl[3];
        float z = bias;
#pragma unroll
        for (int e = 0; e < 4; ++e) { z += g0[e] * gw[e]; z += g1[e] * gw[4 + e]; z += g2[e] * gw[8 + e]; z += g3[e] * gw[12 + e]; }
        float la = (fminf(z, 0.f) - __logf(1.0f + __expf(-fabsf(z)))) * 0.0625f;
        if (!valid) la = 0.f;
        run += la; cs[p] = run;
        qv[p] = KV ? 0.f : pg8::bf2f(QE[pos * 72 + d]); kv[p] = pg8::bf2f(KE[pos * 72 + d]);
        if (p & 1) __builtin_amdgcn_sched_barrier(0);
    }
    LAS float* SEG = (LAS float*)(L + G_SEG);
    SEG[seg * 64 + d] = run;
    __syncthreads();
    float off = 0.f, tot = 0.f;
#pragma unroll
    for (int s = 0; s < 8; ++s) { const float v = SEG[s * 64 + d]; tot += v; if (s < seg) off += v; }
    float k2[8];
#pragma unroll
    for (int p = 0; p < 8; ++p) {
        const int pos = seg * 8 + p; const float bb = off + cs[p];
        if (!KV) { QE[pos * 72 + d] = (unsigned short)f2bf(qv[p] * __expf(bb)); KE[pos * 72 + d] = (unsigned short)f2bf(kv[p] * __expf(-bb)); }
        k2[p] = kv[p] * __expf(tot - bb);
    }
    if (KV) {
        *(LAS bf16x8*)(L + G_K2T + (d * 72 + seg * 8) * 2) = pack8(k2[0], k2[1], k2[2], k2[3], k2[4], k2[5], k2[6], k2[7]);
        if (seg == 0) ((float*)(P.ws + WS_DEC))[(size_t)((b * 4 + h) * 129 + j) * 64 + d] = __expf(tot);
    }
}
__device__ __forceinline__ void gla_kv_item(const Params& P, LAS unsigned char* L, int item, const float (&gw)[16], float bias, int tid, int wave, int lane) {
    const int j = item % 129, bh = item / 129, h = bh & 3, b = bh >> 2;
    gla_prep<true>(P, L, gw, bias, b, h, j, tid);
    __syncthreads();
    const int dvt = wave >> 1, dkt = wave & 1, r = lane & 31, hi = lane >> 5;
    f32x16 acc;
#pragma unroll
    for (int i = 0; i < 16; ++i) acc[i] = 0.f;
#pragma unroll
    for (int s = 0; s < 4; ++s) {
        const bf16x8 a = *(const LAS bf16x8*)(L + G_VT + ((dvt * 32 + r) * 72 + 16 * s + 8 * hi) * 2);
        const bf16x8 bb = *(const LAS bf16x8*)(L + G_K2T + ((dkt * 32 + r) * 72 + 16 * s + 8 * hi) * 2);
        acc = MFMA32(a, bb, acc);
    }
    bf16* kvg = (bf16*)(P.ws + WS_KV) + (size_t)item * 8192;
#pragma unroll
    for (int i = 0; i < 16; ++i) kvg[(dvt * 32 + crow(i, hi)) * 64 + dkt * 32 + r] = (bf16)f2bf(acc[i]);
    __syncthreads();
}
__device__ __forceinline__ void gla_scan(const Params& P, int wave, int lane, int G) {
    const bf16* kvg = (const bf16*)(P.ws + WS_KV); const float* dec = (const float*)(P.ws + WS_DEC); bf16* st = (bf16*)(P.ws + WS_ST);
    if (wave >= 4) return;
    for (int wv = wave * G + blockIdx.x; wv < 1024; wv += G * 4) {
        const int gidx = wv * 64 + lane, bh = gidx >> 13, e = gidx & 8191, dk = e & 63;
        const size_t base = (size_t)bh * 129;
        float S = 0.f;
        for (int j0 = 0; j0 < 128; j0 += 8) {
            float kvv[8], dd[8];
#pragma unroll
            for (int u = 0; u < 8; ++u) { kvv[u] = pg8::bf2f(__builtin_nontemporal_load(kvg + (base + j0 + u) * 8192 + e)); dd[u] = dec[(base + j0 + u) * 64 + dk]; }
#pragma unroll
            for (int u = 0; u < 8; ++u) { S = dd[u] * S + kvv[u]; st[(base + j0 + u + 1) * 8192 + e] = (bf16)f2bf(S); }
        }
    }
}
__device__ __forceinline__ void gla_out_item(const Params& P, LAS unsigned char* L, int item  , const float (&gw)[16], float bias, int tid, int wave, int lane) {
    const int j = (item & 127) + 1, bh = item >> 7, h = bh & 3, b = bh >> 2;
    const bf16* PB = (const bf16*)(P.ws + WS_R1); bf16* yb = (bf16*)P.out + (size_t)NFR * 512;
    gla_prep<false>(P, L, gw, bias, b, h, j, tid);
    __syncthreads();
    const int it = wave & 1, dvt = wave >> 1, r = lane & 31, hi = lane >> 5;
    bf16x8 qf[4];
#pragma unroll
    for (int s = 0; s < 4; ++s) qf[s] = *(const LAS bf16x8*)(L + G_QE + ((it * 32 + r) * 72 + 16 * s + 8 * hi) * 2);
    f32x16 o;
#pragma unroll
    for (int i = 0; i < 16; ++i) o[i] = 0.f;
#pragma unroll
    for (int jt = 0; jt < 2; ++jt) {
        if (jt <= it) {
            f32x16 at;
#pragma unroll
            for (int i = 0; i < 16; ++i) at[i] = 0.f;
#pragma unroll
            for (int s = 0; s < 4; ++s) { const bf16x8 a = *(const LAS bf16x8*)(L + G_KE + ((jt * 32 + r) * 72 + 16 * s + 8 * hi) * 2); at = MFMA32(a, qf[s], at); }
            if (jt == it) {
#pragma unroll
                for (int i = 0; i < 16; ++i) if (crow(i, hi) > r) at[i] = 0.f;
            }
#pragma unroll
            for (int s2 = 0; s2 < 2; ++s2) {
                const bf16x8 pb = pack8(at[8 * s2], at[8 * s2 + 1], at[8 * s2 + 2], at[8 * s2 + 3], at[8 * s2 + 4], at[8 * s2 + 5], at[8 * s2 + 6], at[8 * s2 + 7]);
                const LAS unsigned char* vp = L + G_VT + ((dvt * 32 + r) * 72 + jt * 32 + 16 * s2 + 4 * hi) * 2;
                const s16x4 lo = *(const LAS s16x4*)vp, h4 = *(const LAS s16x4*)(vp + 16);
                o = MFMA32(__builtin_shufflevector(lo, h4, 0, 1, 2, 3, 4, 5, 6, 7), pb, o);
            }
        }
    }
#pragma unroll
    for (int s = 0; s < 4; ++s) { const bf16x8 a = *(const LAS bf16x8*)(L + G_ST + ((dvt * 32 + r) * 72 + 16 * s + 8 * hi) * 2); o = MFMA32(a, qf[s], o); }
    const int row = b * 8192 + (j - 1) * 64 + it * 32 + r;
    u32x2 grv[4]; f32x4 gnv[4];
#pragma unroll
    for (int g4 = 0; g4 < 4; ++g4) { const int dv0 = dvt * 32 + 8 * g4 + 4 * hi; gnv[g4] = *(const f32x4*)(P.in[10] + dv0); grv[g4] = *(const u32x2*)(PB + (size_t)row * PBW + 1792 + h * 128 + dv0); }
    float ss = 0.f;
#pragma unroll
    for (int i = 0; i < 16; ++i) ss += o[i] * o[i];
    ss += __shfl_xor(ss, 32);
    LAS float* SS = (LAS float*)(L + G_SS);
    if (hi == 0) SS[dvt * 64 + it * 32 + r] = ss;
    __syncthreads();
    const float tot = (SS[it * 32 + r] + SS[64 + it * 32 + r]) + (SS[128 + it * 32 + r] + SS[192 + it * 32 + r]);
    const float rstd = __builtin_amdgcn_rsqf(tot * (1.0f / 128.0f) + 1e-6f);
#pragma unroll
    for (int g4 = 0; g4 < 4; ++g4) {
        const int dv0 = dvt * 32 + 8 * g4 + 4 * hi;
        const f32x4 gn = gnv[g4];
        const u32x2 gr = grv[g4];
        u32x2 w;
        w.x = pk2(o[4 * g4] * rstd * gn[0] * pg8::bflo(gr.x), o[4 * g4 + 1] * rstd * gn[1] * pg8::bfhi(gr.x));
        w.y = pk2(o[4 * g4 + 2] * rstd * gn[2] * pg8::bflo(gr.y), o[4 * g4 + 3] * rstd * gn[3] * pg8::bfhi(gr.y));
        *(u32x2*)(yb + (size_t)row * 512 + h * 128 + dv0) = w;
    }
    __syncthreads();
}

constexpr int DUMP_OFF = 131072 + 2048;
__device__ __forceinline__ void prefetch_tile(const bf16* base, int ld, int pm, int pn, LAS unsigned char* lds, int wave, int lane) {
    const bf16* p = base + (size_t)(pm * 256 + wave * 32 + (lane >> 5)) * ld + pn * 256 + (lane & 31) * 8;
#pragma unroll 2
    for (int i = 0; i < 16; ++i, p += 2 * (size_t)ld)
        __builtin_amdgcn_global_load_lds((const unsigned*)p, (LAS unsigned*)(lds + DUMP_OFF + wave * 1024), 16, 0, 0);
}

__global__ void __launch_bounds__(512, 2) mega_fwd(Params P) {
    extern __shared__ __attribute__((aligned(16))) unsigned char lds_raw[];
    LAS unsigned char* lds = (LAS unsigned char*)lds_raw;
    cg::grid_group grid = cg::this_grid();
    const int tid = threadIdx.x, lane = tid & 63, wave = __builtin_amdgcn_readfirstlane(tid >> 6), G = gridDim.x;
    unsigned char* ws = P.ws;
    const int lo = P.ph_lo, hi = P.ph_hi;
    if (tid < 64) ((LAS unsigned*)(lds + MISC_OFF))[tid] = 0u;
    __syncthreads();
    XcdBarrier bar = xcd_barrier_post((unsigned*)(ws + WS_CTL), (volatile LAS unsigned*)(lds + MISC_OFF) + 8);
#define IN(k) (lo <= (k) && (k) < hi)
#define GSYNC() do { if (P.cg_sync) grid.sync(); else xcd_barrier(bar); } while (0)
#if defined(MK_TPROBE)
#define STAMP(i) do { if (blockIdx.x == 0 && tid == 0) ((volatile LAS unsigned long long*)(lds + MISC_OFF + 64))[(i)] = __builtin_amdgcn_s_memrealtime(); } while (0)
#else
#define STAMP(i) do { } while (0)
#endif
#define SEAM(k) do { if (IN(k) && IN((k) + 1)) GSYNC(); STAMP((k) + 1); } while (0)
#define DUPQ(k) ((MK_DUP >> (k)) & 1)
    bf16* hb = (bf16*)(ws + WS_HB); float* ssp = (float*)(ws + WS_SSP); bf16* R1 = (bf16*)(ws + WS_R1);

    STAMP(0);
    if (IN(0)) {
        p0_prep(P, lds, wave, lane, G);
#if (MK_DUP >> 0) & 1
        GSYNC();
        p0_prep(P, lds, wave, lane, G);
#endif
    }
    SEAM(0);
    if (IN(1)) {
        {
        meta_p1(P, wave, lane, G);
        prep_items(P, 2 * I_GU + (int)blockIdx.x * 8 + wave, IT_P0, G * 8, (LAS unsigned*)(lds + wave * 16384), lane); __syncthreads();
        pg8::Gemm g{hb, (const bf16*)(ws + WS_WGU1), NFR, NGU, D}; pg8::StaticOrder S; S.init(NFR, NGU, G, (int)blockIdx.x);
        pg8::EpiSwiglu E{R1, ssp};
        pg8::gemm_phase<pg8::EpiSwiglu, pg8::StaticOrder, true, true>(lds, g, S, E);
    }
#if (MK_DUP >> 1) & 1
        GSYNC();
        {
        meta_p1(P, wave, lane, G);
        prep_items(P, 2 * I_GU + (int)blockIdx.x * 8 + wave, IT_P0, G * 8, (LAS unsigned*)(lds + wave * 16384), lane); __syncthreads();
        pg8::Gemm g{hb, (const bf16*)(ws + WS_WGU1), NFR, NGU, D}; pg8::StaticOrder S; S.init(NFR, NGU, G, (int)blockIdx.x);
        pg8::EpiSwiglu E{R1, ssp};
        pg8::gemm_phase<pg8::EpiSwiglu, pg8::StaticOrder, true, true>(lds, g, S, E);
    }
#endif
    }
    SEAM(1);
    if (IN(2)) {
        {
        meta_p2(P, lds, wave, lane);
        pg8::Gemm g{R1, (const bf16*)(ws + WS_WD1), NFR, D, FF}; pg8::StaticOrder S; S.init(NFR, D, G, (int)blockIdx.x);
        pg8::EpiResid<false> E{hb, nullptr, ssp, 0.5f};
        pg8::gemm_phase<pg8::EpiResid<false>, pg8::StaticOrder, true, true>(lds, g, S, E);
    }
#if (MK_DUP >> 2) & 1
        GSYNC();
        {
        meta_p2(P, lds, wave, lane);
        pg8::Gemm g{R1, (const bf16*)(ws + WS_WD1), NFR, D, FF}; pg8::StaticOrder S; S.init(NFR, D, G, (int)blockIdx.x);
        pg8::EpiResid<false> E{hb, nullptr, ssp, 0.5f};
        pg8::gemm_phase<pg8::EpiResid<false>, pg8::StaticOrder, true, true>(lds, g, S, E);
    }
#endif
    }
    SEAM(2);
    if (IN(3)) {
        {
        meta_p3(P, wave, lane, G);
        pg8::Gemm g{hb, (const bf16*)(ws + WS_WIN), NFR, NIN, D}; pg8::StaticOrder S; S.init(NFR, NIN, G, (int)blockIdx.x);
        pg8::EpiIn E{R1, (float*)(ws + WS_GLOW), ssp};
        pg8::gemm_phase<pg8::EpiIn, pg8::StaticOrder, true, true>(lds, g, S, E);
    }
#if (MK_DUP >> 3) & 1
        GSYNC();
        {
        meta_p3(P, wave, lane, G);
        pg8::Gemm g{hb, (const bf16*)(ws + WS_WIN), NFR, NIN, D}; pg8::StaticOrder S; S.init(NFR, NIN, G, (int)blockIdx.x);
        pg8::EpiIn E{R1, (float*)(ws + WS_GLOW), ssp};
        pg8::gemm_phase<pg8::EpiIn, pg8::StaticOrder, true, true>(lds, g, S, E);
    }
#endif
    }
    SEAM(3);
    if (IN(4)) {
        {
        { GlaLd gl; int it = blockIdx.x;
          if (it < 1032) gla_load<true>(P, gl, (it / 129) >> 2, (it / 129) & 3, it % 129, tid);
          while (it < 1032) { const int nx = it + G, ld = nx < 1032 ? nx : it;
              gla_stage<true>(lds, gl, tid); float gw[16];
#pragma unroll
              for (int q = 0; q < 16; ++q) gw[q] = gl.gw[q];
              const float bias = gl.bias;
              __syncthreads();
              gla_load<true>(P, gl, (ld / 129) >> 2, (ld / 129) & 3, ld % 129, tid);
              gla_kv_item(P, lds, it, gw, bias, tid, wave, lane); it = nx; } }
        { const int bx = blockIdx.x, vcu = (G % 8 == 0) ? (bx % 8) * (G / 8) + bx / 8 : bx;
          for (int it = vcu; it < 512; it += G) attn_item(P, lds, it, tid, wave, lane); }
#if defined(MK_DUPA)
        for (int it = blockIdx.x; it < 512; it += G) attn_item(P, lds, it, tid, wave, lane);
#endif
    }
#if (MK_DUP >> 4) & 1
        GSYNC();
        {
        { const int bx = blockIdx.x, vcu = (G % 8 == 0) ? (bx % 8) * (G / 8) + bx / 8 : bx;
          for (int it = vcu; it < 512; it += G) attn_item(P, lds, it, tid, wave, lane); }
        { GlaLd gl; int it = blockIdx.x;
          if (it < 1032) gla_load<true>(P, gl, (it / 129) >> 2, (it / 129) & 3, it % 129, tid);
          while (it < 1032) { const int nx = it + G, ld = nx < 1032 ? nx : it;
              gla_stage<true>(lds, gl, tid); float gw[16];
#pragma unroll
              for (int q = 0; q < 16; ++q) gw[q] = gl.gw[q];
              const float bias = gl.bias;
              __syncthreads();
              gla_load<true>(P, gl, (ld / 129) >> 2, (ld / 129) & 3, ld % 129, tid);
              gla_kv_item(P, lds, it, gw, bias, tid, wave, lane); it = nx; } }
    }
#endif
    }
    SEAM(4);
    if (IN(5)) {
        { gla_scan(P, wave, lane, G);
          if (wave >= 4) prep_items(P, IT_P0 + (wave - 4) * G + (int)blockIdx.x, IT_END, 4 * G, (LAS unsigned*)(lds + wave * 16384), lane); }
#if (MK_DUP >> 5) & 1
        GSYNC();
        { gla_scan(P, wave, lane, G);
          if (wave >= 4) prep_items(P, IT_P0 + (wave - 4) * G + (int)blockIdx.x, IT_END, 4 * G, (LAS unsigned*)(lds + wave * 16384), lane); }
#endif
    }
    SEAM(5);
    if (IN(6)) {
        { GlaLd gl; int it = blockIdx.x;
          if (it < 1024) gla_load<false>(P, gl, (it >> 7) >> 2, (it >> 7) & 3, (it & 127) + 1, tid);
          while (it < 1024) { const int nx = it + G, ld = nx < 1024 ? nx : it;
              gla_stage<false>(lds, gl, tid); float gw[16];
#pragma unroll
              for (int q = 0; q < 16; ++q) gw[q] = gl.gw[q];
              const float bias = gl.bias;
              __syncthreads();
              gla_load<false>(P, gl, (ld >> 7) >> 2, (ld >> 7) & 3, (ld & 127) + 1, tid);
              gla_out_item(P, lds, it, gw, bias, tid, wave, lane); it = nx; } }
#if (MK_DUP >> 6) & 1
        GSYNC();
        { GlaLd gl; int it = blockIdx.x;
          if (it < 1024) gla_load<false>(P, gl, (it >> 7) >> 2, (it >> 7) & 3, (it & 127) + 1, tid);
          while (it < 1024) { const int nx = it + G, ld = nx < 1024 ? nx : it;
              gla_stage<false>(lds, gl, tid); float gw[16];
#pragma unroll
              for (int q = 0; q < 16; ++q) gw[q] = gl.gw[q];
              const float bias = gl.bias;
              __syncthreads();
              gla_load<false>(P, gl, (ld >> 7) >> 2, (ld >> 7) & 3, (ld & 127) + 1, tid);
              gla_out_item(P, lds, it, gw, bias, tid, wave, lane); it = nx; } }
#endif
    }
    SEAM(6);
    if (IN(7)) {
        {
        bf16* mixed = (bf16*)(ws + WS_KV);
        { pg8::Gemm g{(const bf16*)P.out, (const bf16*)(ws + WS_WA), NFR, D, 512}; pg8::StaticOrder S; S.init(NFR, D, G, (int)blockIdx.x);
          pg8::EpiMix<false> E{(const unsigned char*)R1 + 4608, mixed};
          pg8::gemm_phase<pg8::EpiMix<false>, pg8::StaticOrder, true, true>(lds, g, S, E); }
        { pg8::Gemm g{(const bf16*)P.out + (size_t)NFR * 512, (const bf16*)(ws + WS_WB), NFR, D, 512}; pg8::StaticOrder S; S.init(NFR, D, G, (int)blockIdx.x);
          pg8::EpiMix<true> E{(const unsigned char*)R1 + 4608 + 1024, mixed};
          pg8::gemm_phase<pg8::EpiMix<true>, pg8::StaticOrder, true, true>(lds, g, S, E); }
    }
#if (MK_DUP >> 7) & 1
        GSYNC();
        {
        bf16* mixed = (bf16*)(ws + WS_KV);
        { pg8::Gemm g{(const bf16*)P.out, (const bf16*)(ws + WS_WA), NFR, D, 512}; pg8::StaticOrder S; S.init(NFR, D, G, (int)blockIdx.x);
          pg8::EpiMix<false> E{(const unsigned char*)R1 + 4608, mixed};
          pg8::gemm_phase<pg8::EpiMix<false>, pg8::StaticOrder, true, true>(lds, g, S, E); }
        { pg8::Gemm g{(const bf16*)P.out + (size_t)NFR * 512, (const bf16*)(ws + WS_WB), NFR, D, 512}; pg8::StaticOrder S; S.init(NFR, D, G, (int)blockIdx.x);
          pg8::EpiMix<true> E{(const unsigned char*)R1 + 4608 + 1024, mixed};
          pg8::gemm_phase<pg8::EpiMix<true>, pg8::StaticOrder, true, true>(lds, g, S, E); }
    }
#endif
    }
    SEAM(7);
    if (IN(8)) {
        {
        pg8::Gemm g{(const bf16*)(ws + WS_KV), (const bf16*)(ws + WS_WOUT), NFR, D, D}; pg8::StaticOrder S; S.init(NFR, D, G, (int)blockIdx.x);
#if defined(MK_DRY8)
        { pg8::EpiResid<false> E0{hb, nullptr, ssp, 0.0f}; pg8::gemm_phase<pg8::EpiResid<false>, pg8::StaticOrder, true, true>(lds, g, S, E0); GSYNC(); }
#endif
        pg8::EpiResid<false> E{hb, nullptr, ssp, 1.0f};
        pg8::gemm_phase<pg8::EpiResid<false>, pg8::StaticOrder, true, true>(lds, g, S, E);
    }
#if (MK_DUP >> 8) & 1
        GSYNC();
        {
        pg8::Gemm g{(const bf16*)(ws + WS_KV), (const bf16*)(ws + WS_WOUT), NFR, D, D}; pg8::StaticOrder S; S.init(NFR, D, G, (int)blockIdx.x);
        pg8::EpiResid<false> E{hb, nullptr, ssp, 1.0f};
        pg8::gemm_phase<pg8::EpiResid<false>, pg8::StaticOrder, true, true>(lds, g, S, E);
    }
#endif
    }
    SEAM(8);
    if (IN(9)) {
        {
        pg8::Gemm g{hb, (const bf16*)(ws + WS_WGU2), NFR, NGU, D}; pg8::StaticOrder S; S.init(NFR, NGU, G, (int)blockIdx.x);
        pg8::EpiSwiglu E{R1, ssp};
        pg8::gemm_phase<pg8::EpiSwiglu, pg8::StaticOrder, true, true>(lds, g, S, E);
    }
#if (MK_DUP >> 9) & 1
        GSYNC();
        {
        pg8::Gemm g{hb, (const bf16*)(ws + WS_WGU2), NFR, NGU, D}; pg8::StaticOrder S; S.init(NFR, NGU, G, (int)blockIdx.x);
        pg8::EpiSwiglu E{R1, ssp};
        pg8::gemm_phase<pg8::EpiSwiglu, pg8::StaticOrder, true, true>(lds, g, S, E);
    }
#endif
    }
    SEAM(9);
    if (IN(10)) {
        {
        pg8::Gemm g{R1, (const bf16*)(ws + WS_WD2), NFR, D, FF}; pg8::StaticOrder S; S.init(NFR, D, G, (int)blockIdx.x);
#if defined(MK_DRY10)
        { pg8::EpiResid<false> E0{hb, nullptr, ssp, 0.0f}; pg8::gemm_phase<pg8::EpiResid<false>, pg8::StaticOrder, true, true>(lds, g, S, E0); GSYNC(); }
#endif
        if (S.nwg == G) { pg8::EpiFinal E{hb, P.out, ssp, (unsigned*)(ws + WS_CTL) + 4096, P.in[19], 0.5f};
            pg8::gemm_phase<pg8::EpiFinal, pg8::StaticOrder, false, true>(lds, g, S, E); }
        else { pg8::EpiResid<true> E{hb, P.out, ssp, 0.5f};
            pg8::gemm_phase<pg8::EpiResid<true>, pg8::StaticOrder, true, true>(lds, g, S, E); }
    }
#if (MK_DUP >> 10) & 1
        GSYNC();
        {
        pg8::Gemm g{R1, (const bf16*)(ws + WS_WD2), NFR, D, FF}; pg8::StaticOrder S; S.init(NFR, D, G, (int)blockIdx.x);
        if (S.nwg == G) { pg8::EpiFinal E{hb, P.out, ssp, (unsigned*)(ws + WS_CTL) + 4096, P.in[19], 0.5f};
            pg8::gemm_phase<pg8::EpiFinal, pg8::StaticOrder, false, true>(lds, g, S, E); }
        else { pg8::EpiResid<true> E{hb, P.out, ssp, 0.5f};
            pg8::gemm_phase<pg8::EpiResid<true>, pg8::StaticOrder, true, true>(lds, g, S, E); }
    }
#endif
    }
    if (G != 256) SEAM(10); else STAMP(11);
    if (IN(11)) {
        {
        const int gw = blockIdx.x * 8 + wave, NGW = G * 8;
        for (int m = gw; m < (G == 256 ? 0 : NFR); m += NGW) {
            f32x4* rowp = (f32x4*)(P.out + (size_t)m * D) + lane;
            float s = ssp[(size_t)m * 16 + (lane & 15)];
            s += __shfl_xor(s, 1); s += __shfl_xor(s, 2); s += __shfl_xor(s, 4); s += __shfl_xor(s, 8);
            const float rs = __builtin_amdgcn_rsqf(s * (1.0f / 1024.0f) + 1e-6f);
#pragma unroll
            for (int j = 0; j < 4; ++j) { const f32x4 gn = ((const f32x4*)P.in[19])[lane + 64 * j]; f32x4 v = rowp[64 * j]; rowp[64 * j] = v * rs * gn; }
        }
    }
#if (MK_DUP >> 11) & 1
        GSYNC();
        {
        const int gw = blockIdx.x * 8 + wave, NGW = G * 8;
        for (int m = gw; m < (G == 256 ? 0 : NFR); m += NGW) {
            f32x4* rowp = (f32x4*)(P.out + (size_t)m * D) + lane;
            float s = ssp[(size_t)m * 16 + (lane & 15)];
            s += __shfl_xor(s, 1); s += __shfl_xor(s, 2); s += __shfl_xor(s, 4); s += __shfl_xor(s, 8);
            const float rs = __builtin_amdgcn_rsqf(s * (1.0f / 1024.0f) + 1e-6f);
#pragma unroll
            for (int j = 0; j < 4; ++j) { const f32x4 gn = ((const f32x4*)P.in[19])[lane + 64 * j]; f32x4 v = rowp[64 * j]; rowp[64 * j] = v * rs * gn; }
        }
    }
#endif
    }
#if defined(MK_TPROBE)
    STAMP(12);
    if (blockIdx.x == 0 && tid == 0) { volatile LAS unsigned long long* ts = (volatile LAS unsigned long long*)(lds + MISC_OFF + 64);
        const unsigned long long dt = ts[MK_TPROBE + 1] - ts[MK_TPROBE], t0 = __builtin_amdgcn_s_memrealtime();
        while (__builtin_amdgcn_s_memrealtime() - t0 < dt) __builtin_amdgcn_s_sleep(4); }
#endif
#if defined(MK_XSYNC)
    for (int xs_ = 0; xs_ < MK_XSYNC; ++xs_) GSYNC();
#endif
#undef IN
#undef SEAM
}

extern "C" void kernel_launch(void* const* d_in, const int* in_sizes, int n_in, void* d_out, int out_size, void* d_ws, size_t ws_size, hipStream_t stream) {
    static int grid = 0;
    if (grid == 0) {
        if (n_in != 20 || out_size != NFR * D || ws_size < WS_END) { fprintf(stderr, "kernel_launch: unexpected shapes (n_in %d out %d ws %zu)\n", n_in, out_size, ws_size); grid = -1; return; }
        int dev = 0, cus = 0, per_cu = 0;
        hipGetDevice(&dev); hipDeviceGetAttribute(&cus, hipDeviceAttributeMultiprocessorCount, dev);
        if (hipFuncSetAttribute((const void*)mega_fwd, hipFuncAttributeMaxDynamicSharedMemorySize, LDS_BYTES) != hipSuccess) { fprintf(stderr, "kernel_launch: hipFuncSetAttribute failed\n"); grid = -1; return; }
        if (hipOccupancyMaxActiveBlocksPerMultiprocessor(&per_cu, (const void*)mega_fwd, 512, LDS_BYTES) != hipSuccess || per_cu < 1) { fprintf(stderr, "kernel_launch: occupancy query failed (%d)\n", per_cu); (void)hipGetLastError(); grid = -1; return; }
        grid = cus * per_cu;
        fprintf(stderr, "kernel_launch: %d CUs x %d blocks -> grid %d\n", cus, per_cu, grid);
    }
    if (grid < 0) return;
    Params p{};
    for (int i = 0; i < 20; ++i) p.in[i] = (const float*)d_in[i];
    p.out = (float*)d_out; p.ws = (unsigned char*)d_ws; p.cg_sync = 0; p.pad = 0;
    if (hipMemsetAsync((char*)d_ws + WS_CTL, 0, CTL_BYTES, stream) != hipSuccess) { fprintf(stderr, "kernel_launch: hipMemsetAsync failed\n"); return; }
#if MK_PER_PHASE
    for (int ph = 0; ph < NPH; ++ph) { p.ph_lo = ph; p.ph_hi = ph + 1; hipLaunchKernelGGL(mega_fwd, dim3(grid), dim3(512), LDS_BYTES, stream, p); }
#else
    p.ph_lo = 0; p.ph_hi = NPH;
    void* args[] = {&p};
    hipError_t e = hipLaunchCooperativeKernel((const void*)mega_fwd, dim3(grid), dim3(512), args, LDS_BYTES, stream);
    if (e != hipSuccess) fprintf(stderr, "kernel_launch: cooperative launch failed: %s (grid %d)\n", hipGetErrorString(e), grid);
#endif
}
```

```cpp
#include <hip/hip_runtime.h>
#include <hip/hip_cooperative_groups.h>
#include <cstdio>
#include <cstdint>
namespace cg = cooperative_groups;
namespace pg8 {
#define PG8_LAS __attribute__((address_space(3)))
typedef unsigned short bf16_t;
typedef short bf16x8 __attribute__((ext_vector_type(8)));
typedef float f32x4 __attribute__((ext_vector_type(4)));
typedef unsigned u32x4 __attribute__((ext_vector_type(4)));
constexpr int BM = 256, BK = 64, HALF = 128, HTB = HALF * BK * 2  , STAGE_BYTES = 8 * HTB, NXCD = 8, WGM = 8;

__host__ __device__ __forceinline__ int lds_byte(int r, int c) { const int st = (r >> 4) * 2 + (c >> 5), rr = r & 15, cc = c & 31, ob = rr * 64 + cc * 2; return st * 1024 + (ob ^ (((ob >> 9) & 1) << 5)); }
__host__ __device__ __forceinline__ void stage_rc(int b, int& R, int& C) { const int st = b / 1024, sb = b % 1024, swz = sb ^ (((sb >> 9) & 1) << 5); R = (st >> 1) * 16 + swz / 64; C = (st & 1) * 32 + (swz % 64) / 2; }
__host__ __device__ __forceinline__ int perm32(int rho) { const int n = rho >> 4, i = rho & 15; return 8 * (i >> 2) + 4 * n + (i & 3); }

struct Unit { int pm, pn; };
struct Gemm { const bf16_t* A; const bf16_t* Bt; int M, N, K; };

struct StaticOrder {
    int nM, nN, nwg, G, c, wgm;
    __host__ __device__ void init(int M, int N, int G_, int c_, int wgm_ = 4) { nM = M / BM; nN = N / BM; nwg = nM * nN; G = G_; c = c_; wgm = wgm_; }
    __host__ __device__ __forceinline__ bool next(int i, Unit& u) const {
        const long L = (long)i * G + c; if (L >= nwg) return false;
        int wgid = (int)L; { const int q = nwg / NXCD, r = nwg % NXCD, xcd = wgid % NXCD, off = wgid / NXCD; wgid = (xcd < r ? xcd * (q + 1) : r * (q + 1) + (xcd - r) * q) + off; }
        const int nig = wgm * nN, gid = wgid / nig, fm = gid * wgm, gsz = (nM - fm) < wgm ? (nM - fm) : wgm;
        u.pm = fm + ((wgid % nig) % gsz); u.pn = (wgid % nig) / gsz; return true;
    }
    __device__ __forceinline__ void a_ready(const Unit&) const {}
    __device__ __forceinline__ void done(const Unit&) const {}
};

__device__ __forceinline__ unsigned cvt_pk_bf16(float lo, float hi) { unsigned r; asm volatile("v_cvt_pk_bf16_f32 %0, %1, %2" : "=v"(r) : "v"(lo), "v"(hi)); return r; }
typedef float f32x2 __attribute__((ext_vector_type(2)));
constexpr int XD = 1024, XFF = 2816, XPBW = 4352, XNFR = 16384;
__device__ __forceinline__ float row_rstd(const float* ssp, int row, int fq) {
    const f32x4 p = *(const f32x4*)(ssp + (size_t)row * 16 + 4 * fq);
    float s = (p[0] + p[1]) + (p[2] + p[3]);
    s += __shfl_xor(s, 16); s += __shfl_xor(s, 32);
    return __builtin_amdgcn_rsqf(s * (1.0f / 1024.0f) + 1e-6f);
}
__device__ __forceinline__ float sigm(float x) { return __builtin_amdgcn_rcpf(1.0f + __expf(-x)); }
__device__ __forceinline__ float bf2f(unsigned short b) { return __uint_as_float((unsigned)b << 16); }
__device__ __forceinline__ float bflo(unsigned w) { return __uint_as_float(w << 16); }
__device__ __forceinline__ float bfhi(unsigned w) { return __uint_as_float(w & 0xffff0000u); }

struct EpiSwiglu {
    static constexpr bool PERM = true, AFTER_DRAIN = false;
    bf16_t* O; const float* ssp;
    __device__ __forceinline__ void operator()(const f32x4 (&acc)[2][2][4][2], const Unit& u, int wr, int wc, int fr, int fq) const {
        const int row0 = u.pm * BM + wr * 64 + fr, col0 = u.pn * HALF + wc * 32 + 8 * fq;
        float rsv[2][4];
#pragma unroll
        for (int ai = 0; ai < 2; ++ai)
#pragma unroll
            for (int m = 0; m < 4; ++m) rsv[ai][m] = row_rstd(ssp, row0 + ai * HALF + m * 16, fq);
#pragma unroll
        for (int ai = 0; ai < 2; ++ai)
#pragma unroll
            for (int m = 0; m < 4; ++m) {
                const int row = row0 + ai * HALF + m * 16; const float rs = rsv[ai][m];
                const f32x4 g0 = acc[ai][0][m][0] * rs, g1 = acc[ai][0][m][1] * rs, u0 = acc[ai][1][m][0] * rs, u1 = acc[ai][1][m][1] * rs;
                u32x4 w;
                w.x = cvt_pk_bf16(g0[0] * sigm(g0[0]) * u0[0], g0[1] * sigm(g0[1]) * u0[1]);
                w.y = cvt_pk_bf16(g0[2] * sigm(g0[2]) * u0[2], g0[3] * sigm(g0[3]) * u0[3]);
                w.z = cvt_pk_bf16(g1[0] * sigm(g1[0]) * u1[0], g1[1] * sigm(g1[1]) * u1[1]);
                w.w = cvt_pk_bf16(g1[2] * sigm(g1[2]) * u1[2], g1[3] * sigm(g1[3]) * u1[3]);
                *(u32x4*)(O + (size_t)row * XFF + col0) = w;
            }
    }
};

template <bool FOUT> struct EpiResid {
    static constexpr bool PERM = false, AFTER_DRAIN = false;
    bf16_t* hb; float* out; float* ssp; float scale;
    __device__ __forceinline__ void operator()(const f32x4 (&acc)[2][2][4][2], const Unit& u, int wr, int wc, int fr, int fq) const {
        typedef unsigned u32x2v __attribute__((ext_vector_type(2)));
        const int row0 = u.pm * BM + wr * 64 + fr, col0 = u.pn * BM + wc * 32 + 4 * fq;
#pragma unroll
        for (int ai = 0; ai < 2; ++ai)
#pragma unroll
            for (int m = 0; m < 4; ++m) {
                const int row = row0 + ai * HALF + m * 16;
                float sq = 0.f;
#pragma unroll
                for (int bj = 0; bj < 2; ++bj)
#pragma unroll
                    for (int n = 0; n < 2; ++n) {
                        const int c = col0 + bj * HALF + n * 16;
                        const u32x2v b = *(const u32x2v*)(hb + (size_t)row * XD + c);
                        const f32x4 v = (f32x4){bflo(b.x), bfhi(b.x), bflo(b.y), bfhi(b.y)} + acc[ai][bj][m][n] * scale;
                        sq += (v[0] * v[0] + v[1] * v[1]) + (v[2] * v[2] + v[3] * v[3]);
                        if (FOUT) *(f32x4*)(out + (size_t)row * XD + c) = v;
                        else { u32x2v w; w.x = cvt_pk_bf16(v[0], v[1]); w.y = cvt_pk_bf16(v[2], v[3]); *(u32x2v*)(hb + (size_t)row * XD + c) = w; }
                    }
                sq += __shfl_xor(sq, 16); sq += __shfl_xor(sq, 32);
                if (fq == 0) ssp[(size_t)row * 16 + u.pn * 4 + wc] = sq;
            }
    }
};
struct EpiFinal {
    static constexpr bool PERM = false, AFTER_DRAIN = true;
    const bf16_t* hb; float* out; float* ssp; unsigned* cnt; const float* gain; float scale;
    __device__ __forceinline__ void operator()(const f32x4 (&)[2][2][4][2], const Unit&, int, int, int, int) const {}
    __device__ __forceinline__ void fused(f32x4 (&acc)[2][2][4][2], const Unit& u, int wr, int wc, int fr, int fq, PG8_LAS unsigned char*, int, int lane) const {
        typedef unsigned u32x2v __attribute__((ext_vector_type(2)));
        const int row0 = u.pm * BM + wr * 64 + fr, col0 = u.pn * BM + wc * 32 + 4 * fq;
#pragma unroll
        for (int ai = 0; ai < 2; ++ai)
#pragma unroll
            for (int m = 0; m < 4; ++m) {
                const int row = row0 + ai * HALF + m * 16;
                float sq = 0.f;
#pragma unroll
                for (int bj = 0; bj < 2; ++bj)
#pragma unroll
                    for (int n = 0; n < 2; ++n) {
                        const u32x2v b = *(const u32x2v*)(hb + (size_t)row * XD + col0 + bj * HALF + n * 16);
                        const f32x4 v = (f32x4){bflo(b.x), bfhi(b.x), bflo(b.y), bfhi(b.y)} + acc[ai][bj][m][n] * scale;
                        sq += (v[0] * v[0] + v[1] * v[1]) + (v[2] * v[2] + v[3] * v[3]);
                        acc[ai][bj][m][n] = v;
                    }
                sq += __shfl_xor(sq, 16); sq += __shfl_xor(sq, 32);
                if (fq == 0) __hip_atomic_store(ssp + (size_t)row * 16 + u.pn * 4 + wc, sq, __ATOMIC_RELAXED, __HIP_MEMORY_SCOPE_AGENT);
            }
        asm volatile("s_waitcnt vmcnt(0)" ::: "memory");
        unsigned* c = cnt + 64 * u.pm;
        if (lane == 0) __hip_atomic_fetch_add(c, 1u, __ATOMIC_RELAXED, __HIP_MEMORY_SCOPE_AGENT);
        for (unsigned sp = 0; sp < (1u << 20); ++sp) {
            if ((unsigned)__builtin_amdgcn_readfirstlane((int)__hip_atomic_load(c, __ATOMIC_RELAXED, __HIP_MEMORY_SCOPE_AGENT)) >= 32u) break;
            __builtin_amdgcn_s_sleep(2);
        }
        __builtin_amdgcn_fence(__ATOMIC_ACQUIRE, "agent");
        f32x4 gn[2][2];
#pragma unroll
        for (int bj = 0; bj < 2; ++bj)
#pragma unroll
            for (int n = 0; n < 2; ++n) gn[bj][n] = *(const f32x4*)(gain + col0 + bj * HALF + n * 16);
#pragma unroll
        for (int ai = 0; ai < 2; ++ai)
#pragma unroll
            for (int m = 0; m < 4; ++m) {
                const int row = row0 + ai * HALF + m * 16;
                const float* sp4 = ssp + (size_t)row * 16 + 4 * fq;
                float s = (__hip_atomic_load(sp4, __ATOMIC_RELAXED, __HIP_MEMORY_SCOPE_AGENT) + __hip_atomic_load(sp4 + 1, __ATOMIC_RELAXED, __HIP_MEMORY_SCOPE_AGENT))
                        + (__hip_atomic_load(sp4 + 2, __ATOMIC_RELAXED, __HIP_MEMORY_SCOPE_AGENT) + __hip_atomic_load(sp4 + 3, __ATOMIC_RELAXED, __HIP_MEMORY_SCOPE_AGENT));
                s += __shfl_xor(s, 16); s += __shfl_xor(s, 32);
                const float rs = __builtin_amdgcn_rsqf(s * (1.0f / 1024.0f) + 1e-6f);
#pragma unroll
                for (int bj = 0; bj < 2; ++bj)
#pragma unroll
                    for (int n = 0; n < 2; ++n) __builtin_nontemporal_store(acc[ai][bj][m][n] * rs * gn[bj][n], (f32x4*)(out + (size_t)row * XD + col0 + bj * HALF + n * 16));
            }
    }
};

struct EpiIn {
    static constexpr bool PERM = true, AFTER_DRAIN = false;
    bf16_t* PB; float* glow; const float* ssp;
    __device__ __forceinline__ void operator()(const f32x4 (&acc)[2][2][4][2], const Unit& u, int wr, int wc, int fr, int fq) const {
        const int row0 = u.pm * BM + wr * 64 + fr, tile = u.pn;
        if (tile == 17) {
            if (wc == 0 && fq < 2) {
#pragma unroll
                for (int ai = 0; ai < 2; ++ai)
#pragma unroll
                    for (int m = 0; m < 4; ++m) {
                        const int row = row0 + ai * HALF + m * 16;
                        const f32x4 p = *(const f32x4*)(ssp + (size_t)row * 16), q = *(const f32x4*)(ssp + (size_t)row * 16 + 4), r = *(const f32x4*)(ssp + (size_t)row * 16 + 8), t = *(const f32x4*)(ssp + (size_t)row * 16 + 12);
                        const float s = (((p[0] + p[1]) + (p[2] + p[3])) + ((q[0] + q[1]) + (q[2] + q[3]))) + (((r[0] + r[1]) + (r[2] + r[3])) + ((t[0] + t[1]) + (t[2] + t[3])));
                        const float rs = __builtin_amdgcn_rsqf(s * (1.0f / 1024.0f) + 1e-6f);
                        *(f32x4*)(glow + (size_t)row * 16 + 8 * fq) = acc[ai][0][m][0] * rs;
                        *(f32x4*)(glow + (size_t)row * 16 + 8 * fq + 4) = acc[ai][0][m][1] * rs;
                    }
            }
            return;
        }
        const int mode = (tile <= 1 || tile == 3) ? 1 : (tile == 7 || tile == 8) ? 2 : (tile >= 9 ? 3 : 0);
        const int col0 = tile * BM + wc * 32 + 8 * fq;
        float rsv[2][4];
#pragma unroll
        for (int ai = 0; ai < 2; ++ai)
#pragma unroll
            for (int m = 0; m < 4; ++m) rsv[ai][m] = row_rstd(ssp, row0 + ai * HALF + m * 16, fq);
#pragma unroll
        for (int ai = 0; ai < 2; ++ai)
#pragma unroll
            for (int m = 0; m < 4; ++m) {
                const int row = row0 + ai * HALF + m * 16; const float rs = rsv[ai][m];
#pragma unroll
                for (int bj = 0; bj < 2; ++bj) {
                    f32x4 v0 = acc[ai][bj][m][0] * rs, v1 = acc[ai][bj][m][1] * rs;
                    if (mode == 1) { v0 = v0 * 0.125f; v1 = v1 * 0.125f; }
                    else if (mode == 2) {
#pragma unroll
                        for (int j = 0; j < 4; ++j) { v0[j] = v0[j] * sigm(v0[j]); v1[j] = v1[j] * sigm(v1[j]); } }
                    else if (mode == 3) {
                        typedef unsigned u32x2v __attribute__((ext_vector_type(2)));
                        unsigned q[8];
#pragma unroll
                        for (int j = 0; j < 4; ++j) { q[j] = (unsigned)(sigm(v0[j]) * 255.0f + 0.5f); q[4 + j] = (unsigned)(sigm(v1[j]) * 255.0f + 0.5f); }
                        u32x2v w8; w8.x = q[0] | (q[1] << 8) | (q[2] << 16) | (q[3] << 24); w8.y = q[4] | (q[5] << 8) | (q[6] << 16) | (q[7] << 24);
                        *(u32x2v*)((unsigned char*)(PB + (size_t)row * XPBW) + 4608 + (tile - 9) * BM + bj * HALF + wc * 32 + 8 * fq) = w8;
                        continue; }
                    u32x4 w; w.x = cvt_pk_bf16(v0[0], v0[1]); w.y = cvt_pk_bf16(v0[2], v0[3]); w.z = cvt_pk_bf16(v1[0], v1[1]); w.w = cvt_pk_bf16(v1[2], v1[3]);
                    *(u32x4*)(PB + (size_t)row * XPBW + col0 + bj * HALF) = w;
                }
            }
    }
};

template <bool ADD> struct EpiMix {
    static constexpr bool PERM = true, AFTER_DRAIN = false;
    const unsigned char* gate; bf16_t* mixed;
    __device__ __forceinline__ void operator()(const f32x4 (&acc)[2][2][4][2], const Unit& u, int wr, int wc, int fr, int fq) const {
        const int row0 = u.pm * BM + wr * 64 + fr, col0 = u.pn * BM + wc * 32 + 8 * fq;
#pragma unroll
        for (int ai = 0; ai < 2; ++ai)
#pragma unroll
            for (int m = 0; m < 4; ++m) {
                const int row = row0 + ai * HALF + m * 16;
#pragma unroll
                for (int bj = 0; bj < 2; ++bj) {
                    const int c = col0 + bj * HALF;
                    typedef unsigned u32x2v __attribute__((ext_vector_type(2)));
                    const u32x2v g = *(const u32x2v*)(gate + (size_t)row * (XPBW * 2) + c);
                    const f32x4 a0 = acc[ai][bj][m][0] * (1.0f / 255.0f), a1 = acc[ai][bj][m][1] * (1.0f / 255.0f);
                    float v[8] = {(float)(g.x & 0xffu) * a0[0], (float)((g.x >> 8) & 0xffu) * a0[1], (float)((g.x >> 16) & 0xffu) * a0[2], (float)(g.x >> 24) * a0[3],
                                  (float)(g.y & 0xffu) * a1[0], (float)((g.y >> 8) & 0xffu) * a1[1], (float)((g.y >> 16) & 0xffu) * a1[2], (float)(g.y >> 24) * a1[3]};
                    if (ADD) { const u32x4 o = *(const u32x4*)(mixed + (size_t)row * XD + c);
                        v[0] += bflo(o.x); v[1] += bfhi(o.x); v[2] += bflo(o.y); v[3] += bfhi(o.y); v[4] += bflo(o.z); v[5] += bfhi(o.z); v[6] += bflo(o.w); v[7] += bfhi(o.w); }
                    u32x4 w; w.x = cvt_pk_bf16(v[0], v[1]); w.y = cvt_pk_bf16(v[2], v[3]); w.z = cvt_pk_bf16(v[4], v[5]); w.w = cvt_pk_bf16(v[6], v[7]);
                    *(u32x4*)(mixed + (size_t)row * XD + c) = w;
                }
            }
    }
};


template <class Epi, class Sched, bool ALIGN_EPI = false, bool SP2 = false>
__device__ __forceinline__ void gemm_phase(PG8_LAS unsigned char* lds, const Gemm g, const Sched& S, const Epi& E) {
    const int tid = threadIdx.x, wid = __builtin_amdgcn_readfirstlane(tid >> 6), lane = tid & 63, wr = wid >> 2, wc = wid & 3, fr = lane & 15, fq = lane >> 4;
    const int K = g.K, nt = K / BK;
    unsigned voffA[2], voffB[2];
#pragma unroll
    for (int i = 0; i < 2; ++i) { int R, C; stage_rc(tid * 16 + i * 8192, R, C); const int Rb = Epi::PERM ? ((R & ~31) + perm32(R & 31)) : R;
        voffA[i] = (unsigned)(R * K + C) * 2u; voffB[i] = (unsigned)(Rb * K + C) * 2u; }
    const size_t kstep = (size_t)(BK * 2);
    const size_t hstep = (size_t)HALF * K * 2;
    const size_t tstep = 2 * hstep;
    const unsigned ldsw = (unsigned)wid * 1024u;
    const int aoff = lds_byte(wr * 64 + fr, fq * 8), boff = lds_byte(wc * 32 + fr, fq * 8);
#define PG8_SA(b, h) (((b) * 2 + (h)) * HTB)
#define PG8_SB(b, h) ((4 + (b) * 2 + (h)) * HTB)
#define PG8_STAGE(bufoff, gbase, voff) do { _Pragma("unroll") for (int _i = 0; _i < 2; ++_i) \
        __builtin_amdgcn_global_load_lds((const unsigned*)((const char*)(gbase) + (voff)[_i]), (PG8_LAS unsigned*)(lds + (bufoff) + ldsw + _i * 8192), 16, 0, 0); } while (0)
#define PG8_LDA(dst, b, h) do { _Pragma("unroll") for (int m = 0; m < 4; ++m) _Pragma("unroll") for (int k = 0; k < 2; ++k) dst[m][k] = *(const PG8_LAS bf16x8*)(lds + PG8_SA(b, h) + aoff + m * 2048 + k * 1024); } while (0)
#define PG8_LDB(dst, b, h) do { _Pragma("unroll") for (int n = 0; n < 2; ++n) _Pragma("unroll") for (int k = 0; k < 2; ++k) dst[n][k] = *(const PG8_LAS bf16x8*)(lds + PG8_SB(b, h) + boff + n * 2048 + k * 1024); } while (0)
#define PG8_MMA(ai, bj, At, Bt) do { __builtin_amdgcn_s_setprio(1); _Pragma("unroll") for (int m = 0; m < 4; ++m) _Pragma("unroll") for (int n = 0; n < 2; ++n) _Pragma("unroll") for (int k = 0; k < 2; ++k) \
        acc[ai][bj][m][n] = __builtin_amdgcn_mfma_f32_16x16x32_bf16(Bt[n][k], At[m][k], acc[ai][bj][m][n], 0, 0, 0); __builtin_amdgcn_s_setprio(0); } while (0)
#define PG8_WAIT_V(n) asm volatile("s_waitcnt vmcnt(" #n ")" ::: "memory")
#define PG8_WAIT_L(n) asm volatile("s_waitcnt lgkmcnt(" #n ")" ::: "memory")
#define PG8_BAR __builtin_amdgcn_s_barrier()
#define PG8_SCHED __builtin_amdgcn_sched_barrier(0)
    Unit cur, nxt; int ui = 0;
    if (!S.next(0, cur)) return;
    f32x4 acc[2][2][4][2];
#pragma unroll
    for (int a = 0; a < 2; ++a)
#pragma unroll
        for (int b = 0; b < 2; ++b)
#pragma unroll
            for (int m = 0; m < 4; ++m)
#pragma unroll
                for (int n = 0; n < 2; ++n) acc[a][b][m][n] = (f32x4){0.f, 0.f, 0.f, 0.f};
    bf16x8 At[4][2], B0[2][2], B1[2][2];
    const char* cA = (const char*)g.A + (size_t)cur.pm * tstep; const char* cB = (const char*)g.Bt + (size_t)cur.pn * tstep;
    S.a_ready(cur);
    if constexpr (SP2) {
        PG8_STAGE(PG8_SB(0, 0), cB, voffB); PG8_STAGE(PG8_SB(0, 1), cB + hstep, voffB); PG8_STAGE(PG8_SA(0, 0), cA, voffA); PG8_STAGE(PG8_SA(0, 1), cA + hstep, voffA);
        if (wr == 1) PG8_BAR;
        PG8_WAIT_V(2); PG8_BAR;
        PG8_STAGE(PG8_SB(1, 0), cB + kstep, voffB); PG8_STAGE(PG8_SA(1, 0), cA + kstep, voffA); PG8_STAGE(PG8_SB(1, 1), cB + hstep + kstep, voffB);
        PG8_WAIT_V(6); PG8_BAR;
    } else {
        PG8_STAGE(PG8_SB(0, 0), cB, voffB); PG8_STAGE(PG8_SA(0, 0), cA, voffA); PG8_STAGE(PG8_SB(0, 1), cB + hstep, voffB); PG8_STAGE(PG8_SA(0, 1), cA + hstep, voffA);
        if (wr == 1) PG8_BAR;
        PG8_WAIT_V(4); PG8_BAR;
        PG8_STAGE(PG8_SB(1, 0), cB + kstep, voffB); PG8_STAGE(PG8_SA(1, 0), cA + kstep, voffA); PG8_STAGE(PG8_SB(1, 1), cB + hstep + kstep, voffB);
        PG8_WAIT_V(6); PG8_BAR;
    }
    for (;;) {
        const bool has_next = S.next(ui + 1, nxt);
        const char* nA = has_next ? (const char*)g.A + (size_t)nxt.pm * tstep : cA; const char* nB = has_next ? (const char*)g.Bt + (size_t)nxt.pn * tstep : cB;
        for (int t = 0; t < nt; t += 2) {
            const bool last = (t == nt - 2);
            const char* a1 = cA + (size_t)(t + 1) * kstep;
            const char* a2 = last ? nA : cA + (size_t)(t + 2) * kstep; const char* b2 = last ? nB : cB + (size_t)(t + 2) * kstep;
            const char* a3 = a2 + kstep; const char* b3 = b2 + kstep;
            if (last && has_next) S.a_ready(nxt);
            if constexpr (SP2) {
            PG8_LDB(B0, 0, 0); PG8_LDB(B1, 0, 1); PG8_SCHED; PG8_LDA(At, 0, 0); PG8_STAGE(PG8_SA(1, 1), a1 + hstep, voffA);
            PG8_WAIT_V(8); PG8_WAIT_L(0); PG8_BAR; PG8_MMA(0, 0, At, B0); PG8_MMA(0, 1, At, B1); PG8_BAR; PG8_SCHED;
            PG8_LDA(At, 0, 1); PG8_STAGE(PG8_SB(0, 0), b2, voffB); PG8_STAGE(PG8_SB(0, 1), b2 + hstep, voffB); PG8_STAGE(PG8_SA(0, 0), a2, voffA);
            PG8_WAIT_V(8); PG8_WAIT_L(0); PG8_BAR; PG8_MMA(1, 0, At, B0); PG8_MMA(1, 1, At, B1); PG8_BAR; PG8_SCHED;
            PG8_LDB(B0, 1, 0); PG8_LDB(B1, 1, 1); PG8_SCHED; PG8_LDA(At, 1, 0); PG8_STAGE(PG8_SA(0, 1), a2 + hstep, voffA);
            PG8_WAIT_V(8); PG8_WAIT_L(0); PG8_BAR; PG8_MMA(0, 0, At, B0); PG8_MMA(0, 1, At, B1); PG8_BAR; PG8_SCHED;
            PG8_LDA(At, 1, 1); PG8_STAGE(PG8_SB(1, 0), b3, voffB); PG8_STAGE(PG8_SB(1, 1), b3 + hstep, voffB); PG8_STAGE(PG8_SA(1, 0), a3, voffA);
            PG8_WAIT_V(8); PG8_WAIT_L(0); PG8_BAR; PG8_MMA(1, 0, At, B0); PG8_MMA(1, 1, At, B1); PG8_BAR; PG8_SCHED;
            } else {
            PG8_LDB(B0, 0, 0); PG8_SCHED; PG8_LDA(At, 0, 0); PG8_STAGE(PG8_SA(1, 1), a1 + hstep, voffA);
            PG8_WAIT_L(8); PG8_BAR; PG8_WAIT_L(0); PG8_MMA(0, 0, At, B0); PG8_BAR; PG8_SCHED;
            PG8_LDB(B1, 0, 1); PG8_STAGE(PG8_SB(0, 0), b2, voffB);
            PG8_BAR; PG8_WAIT_L(0); PG8_MMA(0, 1, At, B1); PG8_BAR;
            PG8_LDA(At, 0, 1); PG8_STAGE(PG8_SA(0, 0), a2, voffA);
            PG8_BAR; PG8_WAIT_L(0); PG8_MMA(1, 0, At, B0); PG8_BAR; PG8_SCHED;
            PG8_STAGE(PG8_SB(0, 1), b2 + hstep, voffB);
            PG8_WAIT_V(6); PG8_BAR; PG8_MMA(1, 1, At, B1); PG8_BAR;
            PG8_LDB(B0, 1, 0); PG8_SCHED; PG8_LDA(At, 1, 0); PG8_STAGE(PG8_SA(0, 1), a2 + hstep, voffA);
            PG8_WAIT_L(8); PG8_BAR; PG8_WAIT_L(0); PG8_MMA(0, 0, At, B0); PG8_BAR; PG8_SCHED;
            PG8_LDB(B1, 1, 1); PG8_STAGE(PG8_SB(1, 0), b3, voffB);
            PG8_BAR; PG8_WAIT_L(0); PG8_MMA(0, 1, At, B1); PG8_BAR;
            PG8_LDA(At, 1, 1); PG8_STAGE(PG8_SA(1, 0), a3, voffA);
            PG8_BAR; PG8_WAIT_L(0); PG8_MMA(1, 0, At, B0); PG8_BAR; PG8_SCHED;
            PG8_STAGE(PG8_SB(1, 1), b3 + hstep, voffB);
            PG8_WAIT_V(6); PG8_BAR; PG8_MMA(1, 1, At, B1); PG8_BAR;
            }
        }
        if constexpr (ALIGN_EPI) { if (wr == 0) PG8_BAR; }
        if constexpr (!Epi::AFTER_DRAIN) { E(acc, cur, wr, wc, fr, fq); S.done(cur); }
        if (!has_next) break;
#pragma unroll
        for (int a = 0; a < 2; ++a)
#pragma unroll
            for (int b = 0; b < 2; ++b)
#pragma unroll
                for (int m = 0; m < 4; ++m)
#pragma unroll
                    for (int n = 0; n < 2; ++n) acc[a][b][m][n] = (f32x4){0.f, 0.f, 0.f, 0.f};
        cur = nxt; cA = nA; cB = nB; ++ui;
        if constexpr (ALIGN_EPI) { if (wr == 1) PG8_BAR; }
    }
    PG8_WAIT_V(0);
    if constexpr (!ALIGN_EPI) { if (wr == 0) PG8_BAR; }
    PG8_BAR;
    if constexpr (Epi::AFTER_DRAIN) { E.fused(acc, cur, wr, wc, fr, fq, lds, wid, lane); S.done(cur); }
#undef PG8_SA
#undef PG8_SB
#undef PG8_STAGE
#undef PG8_LDA
#undef PG8_LDB
#undef PG8_MMA
#undef PG8_WAIT_V
#undef PG8_WAIT_L
#undef PG8_BAR
#undef PG8_SCHED
}
}
#define LAS __attribute__((address_space(3)))
#define XB_TMO      128
#define XB_XCNT(j)  (256  + 64 * (j))
#define XB_XSUB(j)  (1280 + 64 * (j))
#define XB_XGEN(j)  (2304 + 64 * (j))
#define XB_TOP      3328
#define XB_TOPGEN   3392
#define XCD_BAR_WORDS 3456
#define XB_SPIN_CAP (1u << 18)

__device__ __forceinline__ unsigned xb_ld(unsigned* p)              { return __hip_atomic_load(p, __ATOMIC_RELAXED, __HIP_MEMORY_SCOPE_AGENT); }
__device__ __forceinline__ unsigned xb_add(unsigned* p, unsigned v) { return __hip_atomic_fetch_add(p, v, __ATOMIC_RELAXED, __HIP_MEMORY_SCOPE_AGENT); }
__device__ __forceinline__ unsigned xb_xcc_id() { return (unsigned)__builtin_amdgcn_s_getreg((3 << 11) | 20) & 0xFu; }
#define XB_SPIN(cond, bar) do { unsigned _sp = 0; while (cond) { __builtin_amdgcn_s_sleep(1); \
    if ((++_sp & 255u) == 0u) { if (xb_ld(&(bar)[XB_TMO])) break; if (_sp > XB_SPIN_CAP) { atomicAdd(&(bar)[XB_TMO], 1u); break; } } } } while (0)

struct XcdBarrier {
    unsigned* bar; unsigned x;
    volatile LAS unsigned* st;
};

__device__ __forceinline__ XcdBarrier xcd_barrier_post(unsigned* bar, volatile LAS unsigned* st) {
    XcdBarrier b; b.bar = bar; b.x = xb_xcc_id(); b.st = st;
    if (threadIdx.x == 0) (void)xb_add(&bar[XB_XCNT(b.x)], 1u);
    return b;
}
__device__ __forceinline__ void xcd_barrier_complete(unsigned* bar, unsigned x, unsigned& nloc, unsigned& nx) {
    const unsigned G = gridDim.x * gridDim.y * gridDim.z;
    unsigned sum, cnt, mine, sp = 0u;
    for (;;) {
        sum = 0u; cnt = 0u; mine = 0u;
#pragma unroll
        for (unsigned j = 0; j < 16; ++j) { const unsigned c = xb_ld(&bar[XB_XCNT(j)]); sum += c; cnt += (c > 0u) ? 1u : 0u; mine = (j == x) ? c : mine; }
        if (sum == G) break;
        __builtin_amdgcn_s_sleep(1);
        if ((++sp & 255u) == 0u) { if (xb_ld(&bar[XB_TMO])) break; if (sp > XB_SPIN_CAP) { atomicAdd(&bar[XB_TMO], 1u); break; } }
    }
    nloc = mine > 0u ? mine : 1u; nx = cnt > 0u ? cnt : 1u;
}

__device__ __forceinline__ void xcd_barrier(const XcdBarrier& b) {
    asm volatile("s_waitcnt vmcnt(0)" ::: "memory");
    __syncthreads();
    if (threadIdx.x == 0) {
        unsigned* bar = b.bar;
        __builtin_amdgcn_s_waitcnt(0);
        unsigned nloc = b.st[0], nx = b.st[1];
        if (nloc == 0u) { xcd_barrier_complete(bar, b.x, nloc, nx); b.st[0] = nloc; b.st[1] = nx; }
        const unsigned old = xb_add(&bar[XB_XSUB(b.x)], 1u);
        const unsigned gen = old / nloc;
        if (old + 1u == (gen + 1u) * nloc) {
            __builtin_amdgcn_fence(__ATOMIC_RELEASE, "agent");
            asm volatile("s_waitcnt vmcnt(0)" ::: "memory");
            const unsigned og = xb_add(&bar[XB_TOP], 1u);
            const unsigned tg = og / nx;
            if (og + 1u == (tg + 1u) * nx) xb_add(&bar[XB_TOPGEN], 1u);
            else XB_SPIN(xb_ld(&bar[XB_TOPGEN]) == tg, bar);
            __builtin_amdgcn_fence(__ATOMIC_ACQUIRE, "agent");
            xb_add(&bar[XB_XGEN(b.x)], 1u);
            asm volatile("s_waitcnt vmcnt(0)" ::: "memory");
        } else {
            XB_SPIN(xb_ld(&bar[XB_XGEN(b.x)]) == gen, bar);
            __builtin_amdgcn_fence(__ATOMIC_ACQUIRE, "agent");
            asm volatile("s_waitcnt vmcnt(0)" ::: "memory");
        }
    }
    __syncthreads();
}

#ifndef MK_DUP
#define MK_DUP 0
#endif
#ifndef MK_PER_PHASE
#define MK_PER_PHASE 0
#endif
#define LAS __attribute__((address_space(3)))
typedef unsigned short bf16;
typedef short bf16x8 __attribute__((ext_vector_type(8)));
typedef short s16x4 __attribute__((ext_vector_type(4)));
typedef float f32x4 __attribute__((ext_vector_type(4)));
typedef float f32x16 __attribute__((ext_vector_type(16)));
typedef unsigned u32x4 __attribute__((ext_vector_type(4)));
typedef unsigned u32x2 __attribute__((ext_vector_type(2)));
typedef float f32x2m __attribute__((ext_vector_type(2)));
#define MFMA32(a, b, c) __builtin_amdgcn_mfma_f32_32x32x16_bf16((a), (b), (c), 0, 0, 0)
#define LDS_WAIT() asm volatile("s_waitcnt lgkmcnt(0)" ::: "memory")

constexpr int NFR = 16384, MT = 16640, D = 1024, FF = 2816, NGU = 5632, NIN = 4608, PBW = 4352, DIN = 4368;
constexpr int NPH = 12;
constexpr int LDS_BYTES = 147456, MISC_OFF = 131072 + 320, CTL_BYTES = 32768;
constexpr size_t MiB = 1u << 20;
constexpr size_t WS_WGU1 = 0, WS_WD1 = 11 * MiB, WS_ST = 0  , WS_WGU2 = 17 * MiB, WS_WD2 = 28 * MiB, WS_WIN = 34 * MiB,
                 WS_WA = 43 * MiB, WS_WB = 44 * MiB, WS_WOUT = 45 * MiB, WS_SSP = 47 * MiB, WS_GLOW = 49 * MiB, WS_DEC = 51 * MiB, WS_CTL = 51 * MiB + MiB / 2  , WS_MSSP = 51 * MiB + 3 * MiB / 4  ,
                 WS_HB = 52 * MiB, WS_YA = 52 * MiB, WS_YB = 68 * MiB  , WS_R1 = 85 * MiB  ,
                 WS_KV = 223 * MiB + MiB / 2  , WS_END = 256 * MiB;
static_assert(WS_ST + (size_t)1032 * 8192 * 2 <= WS_WGU2 && WS_R1 + (size_t)MT * PBW * 2 <= WS_KV && WS_KV + (size_t)NFR * D * 2 <= WS_END && WS_HB + (size_t)MT * D * 2 <= WS_R1, "d_ws map");

struct Params { const float* in[20]; float* out; unsigned char* ws; int ph_lo, ph_hi, cg_sync, pad; };

__device__ __forceinline__ int crow(int reg, int h) { return (reg & 3) + 8 * (reg >> 2) + 4 * h; }
typedef __bf16 bf16n2 __attribute__((ext_vector_type(2)));
__device__ __forceinline__ unsigned pk2(float lo, float hi) { bf16n2 v; v.x = (__bf16)lo; v.y = (__bf16)hi; return __builtin_bit_cast(unsigned, v); }
__device__ __forceinline__ unsigned f2bf(float f) { return (unsigned)__builtin_bit_cast(unsigned short, (__bf16)f); }
__device__ __forceinline__ float wave_sum(float v) {
#pragma unroll
    for (int o = 1; o < 64; o <<= 1) v += __shfl_xor(v, o);
    return v;
}
__device__ __forceinline__ bf16x8 pack8(float a, float b, float c, float d, float e, float f, float g, float h) {
    u32x4 p; p.x = pk2(a, b); p.y = pk2(c, d); p.z = pk2(e, f); p.w = pk2(g, h); return __builtin_bit_cast(bf16x8, p);
}

struct TrDesc { const float* W; const float* gain; bf16* WT; int K, N, k0, sn0, nvalid, drow0; };
__device__ __forceinline__ void tr_load(const TrDesc& d, f32x4 (&a)[8], f32x4 (&b)[8], int lane) {
    const int n4 = (lane & 15) * 4, kp = lane >> 4; const bool cv = n4 < d.nvalid;
#pragma unroll
    for (int st = 0; st < 8; ++st) { const float* p = d.W + (size_t)(d.k0 + 8 * st + 2 * kp) * d.N + d.sn0 + n4;
        a[st] = cv ? __builtin_nontemporal_load((const f32x4*)p) : (f32x4){0.f, 0.f, 0.f, 0.f}; b[st] = cv ? __builtin_nontemporal_load((const f32x4*)(p + d.N)) : (f32x4){0.f, 0.f, 0.f, 0.f}; }
}
__device__ __forceinline__ void tr_store(const TrDesc& d, const f32x4 (&a)[8], const f32x4 (&b)[8], LAS unsigned* T, int lane) {
    const int n4 = (lane & 15) * 4, kp = lane >> 4;
#pragma unroll
    for (int st = 0; st < 8; ++st) { const int k = d.k0 + 8 * st + 2 * kp; float g0 = 1.f, g1 = 1.f; if (d.gain) { g0 = d.gain[k]; g1 = d.gain[k + 1]; }
        LAS unsigned* t = T + n4 * 33 + 4 * st + kp;
        t[0] = pk2(a[st][0] * g0, b[st][0] * g1); t[33] = pk2(a[st][1] * g0, b[st][1] * g1); t[66] = pk2(a[st][2] * g0, b[st][2] * g1); t[99] = pk2(a[st][3] * g0, b[st][3] * g1); }
    LDS_WAIT(); asm volatile("" ::: "memory");
    const int c = lane & 7;
#pragma unroll
    for (int q = 0; q < 8; ++q) { const int n = (lane >> 3) + 8 * q; const LAS unsigned* t = T + n * 33 + 4 * c;
        u32x4 o; o.x = t[0]; o.y = t[1]; o.z = t[2]; o.w = t[3];
        *(u32x4*)(d.WT + (size_t)(d.drow0 + n) * d.K + d.k0 + 8 * c) = o; }
    LDS_WAIT(); asm volatile("" ::: "memory");
}
constexpr int I_GU = 16 * 44, I_DN = 44 * 16, I_IN = 16 * 72, I_BR = 8 * 16, I_WO = 16 * 16;
constexpr int IT_P0 = 2 * I_GU + I_DN + I_IN, IT_END = IT_P0 + 2 * I_BR + I_WO + 2 * I_GU + I_DN;
__device__ __forceinline__ TrDesc prep_desc(const Params& P, int it) {
    unsigned char* ws = P.ws; int r = it; TrDesc d;
    if (r < 2 * I_GU) { const int up = r >= I_GU; r -= up * I_GU; const int kb = r / 44, n0 = (r % 44) * 64;
        d = TrDesc{up ? P.in[4] : P.in[3], P.in[2], (bf16*)(ws + WS_WGU1), D, FF, kb * 64, n0, 64, (n0 >> 7) * 256 + (n0 & 127) + up * 128}; return d; }
    r -= 2 * I_GU;
    if (r < I_DN) { d = TrDesc{P.in[5], nullptr, (bf16*)(ws + WS_WD1), FF, D, (r / 16) * 64, (r % 16) * 64, 64, (r % 16) * 64}; return d; }
    r -= I_DN;
    if (r < I_IN) { const int kb = r / 72, d0 = (r % 72) * 64; int sn0, nv;
        if (d0 < 2304) { sn0 = d0; nv = 64; } else if (d0 < 4352) { sn0 = d0 + 16; nv = 64; } else if (d0 == 4352) { sn0 = 2304; nv = 16; } else { sn0 = 0; nv = 0; }
        d = TrDesc{P.in[7], P.in[6], (bf16*)(ws + WS_WIN), D, DIN, kb * 64, sn0, nv, d0}; return d; }
    r -= I_IN;
    if (r < I_BR) { d = TrDesc{P.in[12], nullptr, (bf16*)(ws + WS_WA), 512, D, (r / 16) * 64, (r % 16) * 64, 64, (r % 16) * 64}; return d; }
    r -= I_BR;
    if (r < I_BR) { d = TrDesc{P.in[13], nullptr, (bf16*)(ws + WS_WB), 512, D, (r / 16) * 64, (r % 16) * 64, 64, (r % 16) * 64}; return d; }
    r -= I_BR;
    if (r < I_WO) { d = TrDesc{P.in[14], nullptr, (bf16*)(ws + WS_WOUT), D, D, (r / 16) * 64, (r % 16) * 64, 64, (r % 16) * 64}; return d; }
    r -= I_WO;
    if (r < 2 * I_GU) { const int up = r >= I_GU; r -= up * I_GU; const int kb = r / 44, n0 = (r % 44) * 64;
        d = TrDesc{up ? P.in[17] : P.in[16], P.in[15], (bf16*)(ws + WS_WGU2), D, FF, kb * 64, n0, 64, (n0 >> 7) * 256 + (n0 & 127) + up * 128}; return d; }
    r -= 2 * I_GU;
    d = TrDesc{P.in[18], nullptr, (bf16*)(ws + WS_WD2), FF, D, (r / 16) * 64, (r % 16) * 64, 64, (r % 16) * 64}; return d;
}
__device__ __forceinline__ void prep_items(const Params& P, int first, int hi, int stride, LAS unsigned* scr, int lane) {
    for (int it = first; it < hi; it += 2 * stride) {
        const bool two = it + stride < hi;
        const TrDesc d0 = prep_desc(P, it), d1 = prep_desc(P, two ? it + stride : it);
        f32x4 a0[8], b0[8], a1[8], b1[8];
        tr_load(d0, a0, b0, lane);
        if (two) tr_load(d1, a1, b1, lane);
        tr_store(d0, a0, b0, scr, lane);
        if (two) tr_store(d1, a1, b1, scr, lane);
    }
}
__device__ __forceinline__ void prep_in_slack(const Params& P, LAS unsigned char* lds, int lo, int hi, int nwg, int wave, int lane, int G) {
    const int rem = nwg % G, c = (int)blockIdx.x; int ns, si;
    if (rem == 0) { ns = G; si = c; } else { if (c < rem) return; ns = G - rem; si = c - rem; }
    prep_items(P, lo + wave * ns + si, hi, ns * 8, (LAS unsigned*)(lds + wave * 16384), lane);
}
__device__ __forceinline__ void p0_prep(const Params& P, LAS unsigned char* lds, int wave, int lane, int G) {
    unsigned char* ws = P.ws;
    LAS unsigned* scr = (LAS unsigned*)(lds + wave * 16384);
    const int gw = blockIdx.x * 8 + wave, NGW = G * 8;
    prep_items(P, gw, 2 * I_GU, NGW, scr, lane);
    bf16* hb = (bf16*)(ws + WS_HB); float* ssp = (float*)(ws + WS_SSP);
    for (int m0 = gw; m0 < MT; m0 += 2 * NGW) {
        f32x4 v[2][4]; float s[2];
#pragma unroll
        for (int u = 0; u < 2; ++u) { const int m = m0 + u * NGW;
            const float* src = m < NFR ? P.in[0] + (size_t)m * D : (m < NFR + 16 ? P.in[1] + (size_t)(m - NFR) * D : nullptr);
#pragma unroll
            for (int j = 0; j < 4; ++j) v[u][j] = src ? __builtin_nontemporal_load((const f32x4*)src + lane + 64 * j) : (f32x4){0.f, 0.f, 0.f, 0.f}; }
#pragma unroll
        for (int u = 0; u < 2; ++u) { const int m = m0 + u * NGW; s[u] = 0.f;
#pragma unroll
            for (int j = 0; j < 4; ++j) s[u] += (v[u][j][0] * v[u][j][0] + v[u][j][1] * v[u][j][1]) + (v[u][j][2] * v[u][j][2] + v[u][j][3] * v[u][j][3]);
            s[u] = wave_sum(s[u]);
            if (m < MT) {
                u32x2* o8 = (u32x2*)(hb + (size_t)m * D) + lane;
#pragma unroll
                for (int j = 0; j < 4; ++j) { u32x2 w; w.x = pk2(v[u][j][0], v[u][j][1]); w.y = pk2(v[u][j][2], v[u][j][3]); o8[64 * j] = w; }
                if (lane < 16) ssp[(size_t)m * 16 + lane] = lane == 0 ? s[u] : 0.f; } }
    }
}

typedef float f32x4m __attribute__((ext_vector_type(4)));
#define MFMA16(a, b, c) __builtin_amdgcn_mfma_f32_16x16x32_bf16((a), (b), (c), 0, 0, 0)
__device__ __forceinline__ f32x4m meta_mm(const bf16* A, const bf16* Brow, int K, int k0, int nsteps, int lane) {
    const int r = lane & 15, quad = lane >> 4;
    const bf16* ap = A + (size_t)r * K + k0 + quad * 8; const bf16* bp = Brow + (size_t)r * K + k0 + quad * 8;
    f32x4m acc = (f32x4m){0.f, 0.f, 0.f, 0.f};
#pragma unroll 8
    for (int st = 0; st < nsteps; ++st) { const bf16x8 a = *(const bf16x8*)(ap + 32 * st), b = *(const bf16x8*)(bp + 32 * st); acc = MFMA16(a, b, acc); }
    return acc;
}
__device__ __forceinline__ float sum16(const float* p) { const f32x4 a = *(const f32x4*)p, b = *(const f32x4*)(p + 4), c = *(const f32x4*)(p + 8), d = *(const f32x4*)(p + 12);
    return (((a[0] + a[1]) + (a[2] + a[3])) + ((b[0] + b[1]) + (b[2] + b[3]))) + (((c[0] + c[1]) + (c[2] + c[3])) + ((d[0] + d[1]) + (d[2] + d[3]))); }
__device__ __forceinline__ void meta_p1(const Params& P, int wave, int lane, int G) {
    const int mt = (G - 1 - (int)blockIdx.x) * 8 + wave; if (mt >= 176) return;
    unsigned char* ws = P.ws; const bf16* hbm = (const bf16*)(ws + WS_HB) + (size_t)NFR * D; const bf16* W = (const bf16*)(ws + WS_WGU1);
    bf16* actm = (bf16*)(ws + WS_R1) + (size_t)NFR * FF; const float* ssp = (const float*)(ws + WS_SSP) + (size_t)NFR * 16;
    const int c0 = 16 * mt, grow = (c0 >> 7) * 256 + (c0 & 127), r = lane & 15, quad = lane >> 4;
    const f32x4m g = meta_mm(hbm, W + (size_t)grow * D, D, 0, 32, lane), u = meta_mm(hbm, W + (size_t)(grow + 128) * D, D, 0, 32, lane);
#pragma unroll
    for (int j = 0; j < 4; ++j) { const int row = quad * 4 + j; const float rs = __builtin_amdgcn_rsqf(sum16(ssp + row * 16) * (1.0f / 1024.0f) + 1e-6f);
        const float gv = g[j] * rs, uv = u[j] * rs; actm[(size_t)row * FF + c0 + r] = (bf16)f2bf(gv * pg8::sigm(gv) * uv); }
}
__device__ __forceinline__ void meta_p2(const Params& P, LAS unsigned char* L, int wave, int lane) {
    if (blockIdx.x >= 64) return;
    unsigned char* ws = P.ws; const bf16* actm = (const bf16*)(ws + WS_R1) + (size_t)NFR * FF; const bf16* W = (const bf16*)(ws + WS_WD1);
    bf16* hbm = (bf16*)(ws + WS_HB) + (size_t)NFR * D; float* mssp = (float*)(ws + WS_MSSP);
    const int ct = blockIdx.x, r = lane & 15, quad = lane >> 4;
    const bf16* ap = actm + (size_t)r * FF + wave * 352 + quad * 8; const bf16* bp = W + (size_t)(ct * 16 + r) * FF + wave * 352 + quad * 8;
    bf16x8 av[11], bv[11];
#pragma unroll
    for (int st = 0; st < 11; ++st) { av[st] = *(const bf16x8*)(ap + 32 * st); bv[st] = *(const bf16x8*)(bp + 32 * st); }
    f32x4m acc = (f32x4m){0.f, 0.f, 0.f, 0.f};
#pragma unroll
    for (int st = 0; st < 11; ++st) acc = MFMA16(av[st], bv[st], acc);
    LAS f32x4m* red = (LAS f32x4m*)L;
    red[wave * 64 + lane] = acc;
    __syncthreads();
    if (wave == 0) {
        f32x4m t = red[lane];
#pragma unroll
        for (int w = 1; w < 8; ++w) t = t + red[w * 64 + lane];
#pragma unroll
        for (int j = 0; j < 4; ++j) { const int row = quad * 4 + j, col = ct * 16 + r; const float v = P.in[1][(size_t)row * D + col] + 0.5f * t[j];
            hbm[(size_t)row * D + col] = (bf16)f2bf(v);
            float sq = v * v; sq += __shfl_xor(sq, 1); sq += __shfl_xor(sq, 2); sq += __shfl_xor(sq, 4); sq += __shfl_xor(sq, 8);
            if (r == 0) mssp[row * 64 + ct] = sq; }
    }
    __syncthreads();
}
__device__ __forceinline__ void meta_p3(const Params& P, int wave, int lane, int G) {
    const int mt = (G - 1 - (int)blockIdx.x) * 8 + wave; if (mt >= 65) return;
    unsigned char* ws = P.ws; const bf16* hbm = (const bf16*)(ws + WS_HB) + (size_t)NFR * D; const bf16* W = (const bf16*)(ws + WS_WIN);
    bf16* PBm = (bf16*)(ws + WS_R1) + (size_t)NFR * PBW; float* glowm = (float*)(ws + WS_GLOW) + (size_t)NFR * 16; const float* mssp = (const float*)(ws + WS_MSSP);
    const int col0 = mt < 16 ? 512 + 16 * mt : (mt < 32 ? 1024 + 16 * (mt - 16) : (mt < 64 ? 1280 + 16 * (mt - 32) : 4352)), r = lane & 15, quad = lane >> 4;
    const f32x4m acc = meta_mm(hbm, W + (size_t)col0 * D, D, 0, 32, lane);
#pragma unroll
    for (int j = 0; j < 4; ++j) { const int row = quad * 4 + j;
        const f32x4 p = *(const f32x4*)(mssp + row * 64 + 4 * r); float sq = (p[0] + p[1]) + (p[2] + p[3]);
        sq += __shfl_xor(sq, 1); sq += __shfl_xor(sq, 2); sq += __shfl_xor(sq, 4); sq += __shfl_xor(sq, 8);
        const float v = acc[j] * __builtin_amdgcn_rsqf(sq * (1.0f / 1024.0f) + 1e-6f);
        if (mt < 64) PBm[(size_t)row * PBW + col0 + r] = (bf16)f2bf(v); else glowm[row * 16 + r] = v; }
}

constexpr int A_KS = 0, A_VT = 32256, A_VTS = 228;
__device__ __forceinline__ void attn_item(const Params& P, LAS unsigned char* L, int item, int tid, int wave, int lane) {
    const bf16* PB = (const bf16*)(P.ws + WS_R1); bf16* ya = (bf16*)P.out;
    const int kvh = item & 1, c = (item >> 1) & 127, b = item >> 8;
#pragma unroll
    for (int i = 0; i < 4; ++i) {
        const int key = (tid & 63) + 64 * i;
        if (key < 224) {
            bool valid; int row;
            if (key < 16) { valid = true; row = NFR + key; }
            else if (key < 32) { valid = false; row = 0; }
            else { const int ki = c * 64 - 128 + (key - 32); valid = ki >= 0; row = b * 8192 + (valid ? ki : 0); }
            u32x4 kk = (u32x4){0u, 0u, 0u, 0u}, vv = (u32x4){0u, 0u, 0u, 0u};
            if (valid) { const bf16* p = PB + (size_t)row * PBW + 512 + kvh * 64 + wave * 8; kk = *(const u32x4*)p; vv = *(const u32x4*)(p + 128); }
            *(LAS u32x4*)(L + A_KS + key * 144 + wave * 16) = kk;
            LAS unsigned short* vt = (LAS unsigned short*)(L + A_VT) + (wave * 8) * A_VTS + key;
            vt[0 * A_VTS] = (unsigned short)(vv.x & 0xffffu); vt[1 * A_VTS] = (unsigned short)(vv.x >> 16);
            vt[2 * A_VTS] = (unsigned short)(vv.y & 0xffffu); vt[3 * A_VTS] = (unsigned short)(vv.y >> 16);
            vt[4 * A_VTS] = (unsigned short)(vv.z & 0xffffu); vt[5 * A_VTS] = (unsigned short)(vv.z >> 16);
            vt[6 * A_VTS] = (unsigned short)(vv.w & 0xffffu); vt[7 * A_VTS] = (unsigned short)(vv.w >> 16);
        }
    }
    __syncthreads();
    const int g = wave >> 1, pos0 = (wave & 1) * 32, h = kvh * 4 + g, r = lane & 31, hi = lane >> 5;
    const int qrow = b * 8192 + c * 64 + pos0 + r;
    bf16x8 q[4];
#pragma unroll
    for (int s = 0; s < 4; ++s) q[s] = *(const bf16x8*)(PB + (size_t)qrow * PBW + h * 64 + 16 * s + 8 * hi);
    f32x16 S[7];
#pragma unroll
    for (int kt = 0; kt < 7; ++kt) {
#pragma unroll
        for (int i = 0; i < 16; ++i) S[kt][i] = 0.f;
#pragma unroll
        for (int s = 0; s < 4; ++s) { const bf16x8 a = *(const LAS bf16x8*)(L + A_KS + (kt * 32 + r) * 144 + (16 * s + 8 * hi) * 2); S[kt] = MFMA32(a, q[s], S[kt]); }
        asm volatile("" ::: "memory");
    }
    __builtin_amdgcn_sched_barrier(0);
    const float slope = exp2f(-(float)(h + 1)), sink = P.in[11][h];
    const float NEG = -__builtin_inff();
    float m = sink;
#pragma unroll
    for (int i = 0; i < 16; ++i) { if (i >= 8) S[0][i] = NEG; else m = fmaxf(m, S[0][i]); }
    int oz; asm volatile("v_mov_b32 %0, 0" : "=v"(oz));
    const int smin = 128 - 64 * c, pq = pos0 + r + 128 + oz;
#pragma unroll
    for (int kt = 1; kt < 7; ++kt) {
#pragma unroll
        for (int i = 0; i < 16; ++i) { const int s = (kt - 1) * 32 + crow(i, hi); float v = S[kt][i] - slope * fabsf((float)(pq - s)); if (s < smin) v = NEG; S[kt][i] = v; m = fmaxf(m, v); }
        __builtin_amdgcn_sched_barrier(0);
    }
    m = fmaxf(m, __shfl_xor(m, 32));
    __builtin_amdgcn_sched_barrier(0);
    float sum = 0.f; const float ml = m * 1.44269504f;
    bf16x8 pbv[7][2];
#pragma unroll
    for (int kt = 0; kt < 7; ++kt) {
#pragma unroll
        for (int i = 0; i < 16; ++i) { const float p = __builtin_amdgcn_exp2f(S[kt][i] * 1.44269504f - ml); S[kt][i] = p; sum += p; }
        pbv[kt][0] = pack8(S[kt][0], S[kt][1], S[kt][2], S[kt][3], S[kt][4], S[kt][5], S[kt][6], S[kt][7]);
        pbv[kt][1] = pack8(S[kt][8], S[kt][9], S[kt][10], S[kt][11], S[kt][12], S[kt][13], S[kt][14], S[kt][15]);
    }
    __builtin_amdgcn_sched_barrier(0);
    sum += __shfl_xor(sum, 32); sum += exp2f(sink * 1.44269504f - ml);
    const float inv = 1.0f / sum;
    f32x16 O[2];
#pragma unroll
    for (int i = 0; i < 16; ++i) { O[0][i] = 0.f; O[1][i] = 0.f; }
#pragma unroll
    for (int kt = 0; kt < 7; ++kt)
#pragma unroll
        for (int s2 = 0; s2 < 2; ++s2) {
            const bf16x8 pb = pbv[kt][s2];
#pragma unroll
            for (int dt = 0; dt < 2; ++dt) {
                const LAS unsigned char* vp = L + A_VT + ((dt * 32 + r) * A_VTS + kt * 32 + 16 * s2 + 4 * hi) * 2;
                const s16x4 lo = *(const LAS s16x4*)vp, h4 = *(const LAS s16x4*)(vp + 16);
                const bf16x8 va = __builtin_shufflevector(lo, h4, 0, 1, 2, 3, 4, 5, 6, 7);
                O[dt] = MFMA32(va, pb, O[dt]);
            }
            asm volatile("" ::: "memory");
        }
#pragma unroll
    for (int dt = 0; dt < 2; ++dt)
#pragma unroll
        for (int g4 = 0; g4 < 4; ++g4) {
            u32x2 w; w.x = pk2(O[dt][4 * g4] * inv, O[dt][4 * g4 + 1] * inv); w.y = pk2(O[dt][4 * g4 + 2] * inv, O[dt][4 * g4 + 3] * inv);
            *(u32x2*)(ya + (size_t)qrow * 512 + h * 64 + dt * 32 + 8 * g4 + 4 * hi) = w;
        }
    __syncthreads();
}

constexpr int G_QE = 0, G_KE = 9216, G_K2T = 18432, G_VT = 27648, G_ST = 46080, G_SEG = 64512, G_SS = 66560, G_GL = 67584;
struct GlaLd { f32x2m glv; u32x4 qraw, kraw, va, vc, sa, sc; float gw[16]; float bias; };
template <bool KV> __device__ __forceinline__ void gla_load(const Params& P, GlaLd& g, int b, int h, int j, int tid) {
    const bf16* PB = (const bf16*)(P.ws + WS_R1); const float* glow = (const float*)(P.ws + WS_GLOW);
    const int d = tid & 63;
    const int posA = tid >> 3, sub = tid & 7; const bool vA = (j > 0) || (posA >= 48);
    const int rowA = vA ? (j == 0 ? NFR + posA - 48 : b * 8192 + (j - 1) * 64 + posA) : NFR;
    g.glv = *(const f32x2m*)(glow + (size_t)rowA * 16 + sub * 2);
    g.qraw = (u32x4){0u, 0u, 0u, 0u}; g.kraw = g.qraw;
    if (vA) { const bf16* p = PB + (size_t)rowA * PBW + h * 64 + sub * 8;
        if (!KV) { g.qraw = __builtin_nontemporal_load((const u32x4*)(p + 768)); g.kraw = __builtin_nontemporal_load((const u32x4*)(p + 1024)); } else g.kraw = *(const u32x4*)(p + 1024); }
    const int posC = tid & 63, dvg = tid >> 6; const bool vC = (j > 0) || (posC >= 48);
    const int rowC = vC ? (j == 0 ? NFR + posC - 48 : b * 8192 + (j - 1) * 64 + posC) : NFR;
    g.va = (u32x4){0u, 0u, 0u, 0u}; g.vc = g.va;
    if (vC) { const bf16* p = PB + (size_t)rowC * PBW + 1280 + h * 128 + dvg * 16; g.va = *(const u32x4*)p; g.vc = *(const u32x4*)(p + 8); }
    g.sa = (u32x4){0u, 0u, 0u, 0u}; g.sc = g.sa;
    if (!KV) { const bf16* sg = (const bf16*)(P.ws + WS_ST) + (size_t)((b * 4 + h) * 129 + j) * 8192 + (tid >> 2) * 64 + (tid & 3) * 16; g.sa = __builtin_nontemporal_load((const u32x4*)sg); g.sc = __builtin_nontemporal_load((const u32x4*)(sg + 8)); }
#pragma unroll
    for (int r = 0; r < 16; ++r) g.gw[r] = P.in[8][r * 256 + h * 64 + d];
    g.bias = P.in[9][h * 64 + d];
}
template <bool KV> __device__ __forceinline__ void gla_stage(LAS unsigned char* L, const GlaLd& g, int tid) {
    const int posA = tid >> 3, sub = tid & 7, posC = tid & 63, dvg = tid >> 6;
    *(LAS f32x2m*)(L + G_GL + (posA * 16 + sub * 2) * 4) = g.glv;
    if (!KV) *(LAS u32x4*)(L + G_QE + (posA * 72 + sub * 8) * 2) = g.qraw;
    *(LAS u32x4*)(L + G_KE + (posA * 72 + sub * 8) * 2) = g.kraw;
    { const u32x4 va = g.va, vc = g.vc; LAS unsigned short* vt = (LAS unsigned short*)(L + G_VT) + (dvg * 16) * 72 + posC;
      vt[0 * 72] = (unsigned short)(va.x & 0xffffu); vt[1 * 72] = (unsigned short)(va.x >> 16); vt[2 * 72] = (unsigned short)(va.y & 0xffffu); vt[3 * 72] = (unsigned short)(va.y >> 16);
      vt[4 * 72] = (unsigned short)(va.z & 0xffffu); vt[5 * 72] = (unsigned short)(va.z >> 16); vt[6 * 72] = (unsigned short)(va.w & 0xffffu); vt[7 * 72] = (unsigned short)(va.w >> 16);
      vt[8 * 72] = (unsigned short)(vc.x & 0xffffu); vt[9 * 72] = (unsigned short)(vc.x >> 16); vt[10 * 72] = (unsigned short)(vc.y & 0xffffu); vt[11 * 72] = (unsigned short)(vc.y >> 16);
      vt[12 * 72] = (unsigned short)(vc.z & 0xffffu); vt[13 * 72] = (unsigned short)(vc.z >> 16); vt[14 * 72] = (unsigned short)(vc.w & 0xffffu); vt[15 * 72] = (unsigned short)(vc.w >> 16); }
    if (!KV) { const int dv = tid >> 2, part = tid & 3; *(LAS u32x4*)(L + G_ST + (dv * 72 + part * 16) * 2) = g.sa; *(LAS u32x4*)(L + G_ST + (dv * 72 + part * 16 + 8) * 2) = g.sc; }
}
template <bool KV> __device__ __forceinline__ void gla_prep(const Params& P, LAS unsigned char* L, const float (&gw)[16], float bias, int b, int h, int j, int tid) {
    const int d = tid & 63, seg = tid >> 6;
    LAS unsigned short* QE = (LAS unsigned short*)(L + G_QE); LAS unsigned short* KE = (LAS unsigned short*)(L + G_KE);
    float cs[8], qv[8], kv[8]; float run = 0.f;
#pragma unroll
    for (int p = 0; p < 8; ++p) {
        const int pos = seg * 8 + p; const bool valid = (j > 0) || (pos >= 48);
        const LAS f32x4* gl = (const LAS f32x4*)(L + G_GL + pos * 64);
        const f32x4 g0 = gl[0], g1 = gl[1], g2 = gl[2], g3 = gl[3];
        float z = bias;
#pragma unroll
        for (int e = 0; e < 4; ++e) { z += g0[e] * gw[e]; z += g1[e] * gw[4 + e]; z += g2[e] * gw[8 + e]; z += g3[e] * gw[12 + e]; }
        float la = (fminf(z, 0.f) - __logf(1.0f + __expf(-fabsf(z)))) * 0.0625f;
        if (!valid) la = 0.f;
        run += la; cs[p] = run;
        qv[p] = KV ? 0.f : pg8::bf2f(QE[pos * 72 + d]); kv[p] = pg8::bf2f(KE[pos * 72 + d]);
        if (p & 1) __builtin_amdgcn_sched_barrier(0);
    }
    LAS float* SEG = (LAS float*)(L + G_SEG);
    SEG[seg * 64 + d] = run;
    __syncthreads();
    float off = 0.f, tot = 0.f;
#pragma unroll
    for (int s = 0; s < 8; ++s) { const float v = SEG[s * 64 + d]; tot += v; if (s < seg) off += v; }
    float k2[8];
#pragma unroll
    for (int p = 0; p < 8; ++p) {
        const int pos = seg * 8 + p; const float bb = off + cs[p];
        if (!KV) { QE[pos * 72 + d] = (unsigned short)f2bf(qv[p] * __expf(bb)); KE[pos * 72 + d] = (unsigned short)f2bf(kv[p] * __expf(-bb)); }
        k2[p] = kv[p] * __expf(tot - bb);
    }
    if (KV) {
        *(LAS bf16x8*)(L + G_K2T + (d * 72 + seg * 8) * 2) = pack8(k2[0], k2[1], k2[2], k2[3], k2[4], k2[5], k2[6], k2[7]);
        if (seg == 0) ((float*)(P.ws + WS_DEC))[(size_t)((b * 4 + h) * 129 + j) * 64 + d] = __expf(tot);
    }
}
__device__ __forceinline__ void gla_kv_item(const Params& P, LAS unsigned char* L, int item, const float (&gw)[16], float bias, int tid, int wave, int lane) {
    const int j = item % 129, bh = item / 129, h = bh & 3, b = bh >> 2;
    gla_prep<true>(P, L, gw, bias, b, h, j, tid);
    __syncthreads();
    const int dvt = wave >> 1, dkt = wave & 1, r = lane & 31, hi = lane >> 5;
    f32x16 acc;
#pragma unroll
    for (int i = 0; i < 16; ++i) acc[i] = 0.f;
#pragma unroll
    for (int s = 0; s < 4; ++s) {
        const bf16x8 a = *(const LAS bf16x8*)(L + G_VT + ((dvt * 32 + r) * 72 + 16 * s + 8 * hi) * 2);
        const bf16x8 bb = *(const LAS bf16x8*)(L + G_K2T + ((dkt * 32 + r) * 72 + 16 * s + 8 * hi) * 2);
        acc = MFMA32(a, bb, acc);
    }
    bf16* kvg = (bf16*)(P.ws + WS_KV) + (size_t)item * 8192;
#pragma unroll
    for (int i = 0; i < 16; ++i) kvg[(dvt * 32 + crow(i, hi)) * 64 + dkt * 32 + r] = (bf16)f2bf(acc[i]);
    __syncthreads();
}
__device__ __forceinline__ void gla_scan(const Params& P, int wave, int lane, int G) {
    const bf16* kvg = (const bf16*)(P.ws + WS_KV); const float* dec = (const float*)(P.ws + WS_DEC); bf16* st = (bf16*)(P.ws + WS_ST);
    if (wave >= 4) return;
    for (int wv = wave * G + blockIdx.x; wv < 1024; wv += G * 4) {
        const int gidx = wv * 64 + lane, bh = gidx >> 13, e = gidx & 8191, dk = e & 63;
        const size_t base = (size_t)bh * 129;
        float S = 0.f;
        for (int j0 = 0; j0 < 128; j0 += 8) {
            float kvv[8], dd[8];
#pragma unroll
            for (int u = 0; u < 8; ++u) { kvv[u] = pg8::bf2f(__builtin_nontemporal_load(kvg + (base + j0 + u) * 8192 + e)); dd[u] = dec[(base + j0 + u) * 64 + dk]; }
#pragma unroll
            for (int u = 0; u < 8; ++u) { S = dd[u] * S + kvv[u]; st[(base + j0 + u + 1) * 8192 + e] = (bf16)f2bf(S); }
        }
    }
}
__device__ __forceinline__ void gla_out_item(const Params& P, LAS unsigned char* L, int item  , const float (&gw)[16], float bias, int tid, int wave, int lane) {
    const int j = (item & 127) + 1, bh = item >> 7, h = bh & 3, b = bh >> 2;
    const bf16* PB = (const bf16*)(P.ws + WS_R1); bf16* yb = (bf16*)P.out + (size_t)NFR * 512;
    gla_prep<false>(P, L, gw, bias, b, h, j, tid);
    __syncthreads();
    const int it = wave & 1, dvt = wave >> 1, r = lane & 31, hi = lane >> 5;
    bf16x8 qf[4];
#pragma unroll
    for (int s = 0; s < 4; ++s) qf[s] = *(const LAS bf16x8*)(L + G_QE + ((it * 32 + r) * 72 + 16 * s + 8 * hi) * 2);
    f32x16 o;
#pragma unroll
    for (int i = 0; i < 16; ++i) o[i] = 0.f;
#pragma unroll
    for (int jt = 0; jt < 2; ++jt) {
        if (jt <= it) {
            f32x16 at;
#pragma unroll
            for (int i = 0; i < 16; ++i) at[i] = 0.f;
#pragma unroll
            for (int s = 0; s < 4; ++s) { const bf16x8 a = *(const LAS bf16x8*)(L + G_KE + ((jt * 32 + r) * 72 + 16 * s + 8 * hi) * 2); at = MFMA32(a, qf[s], at); }
            if (jt == it) {
#pragma unroll
                for (int i = 0; i < 16; ++i) if (crow(i, hi) > r) at[i] = 0.f;
            }
#pragma unroll
            for (int s2 = 0; s2 < 2; ++s2) {
                const bf16x8 pb = pack8(at[8 * s2], at[8 * s2 + 1], at[8 * s2 + 2], at[8 * s2 + 3], at[8 * s2 + 4], at[8 * s2 + 5], at[8 * s2 + 6], at[8 * s2 + 7]);
                const LAS unsigned char* vp = L + G_VT + ((dvt * 32 + r) * 72 + jt * 32 + 16 * s2 + 4 * hi) * 2;
                const s16x4 lo = *(const LAS s16x4*)vp, h4 = *(const LAS s16x4*)(vp + 16);
                o = MFMA32(__builtin_shufflevector(lo, h4, 0, 1, 2, 3, 4, 5, 6, 7), pb, o);
            }
        }
    }
#pragma unroll
    for (int s = 0; s < 4; ++s) { const bf16x8 a = *(const LAS bf16x8*)(L + G_ST + ((dvt * 32 + r) * 72 + 16 * s + 8 * hi) * 2); o = MFMA32(a, qf[s], o); }
    const int row = b * 8192 + (j - 1) * 64 + it * 32 + r;
    u32x2 grv[4]; f32x4 gnv[4];
#pragma unroll
    for (int g4 = 0; g4 < 4; ++g4) { const int dv0 = dvt * 32 + 8 * g4 + 4 * hi; gnv[g4] = *(const f32x4*)(P.in[10] + dv0); grv[g4] = *(const u32x2*)(PB + (size_t)row * PBW + 1792 + h * 128 + dv0); }
    float ss = 0.f;
#pragma unroll
    for (int i = 0; i < 16; ++i) ss += o[i] * o[i];
    ss += __shfl_xor(ss, 32);
    LAS float* SS = (LAS float*)(L + G_SS);
    if (hi == 0) SS[dvt * 64 + it * 32 + r] = ss;
    __syncthreads();
    const float tot = (SS[it * 32 + r] + SS[64 + it * 32 + r]) + (SS[128 + it * 32 + r] + SS[192 + it * 32 + r]);
    const float rstd = __builtin_amdgcn_rsqf(tot * (1.0f / 128.0f) + 1e-6f);
#pragma unroll
    for (int g4 = 0; g4 < 4; ++g4) {
        const int dv0 = dvt * 32 + 8 * g4 + 4 * hi;
        const f32x4 gn = gnv[g4];
        const u32x2 gr = grv[g4];
        u32x2 w;
        w.x = pk2(o[4 * g4] * rstd * gn[0] * pg8::bflo(gr.x), o[4 * g4 + 1] * rstd * gn[1] * pg8::bfhi(gr.x));
        w.y = pk2(o[4 * g4 + 2] * rstd * gn[2] * pg8::bflo(gr.y), o[4 * g4 + 3] * rstd * gn[3] * pg8::bfhi(gr.y));
        *(u32x2*)(yb + (size_t)row * 512 + h * 128 + dv0) = w;
    }
    __syncthreads();
}

constexpr int DUMP_OFF = 131072 + 2048;
__device__ __forceinline__ void prefetch_tile(const bf16* base, int ld, int pm, int pn, LAS unsigned char* lds, int wave, int lane) {
    const bf16* p = base + (size_t)(pm * 256 + wave * 32 + (lane >> 5)) * ld + pn * 256 + (lane & 31) * 8;
#pragma unroll 2
    for (int i = 0; i < 16; ++i, p += 2 * (size_t)ld)
        __builtin_amdgcn_global_load_lds((const unsigned*)p, (LAS unsigned*)(lds + DUMP_OFF + wave * 1024), 16, 0, 0);
}

__global__ void __launch_bounds__(512, 2) mega_fwd(Params P) {
    extern __shared__ __attribute__((aligned(16))) unsigned char lds_raw[];
    LAS unsigned char* lds = (LAS unsigned char*)lds_raw;
    cg::grid_group grid = cg::this_grid();
    const int tid = threadIdx.x, lane = tid & 63, wave = __builtin_amdgcn_readfirstlane(tid >> 6), G = gridDim.x;
    unsigned char* ws = P.ws;
    const int lo = P.ph_lo, hi = P.ph_hi;
    if (tid < 64) ((LAS unsigned*)(lds + MISC_OFF))[tid] = 0u;
    __syncthreads();
    XcdBarrier bar = xcd_barrier_post((unsigned*)(ws + WS_CTL), (volatile LAS unsigned*)(lds + MISC_OFF) + 8);
#define IN(k) (lo <= (k) && (k) < hi)
#define GSYNC() do { if (P.cg_sync) grid.sync(); else xcd_barrier(bar); } while (0)
#if defined(MK_TPROBE)
#define STAMP(i) do { if (blockIdx.x == 0 && tid == 0) ((volatile LAS unsigned long long*)(lds + MISC_OFF + 64))[(i)] = __builtin_amdgcn_s_memrealtime(); } while (0)
#else
#define STAMP(i) do { } while (0)
#endif
#define SEAM(k) do { if (IN(k) && IN((k) + 1)) GSYNC(); STAMP((k) + 1); } while (0)
#define DUPQ(k) ((MK_DUP >> (k)) & 1)
    bf16* hb = (bf16*)(ws + WS_HB); float* ssp = (float*)(ws + WS_SSP); bf16* R1 = (bf16*)(ws + WS_R1);

    STAMP(0);
    if (IN(0)) {
        p0_prep(P, lds, wave, lane, G);
#if (MK_DUP >> 0) & 1
        GSYNC();
        p0_prep(P, lds, wave, lane, G);
#endif
    }
    SEAM(0);
    if (IN(1)) {
        {
        meta_p1(P, wave, lane, G);
        prep_items(P, 2 * I_GU + (int)blockIdx.x * 8 + wave, IT_P0, G * 8, (LAS unsigned*)(lds + wave * 16384), lane); __syncthreads();
        pg8::Gemm g{hb, (const bf16*)(ws + WS_WGU1), NFR, NGU, D}; pg8::StaticOrder S; S.init(NFR, NGU, G, (int)blockIdx.x);
        pg8::EpiSwiglu E{R1, ssp};
        pg8::gemm_phase<pg8::EpiSwiglu, pg8::StaticOrder, true, true>(lds, g, S, E);
    }
#if (MK_DUP >> 1) & 1
        GSYNC();
        {
        meta_p1(P, wave, lane, G);
        prep_items(P, 2 * I_GU + (int)blockIdx.x * 8 + wave, IT_P0, G * 8, (LAS unsigned*)(lds + wave * 16384), lane); __syncthreads();
        pg8::Gemm g{hb, (const bf16*)(ws + WS_WGU1), NFR, NGU, D}; pg8::StaticOrder S; S.init(NFR, NGU, G, (int)blockIdx.x);
        pg8::EpiSwiglu E{R1, ssp};
        pg8::gemm_phase<pg8::EpiSwiglu, pg8::StaticOrder, true, true>(lds, g, S, E);
    }
#endif
    }
    SEAM(1);
    if (IN(2)) {
        {
        meta_p2(P, lds, wave, lane);
        pg8::Gemm g{R1, (const bf16*)(ws + WS_WD1), NFR, D, FF}; pg8::StaticOrder S; S.init(NFR, D, G, (int)blockIdx.x);
        pg8::EpiResid<false> E{hb, nullptr, ssp, 0.5f};
        pg8::gemm_phase<pg8::EpiResid<false>, pg8::StaticOrder, true, true>(lds, g, S, E);
    }
#if (MK_DUP >> 2) & 1
        GSYNC();
        {
        meta_p2(P, lds, wave, lane);
        pg8::Gemm g{R1, (const bf16*)(ws + WS_WD1), NFR, D, FF}; pg8::StaticOrder S; S.init(NFR, D, G, (int)blockIdx.x);
        pg8::EpiResid<false> E{hb, nullptr, ssp, 0.5f};
        pg8::gemm_phase<pg8::EpiResid<false>, pg8::StaticOrder, true, true>(lds, g, S, E);
    }
#endif
    }
    SEAM(2);
    if (IN(3)) {
        {
        meta_p3(P, wave, lane, G);
        pg8::Gemm g{hb, (const bf16*)(ws + WS_WIN), NFR, NIN, D}; pg8::StaticOrder S; S.init(NFR, NIN, G, (int)blockIdx.x);
        pg8::EpiIn E{R1, (float*)(ws + WS_GLOW), ssp};
        pg8::gemm_phase<pg8::EpiIn, pg8::StaticOrder, true, true>(lds, g, S, E);
    }
#if (MK_DUP >> 3) & 1
        GSYNC();
        {
        meta_p3(P, wave, lane, G);
        pg8::Gemm g{hb, (const bf16*)(ws + WS_WIN), NFR, NIN, D}; pg8::StaticOrder S; S.init(NFR, NIN, G, (int)blockIdx.x);
        pg8::EpiIn E{R1, (float*)(ws + WS_GLOW), ssp};
        pg8::gemm_phase<pg8::EpiIn, pg8::StaticOrder, true, true>(lds, g, S, E);
    }
#endif
    }
    SEAM(3);
    if (IN(4)) {
        {
        { GlaLd gl; int it = blockIdx.x;
          if (it < 1032) gla_load<true>(P, gl, (it / 129) >> 2, (it / 129) & 3, it % 129, tid);
          while (it < 1032) { const int nx = it + G, ld = nx < 1032 ? nx : it;
              gla_stage<true>(lds, gl, tid); float gw[16];
#pragma unroll
              for (int q = 0; q < 16; ++q) gw[q] = gl.gw[q];
              const float bias = gl.bias;
              __syncthreads();
              gla_load<true>(P, gl, (ld / 129) >> 2, (ld / 129) & 3, ld % 129, tid);
              gla_kv_item(P, lds, it, gw, bias, tid, wave, lane); it = nx; } }
        { const int bx = blockIdx.x, vcu = (G % 8 == 0) ? (bx % 8) * (G / 8) + bx / 8 : bx;
          for (int it = vcu; it < 512; it += G) attn_item(P, lds, it, tid, wave, lane); }
#if defined(MK_DUPA)
        for (int it = blockIdx.x; it < 512; it += G) attn_item(P, lds, it, tid, wave, lane);
#endif
    }
#if (MK_DUP >> 4) & 1
        GSYNC();
        {
        { const int bx = blockIdx.x, vcu = (G % 8 == 0) ? (bx % 8) * (G / 8) + bx / 8 : bx;
          for (int it = vcu; it < 512; it += G) attn_item(P, lds, it, tid, wave, lane); }
        { GlaLd gl; int it = blockIdx.x;
          if (it < 1032) gla_load<true>(P, gl, (it / 129) >> 2, (it / 129) & 3, it % 129, tid);
          while (it < 1032) { const int nx = it + G, ld = nx < 1032 ? nx : it;
              gla_stage<true>(lds, gl, tid); float gw[16];
#pragma unroll
              for (int q = 0; q < 16; ++q) gw[q] = gl.gw[q];
              const float bias = gl.bias;
              __syncthreads();
              gla_load<true>(P, gl, (ld / 129) >> 2, (ld / 129) & 3, ld % 129, tid);
              gla_kv_item(P, lds, it, gw, bias, tid, wave, lane); it = nx; } }
    }
#endif
    }
    SEAM(4);
    if (IN(5)) {
        { gla_scan(P, wave, lane, G);
          if (wave >= 4) prep_items(P, IT_P0 + (wave - 4) * G + (int)blockIdx.x, IT_END, 4 * G, (LAS unsigned*)(lds + wave * 16384), lane); }
#if (MK_DUP >> 5) & 1
        GSYNC();
        { gla_scan(P, wave, lane, G);
          if (wave >= 4) prep_items(P, IT_P0 + (wave - 4) * G + (int)blockIdx.x, IT_END, 4 * G, (LAS unsigned*)(lds + wave * 16384), lane); }
#endif
    }
    SEAM(5);
    if (IN(6)) {
        { GlaLd gl; int it = blockIdx.x;
          if (it < 1024) gla_load<false>(P, gl, (it >> 7) >> 2, (it >> 7) & 3, (it & 127) + 1, tid);
          while (it < 1024) { const int nx = it + G, ld = nx < 1024 ? nx : it;
              gla_stage<false>(lds, gl, tid); float gw[16];
#pragma unroll
              for (int q = 0; q < 16; ++q) gw[q] = gl.gw[q];
              const float bias = gl.bias;
              __syncthreads();
              gla_load<false>(P, gl, (ld >> 7) >> 2, (ld >> 7) & 3, (ld & 127) + 1, tid);
              gla_out_item(P, lds, it, gw, bias, tid, wave, lane); it = nx; } }
#if (MK_DUP >> 6) & 1
        GSYNC();
        { GlaLd gl; int it = blockIdx.x;
          if (it < 1024) gla_load<false>(P, gl, (it >> 7) >> 2, (it >> 7) & 3, (it & 127) + 1, tid);
          while (it < 1024) { const int nx = it + G, ld = nx < 1024 ? nx : it;
              gla_stage<false>(lds, gl, tid); float gw[16];
#pragma unroll
              for (int q = 0; q < 16; ++q) gw[q] = gl.gw[q];
              const float bias = gl.bias;
              __syncthreads();
              gla_load<false>(P, gl, (ld >> 7) >> 2, (ld >> 7) & 3, (ld & 127) + 1, tid);
              gla_out_item(P, lds, it, gw, bias, tid, wave, lane); it = nx; } }
#endif
    }
    SEAM(6);
    if (IN(7)) {
        {
        bf16* mixed = (bf16*)(ws + WS_KV);
        { pg8::Gemm g{(const bf16*)P.out, (const bf16*)(ws + WS_WA), NFR, D, 512}; pg8::StaticOrder S; S.init(NFR, D, G, (int)blockIdx.x);
          pg8::EpiMix<false> E{(const unsigned char*)R1 + 4608, mixed};
          pg8::gemm_phase<pg8::EpiMix<false>, pg8::StaticOrder, true, true>(lds, g, S, E); }
        { pg8::Gemm g{(const bf16*)P.out + (size_t)NFR * 512, (const bf16*)(ws + WS_WB), NFR, D, 512}; pg8::StaticOrder S; S.init(NFR, D, G, (int)blockIdx.x);
          pg8::EpiMix<true> E{(const unsigned char*)R1 + 4608 + 1024, mixed};
          pg8::gemm_phase<pg8::EpiMix<true>, pg8::StaticOrder, true, true>(lds, g, S, E); }
    }
#if (MK_DUP >> 7) & 1
        GSYNC();
        {
        bf16* mixed = (bf16*)(ws + WS_KV);
        { pg8::Gemm g{(const bf16*)P.out, (const bf16*)(ws + WS_WA), NFR, D, 512}; pg8::StaticOrder S; S.init(NFR, D, G, (int)blockIdx.x);
          pg8::EpiMix<false> E{(const unsigned char*)R1 + 4608, mixed};
          pg8::gemm_phase<pg8::EpiMix<false>, pg8::StaticOrder, true, true>(lds, g, S, E); }
        { pg8::Gemm g{(const bf16*)P.out + (size_t)NFR * 512, (const bf16*)(ws + WS_WB), NFR, D, 512}; pg8::StaticOrder S; S.init(NFR, D, G, (int)blockIdx.x);
          pg8::EpiMix<true> E{(const unsigned char*)R1 + 4608 + 1024, mixed};
          pg8::gemm_phase<pg8::EpiMix<true>, pg8::StaticOrder, true, true>(lds, g, S, E); }
    }
#endif
    }
    SEAM(7);
    if (IN(8)) {
        {
        pg8::Gemm g{(const bf16*)(ws + WS_KV), (const bf16*)(ws + WS_WOUT), NFR, D, D}; pg8::StaticOrder S; S.init(NFR, D, G, (int)blockIdx.x);
#if defined(MK_DRY8)
        { pg8::EpiResid<false> E0{hb, nullptr, ssp, 0.0f}; pg8::gemm_phase<pg8::EpiResid<false>, pg8::StaticOrder, true, true>(lds, g, S, E0); GSYNC(); }
#endif
        pg8::EpiResid<false> E{hb, nullptr, ssp, 1.0f};
        pg8::gemm_phase<pg8::EpiResid<false>, pg8::StaticOrder, true, true>(lds, g, S, E);
    }
#if (MK_DUP >> 8) & 1
        GSYNC();
        {
        pg8::Gemm g{(const bf16*)(ws + WS_KV), (const bf16*)(ws + WS_WOUT), NFR, D, D}; pg8::StaticOrder S; S.init(NFR, D, G, (int)blockIdx.x);
        pg8::EpiResid<false> E{hb, nullptr, ssp, 1.0f};
        pg8::gemm_phase<pg8::EpiResid<false>, pg8::StaticOrder, true, true>(lds, g, S, E);
    }
#endif
    }
    SEAM(8);
    if (IN(9)) {
        {
        pg8::Gemm g{hb, (const bf16*)(ws + WS_WGU2), NFR, NGU, D}; pg8::StaticOrder S; S.init(NFR, NGU, G, (int)blockIdx.x);
        pg8::EpiSwiglu E{R1, ssp};
        pg8::gemm_phase<pg8::EpiSwiglu, pg8::StaticOrder, true, true>(lds, g, S, E);
    }
#if (MK_DUP >> 9) & 1
        GSYNC();
        {
        pg8::Gemm g{hb, (const bf16*)(ws + WS_WGU2), NFR, NGU, D}; pg8::StaticOrder S; S.init(NFR, NGU, G, (int)blockIdx.x);
        pg8::EpiSwiglu E{R1, ssp};
        pg8::gemm_phase<pg8::EpiSwiglu, pg8::StaticOrder, true, true>(lds, g, S, E);
    }
#endif
    }
    SEAM(9);
    if (IN(10)) {
        {
        pg8::Gemm g{R1, (const bf16*)(ws + WS_WD2), NFR, D, FF}; pg8::StaticOrder S; S.init(NFR, D, G, (int)blockIdx.x);
#if defined(MK_DRY10)
        { pg8::EpiResid<false> E0{hb, nullptr, ssp, 0.0f}; pg8::gemm_phase<pg8::EpiResid<false>, pg8::StaticOrder, true, true>(lds, g, S, E0); GSYNC(); }
#endif
        if (S.nwg == G) { pg8::EpiFinal E{hb, P.out, ssp, (unsigned*)(ws + WS_CTL) + 4096, P.in[19], 0.5f};
            pg8::gemm_phase<pg8::EpiFinal, pg8::StaticOrder, false, true>(lds, g, S, E); }
        else { pg8::EpiResid<true> E{hb, P.out, ssp, 0.5f};
            pg8::gemm_phase<pg8::EpiResid<true>, pg8::StaticOrder, true, true>(lds, g, S, E); }
    }
#if (MK_DUP >> 10) & 1
        GSYNC();
        {
        pg8::Gemm g{R1, (const bf16*)(ws + WS_WD2), NFR, D, FF}; pg8::StaticOrder S; S.init(NFR, D, G, (int)blockIdx.x);
        if (S.nwg == G) { pg8::EpiFinal E{hb, P.out, ssp, (unsigned*)(ws + WS_CTL) + 4096, P.in[19], 0.5f};
            pg8::gemm_phase<pg8::EpiFinal, pg8::StaticOrder, false, true>(lds, g, S, E); }
        else { pg8::EpiResid<true> E{hb, P.out, ssp, 0.5f};
            pg8::gemm_phase<pg8::EpiResid<true>, pg8::StaticOrder, true, true>(lds, g, S, E); }
    }
#endif
    }
    if (G != 256) SEAM(10); else STAMP(11);
    if (IN(11)) {
        {
        const int gw = blockIdx.x * 8 + wave, NGW = G * 8;
        for (int m = gw; m < (G == 256 ? 0 : NFR); m += NGW) {
            f32x4* rowp = (f32x4*)(P.out + (size_t)m * D) + lane;
            float s = ssp[(size_t)m * 16 + (lane & 15)];
            s += __shfl_xor(s, 1); s += __shfl_xor(s, 2); s += __shfl_xor(s, 4); s += __shfl_xor(s, 8);
            const float rs = __builtin_amdgcn_rsqf(s * (1.0f / 1024.0f) + 1e-6f);
#pragma unroll
            for (int j = 0; j < 4; ++j) { const f32x4 gn = ((const f32x4*)P.in[19])[lane + 64 * j]; f32x4 v = rowp[64 * j]; rowp[64 * j] = v * rs * gn; }
        }
    }
#if (MK_DUP >> 11) & 1
        GSYNC();
        {
        const int gw = blockIdx.x * 8 + wave, NGW = G * 8;
        for (int m = gw; m < (G == 256 ? 0 : NFR); m += NGW) {
            f32x4* rowp = (f32x4*)(P.out + (size_t)m * D) + lane;
            float s = ssp[(size_t)m * 16 + (lane & 15)];
            s += __shfl_xor(s, 1); s += __shfl_xor(s, 2); s += __shfl_xor(s, 4); s += __shfl_xor(s, 8);
            const float rs = __builtin_amdgcn_rsqf(s * (1.0f / 1024.0f) + 1e-6f);
#pragma unroll
            for (int j = 0; j < 4; ++j) { const f32x4 gn = ((const f32x4*)P.in[19])[lane + 64 * j]; f32x4 v = rowp[64 * j]; rowp[64 * j] = v * rs * gn; }
        }
    }
#endif
    }
#if defined(MK_TPROBE)
    STAMP(12);
    if (blockIdx.x == 0 && tid == 0) { volatile LAS unsigned long long* ts = (volatile LAS unsigned long long*)(lds + MISC_OFF + 64);
        const unsigned long long dt = ts[MK_TPROBE + 1] - ts[MK_TPROBE], t0 = __builtin_amdgcn_s_memrealtime();
        while (__builtin_amdgcn_s_memrealtime() - t0 < dt) __builtin_amdgcn_s_sleep(4); }
#endif
#if defined(MK_XSYNC)
    for (int xs_ = 0; xs_ < MK_XSYNC; ++xs_) GSYNC();
#endif
#undef IN
#undef SEAM
}

extern "C" void kernel_launch(void* const* d_in, const int* in_sizes, int n_in, void* d_out, int out_size, void* d_ws, size_t ws_size, hipStream_t stream) {
    static int grid = 0;
    if (grid == 0) {
        if (n_in != 20 || out_size != NFR * D || ws_size < WS_END) { fprintf(stderr, "kernel_launch: unexpected shapes (n_in %d out %d ws %zu)\n", n_in, out_size, ws_size); grid = -1; return; }
        int dev = 0, cus = 0, per_cu = 0;
        hipGetDevice(&dev); hipDeviceGetAttribute(&cus, hipDeviceAttributeMultiprocessorCount, dev);
        if (hipFuncSetAttribute((const void*)mega_fwd, hipFuncAttributeMaxDynamicSharedMemorySize, LDS_BYTES) != hipSuccess) { fprintf(stderr, "kernel_launch: hipFuncSetAttribute failed\n"); grid = -1; return; }
        if (hipOccupancyMaxActiveBlocksPerMultiprocessor(&per_cu, (const void*)mega_fwd, 512, LDS_BYTES) != hipSuccess || per_cu < 1) { fprintf(stderr, "kernel_launch: occupancy query failed (%d)\n", per_cu); (void)hipGetLastError(); grid = -1; return; }
        grid = cus * per_cu;
        fprintf(stderr, "kernel_launch: %d CUs x %d blocks -> grid %d\n", cus, per_cu, grid);
    }
    if (grid < 0) return;
    Params p{};
    for (int i = 0; i < 20; ++i) p.in[i] = (const float*)d_in[i];
    p.out = (float*)d_out; p.ws = (unsigned char*)d_ws; p.cg_sync = 0; p.pad = 0;
    if (hipMemsetAsync((char*)d_ws + WS_CTL, 0, CTL_BYTES, stream) != hipSuccess) { fprintf(stderr, "kernel_launch: hipMemsetAsync failed\n"); return; }
#if MK_PER_PHASE
    for (int ph = 0; ph < NPH; ++ph) { p.ph_lo = ph; p.ph_hi = ph + 1; hipLaunchKernelGGL(mega_fwd, dim3(grid), dim3(512), LDS_BYTES, stream, p); }
#else
    p.ph_lo = 0; p.ph_hi = NPH;
    void* args[] = {&p};
    hipError_t e = hipLaunchCooperativeKernel((const void*)mega_fwd, dim3(grid), dim3(512), args, LDS_BYTES, stream);
    if (e != hipSuccess) fprintf(stderr, "kernel_launch: cooperative launch failed: %s (grid %d)\n", hipGetErrorString(e), grid);
#endif
}
```
